# Optimizing an MI355X kernel written in HIP

```python
import math
import jax, jax.numpy as jnp
from jax import lax
import numpy as np

D_MODEL = 1024
BATCH = 4
SEQ = 8192
DEPTH = 1
DEC_BATCH = 32
DEC_SEQ = 16
PAST_LEN = 1024

CHUNK = 64
N_BAND_CHUNKS = 8
HEAD_DIM = 64
A_HEADS = 4
A_WIDTH = A_HEADS * HEAD_DIM
REL_CLIP = 128
B_HEADS = 4
B_VDIM = 2 * HEAD_DIM
B_QK_WIDTH = B_HEADS * 2 * HEAD_DIM
B_WIDTH = B_HEADS * B_VDIM
M_HEADS = 4
M_WIDTH = M_HEADS * HEAD_DIM
N_MEM = 256
MIX_WIDTH = A_WIDTH + B_WIDTH + M_WIDTH
PROJ_WIDTHS = (A_WIDTH, A_WIDTH, A_WIDTH, B_QK_WIDTH, B_QK_WIDTH, B_WIDTH, M_WIDTH, MIX_WIDTH)
PROJ_TOTAL = sum(PROJ_WIDTHS)
PROJ_SPLITS = tuple(int(s) for s in np.cumsum(PROJ_WIDTHS)[:-1])
ROPE_THETA = 10000.0
Q_BLOCK = 128
DEEPNORM_ALPHA = (2.0 * DEPTH) ** 0.25
DEEPNORM_BETA = (8.0 * DEPTH) ** -0.25
LN_EPS = 1e-5
RMS_EPS = 1e-5
NEG_INF = -1e30

kernel_name = 'hybrid_stream_band_diff_mem_step'


def layer_norm(x, g, b):
    xf = x.astype(jnp.float32)
    mu = jnp.mean(xf, -1, keepdims=True)
    var = jnp.mean(jnp.square(xf - mu), -1, keepdims=True)
    return ((xf - mu) * lax.rsqrt(var + LN_EPS) * g.astype(jnp.float32) + b.astype(jnp.float32)).astype(x.dtype)


def rope(x, pos):
    half = x.shape[-1] // 2
    inv = ROPE_THETA ** (-jnp.arange(half, dtype=jnp.float32) / half)
    ang = pos.astype(jnp.float32)[:, None] * inv[None, :]
    shape = (pos.shape[0],) + (1,) * (x.ndim - 3) + (half,)
    cos = jnp.cos(ang).reshape(shape)
    sin = jnp.sin(ang).reshape(shape)
    x1 = x[..., :half].astype(jnp.float32)
    x2 = x[..., half:].astype(jnp.float32)
    return jnp.concatenate([x1 * cos - x2 * sin, x2 * cos + x1 * sin], -1).astype(x.dtype)


def split_projection(x, w_in, pos):
    Bt, S, _ = x.shape
    h = jnp.einsum('bsd,de->bse', x, w_in)
    a_q, a_k, a_v, b_q, b_k, b_v, m_q, gate = jnp.split(h, PROJ_SPLITS, axis=-1)
    a_q = a_q.reshape(Bt, S, A_HEADS, HEAD_DIM)
    a_k = a_k.reshape(Bt, S, A_HEADS, HEAD_DIM)
    a_v = a_v.reshape(Bt, S, A_HEADS, HEAD_DIM)
    b_q = rope(b_q.reshape(Bt, S, B_HEADS, 2, HEAD_DIM), pos)
    b_k = rope(b_k.reshape(Bt, S, B_HEADS, 2, HEAD_DIM), pos)
    b_v = b_v.reshape(Bt, S, B_HEADS, B_VDIM)
    m_q = m_q.reshape(Bt, S, M_HEADS, HEAD_DIM)
    return a_q, a_k, a_v, b_q, b_k, b_v, m_q, gate


def rel_position_bias(table, dist):
    return table[:, jnp.clip(dist, -REL_CLIP, REL_CLIP) + REL_CLIP].astype(jnp.float32)


def band_attention_prompt(q, k, v, rel_bias):
    Bt, S, H, d = q.shape
    nc = S // CHUNK
    nb = N_BAND_CHUNKS + 1
    pad = ((0, 0), (N_BAND_CHUNKS, 0), (0, 0), (0, 0), (0, 0))
    kc = jnp.pad(k.reshape(Bt, nc, CHUNK, H, d), pad)
    vc = jnp.pad(v.reshape(Bt, nc, CHUNK, H, d), pad)
    k_band = jnp.concatenate([kc[:, j:j + nc] for j in range(nb)], axis=2)
    v_band = jnp.concatenate([vc[:, j:j + nc] for j in range(nb)], axis=2)
    qc = q.reshape(Bt, nc, CHUNK, H, d)
    s = jnp.einsum('bcqhd,bckhd->bchqk', qc, k_band).astype(jnp.float32) * (d ** -0.5)
    qi = jnp.arange(CHUNK)
    ki = jnp.arange(nb * CHUNK)
    dist = qi[:, None] + N_BAND_CHUNKS * CHUNK - ki[None, :]
    s = s + rel_position_bias(rel_bias, dist)[None, None]
    valid = (jnp.arange(nc)[:, None] + ki[None, :] // CHUNK) >= N_BAND_CHUNKS
    s = jnp.where(valid[None, :, None, None, :], s, NEG_INF)
    p = jax.nn.softmax(s, axis=-1)
    o = jnp.einsum('bchqk,bckhd->bcqhd', p.astype(v.dtype), v_band)
    return o.reshape(Bt, S, H, d)


def band_attention_sample(q, k_new, v_new, k_cache, v_cache, rel_bias):
    T = q.shape[1]
    R = k_cache.shape[1]
    k = jnp.concatenate([k_cache, k_new], axis=1)
    v = jnp.concatenate([v_cache, v_new], axis=1)
    s = jnp.einsum('bqhd,bkhd->bhqk', q, k).astype(jnp.float32) * (q.shape[-1] ** -0.5)
    dist = jnp.arange(T)[:, None] + R - jnp.arange(R + T)[None, :]
    s = s + rel_position_bias(rel_bias, dist)[None]
    p = jax.nn.softmax(s, axis=-1)
    return jnp.einsum('bhqk,bkhd->bqhd', p.astype(v.dtype), v)


def diff_lambda_value(lp, lambda_init):
    lpf = lp.astype(jnp.float32)
    return jnp.exp(jnp.sum(lpf[0] * lpf[1])) - jnp.exp(jnp.sum(lpf[2] * lpf[3])) + lambda_init


def diff_core(q, k, v, lam, mask):
    s = jnp.einsum('bqhmd,bkhmd->bhmqk', q, k).astype(jnp.float32) * (q.shape[-1] ** -0.5)
    if mask is not None:
        s = jnp.where(mask, s, NEG_INF)
    p = jax.nn.softmax(s, axis=-1)
    w = p[:, :, 0] - lam * p[:, :, 1]
    return jnp.einsum('bhqk,bkhe->bqhe', w.astype(v.dtype), v)


def diff_attention_prompt(q, k, v, lam):
    Bt, S, H, _, d = q.shape
    nblk = S // Q_BLOCK
    qb = jnp.moveaxis(q.reshape(Bt, nblk, Q_BLOCK, H, 2, d), 1, 0)
    k_chunk = jnp.arange(S) // CHUNK

    def block(args):
        qi, i = args
        q_chunk = (i * Q_BLOCK + jnp.arange(Q_BLOCK)) // CHUNK
        mask = k_chunk[None, :] <= q_chunk[:, None]
        return diff_core(qi, k, v, lam, mask)

    out = lax.map(block, (qb, jnp.arange(nblk)))
    return jnp.moveaxis(out, 0, 1).reshape(Bt, S, H, v.shape[-1])


def diff_post(o, g, lambda_init):
    of = o.astype(jnp.float32)
    of = of * lax.rsqrt(jnp.mean(of * of, -1, keepdims=True) + RMS_EPS) * g.astype(jnp.float32) * (1.0 - lambda_init)
    return of.astype(o.dtype)


def memory_kv(mem, w_mem_kv):
    Bt, N, _ = mem.shape
    kv = jnp.einsum('bnd,de->bne', mem, w_mem_kv)
    mk, mv = jnp.split(kv, 2, axis=-1)
    return mk.reshape(Bt, N, M_HEADS, HEAD_DIM), mv.reshape(Bt, N, M_HEADS, HEAD_DIM)


def memory_attention(q, mk, mv):
    s = jnp.einsum('bqhd,bkhd->bhqk', q, mk).astype(jnp.float32) * (q.shape[-1] ** -0.5)
    p = jax.nn.softmax(s, axis=-1)
    return jnp.einsum('bhqk,bkhd->bqhd', p.astype(mv.dtype), mv)


def merge_output(x, o_a, o_b, o_m, gate, w_out, g, b):
    Bt, S, _ = x.shape
    mixed = jnp.concatenate([o_a.reshape(Bt, S, A_WIDTH), o_b.reshape(Bt, S, B_WIDTH), o_m.reshape(Bt, S, M_WIDTH)], -1)
    y = jnp.einsum('bse,ed->bsd', mixed * jax.nn.silu(gate), w_out)
    return layer_norm(DEEPNORM_ALPHA * x + y, g, b)


def setup_inputs(seed: int = 0) -> dict:
    key = jax.random.key(seed)
    ks = jax.random.split(key, 18)
    a_rows = min(N_BAND_CHUNKS * CHUNK, PAST_LEN)
    nrm = jax.random.normal
    return {
        'x_prompt': nrm(ks[0], (BATCH, SEQ, D_MODEL), jnp.float32),
        'x_sample': nrm(ks[1], (DEC_BATCH, DEC_SEQ, D_MODEL), jnp.float32),
        'cache_a_k': nrm(ks[2], (DEPTH, DEC_BATCH, a_rows, A_HEADS, HEAD_DIM), jnp.float32),
        'cache_a_v': nrm(ks[3], (DEPTH, DEC_BATCH, a_rows, A_HEADS, HEAD_DIM), jnp.float32),
        'cache_b_k': nrm(ks[4], (DEPTH, DEC_BATCH, PAST_LEN, B_HEADS, 2, HEAD_DIM), jnp.float32),
        'cache_b_v': nrm(ks[5], (DEPTH, DEC_BATCH, PAST_LEN, B_HEADS, B_VDIM), jnp.float32),
        'cache_mem_k': nrm(ks[6], (DEPTH, DEC_BATCH, N_MEM, M_HEADS, HEAD_DIM), jnp.float32),
        'cache_mem_v': nrm(ks[7], (DEPTH, DEC_BATCH, N_MEM, M_HEADS, HEAD_DIM), jnp.float32),
        'mem_prompt': nrm(ks[8], (BATCH, N_MEM, D_MODEL), jnp.float32),
        'w_in': nrm(ks[9], (DEPTH, D_MODEL, PROJ_TOTAL), jnp.float32) * D_MODEL ** -0.5,
        'w_mem_kv': nrm(ks[10], (DEPTH, D_MODEL, 2 * M_WIDTH), jnp.float32) * D_MODEL ** -0.5,
        'a_rel_bias': nrm(ks[11], (DEPTH, A_HEADS, 2 * REL_CLIP + 1), jnp.float32) * 0.5,
        'diff_lambda': nrm(ks[12], (DEPTH, 4, HEAD_DIM), jnp.float32) * 0.1,
        'diff_subln_g': 1.0 + 0.05 * nrm(ks[13], (DEPTH, B_VDIM), jnp.float32),
        'w_out': nrm(ks[14], (DEPTH, MIX_WIDTH, D_MODEL), jnp.float32) * (MIX_WIDTH ** -0.5) * DEEPNORM_BETA,
        'ln_g': 1.0 + 0.05 * nrm(ks[15], (DEPTH, D_MODEL), jnp.float32),
        'ln_b': 0.05 * nrm(ks[16], (DEPTH, D_MODEL), jnp.float32),
    }


def reference(x_prompt, x_sample, cache_a_k, cache_a_v, cache_b_k, cache_b_v, cache_mem_k, cache_mem_v, mem_prompt,
              w_in, w_mem_kv, a_rel_bias, diff_lambda, diff_subln_g, w_out, ln_g, ln_b):
    S = x_prompt.shape[1]
    T = x_sample.shape[1]
    past = cache_b_k.shape[2]
    pos_p = jnp.arange(S)
    pos_s = past + jnp.arange(T)
    a_rows_p = min(N_BAND_CHUNKS * CHUNK, S)
    xp, xs = x_prompt, x_sample
    ak_p, av_p, bk_p, bv_p, mk_p, mv_p = [], [], [], [], [], []
    ak_s, av_s, bk_s, bv_s = [], [], [], []
    for layer in range(DEPTH):
        lambda_init = 0.8 - 0.6 * math.exp(-0.3 * layer)
        lam = diff_lambda_value(diff_lambda[layer], lambda_init)
        aq, ak, av, bq, bk, bv, mq, gate = split_projection(xp, w_in[layer], pos_p)
        mk, mv = memory_kv(mem_prompt, w_mem_kv[layer])
        o_a = band_attention_prompt(aq, ak, av, a_rel_bias[layer])
        o_b = diff_post(diff_attention_prompt(bq, bk, bv, lam), diff_subln_g[layer], lambda_init)
        o_m = memory_attention(mq, mk, mv)
        xp_next = merge_output(xp, o_a, o_b, o_m, gate, w_out[layer], ln_g[layer], ln_b[layer])
        ak_p.append(ak[:, S - a_rows_p:])
        av_p.append(av[:, S - a_rows_p:])
        bk_p.append(bk)
        bv_p.append(bv)
        mk_p.append(mk)
        mv_p.append(mv)
        sq, sk, sv, tq, tk, tv, nq, sgate = split_projection(xs, w_in[layer], pos_s)
        s_a = band_attention_sample(sq, sk, sv, cache_a_k[layer], cache_a_v[layer], a_rel_bias[layer])
        tk_all = jnp.concatenate([cache_b_k[layer], tk], axis=1)
        tv_all = jnp.concatenate([cache_b_v[layer], tv], axis=1)
        s_b = diff_post(diff_core(tq, tk_all, tv_all, lam, None), diff_subln_g[layer], lambda_init)
        s_m = memory_attention(nq, cache_mem_k[layer], cache_mem_v[layer])
        xs = merge_output(xs, s_a, s_b, s_m, sgate, w_out[layer], ln_g[layer], ln_b[layer])
        ak_s.append(sk)
        av_s.append(sv)
        bk_s.append(tk)
        bv_s.append(tv)
        xp = xp_next
    return (xp, xs,
            jnp.stack(ak_p), jnp.stack(av_p), jnp.stack(bk_p), jnp.stack(bv_p), jnp.stack(mk_p), jnp.stack(mv_p),
            jnp.stack(ak_s), jnp.stack(av_s), jnp.stack(bk_s), jnp.stack(bv_s))
```

```cpp
#include <hip/hip_runtime.h>
#include <hip/hip_cooperative_groups.h>
#include <cstdio>
#include <cstdint>
namespace cg = cooperative_groups;

typedef unsigned short bf16_t;
typedef short bf16x8 __attribute__((ext_vector_type(8)));
typedef short s16x4 __attribute__((ext_vector_type(4)));
typedef float f32x16 __attribute__((ext_vector_type(16)));
typedef float f32x2_t __attribute__((ext_vector_type(2)));
typedef __bf16 bf16x2_t __attribute__((ext_vector_type(2)));
typedef unsigned u32x2 __attribute__((ext_vector_type(2)));
typedef unsigned u32x4 __attribute__((ext_vector_type(4)));
#define DI __device__ __forceinline__
#define MFMA32(a, b, c) __builtin_amdgcn_mfma_f32_32x32x16_bf16((a), (b), (c), 0, 0, 0)
#define LDS3 __attribute__((address_space(3)))

constexpr int D_MODEL = 1024, SEQ = 8192, NB = 4, NTOKP = NB * SEQ, SB = 32, ST = 16, NTOKS = SB * ST, NTOK = NTOKP + NTOKS;
constexpr int PAST = 1024, RA = 512, NMEM = 256, PROJ = 3584;
constexpr int SAK_ROWS = 576, SBK_ROWS = 1088;
constexpr int NTOKPAD = NTOK + 64;
constexpr float QSCALE = 0.125f * 1.4426950408889634f;
constexpr float LOG2E = 1.4426950408889634f;
constexpr float ALPHA = 1.189207115002721f;

constexpr long O_Y = 0;
constexpr long O_AKP = (long)NTOK * 1024;
constexpr long O_AVP = O_AKP + (long)NB * RA * 256;
constexpr long O_BKP = O_AVP + (long)NB * RA * 256;
constexpr long O_BVP = O_BKP + (long)NTOKP * 512;
constexpr long O_MKP = O_BVP + (long)NTOKP * 512;
constexpr long O_MVP = O_MKP + (long)NB * NMEM * 256;
constexpr long O_AKS = O_MVP + (long)NB * NMEM * 256;
constexpr long O_AVS = O_AKS + (long)NTOKS * 256;
constexpr long O_BKS = O_AVS + (long)NTOKS * 256;
constexpr long O_BVS = O_BKS + (long)NTOKS * 512;
constexpr long O_END = O_BVS + (long)NTOKS * 512;

constexpr size_t WS_CTR = 0;
constexpr size_t WS_WINT = 256;
constexpr size_t WS_WOUTT = WS_WINT + (size_t)PROJ * 1024 * 2;
constexpr size_t WS_WMEMT = WS_WOUTT + (size_t)1024 * 1024 * 2;
constexpr size_t WS_ROPE = WS_WMEMT + (size_t)512 * 1024 * 2;
constexpr size_t OB_AQ = 0;
constexpr size_t OB_BQ = OB_AQ + (size_t)NTOKPAD * 256 * 2;
constexpr size_t OB_MQ = OB_BQ + (size_t)NTOKPAD * 512 * 2;
constexpr size_t OB_AK = OB_MQ + (size_t)NTOKPAD * 256 * 2;
constexpr size_t OB_AV = OB_AK + (size_t)NTOKP * 256 * 2;
constexpr size_t OB_BK = OB_AV + (size_t)NTOKP * 256 * 2;
constexpr size_t OB_END = OB_BK + (size_t)NTOKP * 512 * 2;
static_assert(OB_END <= (size_t)NTOK * 1024 * 4, "temporaries must fit in the y region");
constexpr size_t WS_BV = WS_ROPE + (size_t)SEQ * 32 * 8;
constexpr size_t WS_G = WS_BV + (size_t)NTOKP * 512 * 2;
constexpr size_t WS_MK = WS_G + (size_t)NTOK * 1024 * 2;
constexpr size_t WS_MV = WS_MK + (size_t)NB * NMEM * 256 * 2;
constexpr size_t WS_SAK = WS_MV + (size_t)NB * NMEM * 256 * 2;
constexpr size_t WS_SAV = WS_SAK + (size_t)SB * SAK_ROWS * 256 * 2;
constexpr size_t WS_SBK = WS_SAV + (size_t)SB * SAK_ROWS * 256 * 2;
constexpr size_t WS_SBV = WS_SBK + (size_t)SB * SBK_ROWS * 512 * 2;
constexpr size_t WS_SMK = WS_SBV + (size_t)SB * SBK_ROWS * 512 * 2;
constexpr size_t WS_SMV = WS_SMK + (size_t)SB * NMEM * 256 * 2;
constexpr size_t WS_END = WS_SMV + (size_t)SB * NMEM * 256 * 2;
static_assert(WS_END <= (size_t)256 * 1024 * 1024, "workspace must fit the guaranteed 256 MiB");

struct Params {
  const float* xp; const float* xs;
  const float* cak; const float* cav; const float* cbk; const float* cbv; const float* cmk; const float* cmv;
  const float* memp; const float* w_in; const float* w_mem; const float* relb; const float* dlam; const float* subg;
  const float* w_out; const float* ln_g; const float* ln_b;
  float* out; char* ws;
};

constexpr int LDS_BYTES = 73728 + 64;
__shared__ __attribute__((aligned(16))) char g_lds[LDS_BYTES];

DI unsigned cvtpk(float lo, float hi) { f32x2_t v = {lo, hi}; bf16x2_t b = __builtin_convertvector(v, bf16x2_t); return __builtin_bit_cast(unsigned, b); }
DI bf16_t f2bf(float x) { return (bf16_t)(cvtpk(x, 0.f) & 0xffffu); }
DI float bf2f(unsigned short b) { return __uint_as_float(((unsigned)b) << 16); }
DI float bflo(unsigned u) { return __uint_as_float(u << 16); }
DI float bfhi(unsigned u) { return __uint_as_float(u & 0xffff0000u); }
DI float fexp2(float x) { return __builtin_amdgcn_exp2f(x); }
DI float xor32f(float v) { return __shfl_xor(v, 32); }

DI void transpose_tile(const float* __restrict__ src, int N, bf16_t* __restrict__ dst, int K, int k0, int n0) {
  float* tile = (float*)g_lds;
  const int tid = threadIdx.x, c = tid & 63, r0 = tid >> 6;
#pragma unroll
  for (int i = 0; i < 16; ++i) { const int row = r0 + 4 * i; tile[row * 65 + c] = src[(long)(k0 + row) * N + n0 + c]; }
  __syncthreads();
#pragma unroll
  for (int i = 0; i < 16; ++i) { const int rr = r0 + 4 * i; dst[(long)(n0 + rr) * K + k0 + c] = f2bf(tile[c * 65 + rr]); }
  __syncthreads();
}

DI void convert_rows(const float* __restrict__ src, bf16_t* __restrict__ dst, int rows_w8, int dst_bstride_w8, long gtid, long gsz) {
  const long total = (long)SB * rows_w8;
  for (long u = gtid; u < total; u += gsz) {
    const int b = (int)(u / rows_w8); const int j = (int)(u - (long)b * rows_w8);
    const float4 a0 = *(const float4*)(src + u * 8), a1 = *(const float4*)(src + u * 8 + 4);
    u32x4 v; v.x = cvtpk(a0.x, a0.y); v.y = cvtpk(a0.z, a0.w); v.z = cvtpk(a1.x, a1.y); v.w = cvtpk(a1.z, a1.w);
    *(u32x4*)(dst + ((long)b * dst_bstride_w8 + j) * 8) = v;
  }
}

DI void phase0(const Params& p) {
  bf16_t* winT = (bf16_t*)(p.ws + WS_WINT); bf16_t* woutT = (bf16_t*)(p.ws + WS_WOUTT); bf16_t* wmemT = (bf16_t*)(p.ws + WS_WMEMT);
  constexpr int T_IN = 16 * 56, T_OUT = 16 * 16, T_MEM = 16 * 8;
  for (int t = blockIdx.x; t < T_IN + T_OUT + T_MEM; t += gridDim.x) {
    if (t < T_IN) transpose_tile(p.w_in, PROJ, winT, 1024, (t / 56) * 64, (t % 56) * 64);
    else if (t < T_IN + T_OUT) { const int u = t - T_IN; transpose_tile(p.w_out, 1024, woutT, 1024, (u >> 4) * 64, (u & 15) * 64); }
    else { const int u = t - T_IN - T_OUT; transpose_tile(p.w_mem, 512, wmemT, 1024, (u >> 3) * 64, (u & 7) * 64); }
  }
  float2* rope = (float2*)(p.ws + WS_ROPE);
  for (int idx = blockIdx.x * 256 + threadIdx.x; idx < SEQ * 32; idx += gridDim.x * 256) {
    const int pos = idx >> 5, i = idx & 31;
    const double inv = exp(-(double)i * (9.210340371976184 / 32.0));
    const double rev = (double)pos * inv * 0.15915494309189535;
    const double fr = rev - rint(rev);
    const float a = (float)(fr * 6.283185307179586);
    rope[idx] = make_float2(cosf(a), sinf(a));
  }
  const int G = gridDim.x;
  const long gtid = (long)blockIdx.x * 256 + threadIdx.x, gsz = (long)G * 256;
  convert_rows(p.cak, (bf16_t*)(p.ws + WS_SAK), RA * 256 / 8, SAK_ROWS * 256 / 8, gtid, gsz);
  convert_rows(p.cav, (bf16_t*)(p.ws + WS_SAV), RA * 256 / 8, SAK_ROWS * 256 / 8, gtid, gsz);
  convert_rows(p.cbk, (bf16_t*)(p.ws + WS_SBK), PAST * 512 / 8, SBK_ROWS * 512 / 8, gtid, gsz);
  convert_rows(p.cbv, (bf16_t*)(p.ws + WS_SBV), PAST * 512 / 8, SBK_ROWS * 512 / 8, gtid, gsz);
  convert_rows(p.cmk, (bf16_t*)(p.ws + WS_SMK), NMEM * 256 / 8, NMEM * 256 / 8, gtid, gsz);
  convert_rows(p.cmv, (bf16_t*)(p.ws + WS_SMV), NMEM * 256 / 8, NMEM * 256 / 8, gtid, gsz);
}

constexpr int G_RS = 144, G_TILE = 128 * G_RS;
template <bool A_F32>
DI void gemm_core(const void* __restrict__ Ap, int lda, const bf16_t* __restrict__ Bp, int ldb, int K, f32x16 (&acc)[2][2]) {
  const int tid = threadIdx.x, lane = tid & 63, w = tid >> 6, wm = w >> 1, wn = w & 1, r = lane & 31, h = lane >> 5;
#pragma unroll
  for (int a = 0; a < 2; ++a)
#pragma unroll
    for (int b = 0; b < 2; ++b)
#pragma unroll
      for (int i = 0; i < 16; ++i) acc[a][b][i] = 0.f;
  float4 ra[8]; u32x4 rab[4]; u32x4 rb[4];
  const int arow = tid >> 4, ac4 = tid & 15, brow = tid >> 3, bch = tid & 7;
  const float* Af = (const float*)Ap; const bf16_t* Ab16 = (const bf16_t*)Ap;
#define G_LOAD(kt)                                                                                              \
  {                                                                                                             \
    if (A_F32) {                                                                                                \
      _Pragma("unroll") for (int i = 0; i < 8; ++i) ra[i] = *(const float4*)(Af + (long)(arow + 16 * i) * lda + (kt) * 64 + ac4 * 4); \
    } else {                                                                                                    \
      _Pragma("unroll") for (int i = 0; i < 4; ++i) rab[i] = *(const u32x4*)(Ab16 + (long)(brow + 32 * i) * lda + (kt) * 64 + bch * 8); \
    }                                                                                                           \
    _Pragma("unroll") for (int i = 0; i < 4; ++i) rb[i] = *(const u32x4*)(Bp + (long)(brow + 32 * i) * ldb + (kt) * 64 + bch * 8); \
  }
#define G_WRITE(buf)                                                                                            \
  {                                                                                                             \
    char* Ab_ = g_lds + (buf) * 2 * G_TILE; char* Bb_ = Ab_ + G_TILE;                                           \
    if (A_F32) {                                                                                                \
      _Pragma("unroll") for (int i = 0; i < 8; ++i) { u32x2 v_; v_.x = cvtpk(ra[i].x, ra[i].y); v_.y = cvtpk(ra[i].z, ra[i].w); *(u32x2*)(Ab_ + (arow + 16 * i) * G_RS + ac4 * 8) = v_; } \
    } else {                                                                                                    \
      _Pragma("unroll") for (int i = 0; i < 4; ++i) *(u32x4*)(Ab_ + (brow + 32 * i) * G_RS + bch * 16) = rab[i]; \
    }                                                                                                           \
    _Pragma("unroll") for (int i = 0; i < 4; ++i) *(u32x4*)(Bb_ + (brow + 32 * i) * G_RS + bch * 16) = rb[i]; \
  }
  G_LOAD(0);
  G_WRITE(0);
  __syncthreads();
  const int nk = K >> 6;
  for (int kt = 0; kt < nk; ++kt) {
    if (kt + 1 < nk) G_LOAD(kt + 1);
    const char* Ab = g_lds + (kt & 1) * 2 * G_TILE; const char* Bb = Ab + G_TILE;
#pragma unroll
    for (int s = 0; s < 4; ++s) {
      const int co = (16 * s + 8 * h) * 2;
      const bf16x8 a0 = *(const bf16x8*)(Ab + (wm * 64 + r) * G_RS + co);
      const bf16x8 a1 = *(const bf16x8*)(Ab + (wm * 64 + 32 + r) * G_RS + co);
      const bf16x8 b0 = *(const bf16x8*)(Bb + (wn * 64 + r) * G_RS + co);
      const bf16x8 b1 = *(const bf16x8*)(Bb + (wn * 64 + 32 + r) * G_RS + co);
      acc[0][0] = MFMA32(a0, b0, acc[0][0]);
      acc[0][1] = MFMA32(a0, b1, acc[0][1]);
      acc[1][0] = MFMA32(a1, b0, acc[1][0]);
      acc[1][1] = MFMA32(a1, b1, acc[1][1]);
    }
    if (kt + 1 < nk) G_WRITE((kt + 1) & 1);
    __syncthreads();
  }
#undef G_LOAD
#undef G_WRITE
}

DI void proj_epilogue(const Params& p, int mt, int nt, f32x16 (&acc)[2][2]) {
  const int tid = threadIdx.x, lane = tid & 63, w = tid >> 6, wm = w >> 1, wn = w & 1, c = lane & 31, h = lane >> 5;
  const int n0 = nt * 128 + wn * 64;
  char* ws = p.ws; float* out = p.out; char* ob = (char*)p.out;
  const float2* rope = (const float2*)(ws + WS_ROPE);
  int seg, cb;
  if (n0 < 256) { seg = 0; cb = n0; }
  else if (n0 < 512) { seg = 1; cb = n0 - 256; }
  else if (n0 < 768) { seg = 2; cb = n0 - 512; }
  else if (n0 < 1280) { seg = 3; cb = n0 - 768; }
  else if (n0 < 1792) { seg = 4; cb = n0 - 1280; }
  else if (n0 < 2304) { seg = 5; cb = n0 - 1792; }
  else if (n0 < 2560) { seg = 6; cb = n0 - 2304; }
  else { seg = 7; cb = n0 - 2560; }
  const int col0 = cb + c, col1 = cb + c + 32;
#pragma unroll
  for (int mi = 0; mi < 2; ++mi) {
#pragma unroll
    for (int i = 0; i < 16; ++i) {
      const int tok = mt * 128 + wm * 64 + mi * 32 + (i & 3) + 8 * (i >> 2) + 4 * h;
      float v0 = acc[mi][0][i], v1 = acc[mi][1][i];
      const bool smp = tok >= NTOKP;
      const int ts = tok - NTOKP, sb = ts >> 4, st = ts & 15;
      const int pb = tok >> 13, ps = tok & (SEQ - 1);
      if (seg == 3 || seg == 4) {
        const int pos = smp ? (PAST + st) : ps;
        const float2 cs = rope[pos * 32 + c];
        const float a = v0 * cs.x - v1 * cs.y, b = v1 * cs.x + v0 * cs.y;
        v0 = a; v1 = b;
      }
      if (seg == 0) {
        bf16_t* q = (bf16_t*)(ob + OB_AQ) + (long)tok * 256;
        q[col0] = f2bf(v0 * QSCALE); q[col1] = f2bf(v1 * QSCALE);
      } else if (seg == 1 || seg == 2) {
        bf16_t* kw; float* o = nullptr;
        if (!smp) {
          kw = (bf16_t*)(ob + (seg == 1 ? OB_AK : OB_AV)) + (long)tok * 256;
          if (ps >= SEQ - RA) o = out + (seg == 1 ? O_AKP : O_AVP) + (long)(pb * RA + ps - (SEQ - RA)) * 256;
        } else {
          kw = (bf16_t*)(ws + (seg == 1 ? WS_SAK : WS_SAV)) + (long)(sb * SAK_ROWS + RA + st) * 256;
          o = out + (seg == 1 ? O_AKS : O_AVS) + (long)ts * 256;
        }
        kw[col0] = f2bf(v0); kw[col1] = f2bf(v1);
        if (o) { o[col0] = v0; o[col1] = v1; }
      } else if (seg == 3) {
        bf16_t* q = (bf16_t*)(ob + OB_BQ) + (long)tok * 512;
        q[col0] = f2bf(v0 * QSCALE); q[col1] = f2bf(v1 * QSCALE);
      } else if (seg == 4 || seg == 5) {
        bf16_t* kw; float* o;
        if (!smp) {
          kw = (seg == 4 ? (bf16_t*)(ob + OB_BK) : (bf16_t*)(ws + WS_BV)) + (long)tok * 512;
          o = out + (seg == 4 ? O_BKP : O_BVP) + (long)tok * 512;
        } else {
          kw = (bf16_t*)(ws + (seg == 4 ? WS_SBK : WS_SBV)) + (long)(sb * SBK_ROWS + PAST + st) * 512;
          o = out + (seg == 4 ? O_BKS : O_BVS) + (long)ts * 512;
        }
        kw[col0] = f2bf(v0); kw[col1] = f2bf(v1);
        o[col0] = v0; o[col1] = v1;
      } else if (seg == 6) {
        bf16_t* q = (bf16_t*)(ob + OB_MQ) + (long)tok * 256;
        q[col0] = f2bf(v0 * QSCALE); q[col1] = f2bf(v1 * QSCALE);
      } else {
        bf16_t* g = (bf16_t*)(ws + WS_G) + (long)tok * 1024;
        const float s0 = v0 / (1.f + __expf(-v0)), s1 = v1 / (1.f + __expf(-v1));
        g[col0] = f2bf(s0); g[col1] = f2bf(s1);
      }
    }
  }
}

DI void mem_epilogue(const Params& p, int mt, int nt, f32x16 (&acc)[2][2]) {
  const int tid = threadIdx.x, lane = tid & 63, w = tid >> 6, wm = w >> 1, wn = w & 1, c = lane & 31, h = lane >> 5;
  const int n0 = nt * 128 + wn * 64;
  const bool isv = n0 >= 256;
  const int cb = isv ? n0 - 256 : n0;
  bf16_t* kw = (bf16_t*)(p.ws + (isv ? WS_MV : WS_MK));
  float* o = p.out + (isv ? O_MVP : O_MKP);
#pragma unroll
  for (int mi = 0; mi < 2; ++mi)
#pragma unroll
    for (int i = 0; i < 16; ++i) {
      const long row = mt * 128 + wm * 64 + mi * 32 + (i & 3) + 8 * (i >> 2) + 4 * h;
      const float v0 = acc[mi][0][i], v1 = acc[mi][1][i];
      kw[row * 256 + cb + c] = f2bf(v0); kw[row * 256 + cb + c + 32] = f2bf(v1);
      o[row * 256 + cb + c] = v0; o[row * 256 + cb + c + 32] = v1;
    }
}

DI void phase1(const Params& p) {
  constexpr int MT = NTOK / 128, NT = PROJ / 128, T1 = MT * NT, T2 = 8 * 4;
  const int G = gridDim.x;
  const int vid = (blockIdx.x & 7) * (G >> 3) + (blockIdx.x >> 3);
  const bf16_t* winT = (const bf16_t*)(p.ws + WS_WINT); const bf16_t* wmemT = (const bf16_t*)(p.ws + WS_WMEMT);
  f32x16 acc[2][2];
  for (int t = vid; t < T1 + T2; t += G) {
    if (t < T1) {
      const int mt = t / NT, nt = t - mt * NT;
      const float* A = (mt < NTOKP / 128) ? p.xp + (long)mt * 128 * 1024 : p.xs + (long)(mt - NTOKP / 128) * 128 * 1024;
      gemm_core<true>(A, 1024, winT + (long)nt * 128 * 1024, 1024, 1024, acc);
      proj_epilogue(p, mt, nt, acc);
    } else {
      const int u = t - T1, mt = u >> 2, nt = u & 3;
      gemm_core<true>(p.memp + (long)mt * 128 * 1024, 1024, wmemT + (long)nt * 128 * 1024, 1024, 1024, acc);
      mem_epilogue(p, mt, nt, acc);
    }
  }
}

struct AttnItem {
  const bf16_t* q; const bf16_t* k; const bf16_t* v; bf16_t* g;
  int qs, ks, nkeys, rows, qpos0, kpos0, head0; bool bias;
};
constexpr int AK_RS = 272, AK_BYTES = 64 * AK_RS, AV_BYTES = 16384, A_BUF = AK_BYTES + AV_BYTES;
constexpr int A_BIAS_OFF = 2 * A_BUF;
constexpr int A_ITEM_OFF = 73728;

template <bool DIFF>
DI void attn_item(const AttnItem& it, float lam, const float* __restrict__ subg) {
  const int tid = threadIdx.x, lane = tid & 63, w = tid >> 6, qh = w & 1, m = w >> 1, r = lane & 31, h = lane >> 5;
  constexpr int NDT = DIFF ? 4 : 2;
  const int ntiles = (it.nkeys + 63) >> 6;
  bf16x8 qf[4];
  {
    const bf16_t* qp = it.q + (long)(qh * 32 + r) * it.qs + m * 64 + 8 * h;
#pragma unroll
    for (int s = 0; s < 4; ++s) qf[s] = *(const bf16x8*)(qp + 16 * s);
  }
  f32x16 oacc[NDT];
#pragma unroll
  for (int d = 0; d < NDT; ++d)
#pragma unroll
    for (int i = 0; i < 16; ++i) oacc[d][i] = 0.f;
  float m_run = -1e30f, l_run = 0.f;
  u32x4 rk[4], rv[4];
  const int kch = tid & 15, krow = tid >> 4, vsub = tid & 3, vkey = tid >> 2;
  const bf16_t* kg = it.k + (long)krow * it.ks + kch * 8;
  const bf16_t* vg = it.v + (long)vkey * it.ks + vsub * 8;
#define A_LOAD(t)                                                                                                \
  {                                                                                                              \
    _Pragma("unroll") for (int i = 0; i < 4; ++i) rk[i] = *(const u32x4*)(kg + (long)((t) * 64 + 16 * i) * it.ks); \
    _Pragma("unroll") for (int i = 0; i < 4; ++i) rv[i] = *(const u32x4*)(vg + (long)((t) * 64) * it.ks + 32 * i); \
  }
#define A_WRITE(buf)                                                                                             \
  {                                                                                                              \
    char* Kb_ = g_lds + (buf) * A_BUF; char* Vb_ = Kb_ + AK_BYTES;                                               \
    _Pragma("unroll") for (int i = 0; i < 4; ++i) *(u32x4*)(Kb_ + (krow + 16 * i) * AK_RS + kch * 16) = rk[i];   \
    _Pragma("unroll") for (int i = 0; i < 4; ++i) *(u32x4*)(Vb_ + i * 4096 + vkey * 64 + vsub * 16) = rv[i];     \
  }
  A_LOAD(0);
  A_WRITE(0);
  __syncthreads();
  const int vlane = ((lane >> 4) & 1) * 32 + (lane & 3) * 8 + (4 * h + ((lane & 15) >> 2)) * 64;
  const float* biasT = (const float*)(g_lds + A_BIAS_OFF) + (it.head0 + m) * 257;
  const int qpos = it.qpos0 + qh * 32 + r;
  for (int t = 0; t < ntiles; ++t) {
    if (t + 1 < ntiles) A_LOAD(t + 1);
    const char* Kb = g_lds + (t & 1) * A_BUF; const char* Vb = Kb + AK_BYTES;
    f32x16 s0, s1;
#pragma unroll
    for (int i = 0; i < 16; ++i) { s0[i] = 0.f; s1[i] = 0.f; }
#pragma unroll
    for (int s = 0; s < 4; ++s) {
      const int co = (m * 64 + 16 * s + 8 * h) * 2;
      const bf16x8 k0 = *(const bf16x8*)(Kb + r * AK_RS + co);
      const bf16x8 k1 = *(const bf16x8*)(Kb + (32 + r) * AK_RS + co);
      s0 = MFMA32(k0, qf[s], s0);
      s1 = MFMA32(k1, qf[s], s1);
    }
    if (it.bias) {
      const int kb = it.kpos0 + t * 64 + 4 * h;
#pragma unroll
      for (int i = 0; i < 16; ++i) {
        const int kk = kb + (i & 3) + 8 * (i >> 2);
        int d0 = qpos - kk, d1 = d0 - 32;
        d0 = min(max(d0, -128), 128) + 128; d1 = min(max(d1, -128), 128) + 128;
        s0[i] += biasT[d0]; s1[i] += biasT[d1];
      }
    }
    if ((t + 1) * 64 > it.nkeys) {
      const int kb = t * 64 + 4 * h;
#pragma unroll
      for (int i = 0; i < 16; ++i) {
        const int kk = kb + (i & 3) + 8 * (i >> 2);
        if (kk >= it.nkeys) s0[i] = -1e30f;
        if (kk + 32 >= it.nkeys) s1[i] = -1e30f;
      }
    }
    float mx = fmaxf(s0[0], s1[0]);
#pragma unroll
    for (int i = 1; i < 16; ++i) mx = fmaxf(mx, fmaxf(s0[i], s1[i]));
    mx = fmaxf(mx, xor32f(mx));
    const float m_new = fmaxf(m_run, mx);
    const float alpha = fexp2(m_run - m_new);
    if (__builtin_amdgcn_ballot_w64(m_new > m_run) != 0ull) {
#pragma unroll
      for (int d = 0; d < NDT; ++d)
#pragma unroll
        for (int i = 0; i < 16; ++i) oacc[d][i] *= alpha;
    }
    l_run *= alpha;
    m_run = m_new;
    float ls = 0.f;
#pragma unroll
    for (int i = 0; i < 16; ++i) { s0[i] = fexp2(s0[i] - m_new); s1[i] = fexp2(s1[i] - m_new); ls += s0[i] + s1[i]; }
    l_run += ls;
    bf16x8 pf[4];
#pragma unroll
    for (int s2 = 0; s2 < 2; ++s2) {
      u32x4 a, b;
      a.x = cvtpk(s0[8 * s2 + 0], s0[8 * s2 + 1]); a.y = cvtpk(s0[8 * s2 + 2], s0[8 * s2 + 3]);
      a.z = cvtpk(s0[8 * s2 + 4], s0[8 * s2 + 5]); a.w = cvtpk(s0[8 * s2 + 6], s0[8 * s2 + 7]);
      b.x = cvtpk(s1[8 * s2 + 0], s1[8 * s2 + 1]); b.y = cvtpk(s1[8 * s2 + 2], s1[8 * s2 + 3]);
      b.z = cvtpk(s1[8 * s2 + 4], s1[8 * s2 + 5]); b.w = cvtpk(s1[8 * s2 + 6], s1[8 * s2 + 7]);
      pf[s2] = __builtin_bit_cast(bf16x8, a); pf[2 + s2] = __builtin_bit_cast(bf16x8, b);
    }
    const LDS3 char* vb3 = (const LDS3 char*)(Vb) + vlane + (DIFF ? 0 : m * 2 * 4096);
#pragma unroll
    for (int d = 0; d < NDT; ++d) {
#pragma unroll
      for (int ks = 0; ks < 4; ++ks) {
        const s16x4 lo = __builtin_bit_cast(s16x4, __builtin_amdgcn_ds_read_tr16_b64_v4i16((LDS3 s16x4*)(vb3 + d * 4096 + ks * 1024)));
        const s16x4 hi = __builtin_bit_cast(s16x4, __builtin_amdgcn_ds_read_tr16_b64_v4i16((LDS3 s16x4*)(vb3 + d * 4096 + ks * 1024 + 512)));
        const bf16x8 vf = __builtin_shufflevector(lo, hi, 0, 1, 2, 3, 4, 5, 6, 7);
        oacc[d] = MFMA32(vf, pf[ks], oacc[d]);
      }
    }
    if (t + 1 < ntiles) A_WRITE((t + 1) & 1);
    __syncthreads();
  }
#undef A_LOAD
#undef A_WRITE
  const float l_tot = l_run + xor32f(l_run);
  const float inv = 1.f / l_tot;
  const int q = qh * 32 + r;
  if (!DIFF) {
    if (q < it.rows) {
      bf16_t* gp = it.g + (long)q * 1024 + m * 64 + 4 * h;
#pragma unroll
      for (int d = 0; d < NDT; ++d)
#pragma unroll
        for (int g4 = 0; g4 < 4; ++g4) {
          u32x2* ptr = (u32x2*)(gp + d * 32 + 8 * g4);
          const u32x2 gv = *ptr;
          u32x2 o;
          o.x = cvtpk(oacc[d][4 * g4 + 0] * inv * bflo(gv.x), oacc[d][4 * g4 + 1] * inv * bfhi(gv.x));
          o.y = cvtpk(oacc[d][4 * g4 + 2] * inv * bflo(gv.y), oacc[d][4 * g4 + 3] * inv * bfhi(gv.y));
          *ptr = o;
        }
    }
  } else {
    float* xb = (float*)g_lds + qh * 4096 + lane;
    if (m == 1) {
      const float sc = lam * inv;
#pragma unroll
      for (int d = 0; d < NDT; ++d)
#pragma unroll
        for (int i = 0; i < 16; ++i) xb[(d * 16 + i) * 64] = oacc[d][i] * sc;
    }
    __syncthreads();
    if (m == 0) {
      float ss = 0.f;
#pragma unroll
      for (int d = 0; d < NDT; ++d)
#pragma unroll
        for (int i = 0; i < 16; ++i) { const float o = oacc[d][i] * inv - xb[(d * 16 + i) * 64]; oacc[d][i] = o; ss += o * o; }
      ss += xor32f(ss);
      const float rn = rsqrtf(ss * (1.f / 128.f) + 1e-5f) * 0.8f;
      if (q < it.rows) {
        bf16_t* gp = it.g + (long)q * 1024 + 4 * h;
#pragma unroll
        for (int d = 0; d < NDT; ++d)
#pragma unroll
          for (int g4 = 0; g4 < 4; ++g4) {
            const float4 sg = *(const float4*)(subg + d * 32 + 8 * g4 + 4 * h);
            u32x2* ptr = (u32x2*)(gp + d * 32 + 8 * g4);
            const u32x2 gv = *ptr;
            u32x2 o;
            o.x = cvtpk(oacc[d][4 * g4 + 0] * rn * sg.x * bflo(gv.x), oacc[d][4 * g4 + 1] * rn * sg.y * bfhi(gv.x));
            o.y = cvtpk(oacc[d][4 * g4 + 2] * rn * sg.z * bflo(gv.y), oacc[d][4 * g4 + 3] * rn * sg.w * bfhi(gv.y));
            *ptr = o;
          }
      }
    }
    __syncthreads();
  }
}

DI void phase2(const Params& p) {
  char* ws = p.ws;
  const int tid = threadIdx.x;
  float* biasT = (float*)(g_lds + A_BIAS_OFF);
  for (int i = tid; i < 4 * 257; i += 256) biasT[i] = p.relb[i] * LOG2E;
  float s1 = 0.f, s2 = 0.f;
  for (int i = 0; i < 64; ++i) { s1 += p.dlam[i] * p.dlam[64 + i]; s2 += p.dlam[128 + i] * p.dlam[192 + i]; }
  const float lam = expf(s1) - expf(s2) + 0.2f;
  __syncthreads();
  int* ctr = (int*)(ws + WS_CTR);
  int* s_item = (int*)(g_lds + A_ITEM_OFF);
  const char* ob = (const char*)p.out;
  const bf16_t* AQ = (const bf16_t*)(ob + OB_AQ); const bf16_t* AK = (const bf16_t*)(ob + OB_AK); const bf16_t* AV = (const bf16_t*)(ob + OB_AV);
  const bf16_t* BQ = (const bf16_t*)(ob + OB_BQ); const bf16_t* BK = (const bf16_t*)(ob + OB_BK); const bf16_t* BV = (const bf16_t*)(ws + WS_BV);
  const bf16_t* MQ = (const bf16_t*)(ob + OB_MQ); const bf16_t* MK = (const bf16_t*)(ws + WS_MK); const bf16_t* MV = (const bf16_t*)(ws + WS_MV);
  const bf16_t* SAK = (const bf16_t*)(ws + WS_SAK); const bf16_t* SAV = (const bf16_t*)(ws + WS_SAV);
  const bf16_t* SBK = (const bf16_t*)(ws + WS_SBK); const bf16_t* SBV = (const bf16_t*)(ws + WS_SBV);
  const bf16_t* SMK = (const bf16_t*)(ws + WS_SMK); const bf16_t* SMV = (const bf16_t*)(ws + WS_SMV);
  bf16_t* G = (bf16_t*)(ws + WS_G);
  constexpr int N_BP = 2048, N_BS = 128, N_AP = 1024, N_AS = 64, N_MP = 1024, N_MS = 64;
  constexpr int N_ALL = N_BP + N_BS + N_AP + N_AS + N_MP + N_MS;
  (void)ctr; (void)s_item;
  for (int item0 = blockIdx.x; item0 < N_ALL; item0 += gridDim.x) {
    int item = item0;
    AttnItem it;
    it.bias = false; it.qpos0 = 0; it.kpos0 = 0; it.head0 = 0; it.rows = 64;
    if (item < N_BP) {
      const int c = 127 - (item >> 4), bh = item & 15, b = bh >> 2, hh = bh & 3;
      const long tok0 = (long)b * SEQ + c * 64;
      it.q = BQ + tok0 * 512 + hh * 128; it.k = BK + (long)b * SEQ * 512 + hh * 128; it.v = BV + (long)b * SEQ * 512 + hh * 128;
      it.qs = 512; it.ks = 512; it.nkeys = (c + 1) * 64; it.g = G + tok0 * 1024 + 256 + hh * 128;
      attn_item<true>(it, lam, p.subg);
      continue;
    }
    item -= N_BP;
    if (item < N_BS) {
      const int b = item >> 2, hh = item & 3;
      const long tok0 = NTOKP + b * ST;
      it.q = BQ + tok0 * 512 + hh * 128; it.k = SBK + (long)b * SBK_ROWS * 512 + hh * 128; it.v = SBV + (long)b * SBK_ROWS * 512 + hh * 128;
      it.qs = 512; it.ks = 512; it.nkeys = PAST + ST; it.rows = ST; it.g = G + tok0 * 1024 + 256 + hh * 128;
      attn_item<true>(it, lam, p.subg);
      continue;
    }
    item -= N_BS;
    if (item < N_AP) {
      const int c = 127 - (item >> 3), bh = item & 7, b = bh >> 1, hp = bh & 1;
      const int cs = c > 8 ? c - 8 : 0;
      const long tok0 = (long)b * SEQ + c * 64, k0 = (long)b * SEQ + cs * 64;
      it.q = AQ + tok0 * 256 + hp * 128; it.k = AK + k0 * 256 + hp * 128; it.v = AV + k0 * 256 + hp * 128;
      it.qs = 256; it.ks = 256; it.nkeys = (c - cs + 1) * 64; it.g = G + tok0 * 1024 + hp * 128;
      it.bias = true; it.qpos0 = c * 64; it.kpos0 = cs * 64; it.head0 = hp * 2;
    } else if ((item -= N_AP) < N_AS) {
      const int b = item >> 1, hp = item & 1;
      const long tok0 = NTOKP + b * ST;
      it.q = AQ + tok0 * 256 + hp * 128; it.k = SAK + (long)b * SAK_ROWS * 256 + hp * 128; it.v = SAV + (long)b * SAK_ROWS * 256 + hp * 128;
      it.qs = 256; it.ks = 256; it.nkeys = RA + ST; it.rows = ST; it.g = G + tok0 * 1024 + hp * 128;
      it.bias = true; it.qpos0 = RA; it.kpos0 = 0; it.head0 = hp * 2;
    } else if ((item -= N_AS) < N_MP) {
      const int c = item >> 3, bh = item & 7, b = bh >> 1, hp = bh & 1;
      const long tok0 = (long)b * SEQ + c * 64;
      it.q = MQ + tok0 * 256 + hp * 128; it.k = MK + (long)b * NMEM * 256 + hp * 128; it.v = MV + (long)b * NMEM * 256 + hp * 128;
      it.qs = 256; it.ks = 256; it.nkeys = NMEM; it.g = G + tok0 * 1024 + 768 + hp * 128;
    } else {
      item -= N_MP;
      const int b = item >> 1, hp = item & 1;
      const long tok0 = NTOKP + b * ST;
      it.q = MQ + tok0 * 256 + hp * 128; it.k = SMK + (long)b * NMEM * 256 + hp * 128; it.v = SMV + (long)b * NMEM * 256 + hp * 128;
      it.qs = 256; it.ks = 256; it.nkeys = NMEM; it.rows = ST; it.g = G + tok0 * 1024 + 768 + hp * 128;
    }
    attn_item<false>(it, lam, p.subg);
  }
}

DI void phase3(const Params& p) {
  constexpr int MT = NTOK / 128, NT = 8, T3 = MT * NT;
  const int G = gridDim.x;
  const int vid = (blockIdx.x & 7) * (G >> 3) + (blockIdx.x >> 3);
  const bf16_t* Gm = (const bf16_t*)(p.ws + WS_G); const bf16_t* woutT = (const bf16_t*)(p.ws + WS_WOUTT);
  const int tid = threadIdx.x, lane = tid & 63, w = tid >> 6, wm = w >> 1, wn = w & 1, c = lane & 31, h = lane >> 5;
  f32x16 acc[2][2];
  for (int t = vid; t < T3; t += G) {
    const int mt = t >> 3, nt = t & 7;
    gemm_core<false>(Gm + (long)mt * 128 * 1024, 1024, woutT + (long)nt * 128 * 1024, 1024, 1024, acc);
    const float* xrow = (mt < NTOKP / 128) ? p.xp + (long)mt * 128 * 1024 : p.xs + (long)(mt - NTOKP / 128) * 128 * 1024;
    float* orow = p.out + O_Y + (long)mt * 128 * 1024;
    const int col = nt * 128 + wn * 64 + c;
#pragma unroll
    for (int mi = 0; mi < 2; ++mi)
#pragma unroll
      for (int i = 0; i < 16; ++i) {
        const long row = wm * 64 + mi * 32 + (i & 3) + 8 * (i >> 2) + 4 * h;
        orow[row * 1024 + col] = acc[mi][0][i] + ALPHA * xrow[row * 1024 + col];
        orow[row * 1024 + col + 32] = acc[mi][1][i] + ALPHA * xrow[row * 1024 + col + 32];
      }
  }
}

DI void phase4(const Params& p) {
  const int lane = threadIdx.x & 63, w = threadIdx.x >> 6;
  for (int row = blockIdx.x * 4 + w; row < NTOK; row += gridDim.x * 4) {
    float* y = p.out + O_Y + (long)row * 1024;
    float4 v[4];
#pragma unroll
    for (int j = 0; j < 4; ++j) v[j] = *(const float4*)(y + j * 256 + lane * 4);
    float s = 0.f;
#pragma unroll
    for (int j = 0; j < 4; ++j) s += v[j].x + v[j].y + v[j].z + v[j].w;
#pragma unroll
    for (int o = 1; o < 64; o <<= 1) s += __shfl_xor(s, o);
    const float mu = s * (1.f / 1024.f);
    float q = 0.f;
#pragma unroll
    for (int j = 0; j < 4; ++j) { const float a = v[j].x - mu, b = v[j].y - mu, c = v[j].z - mu, d = v[j].w - mu; q += a * a + b * b + c * c + d * d; }
#pragma unroll
    for (int o = 1; o < 64; o <<= 1) q += __shfl_xor(q, o);
    const float rs = rsqrtf(q * (1.f / 1024.f) + 1e-5f);
#pragma unroll
    for (int j = 0; j < 4; ++j) {
      const float4 g = *(const float4*)(p.ln_g + j * 256 + lane * 4), b = *(const float4*)(p.ln_b + j * 256 + lane * 4);
      float4 o;
      o.x = (v[j].x - mu) * rs * g.x + b.x; o.y = (v[j].y - mu) * rs * g.y + b.y; o.z = (v[j].z - mu) * rs * g.z + b.z; o.w = (v[j].w - mu) * rs * g.w + b.w;
      *(float4*)(y + j * 256 + lane * 4) = o;
    }
  }
}

DI void grid_barrier(unsigned* bar, unsigned target) {
  asm volatile("s_waitcnt vmcnt(0) lgkmcnt(0)" ::: "memory");
  __builtin_amdgcn_fence(__ATOMIC_RELEASE, "agent");
  asm volatile("s_waitcnt vmcnt(0)" ::: "memory");
  __syncthreads();
  if (threadIdx.x == 0) {
    __hip_atomic_fetch_add(bar, 1u, __ATOMIC_RELAXED, __HIP_MEMORY_SCOPE_AGENT);
    while (__hip_atomic_load(bar, __ATOMIC_RELAXED, __HIP_MEMORY_SCOPE_AGENT) < target) __builtin_amdgcn_s_sleep(4);
  }
  __syncthreads();
  __builtin_amdgcn_fence(__ATOMIC_ACQUIRE, "agent");
  asm volatile("s_waitcnt vmcnt(0)" ::: "memory");
}
__global__ void __launch_bounds__(256, 2) fwd_megakernel(Params p) {
  cg::grid_group grid = cg::this_grid();
  unsigned* bar = (unsigned*)(p.ws + WS_CTR + 64);
  const unsigned nb = gridDim.x;
  phase0(p);
  grid.sync();
  grid_barrier(bar, nb);
  phase1(p);
  grid_barrier(bar, 2 * nb);
  phase2(p);
  grid_barrier(bar, 3 * nb);
  phase3(p);
  grid_barrier(bar, 4 * nb);
  phase4(p);
}

extern "C" void kernel_launch(void* const* d_in, const int* in_sizes, int n_in, void* d_out, int out_size,
                              void* d_ws, size_t ws_size, hipStream_t stream) {
  static int grid_blocks = 0;
  if (!grid_blocks) {
    int dev = 0, cus = 0, per_cu = 0;
    (void)hipGetDevice(&dev);
    (void)hipDeviceGetAttribute(&cus, hipDeviceAttributeMultiprocessorCount, dev);
    (void)hipOccupancyMaxActiveBlocksPerMultiprocessor(&per_cu, fwd_megakernel, 256, 0);
    if (per_cu > 1) per_cu = 1;
    if (per_cu < 1) per_cu = 1;
    grid_blocks = cus * per_cu;
    if (ws_size < WS_END || out_size != (int)O_END) fprintf(stderr, "kernel_launch: unexpected sizes ws %zu (need %zu) out %d (need %ld)\n", ws_size, (size_t)WS_END, out_size, (long)O_END);
  }
  (void)hipMemsetAsync((char*)d_ws + WS_CTR, 0, 256, stream);
  Params p{};
  p.xp = (const float*)d_in[0]; p.xs = (const float*)d_in[1];
  p.cak = (const float*)d_in[2]; p.cav = (const float*)d_in[3]; p.cbk = (const float*)d_in[4]; p.cbv = (const float*)d_in[5];
  p.cmk = (const float*)d_in[6]; p.cmv = (const float*)d_in[7];
  p.memp = (const float*)d_in[8]; p.w_in = (const float*)d_in[9]; p.w_mem = (const float*)d_in[10]; p.relb = (const float*)d_in[11];
  p.dlam = (const float*)d_in[12]; p.subg = (const float*)d_in[13]; p.w_out = (const float*)d_in[14]; p.ln_g = (const float*)d_in[15]; p.ln_b = (const float*)d_in[16];
  p.out = (float*)d_out; p.ws = (char*)d_ws;
  void* args[] = {&p};
  hipError_t e = hipLaunchCooperativeKernel((void*)fwd_megakernel, dim3(grid_blocks), dim3(256), args, 0, stream);
  if (e != hipSuccess) fprintf(stderr, "cooperative launch failed: %s (grid %d)\n", hipGetErrorString(e), grid_blocks);
}
```

```cpp
#include <hip/hip_runtime.h>
#include <hip/hip_cooperative_groups.h>
#include <cstdio>
#include <cstdint>
namespace cg = cooperative_groups;

typedef unsigned short bf16_t;
typedef short bf16x8 __attribute__((ext_vector_type(8)));
typedef short s16x4 __attribute__((ext_vector_type(4)));
typedef float f32x16 __attribute__((ext_vector_type(16)));
typedef float f32x2_t __attribute__((ext_vector_type(2)));
typedef __bf16 bf16x2_t __attribute__((ext_vector_type(2)));
typedef unsigned u32x2 __attribute__((ext_vector_type(2)));
typedef unsigned u32x4 __attribute__((ext_vector_type(4)));
#define DI __device__ __forceinline__
#define MFMA32(a, b, c) __builtin_amdgcn_mfma_f32_32x32x16_bf16((a), (b), (c), 0, 0, 0)
#define LDS3 __attribute__((address_space(3)))

constexpr int D_MODEL = 1024, SEQ = 8192, NB = 4, NTOKP = NB * SEQ, SB = 32, ST = 16, NTOKS = SB * ST, NTOK = NTOKP + NTOKS;
constexpr int PAST = 1024, RA = 512, NMEM = 256, PROJ = 3584;
constexpr int SAK_ROWS = 576, SBK_ROWS = 1088;
constexpr int NTOKPAD = NTOK + 64;
constexpr float QSCALE = 0.125f * 1.4426950408889634f;
constexpr float LOG2E = 1.4426950408889634f;
constexpr float ALPHA = 1.189207115002721f;

constexpr long O_Y = 0;
constexpr long O_AKP = (long)NTOK * 1024;
constexpr long O_AVP = O_AKP + (long)NB * RA * 256;
constexpr long O_BKP = O_AVP + (long)NB * RA * 256;
constexpr long O_BVP = O_BKP + (long)NTOKP * 512;
constexpr long O_MKP = O_BVP + (long)NTOKP * 512;
constexpr long O_MVP = O_MKP + (long)NB * NMEM * 256;
constexpr long O_AKS = O_MVP + (long)NB * NMEM * 256;
constexpr long O_AVS = O_AKS + (long)NTOKS * 256;
constexpr long O_BKS = O_AVS + (long)NTOKS * 256;
constexpr long O_BVS = O_BKS + (long)NTOKS * 512;
constexpr long O_END = O_BVS + (long)NTOKS * 512;

constexpr size_t WS_CTR = 0;
constexpr size_t WS_WINT = 256;
constexpr size_t WS_WOUTT = WS_WINT + (size_t)PROJ * 1024 * 2;
constexpr size_t WS_WMEMT = WS_WOUTT + (size_t)1024 * 1024 * 2;
constexpr size_t WS_ROPE = WS_WMEMT + (size_t)512 * 1024 * 2;
constexpr size_t OB_AQ = 0;
constexpr size_t OB_BQ = OB_AQ + (size_t)NTOKPAD * 256 * 2;
constexpr size_t OB_MQ = OB_BQ + (size_t)NTOKPAD * 512 * 2;
constexpr size_t OB_AK = OB_MQ + (size_t)NTOKPAD * 256 * 2;
constexpr size_t OB_AV = OB_AK + (size_t)NTOKP * 256 * 2;
constexpr size_t OB_BK = OB_AV + (size_t)NTOKP * 256 * 2;
constexpr size_t OB_END = OB_BK + (size_t)NTOKP * 512 * 2;
static_assert(OB_END <= (size_t)NTOK * 1024 * 4, "temporaries must fit in the y region");
constexpr size_t WS_BV = WS_ROPE + (size_t)SEQ * 32 * 8;
constexpr size_t WS_G = WS_BV + (size_t)NTOKP * 512 * 2;
constexpr size_t WS_MK = WS_G + (size_t)NTOK * 1024 * 2;
constexpr size_t WS_MV = WS_MK + (size_t)NB * NMEM * 256 * 2;
constexpr size_t WS_SAK = WS_MV + (size_t)NB * NMEM * 256 * 2;
constexpr size_t WS_SAV = WS_SAK + (size_t)SB * SAK_ROWS * 256 * 2;
constexpr size_t WS_SBK = WS_SAV + (size_t)SB * SAK_ROWS * 256 * 2;
constexpr size_t WS_SBV = WS_SBK + (size_t)SB * SBK_ROWS * 512 * 2;
constexpr size_t WS_SMK = WS_SBV + (size_t)SB * SBK_ROWS * 512 * 2;
constexpr size_t WS_SMV = WS_SMK + (size_t)SB * NMEM * 256 * 2;
constexpr size_t WS_END = WS_SMV + (size_t)SB * NMEM * 256 * 2;
static_assert(WS_END <= (size_t)256 * 1024 * 1024, "workspace must fit the guaranteed 256 MiB");

struct Params {
  const float* xp; const float* xs;
  const float* cak; const float* cav; const float* cbk; const float* cbv; const float* cmk; const float* cmv;
  const float* memp; const float* w_in; const float* w_mem; const float* relb; const float* dlam; const float* subg;
  const float* w_out; const float* ln_g; const float* ln_b;
  float* out; char* ws;
};

constexpr int TEAM_LDS = 73728 + 64;
constexpr int LDS_BYTES = 2 * TEAM_LDS + 64;
__shared__ __attribute__((aligned(16))) char g_lds_all[LDS_BYTES];
#define TEAM (__builtin_amdgcn_readfirstlane((int)(threadIdx.x >> 8)))
#define g_lds (g_lds_all + TEAM * TEAM_LDS)

DI unsigned cvtpk(float lo, float hi) { f32x2_t v = {lo, hi}; bf16x2_t b = __builtin_convertvector(v, bf16x2_t); return __builtin_bit_cast(unsigned, b); }
DI bf16_t f2bf(float x) { return (bf16_t)(cvtpk(x, 0.f) & 0xffffu); }
DI float bf2f(unsigned short b) { return __uint_as_float(((unsigned)b) << 16); }
DI float bflo(unsigned u) { return __uint_as_float(u << 16); }
DI float bfhi(unsigned u) { return __uint_as_float(u & 0xffff0000u); }
DI float fexp2(float x) { return __builtin_amdgcn_exp2f(x); }
DI float xor32f(float v) { return __shfl_xor(v, 32); }

DI void transpose_tile(const float* __restrict__ src, int N, bf16_t* __restrict__ dst, int K, int k0, int n0) {
  float* tile = (float*)g_lds;
  const int tid = threadIdx.x & 255, c = tid & 63, r0 = tid >> 6;
#pragma unroll
  for (int i = 0; i < 16; ++i) { const int row = r0 + 4 * i; tile[row * 65 + c] = src[(long)(k0 + row) * N + n0 + c]; }
  __syncthreads();
#pragma unroll
  for (int i = 0; i < 16; ++i) { const int rr = r0 + 4 * i; dst[(long)(n0 + rr) * K + k0 + c] = f2bf(tile[c * 65 + rr]); }
  __syncthreads();
}

DI void convert_rows(const float* __restrict__ src, bf16_t* __restrict__ dst, int rows_w8, int dst_bstride_w8, long gtid, long gsz) {
  const long total = (long)SB * rows_w8;
  for (long u = gtid; u < total; u += gsz) {
    const int b = (int)(u / rows_w8); const int j = (int)(u - (long)b * rows_w8);
    const float4 a0 = *(const float4*)(src + u * 8), a1 = *(const float4*)(src + u * 8 + 4);
    u32x4 v; v.x = cvtpk(a0.x, a0.y); v.y = cvtpk(a0.z, a0.w); v.z = cvtpk(a1.x, a1.y); v.w = cvtpk(a1.z, a1.w);
    *(u32x4*)(dst + ((long)b * dst_bstride_w8 + j) * 8) = v;
  }
}

DI void phase0(const Params& p) {
  bf16_t* winT = (bf16_t*)(p.ws + WS_WINT); bf16_t* woutT = (bf16_t*)(p.ws + WS_WOUTT); bf16_t* wmemT = (bf16_t*)(p.ws + WS_WMEMT);
  constexpr int T_IN = 16 * 56, T_OUT = 16 * 16, T_MEM = 16 * 8;
  for (int t = blockIdx.x * 2 + TEAM; t < T_IN + T_OUT + T_MEM; t += gridDim.x * 2) {
    if (t < T_IN) transpose_tile(p.w_in, PROJ, winT, 1024, (t / 56) * 64, (t % 56) * 64);
    else if (t < T_IN + T_OUT) { const int u = t - T_IN; transpose_tile(p.w_out, 1024, woutT, 1024, (u >> 4) * 64, (u & 15) * 64); }
    else { const int u = t - T_IN - T_OUT; transpose_tile(p.w_mem, 512, wmemT, 1024, (u >> 3) * 64, (u & 7) * 64); }
  }
  float2* rope = (float2*)(p.ws + WS_ROPE);
  for (int idx = blockIdx.x * 512 + threadIdx.x; idx < SEQ * 32; idx += gridDim.x * 512) {
    const int pos = idx >> 5, i = idx & 31;
    const double inv = exp(-(double)i * (9.210340371976184 / 32.0));
    const double rev = (double)pos * inv * 0.15915494309189535;
    const double fr = rev - rint(rev);
    const float a = (float)(fr * 6.283185307179586);
    rope[idx] = make_float2(cosf(a), sinf(a));
  }
  const int G = gridDim.x;
  const long gtid = (long)blockIdx.x * 512 + threadIdx.x, gsz = (long)G * 512;
  convert_rows(p.cak, (bf16_t*)(p.ws + WS_SAK), RA * 256 / 8, SAK_ROWS * 256 / 8, gtid, gsz);
  convert_rows(p.cav, (bf16_t*)(p.ws + WS_SAV), RA * 256 / 8, SAK_ROWS * 256 / 8, gtid, gsz);
  convert_rows(p.cbk, (bf16_t*)(p.ws + WS_SBK), PAST * 512 / 8, SBK_ROWS * 512 / 8, gtid, gsz);
  convert_rows(p.cbv, (bf16_t*)(p.ws + WS_SBV), PAST * 512 / 8, SBK_ROWS * 512 / 8, gtid, gsz);
  convert_rows(p.cmk, (bf16_t*)(p.ws + WS_SMK), NMEM * 256 / 8, NMEM * 256 / 8, gtid, gsz);
  convert_rows(p.cmv, (bf16_t*)(p.ws + WS_SMV), NMEM * 256 / 8, NMEM * 256 / 8, gtid, gsz);
}

constexpr int G_RS = 144, G_TILE = 128 * G_RS;
template <bool A_F32>
DI void gemm_core(const void* __restrict__ Ap, int lda, const bf16_t* __restrict__ Bp, int ldb, int K, f32x16 (&acc)[2][2]) {
  const int tid = threadIdx.x & 255, lane = tid & 63, w = tid >> 6, wm = w >> 1, wn = w & 1, r = lane & 31, h = lane >> 5;
#pragma unroll
  for (int a = 0; a < 2; ++a)
#pragma unroll
    for (int b = 0; b < 2; ++b)
#pragma unroll
      for (int i = 0; i < 16; ++i) acc[a][b][i] = 0.f;
  float4 ra[8]; u32x4 rab[4]; u32x4 rb[4];
  const int arow = tid >> 4, ac4 = tid & 15, brow = tid >> 3, bch = tid & 7;
  const float* Af = (const float*)Ap; const bf16_t* Ab16 = (const bf16_t*)Ap;
#define G_LOAD(kt)                                                                                              \
  {                                                                                                             \
    if (A_F32) {                                                                                                \
      _Pragma("unroll") for (int i = 0; i < 8; ++i) ra[i] = *(const float4*)(Af + (long)(arow + 16 * i) * lda + (kt) * 64 + ac4 * 4); \
    } else {                                                                                                    \
      _Pragma("unroll") for (int i = 0; i < 4; ++i) rab[i] = *(const u32x4*)(Ab16 + (long)(brow + 32 * i) * lda + (kt) * 64 + bch * 8); \
    }                                                                                                           \
    _Pragma("unroll") for (int i = 0; i < 4; ++i) rb[i] = *(const u32x4*)(Bp + (long)(brow + 32 * i) * ldb + (kt) * 64 + bch * 8); \
  }
#define G_WRITE(buf)                                                                                            \
  {                                                                                                             \
    char* Ab_ = g_lds + (buf) * 2 * G_TILE; char* Bb_ = Ab_ + G_TILE;                                           \
    if (A_F32) {                                                                                                \
      _Pragma("unroll") for (int i = 0; i < 8; ++i) { u32x2 v_; v_.x = cvtpk(ra[i].x, ra[i].y); v_.y = cvtpk(ra[i].z, ra[i].w); *(u32x2*)(Ab_ + (arow + 16 * i) * G_RS + ac4 * 8) = v_; } \
    } else {                                                                                                    \
      _Pragma("unroll") for (int i = 0; i < 4; ++i) *(u32x4*)(Ab_ + (brow + 32 * i) * G_RS + bch * 16) = rab[i]; \
    }                                                                                                           \
    _Pragma("unroll") for (int i = 0; i < 4; ++i) *(u32x4*)(Bb_ + (brow + 32 * i) * G_RS + bch * 16) = rb[i]; \
  }
  G_LOAD(0);
  G_WRITE(0);
  __syncthreads();
  const int nk = K >> 6;
  for (int kt = 0; kt < nk; ++kt) {
    if (kt + 1 < nk) G_LOAD(kt + 1);
    const char* Ab = g_lds + (kt & 1) * 2 * G_TILE; const char* Bb = Ab + G_TILE;
#pragma unroll
    for (int s = 0; s < 4; ++s) {
      const int co = (16 * s + 8 * h) * 2;
      const bf16x8 a0 = *(const bf16x8*)(Ab + (wm * 64 + r) * G_RS + co);
      const bf16x8 a1 = *(const bf16x8*)(Ab + (wm * 64 + 32 + r) * G_RS + co);
      const bf16x8 b0 = *(const bf16x8*)(Bb + (wn * 64 + r) * G_RS + co);
      const bf16x8 b1 = *(const bf16x8*)(Bb + (wn * 64 + 32 + r) * G_RS + co);
      acc[0][0] = MFMA32(a0, b0, acc[0][0]);
      acc[0][1] = MFMA32(a0, b1, acc[0][1]);
      acc[1][0] = MFMA32(a1, b0, acc[1][0]);
      acc[1][1] = MFMA32(a1, b1, acc[1][1]);
    }
    if (kt + 1 < nk) G_WRITE((kt + 1) & 1);
    __syncthreads();
  }
#undef G_LOAD
#undef G_WRITE
}

DI void proj_epilogue(const Params& p, int mt, int nt, f32x16 (&acc)[2][2]) {
  const int tid = threadIdx.x & 255, lane = tid & 63, w = tid >> 6, wm = w >> 1, wn = w & 1, c = lane & 31, h = lane >> 5;
  const int n0 = nt * 128 + wn * 64;
  char* ws = p.ws; float* out = p.out; char* ob = (char*)p.out;
  const float2* rope = (const float2*)(ws + WS_ROPE);
  int seg, cb;
  if (n0 < 256) { seg = 0; cb = n0; }
  else if (n0 < 512) { seg = 1; cb = n0 - 256; }
  else if (n0 < 768) { seg = 2; cb = n0 - 512; }
  else if (n0 < 1280) { seg = 3; cb = n0 - 768; }
  else if (n0 < 1792) { seg = 4; cb = n0 - 1280; }
  else if (n0 < 2304) { seg = 5; cb = n0 - 1792; }
  else if (n0 < 2560) { seg = 6; cb = n0 - 2304; }
  else { seg = 7; cb = n0 - 2560; }
  const int col0 = cb + c, col1 = cb + c + 32;
#pragma unroll
  for (int mi = 0; mi < 2; ++mi) {
#pragma unroll
    for (int i = 0; i < 16; ++i) {
      const int tok = mt * 128 + wm * 64 + mi * 32 + (i & 3) + 8 * (i >> 2) + 4 * h;
      float v0 = acc[mi][0][i], v1 = acc[mi][1][i];
      const bool smp = tok >= NTOKP;
      const int ts = tok - NTOKP, sb = ts >> 4, st = ts & 15;
      const int pb = tok >> 13, ps = tok & (SEQ - 1);
      if (seg == 3 || seg == 4) {
        const int pos = smp ? (PAST + st) : ps;
        const float2 cs = rope[pos * 32 + c];
        const float a = v0 * cs.x - v1 * cs.y, b = v1 * cs.x + v0 * cs.y;
        v0 = a; v1 = b;
      }
      if (seg == 0) {
        bf16_t* q = (bf16_t*)(ob + OB_AQ) + (long)tok * 256;
        q[col0] = f2bf(v0 * QSCALE); q[col1] = f2bf(v1 * QSCALE);
      } else if (seg == 1 || seg == 2) {
        bf16_t* kw; float* o = nullptr;
        if (!smp) {
          kw = (bf16_t*)(ob + (seg == 1 ? OB_AK : OB_AV)) + (long)tok * 256;
          if (ps >= SEQ - RA) o = out + (seg == 1 ? O_AKP : O_AVP) + (long)(pb * RA + ps - (SEQ - RA)) * 256;
        } else {
          kw = (bf16_t*)(ws + (seg == 1 ? WS_SAK : WS_SAV)) + (long)(sb * SAK_ROWS + RA + st) * 256;
          o = out + (seg == 1 ? O_AKS : O_AVS) + (long)ts * 256;
        }
        kw[col0] = f2bf(v0); kw[col1] = f2bf(v1);
        if (o) { o[col0] = v0; o[col1] = v1; }
      } else if (seg == 3) {
        bf16_t* q = (bf16_t*)(ob + OB_BQ) + (long)tok * 512;
        q[col0] = f2bf(v0 * QSCALE); q[col1] = f2bf(v1 * QSCALE);
      } else if (seg == 4 || seg == 5) {
        bf16_t* kw; float* o;
        if (!smp) {
          kw = (seg == 4 ? (bf16_t*)(ob + OB_BK) : (bf16_t*)(ws + WS_BV)) + (long)tok * 512;
          o = out + (seg == 4 ? O_BKP : O_BVP) + (long)tok * 512;
        } else {
          kw = (bf16_t*)(ws + (seg == 4 ? WS_SBK : WS_SBV)) + (long)(sb * SBK_ROWS + PAST + st) * 512;
          o = out + (seg == 4 ? O_BKS : O_BVS) + (long)ts * 512;
        }
        kw[col0] = f2bf(v0); kw[col1] = f2bf(v1);
        o[col0] = v0; o[col1] = v1;
      } else if (seg == 6) {
        bf16_t* q = (bf16_t*)(ob + OB_MQ) + (long)tok * 256;
        q[col0] = f2bf(v0 * QSCALE); q[col1] = f2bf(v1 * QSCALE);
      } else {
        bf16_t* g = (bf16_t*)(ws + WS_G) + (long)tok * 1024;
        const float s0 = v0 / (1.f + __expf(-v0)), s1 = v1 / (1.f + __expf(-v1));
        g[col0] = f2bf(s0); g[col1] = f2bf(s1);
      }
    }
  }
}

DI void mem_epilogue(const Params& p, int mt, int nt, f32x16 (&acc)[2][2]) {
  const int tid = threadIdx.x & 255, lane = tid & 63, w = tid >> 6, wm = w >> 1, wn = w & 1, c = lane & 31, h = lane >> 5;
  const int n0 = nt * 128 + wn * 64;
  const bool isv = n0 >= 256;
  const int cb = isv ? n0 - 256 : n0;
  bf16_t* kw = (bf16_t*)(p.ws + (isv ? WS_MV : WS_MK));
  float* o = p.out + (isv ? O_MVP : O_MKP);
#pragma unroll
  for (int mi = 0; mi < 2; ++mi)
#pragma unroll
    for (int i = 0; i < 16; ++i) {
      const long row = mt * 128 + wm * 64 + mi * 32 + (i & 3) + 8 * (i >> 2) + 4 * h;
      const float v0 = acc[mi][0][i], v1 = acc[mi][1][i];
      kw[row * 256 + cb + c] = f2bf(v0); kw[row * 256 + cb + c + 32] = f2bf(v1);
      o[row * 256 + cb + c] = v0; o[row * 256 + cb + c + 32] = v1;
    }
}

DI void phase1(const Params& p) {
  constexpr int MT = NTOK / 128, NT = PROJ / 128, T1 = MT * NT, T2 = 8 * 4;
  const int G = gridDim.x;
  const int vid = (blockIdx.x & 7) * (G >> 3) + (blockIdx.x >> 3);
  const bf16_t* winT = (const bf16_t*)(p.ws + WS_WINT); const bf16_t* wmemT = (const bf16_t*)(p.ws + WS_WMEMT);
  f32x16 acc[2][2];
  for (int pt = vid; pt < (T1 + T2) / 2; pt += G) {
    const int t = 2 * pt + TEAM;
    if (t < T1) {
      const int mt = t / NT, nt = t - mt * NT;
      const float* A = (mt < NTOKP / 128) ? p.xp + (long)mt * 128 * 1024 : p.xs + (long)(mt - NTOKP / 128) * 128 * 1024;
      gemm_core<true>(A, 1024, winT + (long)nt * 128 * 1024, 1024, 1024, acc);
      proj_epilogue(p, mt, nt, acc);
    } else {
      const int u = t - T1, mt = u >> 2, nt = u & 3;
      gemm_core<true>(p.memp + (long)mt * 128 * 1024, 1024, wmemT + (long)nt * 128 * 1024, 1024, 1024, acc);
      mem_epilogue(p, mt, nt, acc);
    }
  }
}

struct AttnItem {
  const bf16_t* q; const bf16_t* k; const bf16_t* v; bf16_t* g;
  int qs, ks, nkeys, rows, qpos0, kpos0, head0; bool bias;
};
constexpr int AK_RS = 272, AK_BYTES = 64 * AK_RS, AV_BYTES = 16384, A_BUF = AK_BYTES + AV_BYTES;
constexpr int A_BIAS_OFF = 2 * A_BUF;
constexpr int A_ITEM_OFF = 73728;

template <bool DIFF>
DI void attn_item(const AttnItem& it, float lam, const float* __restrict__ subg) {
  const int tid = threadIdx.x & 255, lane = tid & 63, w = tid >> 6, qh = w & 1, m = w >> 1, r = lane & 31, h = lane >> 5;
  constexpr int NDT = DIFF ? 4 : 2;
  const int ntiles = (it.nkeys + 63) >> 6;
  bf16x8 qf[4];
  {
    const bf16_t* qp = it.q + (long)(qh * 32 + r) * it.qs + m * 64 + 8 * h;
#pragma unroll
    for (int s = 0; s < 4; ++s) qf[s] = *(const bf16x8*)(qp + 16 * s);
  }
  f32x16 oacc[NDT];
#pragma unroll
  for (int d = 0; d < NDT; ++d)
#pragma unroll
    for (int i = 0; i < 16; ++i) oacc[d][i] = 0.f;
  float m_run = -1e30f, l_run = 0.f;
  u32x4 rk[4], rv[4];
  const int kch = tid & 15, krow = tid >> 4, vsub = tid & 3, vkey = tid >> 2;
  const bf16_t* kg = it.k + (long)krow * it.ks + kch * 8;
  const bf16_t* vg = it.v + (long)vkey * it.ks + vsub * 8;
#define A_LOAD(t)                                                                                                \
  {                                                                                                              \
    _Pragma("unroll") for (int i = 0; i < 4; ++i) rk[i] = *(const u32x4*)(kg + (long)((t) * 64 + 16 * i) * it.ks); \
    _Pragma("unroll") for (int i = 0; i < 4; ++i) rv[i] = *(const u32x4*)(vg + (long)((t) * 64) * it.ks + 32 * i); \
  }
#define A_WRITE(buf)                                                                                             \
  {                                                                                                              \
    char* Kb_ = g_lds + (buf) * A_BUF; char* Vb_ = Kb_ + AK_BYTES;                                               \
    _Pragma("unroll") for (int i = 0; i < 4; ++i) *(u32x4*)(Kb_ + (krow + 16 * i) * AK_RS + kch * 16) = rk[i];   \
    _Pragma("unroll") for (int i = 0; i < 4; ++i) *(u32x4*)(Vb_ + i * 4096 + vkey * 64 + vsub * 16) = rv[i];     \
  }
  A_LOAD(0);
  A_WRITE(0);
  __syncthreads();
  const int vlane = ((lane >> 4) & 1) * 32 + (lane & 3) * 8 + (4 * h + ((lane & 15) >> 2)) * 64;
  const float* biasT = (const float*)(g_lds + A_BIAS_OFF) + (it.head0 + m) * 257;
  const int qpos = it.qpos0 + qh * 32 + r;
  for (int t = 0; t < ntiles; ++t) {
    if (t + 1 < ntiles) A_LOAD(t + 1);
    const char* Kb = g_lds + (t & 1) * A_BUF; const char* Vb = Kb + AK_BYTES;
    f32x16 s0, s1;
#pragma unroll
    for (int i = 0; i < 16; ++i) { s0[i] = 0.f; s1[i] = 0.f; }
#pragma unroll
    for (int s = 0; s < 4; ++s) {
      const int co = (m * 64 + 16 * s + 8 * h) * 2;
      const bf16x8 k0 = *(const bf16x8*)(Kb + r * AK_RS + co);
      const bf16x8 k1 = *(const bf16x8*)(Kb + (32 + r) * AK_RS + co);
      s0 = MFMA32(k0, qf[s], s0);
      s1 = MFMA32(k1, qf[s], s1);
    }
    if (it.bias) {
      const int kb = it.kpos0 + t * 64 + 4 * h;
#pragma unroll
      for (int i = 0; i < 16; ++i) {
        const int kk = kb + (i & 3) + 8 * (i >> 2);
        int d0 = qpos - kk, d1 = d0 - 32;
        d0 = min(max(d0, -128), 128) + 128; d1 = min(max(d1, -128), 128) + 128;
        s0[i] += biasT[d0]; s1[i] += biasT[d1];
      }
    }
    if ((t + 1) * 64 > it.nkeys) {
      const int kb = t * 64 + 4 * h;
#pragma unroll
      for (int i = 0; i < 16; ++i) {
        const int kk = kb + (i & 3) + 8 * (i >> 2);
        if (kk >= it.nkeys) s0[i] = -1e30f;
        if (kk + 32 >= it.nkeys) s1[i] = -1e30f;
      }
    }
    float mx = fmaxf(s0[0], s1[0]);
#pragma unroll
    for (int i = 1; i < 16; ++i) mx = fmaxf(mx, fmaxf(s0[i], s1[i]));
    mx = fmaxf(mx, xor32f(mx));
    const float m_new = fmaxf(m_run, mx);
    const float alpha = fexp2(m_run - m_new);
    if (__builtin_amdgcn_ballot_w64(m_new > m_run) != 0ull) {
#pragma unroll
      for (int d = 0; d < NDT; ++d)
#pragma unroll
        for (int i = 0; i < 16; ++i) oacc[d][i] *= alpha;
    }
    l_run *= alpha;
    m_run = m_new;
    float ls = 0.f;
#pragma unroll
    for (int i = 0; i < 16; ++i) { s0[i] = fexp2(s0[i] - m_new); s1[i] = fexp2(s1[i] - m_new); ls += s0[i] + s1[i]; }
    l_run += ls;
    bf16x8 pf[4];
#pragma unroll
    for (int s2 = 0; s2 < 2; ++s2) {
      u32x4 a, b;
      a.x = cvtpk(s0[8 * s2 + 0], s0[8 * s2 + 1]); a.y = cvtpk(s0[8 * s2 + 2], s0[8 * s2 + 3]);
      a.z = cvtpk(s0[8 * s2 + 4], s0[8 * s2 + 5]); a.w = cvtpk(s0[8 * s2 + 6], s0[8 * s2 + 7]);
      b.x = cvtpk(s1[8 * s2 + 0], s1[8 * s2 + 1]); b.y = cvtpk(s1[8 * s2 + 2], s1[8 * s2 + 3]);
      b.z = cvtpk(s1[8 * s2 + 4], s1[8 * s2 + 5]); b.w = cvtpk(s1[8 * s2 + 6], s1[8 * s2 + 7]);
      pf[s2] = __builtin_bit_cast(bf16x8, a); pf[2 + s2] = __builtin_bit_cast(bf16x8, b);
    }
    const LDS3 char* vb3 = (const LDS3 char*)(Vb) + vlane + (DIFF ? 0 : m * 2 * 4096);
#pragma unroll
    for (int d = 0; d < NDT; ++d) {
#pragma unroll
      for (int ks = 0; ks < 4; ++ks) {
        const s16x4 lo = __builtin_bit_cast(s16x4, __builtin_amdgcn_ds_read_tr16_b64_v4i16((LDS3 s16x4*)(vb3 + d * 4096 + ks * 1024)));
        const s16x4 hi = __builtin_bit_cast(s16x4, __builtin_amdgcn_ds_read_tr16_b64_v4i16((LDS3 s16x4*)(vb3 + d * 4096 + ks * 1024 + 512)));
        const bf16x8 vf = __builtin_shufflevector(lo, hi, 0, 1, 2, 3, 4, 5, 6, 7);
        oacc[d] = MFMA32(vf, pf[ks], oacc[d]);
      }
    }
    if (t + 1 < ntiles) A_WRITE((t + 1) & 1);
    __syncthreads();
  }
#undef A_LOAD
#undef A_WRITE
  const float l_tot = l_run + xor32f(l_run);
  const float inv = 1.f / l_tot;
  const int q = qh * 32 + r;
  if (!DIFF) {
    if (q < it.rows) {
      bf16_t* gp = it.g + (long)q * 1024 + m * 64 + 4 * h;
#pragma unroll
      for (int d = 0; d < NDT; ++d)
#pragma unroll
        for (int g4 = 0; g4 < 4; ++g4) {
          u32x2* ptr = (u32x2*)(gp + d * 32 + 8 * g4);
          const u32x2 gv = *ptr;
          u32x2 o;
          o.x = cvtpk(oacc[d][4 * g4 + 0] * inv * bflo(gv.x), oacc[d][4 * g4 + 1] * inv * bfhi(gv.x));
          o.y = cvtpk(oacc[d][4 * g4 + 2] * inv * bflo(gv.y), oacc[d][4 * g4 + 3] * inv * bfhi(gv.y));
          *ptr = o;
        }
    }
  } else {
    float* xb = (float*)g_lds + qh * 4096 + lane;
    if (m == 1) {
      const float sc = lam * inv;
#pragma unroll
      for (int d = 0; d < NDT; ++d)
#pragma unroll
        for (int i = 0; i < 16; ++i) xb[(d * 16 + i) * 64] = oacc[d][i] * sc;
    }
    __syncthreads();
    if (m == 0) {
      float ss = 0.f;
#pragma unroll
      for (int d = 0; d < NDT; ++d)
#pragma unroll
        for (int i = 0; i < 16; ++i) { const float o = oacc[d][i] * inv - xb[(d * 16 + i) * 64]; oacc[d][i] = o; ss += o * o; }
      ss += xor32f(ss);
      const float rn = rsqrtf(ss * (1.f / 128.f) + 1e-5f) * 0.8f;
      if (q < it.rows) {
        bf16_t* gp = it.g + (long)q * 1024 + 4 * h;
#pragma unroll
        for (int d = 0; d < NDT; ++d)
#pragma unroll
          for (int g4 = 0; g4 < 4; ++g4) {
            const float4 sg = *(const float4*)(subg + d * 32 + 8 * g4 + 4 * h);
            u32x2* ptr = (u32x2*)(gp + d * 32 + 8 * g4);
            const u32x2 gv = *ptr;
            u32x2 o;
            o.x = cvtpk(oacc[d][4 * g4 + 0] * rn * sg.x * bflo(gv.x), oacc[d][4 * g4 + 1] * rn * sg.y * bfhi(gv.x));
            o.y = cvtpk(oacc[d][4 * g4 + 2] * rn * sg.z * bflo(gv.y), oacc[d][4 * g4 + 3] * rn * sg.w * bfhi(gv.y));
            *ptr = o;
          }
      }
    }
    __syncthreads();
  }
}

DI void phase2(const Params& p) {
  char* ws = p.ws;
  const int tid = threadIdx.x & 255;
  float* biasT = (float*)(g_lds + A_BIAS_OFF);
  for (int i = tid; i < 4 * 257; i += 256) biasT[i] = p.relb[i] * LOG2E;
  float s1 = 0.f, s2 = 0.f;
  for (int i = 0; i < 64; ++i) { s1 += p.dlam[i] * p.dlam[64 + i]; s2 += p.dlam[128 + i] * p.dlam[192 + i]; }
  const float lam = expf(s1) - expf(s2) + 0.2f;
  __syncthreads();
  int* ctr = (int*)(ws + WS_CTR);
  int* s_item = (int*)(g_lds + A_ITEM_OFF);
  const char* ob = (const char*)p.out;
  const bf16_t* AQ = (const bf16_t*)(ob + OB_AQ); const bf16_t* AK = (const bf16_t*)(ob + OB_AK); const bf16_t* AV = (const bf16_t*)(ob + OB_AV);
  const bf16_t* BQ = (const bf16_t*)(ob + OB_BQ); const bf16_t* BK = (const bf16_t*)(ob + OB_BK); const bf16_t* BV = (const bf16_t*)(ws + WS_BV);
  const bf16_t* MQ = (const bf16_t*)(ob + OB_MQ); const bf16_t* MK = (const bf16_t*)(ws + WS_MK); const bf16_t* MV = (const bf16_t*)(ws + WS_MV);
  const bf16_t* SAK = (const bf16_t*)(ws + WS_SAK); const bf16_t* SAV = (const bf16_t*)(ws + WS_SAV);
  const bf16_t* SBK = (const bf16_t*)(ws + WS_SBK); const bf16_t* SBV = (const bf16_t*)(ws + WS_SBV);
  const bf16_t* SMK = (const bf16_t*)(ws + WS_SMK); const bf16_t* SMV = (const bf16_t*)(ws + WS_SMV);
  bf16_t* G = (bf16_t*)(ws + WS_G);
  constexpr int N_BP = 2048, N_BS = 128, N_AP = 1024, N_AS = 64, N_MP = 1024, N_MS = 64;
  constexpr int N_ALL = N_BP + N_BS + N_AP + N_AS + N_MP + N_MS;
  int* s_pair = (int*)(g_lds_all + 2 * TEAM_LDS);
  (void)s_item;
  for (;;) {
    if (threadIdx.x == 0) *s_pair = atomicAdd(ctr, 1);
    __syncthreads();
    const int pair = *s_pair;
    __syncthreads();
    if (pair >= N_ALL / 2) break;
    int item = 2 * pair + TEAM;
    AttnItem it;
    it.bias = false; it.qpos0 = 0; it.kpos0 = 0; it.head0 = 0; it.rows = 64;
    if (item < N_BP) {
      const int c = 127 - (item >> 4), bh = item & 15, b = bh >> 2, hh = bh & 3;
      const long tok0 = (long)b * SEQ + c * 64;
      it.q = BQ + tok0 * 512 + hh * 128; it.k = BK + (long)b * SEQ * 512 + hh * 128; it.v = BV + (long)b * SEQ * 512 + hh * 128;
      it.qs = 512; it.ks = 512; it.nkeys = (c + 1) * 64; it.g = G + tok0 * 1024 + 256 + hh * 128;
      attn_item<true>(it, lam, p.subg);
      continue;
    }
    item -= N_BP;
    if (item < N_BS) {
      const int b = item >> 2, hh = item & 3;
      const long tok0 = NTOKP + b * ST;
      it.q = BQ + tok0 * 512 + hh * 128; it.k = SBK + (long)b * SBK_ROWS * 512 + hh * 128; it.v = SBV + (long)b * SBK_ROWS * 512 + hh * 128;
      it.qs = 512; it.ks = 512; it.nkeys = PAST + ST; it.rows = ST; it.g = G + tok0 * 1024 + 256 + hh * 128;
      attn_item<true>(it, lam, p.subg);
      continue;
    }
    item -= N_BS;
    if (item < N_AP) {
      const int c = 127 - (item >> 3), bh = item & 7, b = bh >> 1, hp = bh & 1;
      const int cs = c > 8 ? c - 8 : 0;
      const long tok0 = (long)b * SEQ + c * 64, k0 = (long)b * SEQ + cs * 64;
      it.q = AQ + tok0 * 256 + hp * 128; it.k = AK + k0 * 256 + hp * 128; it.v = AV + k0 * 256 + hp * 128;
      it.qs = 256; it.ks = 256; it.nkeys = (c - cs + 1) * 64; it.g = G + tok0 * 1024 + hp * 128;
      it.bias = true; it.qpos0 = c * 64; it.kpos0 = cs * 64; it.head0 = hp * 2;
    } else if ((item -= N_AP) < N_AS) {
      const int b = item >> 1, hp = item & 1;
      const long tok0 = NTOKP + b * ST;
      it.q = AQ + tok0 * 256 + hp * 128; it.k = SAK + (long)b * SAK_ROWS * 256 + hp * 128; it.v = SAV + (long)b * SAK_ROWS * 256 + hp * 128;
      it.qs = 256; it.ks = 256; it.nkeys = RA + ST; it.rows = ST; it.g = G + tok0 * 1024 + hp * 128;
      it.bias = true; it.qpos0 = RA; it.kpos0 = 0; it.head0 = hp * 2;
    } else if ((item -= N_AS) < N_MP) {
      const int c = item >> 3, bh = item & 7, b = bh >> 1, hp = bh & 1;
      const long tok0 = (long)b * SEQ + c * 64;
      it.q = MQ + tok0 * 256 + hp * 128; it.k = MK + (long)b * NMEM * 256 + hp * 128; it.v = MV + (long)b * NMEM * 256 + hp * 128;
      it.qs = 256; it.ks = 256; it.nkeys = NMEM; it.g = G + tok0 * 1024 + 768 + hp * 128;
    } else {
      item -= N_MP;
      const int b = item >> 1, hp = item & 1;
      const long tok0 = NTOKP + b * ST;
      it.q = MQ + tok0 * 256 + hp * 128; it.k = SMK + (long)b * NMEM * 256 + hp * 128; it.v = SMV + (long)b * NMEM * 256 + hp * 128;
      it.qs = 256; it.ks = 256; it.nkeys = NMEM; it.rows = ST; it.g = G + tok0 * 1024 + 768 + hp * 128;
    }
    attn_item<false>(it, lam, p.subg);
  }
}

DI void phase3(const Params& p) {
  constexpr int MT = NTOK / 128, NT = 8, T3 = MT * NT;
  const int G = gridDim.x;
  const int vid = (blockIdx.x & 7) * (G >> 3) + (blockIdx.x >> 3);
  const bf16_t* Gm = (const bf16_t*)(p.ws + WS_G); const bf16_t* woutT = (const bf16_t*)(p.ws + WS_WOUTT);
  const int tid = threadIdx.x & 255, lane = tid & 63, w = tid >> 6, wm = w >> 1, wn = w & 1, c = lane & 31, h = lane >> 5;
  f32x16 acc[2][2];
  for (int pt = vid; pt < T3 / 2; pt += G) {
    const int t = 2 * pt + TEAM;
    const int mt = t >> 3, nt = t & 7;
    gemm_core<false>(Gm + (long)mt * 128 * 1024, 1024, woutT + (long)nt * 128 * 1024, 1024, 1024, acc);
    const float* xrow = (mt < NTOKP / 128) ? p.xp + (long)mt * 128 * 1024 : p.xs + (long)(mt - NTOKP / 128) * 128 * 1024;
    float* orow = p.out + O_Y + (long)mt * 128 * 1024;
    const int col = nt * 128 + wn * 64 + c;
#pragma unroll
    for (int mi = 0; mi < 2; ++mi)
#pragma unroll
      for (int i = 0; i < 16; ++i) {
        const long row = wm * 64 + mi * 32 + (i & 3) + 8 * (i >> 2) + 4 * h;
        orow[row * 1024 + col] = acc[mi][0][i] + ALPHA * xrow[row * 1024 + col];
        orow[row * 1024 + col + 32] = acc[mi][1][i] + ALPHA * xrow[row * 1024 + col + 32];
      }
  }
}

DI void phase4(const Params& p) {
  const int lane = threadIdx.x & 63, w = threadIdx.x >> 6;
  for (int row = blockIdx.x * 8 + w; row < NTOK; row += gridDim.x * 8) {
    float* y = p.out + O_Y + (long)row * 1024;
    float4 v[4];
#pragma unroll
    for (int j = 0; j < 4; ++j) v[j] = *(const float4*)(y + j * 256 + lane * 4);
    float s = 0.f;
#pragma unroll
    for (int j = 0; j < 4; ++j) s += v[j].x + v[j].y + v[j].z + v[j].w;
#pragma unroll
    for (int o = 1; o < 64; o <<= 1) s += __shfl_xor(s, o);
    const float mu = s * (1.f / 1024.f);
    float q = 0.f;
#pragma unroll
    for (int j = 0; j < 4; ++j) { const float a = v[j].x - mu, b = v[j].y - mu, c = v[j].z - mu, d = v[j].w - mu; q += a * a + b * b + c * c + d * d; }
#pragma unroll
    for (int o = 1; o < 64; o <<= 1) q += __shfl_xor(q, o);
    const float rs = rsqrtf(q * (1.f / 1024.f) + 1e-5f);
#pragma unroll
    for (int j = 0; j < 4; ++j) {
      const float4 g = *(const float4*)(p.ln_g + j * 256 + lane * 4), b = *(const float4*)(p.ln_b + j * 256 + lane * 4);
      float4 o;
      o.x = (v[j].x - mu) * rs * g.x + b.x; o.y = (v[j].y - mu) * rs * g.y + b.y; o.z = (v[j].z - mu) * rs * g.z + b.z; o.w = (v[j].w - mu) * rs * g.w + b.w;
      *(float4*)(y + j * 256 + lane * 4) = o;
    }
  }
}

DI void grid_barrier(unsigned* bar, unsigned target) {
  asm volatile("s_waitcnt vmcnt(0) lgkmcnt(0)" ::: "memory");
  __builtin_amdgcn_fence(__ATOMIC_RELEASE, "agent");
  asm volatile("s_waitcnt vmcnt(0)" ::: "memory");
  __syncthreads();
  if (threadIdx.x == 0) {
    __hip_atomic_fetch_add(bar, 1u, __ATOMIC_RELAXED, __HIP_MEMORY_SCOPE_AGENT);
    while (__hip_atomic_load(bar, __ATOMIC_RELAXED, __HIP_MEMORY_SCOPE_AGENT) < target) __builtin_amdgcn_s_sleep(4);
  }
  __syncthreads();
  __builtin_amdgcn_fence(__ATOMIC_ACQUIRE, "agent");
  asm volatile("s_waitcnt vmcnt(0)" ::: "memory");
}
__global__ void __launch_bounds__(512) fwd_megakernel(Params p) {
  cg::grid_group grid = cg::this_grid();
  unsigned* bar = (unsigned*)(p.ws + WS_CTR + 64);
  const unsigned nb = gridDim.x;
  phase0(p);
  grid.sync();
  grid_barrier(bar, nb);
  phase1(p);
  grid_barrier(bar, 2 * nb);
  phase2(p);
  grid_barrier(bar, 3 * nb);
  phase3(p);
  grid_barrier(bar, 4 * nb);
  phase4(p);
}

extern "C" void kernel_launch(void* const* d_in, const int* in_sizes, int n_in, void* d_out, int out_size,
                              void* d_ws, size_t ws_size, hipStream_t stream) {
  static int grid_blocks = 0;
  if (!grid_blocks) {
    int dev = 0, cus = 0, per_cu = 0;
    (void)hipGetDevice(&dev);
    (void)hipDeviceGetAttribute(&cus, hipDeviceAttributeMultiprocessorCount, dev);
    (void)hipOccupancyMaxActiveBlocksPerMultiprocessor(&per_cu, fwd_megakernel, 512, 0);
    if (per_cu > 1) per_cu = 1;
    if (per_cu < 1) per_cu = 1;
    grid_blocks = cus * per_cu;
    if (ws_size < WS_END || out_size != (int)O_END) fprintf(stderr, "kernel_launch: unexpected sizes ws %zu (need %zu) out %d (need %ld)\n", ws_size, (size_t)WS_END, out_size, (long)O_END);
  }
  (void)hipMemsetAsync((char*)d_ws + WS_CTR, 0, 256, stream);
  Params p{};
  p.xp = (const float*)d_in[0]; p.xs = (const float*)d_in[1];
  p.cak = (const float*)d_in[2]; p.cav = (const float*)d_in[3]; p.cbk = (const float*)d_in[4]; p.cbv = (const float*)d_in[5];
  p.cmk = (const float*)d_in[6]; p.cmv = (const float*)d_in[7];
  p.memp = (const float*)d_in[8]; p.w_in = (const float*)d_in[9]; p.w_mem = (const float*)d_in[10]; p.relb = (const float*)d_in[11];
  p.dlam = (const float*)d_in[12]; p.subg = (const float*)d_in[13]; p.w_out = (const float*)d_in[14]; p.ln_g = (const float*)d_in[15]; p.ln_b = (const float*)d_in[16];
  p.out = (float*)d_out; p.ws = (char*)d_ws;
  void* args[] = {&p};
  hipError_t e = hipLaunchCooperativeKernel((void*)fwd_megakernel, dim3(grid_blocks), dim3(512), args, 0, stream);
  if (e != hipSuccess) fprintf(stderr, "cooperative launch failed: %s (grid %d)\n", hipGetErrorString(e), grid_blocks);
}
```

```cpp
#include <hip/hip_runtime.h>
#include <hip/hip_cooperative_groups.h>
#include <cstdio>
#include <cstdint>
namespace cg = cooperative_groups;

typedef unsigned short bf16_t;
typedef short bf16x8 __attribute__((ext_vector_type(8)));
typedef short s16x4 __attribute__((ext_vector_type(4)));
typedef float f32x16 __attribute__((ext_vector_type(16)));
typedef float f32x2_t __attribute__((ext_vector_type(2)));
typedef __bf16 bf16x2_t __attribute__((ext_vector_type(2)));
typedef unsigned u32x2 __attribute__((ext_vector_type(2)));
typedef unsigned u32x4 __attribute__((ext_vector_type(4)));
#define DI __device__ __forceinline__
#define MFMA32(a, b, c) __builtin_amdgcn_mfma_f32_32x32x16_bf16((a), (b), (c), 0, 0, 0)
#define LDS3 __attribute__((address_space(3)))

constexpr int D_MODEL = 1024, SEQ = 8192, NB = 4, NTOKP = NB * SEQ, SB = 32, ST = 16, NTOKS = SB * ST, NTOK = NTOKP + NTOKS;
constexpr int PAST = 1024, RA = 512, NMEM = 256, PROJ = 3584;
constexpr int SAK_ROWS = 576, SBK_ROWS = 1088;
constexpr int NTOKPAD = NTOK + 64;
constexpr float QSCALE = 0.125f * 1.4426950408889634f;
constexpr float LOG2E = 1.4426950408889634f;
constexpr float ALPHA = 1.189207115002721f;

constexpr long O_Y = 0;
constexpr long O_AKP = (long)NTOK * 1024;
constexpr long O_AVP = O_AKP + (long)NB * RA * 256;
constexpr long O_BKP = O_AVP + (long)NB * RA * 256;
constexpr long O_BVP = O_BKP + (long)NTOKP * 512;
constexpr long O_MKP = O_BVP + (long)NTOKP * 512;
constexpr long O_MVP = O_MKP + (long)NB * NMEM * 256;
constexpr long O_AKS = O_MVP + (long)NB * NMEM * 256;
constexpr long O_AVS = O_AKS + (long)NTOKS * 256;
constexpr long O_BKS = O_AVS + (long)NTOKS * 256;
constexpr long O_BVS = O_BKS + (long)NTOKS * 512;
constexpr long O_END = O_BVS + (long)NTOKS * 512;

constexpr size_t WS_CTR = 0;
constexpr size_t WS_WINT = 256;
constexpr size_t WS_WOUTT = WS_WINT + (size_t)PROJ * 1024 * 2;
constexpr size_t WS_WMEMT = WS_WOUTT + (size_t)1024 * 1024 * 2;
constexpr size_t WS_ROPE = WS_WMEMT + (size_t)512 * 1024 * 2;
constexpr size_t OB_AQ = 0;
constexpr size_t OB_BQ = OB_AQ + (size_t)NTOKPAD * 256 * 2;
constexpr size_t OB_MQ = OB_BQ + (size_t)NTOKPAD * 512 * 2;
constexpr size_t OB_AK = OB_MQ + (size_t)NTOKPAD * 256 * 2;
constexpr size_t OB_AV = OB_AK + (size_t)NTOKP * 256 * 2;
constexpr size_t OB_BK = OB_AV + (size_t)NTOKP * 256 * 2;
constexpr size_t OB_END = OB_BK + (size_t)NTOKP * 512 * 2;
static_assert(OB_END <= (size_t)NTOK * 1024 * 4, "temporaries must fit in the y region");
constexpr size_t WS_BV = WS_ROPE + (size_t)SEQ * 32 * 8;
constexpr size_t WS_G = WS_BV + (size_t)NTOKP * 512 * 2;
constexpr size_t WS_MK = WS_G + (size_t)NTOK * 1024 * 2;
constexpr size_t WS_MV = WS_MK + (size_t)NB * NMEM * 256 * 2;
constexpr size_t WS_SAK = WS_MV + (size_t)NB * NMEM * 256 * 2;
constexpr size_t WS_SAV = WS_SAK + (size_t)SB * SAK_ROWS * 256 * 2;
constexpr size_t WS_SBK = WS_SAV + (size_t)SB * SAK_ROWS * 256 * 2;
constexpr size_t WS_SBV = WS_SBK + (size_t)SB * SBK_ROWS * 512 * 2;
constexpr size_t WS_SMK = WS_SBV + (size_t)SB * SBK_ROWS * 512 * 2;
constexpr size_t WS_SMV = WS_SMK + (size_t)SB * NMEM * 256 * 2;
constexpr size_t WS_XB = WS_SMV + (size_t)SB * NMEM * 256 * 2;
constexpr size_t WS_MB = WS_XB + (size_t)NTOK * 1024 * 2;
constexpr size_t WS_END = WS_MB + (size_t)NB * NMEM * 1024 * 2;
static_assert(WS_END <= (size_t)512 * 1024 * 1024, "workspace budget");

struct Params {
  const float* xp; const float* xs;
  const float* cak; const float* cav; const float* cbk; const float* cbv; const float* cmk; const float* cmv;
  const float* memp; const float* w_in; const float* w_mem; const float* relb; const float* dlam; const float* subg;
  const float* w_out; const float* ln_g; const float* ln_b;
  float* out; char* ws;
};

constexpr int TEAM_LDS = 73728 + 64;
constexpr int LDS_BYTES = 2 * TEAM_LDS + 64;
__shared__ __attribute__((aligned(16))) char g_lds_all[LDS_BYTES];
#define TEAM (__builtin_amdgcn_readfirstlane((int)(threadIdx.x >> 8)))
#define g_lds (g_lds_all + TEAM * TEAM_LDS)

DI unsigned cvtpk(float lo, float hi) { f32x2_t v = {lo, hi}; bf16x2_t b = __builtin_convertvector(v, bf16x2_t); return __builtin_bit_cast(unsigned, b); }
DI bf16_t f2bf(float x) { return (bf16_t)(cvtpk(x, 0.f) & 0xffffu); }
DI float bf2f(unsigned short b) { return __uint_as_float(((unsigned)b) << 16); }
DI float bflo(unsigned u) { return __uint_as_float(u << 16); }
DI float bfhi(unsigned u) { return __uint_as_float(u & 0xffff0000u); }
DI float fexp2(float x) { return __builtin_amdgcn_exp2f(x); }
DI float xor32f(float v) { return __shfl_xor(v, 32); }

DI void transpose_tile(const float* __restrict__ src, int N, bf16_t* __restrict__ dst, int K, int k0, int n0) {
  float* tile = (float*)g_lds;
  const int tid = threadIdx.x & 255, c = tid & 63, r0 = tid >> 6;
#pragma unroll
  for (int i = 0; i < 16; ++i) { const int row = r0 + 4 * i; tile[row * 65 + c] = src[(long)(k0 + row) * N + n0 + c]; }
  __syncthreads();
#pragma unroll
  for (int i = 0; i < 16; ++i) { const int rr = r0 + 4 * i; dst[(long)(n0 + rr) * K + k0 + c] = f2bf(tile[c * 65 + rr]); }
  __syncthreads();
}

DI void convert_rows(const float* __restrict__ src, bf16_t* __restrict__ dst, int rows_w8, int dst_bstride_w8, long gtid, long gsz) {
  const long total = (long)SB * rows_w8;
  for (long u = gtid; u < total; u += gsz) {
    const int b = (int)(u / rows_w8); const int j = (int)(u - (long)b * rows_w8);
    const float4 a0 = *(const float4*)(src + u * 8), a1 = *(const float4*)(src + u * 8 + 4);
    u32x4 v; v.x = cvtpk(a0.x, a0.y); v.y = cvtpk(a0.z, a0.w); v.z = cvtpk(a1.x, a1.y); v.w = cvtpk(a1.z, a1.w);
    *(u32x4*)(dst + ((long)b * dst_bstride_w8 + j) * 8) = v;
  }
}

DI void phase0(const Params& p) {
  bf16_t* winT = (bf16_t*)(p.ws + WS_WINT); bf16_t* woutT = (bf16_t*)(p.ws + WS_WOUTT); bf16_t* wmemT = (bf16_t*)(p.ws + WS_WMEMT);
  constexpr int T_IN = 16 * 56, T_OUT = 16 * 16, T_MEM = 16 * 8;
  for (int t = blockIdx.x * 2 + TEAM; t < T_IN + T_OUT + T_MEM; t += gridDim.x * 2) {
    if (t < T_IN) transpose_tile(p.w_in, PROJ, winT, 1024, (t / 56) * 64, (t % 56) * 64);
    else if (t < T_IN + T_OUT) { const int u = t - T_IN; transpose_tile(p.w_out, 1024, woutT, 1024, (u >> 4) * 64, (u & 15) * 64); }
    else { const int u = t - T_IN - T_OUT; transpose_tile(p.w_mem, 512, wmemT, 1024, (u >> 3) * 64, (u & 7) * 64); }
  }
  float2* rope = (float2*)(p.ws + WS_ROPE);
  for (int idx = blockIdx.x * 512 + threadIdx.x; idx < SEQ * 32; idx += gridDim.x * 512) {
    const int pos = idx >> 5, i = idx & 31;
    const double inv = exp(-(double)i * (9.210340371976184 / 32.0));
    const double rev = (double)pos * inv * 0.15915494309189535;
    const double fr = rev - rint(rev);
    const float a = (float)(fr * 6.283185307179586);
    rope[idx] = make_float2(cosf(a), sinf(a));
  }
  const int G = gridDim.x;
  const long gtid = (long)blockIdx.x * 512 + threadIdx.x, gsz = (long)G * 512;
  {
    bf16_t* XB = (bf16_t*)(p.ws + WS_XB); bf16_t* MB = (bf16_t*)(p.ws + WS_MB);
    const long nxp = (long)NTOKP * 1024 / 8, nxs = (long)NTOKS * 1024 / 8, nmb = (long)NB * NMEM * 1024 / 8;
    for (long u = gtid; u < nxp + nxs + nmb; u += gsz) {
      const float* src; bf16_t* dst;
      if (u < nxp) { src = p.xp + u * 8; dst = XB + u * 8; }
      else if (u < nxp + nxs) { src = p.xs + (u - nxp) * 8; dst = XB + u * 8; }
      else { src = p.memp + (u - nxp - nxs) * 8; dst = MB + (u - nxp - nxs) * 8; }
      const float4 a0 = *(const float4*)(src), a1 = *(const float4*)(src + 4);
      u32x4 v; v.x = cvtpk(a0.x, a0.y); v.y = cvtpk(a0.z, a0.w); v.z = cvtpk(a1.x, a1.y); v.w = cvtpk(a1.z, a1.w);
      *(u32x4*)dst = v;
    }
  }
  convert_rows(p.cak, (bf16_t*)(p.ws + WS_SAK), RA * 256 / 8, SAK_ROWS * 256 / 8, gtid, gsz);
  convert_rows(p.cav, (bf16_t*)(p.ws + WS_SAV), RA * 256 / 8, SAK_ROWS * 256 / 8, gtid, gsz);
  convert_rows(p.cbk, (bf16_t*)(p.ws + WS_SBK), PAST * 512 / 8, SBK_ROWS * 512 / 8, gtid, gsz);
  convert_rows(p.cbv, (bf16_t*)(p.ws + WS_SBV), PAST * 512 / 8, SBK_ROWS * 512 / 8, gtid, gsz);
  convert_rows(p.cmk, (bf16_t*)(p.ws + WS_SMK), NMEM * 256 / 8, NMEM * 256 / 8, gtid, gsz);
  convert_rows(p.cmv, (bf16_t*)(p.ws + WS_SMV), NMEM * 256 / 8, NMEM * 256 / 8, gtid, gsz);
}

constexpr int G_RS = 144, GA_BYTES = 128 * G_RS, GB_BYTES = 256 * G_RS, G_STAGE = GA_BYTES + GB_BYTES;
DI void gemm_core(const bf16_t* __restrict__ Ap, int lda, const bf16_t* __restrict__ Bp, int ldb, int K, f32x16 (&acc)[2][2]) {
  const int tid = threadIdx.x, lane = tid & 63, w = tid >> 6, wm = w >> 2, wn = w & 3, r = lane & 31, h = lane >> 5;
#pragma unroll
  for (int a = 0; a < 2; ++a)
#pragma unroll
    for (int b = 0; b < 2; ++b)
#pragma unroll
      for (int i = 0; i < 16; ++i) acc[a][b][i] = 0.f;
  u32x4 ra0[2], rb0[4], ra1[2], rb1[4];
  const int lrow = tid >> 3, lch = tid & 7;
  const bf16_t* Ag = Ap + (long)lrow * lda + lch * 8;
  const bf16_t* Bg = Bp + (long)lrow * ldb + lch * 8;
#define G_LOAD(RA, RB, kt)                                                                                      \
  {                                                                                                             \
    _Pragma("unroll") for (int i = 0; i < 2; ++i) RA[i] = *(const u32x4*)(Ag + (long)(64 * i) * lda + (kt) * 64); \
    _Pragma("unroll") for (int i = 0; i < 4; ++i) RB[i] = *(const u32x4*)(Bg + (long)(64 * i) * ldb + (kt) * 64); \
  }
#define G_WRITE(RA, RB, buf)                                                                                    \
  {                                                                                                             \
    char* Ab_ = g_lds_all + (buf) * G_STAGE; char* Bb_ = Ab_ + GA_BYTES;                                        \
    _Pragma("unroll") for (int i = 0; i < 2; ++i) *(u32x4*)(Ab_ + (lrow + 64 * i) * G_RS + lch * 16) = RA[i];   \
    _Pragma("unroll") for (int i = 0; i < 4; ++i) *(u32x4*)(Bb_ + (lrow + 64 * i) * G_RS + lch * 16) = RB[i];   \
  }
#define G_COMPUTE(buf)                                                                                          \
  {                                                                                                             \
    const char* Ab = g_lds_all + (buf) * G_STAGE; const char* Bb = Ab + GA_BYTES;                               \
    _Pragma("unroll") for (int s = 0; s < 4; ++s) {                                                             \
      const int co = (16 * s + 8 * h) * 2;                                                                      \
      const bf16x8 a0 = *(const bf16x8*)(Ab + (wm * 64 + r) * G_RS + co);                                       \
      const bf16x8 a1 = *(const bf16x8*)(Ab + (wm * 64 + 32 + r) * G_RS + co);                                  \
      const bf16x8 b0 = *(const bf16x8*)(Bb + (wn * 64 + r) * G_RS + co);                                       \
      const bf16x8 b1 = *(const bf16x8*)(Bb + (wn * 64 + 32 + r) * G_RS + co);                                  \
      acc[0][0] = MFMA32(a0, b0, acc[0][0]);                                                                    \
      acc[0][1] = MFMA32(a0, b1, acc[0][1]);                                                                    \
      acc[1][0] = MFMA32(a1, b0, acc[1][0]);                                                                    \
      acc[1][1] = MFMA32(a1, b1, acc[1][1]);                                                                    \
    }                                                                                                           \
  }
  const int nk = K >> 6;
  G_LOAD(ra0, rb0, 0);
  G_LOAD(ra1, rb1, 1);
  G_WRITE(ra0, rb0, 0);
  __syncthreads();
  for (int kt = 0; kt < nk; kt += 2) {
    if (kt + 2 < nk) G_LOAD(ra0, rb0, kt + 2);
    G_COMPUTE(0);
    G_WRITE(ra1, rb1, 1);
    __syncthreads();
    if (kt + 3 < nk) G_LOAD(ra1, rb1, kt + 3);
    G_COMPUTE(1);
    if (kt + 2 < nk) G_WRITE(ra0, rb0, 0);
    __syncthreads();
  }
#undef G_COMPUTE
#undef G_LOAD
#undef G_WRITE
}

DI void proj_epilogue(const Params& p, int mt, int nt, f32x16 (&acc)[2][2]) {
  const int tid = threadIdx.x, lane = tid & 63, w = tid >> 6, wm = w >> 2, wn = w & 3, c = lane & 31, h = lane >> 5;
  const int n0 = nt * 256 + wn * 64;
  char* ws = p.ws; float* out = p.out; char* ob = (char*)p.out;
  const float2* rope = (const float2*)(ws + WS_ROPE);
  int seg, cb;
  if (n0 < 256) { seg = 0; cb = n0; }
  else if (n0 < 512) { seg = 1; cb = n0 - 256; }
  else if (n0 < 768) { seg = 2; cb = n0 - 512; }
  else if (n0 < 1280) { seg = 3; cb = n0 - 768; }
  else if (n0 < 1792) { seg = 4; cb = n0 - 1280; }
  else if (n0 < 2304) { seg = 5; cb = n0 - 1792; }
  else if (n0 < 2560) { seg = 6; cb = n0 - 2304; }
  else { seg = 7; cb = n0 - 2560; }
  const int col0 = cb + c, col1 = cb + c + 32;
  if (seg == 3 || seg == 4) {
#pragma unroll
    for (int mi = 0; mi < 2; ++mi) {
      float2 cs[16];
#pragma unroll
      for (int i = 0; i < 16; ++i) {
        const int tok = mt * 128 + wm * 64 + mi * 32 + (i & 3) + 8 * (i >> 2) + 4 * h;
        const int pos = (tok >= NTOKP) ? (PAST + ((tok - NTOKP) & 15)) : (tok & (SEQ - 1));
        cs[i] = rope[pos * 32 + c];
      }
#pragma unroll
      for (int i = 0; i < 16; ++i) {
        const float v0 = acc[mi][0][i], v1 = acc[mi][1][i];
        acc[mi][0][i] = v0 * cs[i].x - v1 * cs[i].y;
        acc[mi][1][i] = v1 * cs[i].x + v0 * cs[i].y;
      }
    }
  }
#pragma unroll
  for (int mi = 0; mi < 2; ++mi) {
#pragma unroll
    for (int i = 0; i < 16; ++i) {
      const int tok = mt * 128 + wm * 64 + mi * 32 + (i & 3) + 8 * (i >> 2) + 4 * h;
      float v0 = acc[mi][0][i], v1 = acc[mi][1][i];
      const bool smp = tok >= NTOKP;
      const int ts = tok - NTOKP, sb = ts >> 4, st = ts & 15;
      const int pb = tok >> 13, ps = tok & (SEQ - 1);
      if (seg == 0) {
        bf16_t* q = (bf16_t*)(ob + OB_AQ) + (long)tok * 256;
        q[col0] = f2bf(v0 * QSCALE); q[col1] = f2bf(v1 * QSCALE);
      } else if (seg == 1 || seg == 2) {
        bf16_t* kw; float* o = nullptr;
        if (!smp) {
          kw = (bf16_t*)(ob + (seg == 1 ? OB_AK : OB_AV)) + (long)tok * 256;
          if (ps >= SEQ - RA) o = out + (seg == 1 ? O_AKP : O_AVP) + (long)(pb * RA + ps - (SEQ - RA)) * 256;
        } else {
          kw = (bf16_t*)(ws + (seg == 1 ? WS_SAK : WS_SAV)) + (long)(sb * SAK_ROWS + RA + st) * 256;
          o = out + (seg == 1 ? O_AKS : O_AVS) + (long)ts * 256;
        }
        kw[col0] = f2bf(v0); kw[col1] = f2bf(v1);
        if (o) { o[col0] = v0; o[col1] = v1; }
      } else if (seg == 3) {
        bf16_t* q = (bf16_t*)(ob + OB_BQ) + (long)tok * 512;
        q[col0] = f2bf(v0 * QSCALE); q[col1] = f2bf(v1 * QSCALE);
      } else if (seg == 4 || seg == 5) {
        bf16_t* kw; float* o;
        if (!smp) {
          kw = (seg == 4 ? (bf16_t*)(ob + OB_BK) : (bf16_t*)(ws + WS_BV)) + (long)tok * 512;
          o = out + (seg == 4 ? O_BKP : O_BVP) + (long)tok * 512;
        } else {
          kw = (bf16_t*)(ws + (seg == 4 ? WS_SBK : WS_SBV)) + (long)(sb * SBK_ROWS + PAST + st) * 512;
          o = out + (seg == 4 ? O_BKS : O_BVS) + (long)ts * 512;
        }
        kw[col0] = f2bf(v0); kw[col1] = f2bf(v1);
        o[col0] = v0; o[col1] = v1;
      } else if (seg == 6) {
        bf16_t* q = (bf16_t*)(ob + OB_MQ) + (long)tok * 256;
        q[col0] = f2bf(v0 * QSCALE); q[col1] = f2bf(v1 * QSCALE);
      } else {
        bf16_t* g = (bf16_t*)(ws + WS_G) + (long)tok * 1024;
        const float s0 = v0 / (1.f + __expf(-v0)), s1 = v1 / (1.f + __expf(-v1));
        g[col0] = f2bf(s0); g[col1] = f2bf(s1);
      }
    }
  }
}

DI void mem_epilogue(const Params& p, int mt, int nt, f32x16 (&acc)[2][2]) {
  const int tid = threadIdx.x, lane = tid & 63, w = tid >> 6, wm = w >> 2, wn = w & 3, c = lane & 31, h = lane >> 5;
  const int n0 = nt * 256 + wn * 64;
  const bool isv = n0 >= 256;
  const int cb = isv ? n0 - 256 : n0;
  bf16_t* kw = (bf16_t*)(p.ws + (isv ? WS_MV : WS_MK));
  float* o = p.out + (isv ? O_MVP : O_MKP);
#pragma unroll
  for (int mi = 0; mi < 2; ++mi)
#pragma unroll
    for (int i = 0; i < 16; ++i) {
      const long row = mt * 128 + wm * 64 + mi * 32 + (i & 3) + 8 * (i >> 2) + 4 * h;
      const float v0 = acc[mi][0][i], v1 = acc[mi][1][i];
      kw[row * 256 + cb + c] = f2bf(v0); kw[row * 256 + cb + c + 32] = f2bf(v1);
      o[row * 256 + cb + c] = v0; o[row * 256 + cb + c + 32] = v1;
    }
}

DI void phase1(const Params& p) {
  constexpr int MT = NTOK / 128, NT = PROJ / 256, T1 = MT * NT, T2 = 8 * 2;
  const int G = gridDim.x;
  const int vid = (blockIdx.x & 7) * (G >> 3) + (blockIdx.x >> 3);
  const bf16_t* winT = (const bf16_t*)(p.ws + WS_WINT); const bf16_t* wmemT = (const bf16_t*)(p.ws + WS_WMEMT);
  const bf16_t* XB = (const bf16_t*)(p.ws + WS_XB); const bf16_t* MB = (const bf16_t*)(p.ws + WS_MB);
  f32x16 acc[2][2];
  for (int t = vid; t < T1 + T2; t += G) {
    if (t < T1) {
      const int mt = t / NT, nt = t - mt * NT;
      gemm_core(XB + (long)mt * 128 * 1024, 1024, winT + (long)nt * 256 * 1024, 1024, 1024, acc);
      proj_epilogue(p, mt, nt, acc);
    } else {
      const int u = t - T1, mt = u >> 1, nt = u & 1;
      gemm_core(MB + (long)mt * 128 * 1024, 1024, wmemT + (long)nt * 256 * 1024, 1024, 1024, acc);
      mem_epilogue(p, mt, nt, acc);
    }
  }
}

struct AttnItem {
  const bf16_t* q; const bf16_t* k; const bf16_t* v; bf16_t* g;
  int qs, ks, nkeys, rows, qpos0, kpos0, head0; bool bias;
};
constexpr int AK_RS = 272, AK_BYTES = 64 * AK_RS, AV_BYTES = 16384, A_BUF = AK_BYTES + AV_BYTES;
constexpr int A_BIAS_OFF = 2 * A_BUF;
constexpr int A_ITEM_OFF = 73728;

template <bool DIFF>
DI void attn_item(const AttnItem& it, float lam, const float* __restrict__ subg) {
  const int tid = threadIdx.x & 255, lane = tid & 63, w = tid >> 6, qh = w & 1, m = w >> 1, r = lane & 31, h = lane >> 5;
  constexpr int NDT = DIFF ? 4 : 2;
  const int ntiles = (it.nkeys + 63) >> 6;
  bf16x8 qf[4];
  {
    const bf16_t* qp = it.q + (long)(qh * 32 + r) * it.qs + m * 64 + 8 * h;
#pragma unroll
    for (int s = 0; s < 4; ++s) qf[s] = *(const bf16x8*)(qp + 16 * s);
  }
  f32x16 oacc[NDT];
#pragma unroll
  for (int d = 0; d < NDT; ++d)
#pragma unroll
    for (int i = 0; i < 16; ++i) oacc[d][i] = 0.f;
  float m_run = -1e30f, l_run = 0.f;
  u32x4 rk[4], rv[4];
  const int kch = tid & 15, krow = tid >> 4, vsub = tid & 3, vkey = tid >> 2;
  const bf16_t* kg = it.k + (long)krow * it.ks + kch * 8;
  const bf16_t* vg = it.v + (long)vkey * it.ks + vsub * 8;
#define A_LOAD(t)                                                                                                \
  {                                                                                                              \
    _Pragma("unroll") for (int i = 0; i < 4; ++i) rk[i] = *(const u32x4*)(kg + (long)((t) * 64 + 16 * i) * it.ks); \
    _Pragma("unroll") for (int i = 0; i < 4; ++i) rv[i] = *(const u32x4*)(vg + (long)((t) * 64) * it.ks + 32 * i); \
  }
#define A_WRITE(buf)                                                                                             \
  {                                                                                                              \
    char* Kb_ = g_lds + (buf) * A_BUF; char* Vb_ = Kb_ + AK_BYTES;                                               \
    _Pragma("unroll") for (int i = 0; i < 4; ++i) *(u32x4*)(Kb_ + (krow + 16 * i) * AK_RS + kch * 16) = rk[i];   \
    _Pragma("unroll") for (int i = 0; i < 4; ++i) *(u32x4*)(Vb_ + i * 4096 + vkey * 64 + vsub * 16) = rv[i];     \
  }
  A_LOAD(0);
  A_WRITE(0);
  __syncthreads();
  const int vlane = ((lane >> 4) & 1) * 32 + (lane & 3) * 8 + (4 * h + ((lane & 15) >> 2)) * 64;
  const float* biasT = (const float*)(g_lds + A_BIAS_OFF) + (it.head0 + m) * 257;
  const int qpos = it.qpos0 + qh * 32 + r;
  for (int t = 0; t < ntiles; ++t) {
    if (t + 1 < ntiles) A_LOAD(t + 1);
    const char* Kb = g_lds + (t & 1) * A_BUF; const char* Vb = Kb + AK_BYTES;
    f32x16 s0, s1;
#pragma unroll
    for (int i = 0; i < 16; ++i) { s0[i] = 0.f; s1[i] = 0.f; }
#pragma unroll
    for (int s = 0; s < 4; ++s) {
      const int co = (m * 64 + 16 * s + 8 * h) * 2;
      const bf16x8 k0 = *(const bf16x8*)(Kb + r * AK_RS + co);
      const bf16x8 k1 = *(const bf16x8*)(Kb + (32 + r) * AK_RS + co);
      s0 = MFMA32(k0, qf[s], s0);
      s1 = MFMA32(k1, qf[s], s1);
    }
    if (it.bias) {
      const int kb = it.kpos0 + t * 64 + 4 * h;
#pragma unroll
      for (int i = 0; i < 16; ++i) {
        const int kk = kb + (i & 3) + 8 * (i >> 2);
        int d0 = qpos - kk, d1 = d0 - 32;
        d0 = min(max(d0, -128), 128) + 128; d1 = min(max(d1, -128), 128) + 128;
        s0[i] += biasT[d0]; s1[i] += biasT[d1];
      }
    }
    if ((t + 1) * 64 > it.nkeys) {
      const int kb = t * 64 + 4 * h;
#pragma unroll
      for (int i = 0; i < 16; ++i) {
        const int kk = kb + (i & 3) + 8 * (i >> 2);
        if (kk >= it.nkeys) s0[i] = -1e30f;
        if (kk + 32 >= it.nkeys) s1[i] = -1e30f;
      }
    }
    float mx = fmaxf(s0[0], s1[0]);
#pragma unroll
    for (int i = 1; i < 16; ++i) mx = fmaxf(mx, fmaxf(s0[i], s1[i]));
    mx = fmaxf(mx, xor32f(mx));
    const float m_new = fmaxf(m_run, mx);
    const float alpha = fexp2(m_run - m_new);
    if (__builtin_amdgcn_ballot_w64(m_new > m_run) != 0ull) {
#pragma unroll
      for (int d = 0; d < NDT; ++d)
#pragma unroll
        for (int i = 0; i < 16; ++i) oacc[d][i] *= alpha;
    }
    l_run *= alpha;
    m_run = m_new;
    float ls = 0.f;
#pragma unroll
    for (int i = 0; i < 16; ++i) { s0[i] = fexp2(s0[i] - m_new); s1[i] = fexp2(s1[i] - m_new); ls += s0[i] + s1[i]; }
    l_run += ls;
    bf16x8 pf[4];
#pragma unroll
    for (int s2 = 0; s2 < 2; ++s2) {
      u32x4 a, b;
      a.x = cvtpk(s0[8 * s2 + 0], s0[8 * s2 + 1]); a.y = cvtpk(s0[8 * s2 + 2], s0[8 * s2 + 3]);
      a.z = cvtpk(s0[8 * s2 + 4], s0[8 * s2 + 5]); a.w = cvtpk(s0[8 * s2 + 6], s0[8 * s2 + 7]);
      b.x = cvtpk(s1[8 * s2 + 0], s1[8 * s2 + 1]); b.y = cvtpk(s1[8 * s2 + 2], s1[8 * s2 + 3]);
      b.z = cvtpk(s1[8 * s2 + 4], s1[8 * s2 + 5]); b.w = cvtpk(s1[8 * s2 + 6], s1[8 * s2 + 7]);
      pf[s2] = __builtin_bit_cast(bf16x8, a); pf[2 + s2] = __builtin_bit_cast(bf16x8, b);
    }
    const LDS3 char* vb3 = (const LDS3 char*)(Vb) + vlane + (DIFF ? 0 : m * 2 * 4096);
#pragma unroll
    for (int d = 0; d < NDT; ++d) {
#pragma unroll
      for (int ks = 0; ks < 4; ++ks) {
        const s16x4 lo = __builtin_bit_cast(s16x4, __builtin_amdgcn_ds_read_tr16_b64_v4i16((LDS3 s16x4*)(vb3 + d * 4096 + ks * 1024)));
        const s16x4 hi = __builtin_bit_cast(s16x4, __builtin_amdgcn_ds_read_tr16_b64_v4i16((LDS3 s16x4*)(vb3 + d * 4096 + ks * 1024 + 512)));
        const bf16x8 vf = __builtin_shufflevector(lo, hi, 0, 1, 2, 3, 4, 5, 6, 7);
        oacc[d] = MFMA32(vf, pf[ks], oacc[d]);
      }
    }
    if (t + 1 < ntiles) A_WRITE((t + 1) & 1);
    __syncthreads();
  }
#undef A_LOAD
#undef A_WRITE
  const float l_tot = l_run + xor32f(l_run);
  const float inv = 1.f / l_tot;
  const int q = qh * 32 + r;
  if (!DIFF) {
    if (q < it.rows) {
      bf16_t* gp = it.g + (long)q * 1024 + m * 64 + 4 * h;
      u32x2 gvv[NDT][4];
#pragma unroll
      for (int d = 0; d < NDT; ++d)
#pragma unroll
        for (int g4 = 0; g4 < 4; ++g4) gvv[d][g4] = *(const u32x2*)(gp + d * 32 + 8 * g4);
#pragma unroll
      for (int d = 0; d < NDT; ++d)
#pragma unroll
        for (int g4 = 0; g4 < 4; ++g4) {
          u32x2* ptr = (u32x2*)(gp + d * 32 + 8 * g4);
          const u32x2 gv = gvv[d][g4];
          u32x2 o;
          o.x = cvtpk(oacc[d][4 * g4 + 0] * inv * bflo(gv.x), oacc[d][4 * g4 + 1] * inv * bfhi(gv.x));
          o.y = cvtpk(oacc[d][4 * g4 + 2] * inv * bflo(gv.y), oacc[d][4 * g4 + 3] * inv * bfhi(gv.y));
          *ptr = o;
        }
    }
  } else {
    float* xb = (float*)g_lds + qh * 4096 + lane;
    if (m == 1) {
      const float sc = lam * inv;
#pragma unroll
      for (int d = 0; d < NDT; ++d)
#pragma unroll
        for (int i = 0; i < 16; ++i) xb[(d * 16 + i) * 64] = oacc[d][i] * sc;
    }
    __syncthreads();
    if (m == 0) {
      float ss = 0.f;
#pragma unroll
      for (int d = 0; d < NDT; ++d)
#pragma unroll
        for (int i = 0; i < 16; ++i) { const float o = oacc[d][i] * inv - xb[(d * 16 + i) * 64]; oacc[d][i] = o; ss += o * o; }
      ss += xor32f(ss);
      const float rn = rsqrtf(ss * (1.f / 128.f) + 1e-5f) * 0.8f;
      if (q < it.rows) {
        bf16_t* gp = it.g + (long)q * 1024 + 4 * h;
        u32x2 gvv[NDT][4];
#pragma unroll
        for (int d = 0; d < NDT; ++d)
#pragma unroll
          for (int g4 = 0; g4 < 4; ++g4) gvv[d][g4] = *(const u32x2*)(gp + d * 32 + 8 * g4);
#pragma unroll
        for (int d = 0; d < NDT; ++d)
#pragma unroll
          for (int g4 = 0; g4 < 4; ++g4) {
            const float4 sg = *(const float4*)(subg + d * 32 + 8 * g4 + 4 * h);
            u32x2* ptr = (u32x2*)(gp + d * 32 + 8 * g4);
            const u32x2 gv = gvv[d][g4];
            u32x2 o;
            o.x = cvtpk(oacc[d][4 * g4 + 0] * rn * sg.x * bflo(gv.x), oacc[d][4 * g4 + 1] * rn * sg.y * bfhi(gv.x));
            o.y = cvtpk(oacc[d][4 * g4 + 2] * rn * sg.z * bflo(gv.y), oacc[d][4 * g4 + 3] * rn * sg.w * bfhi(gv.y));
            *ptr = o;
          }
      }
    }
    __syncthreads();
  }
}

DI void phase2(const Params& p) {
  char* ws = p.ws;
  const int tid = threadIdx.x & 255;
  float* biasT = (float*)(g_lds + A_BIAS_OFF);
  for (int i = tid; i < 4 * 257; i += 256) biasT[i] = p.relb[i] * LOG2E;
  float s1 = 0.f, s2 = 0.f;
  for (int i = 0; i < 64; ++i) { s1 += p.dlam[i] * p.dlam[64 + i]; s2 += p.dlam[128 + i] * p.dlam[192 + i]; }
  const float lam = expf(s1) - expf(s2) + 0.2f;
  __syncthreads();
  int* ctr = (int*)(ws + WS_CTR);
  int* s_item = (int*)(g_lds + A_ITEM_OFF);
  const char* ob = (const char*)p.out;
  const bf16_t* AQ = (const bf16_t*)(ob + OB_AQ); const bf16_t* AK = (const bf16_t*)(ob + OB_AK); const bf16_t* AV = (const bf16_t*)(ob + OB_AV);
  const bf16_t* BQ = (const bf16_t*)(ob + OB_BQ); const bf16_t* BK = (const bf16_t*)(ob + OB_BK); const bf16_t* BV = (const bf16_t*)(ws + WS_BV);
  const bf16_t* MQ = (const bf16_t*)(ob + OB_MQ); const bf16_t* MK = (const bf16_t*)(ws + WS_MK); const bf16_t* MV = (const bf16_t*)(ws + WS_MV);
  const bf16_t* SAK = (const bf16_t*)(ws + WS_SAK); const bf16_t* SAV = (const bf16_t*)(ws + WS_SAV);
  const bf16_t* SBK = (const bf16_t*)(ws + WS_SBK); const bf16_t* SBV = (const bf16_t*)(ws + WS_SBV);
  const bf16_t* SMK = (const bf16_t*)(ws + WS_SMK); const bf16_t* SMV = (const bf16_t*)(ws + WS_SMV);
  bf16_t* G = (bf16_t*)(ws + WS_G);
  constexpr int N_BP = 2048, N_BS = 128, N_AP = 1024, N_AS = 64, N_MP = 1024, N_MS = 64;
  constexpr int N_ALL = N_BP + N_BS + N_AP + N_AS + N_MP + N_MS;
  int* s_pair = (int*)(g_lds_all + 2 * TEAM_LDS);
  (void)s_item;
  for (;;) {
    if (threadIdx.x == 0) *s_pair = atomicAdd(ctr, 1);
    __syncthreads();
    const int pair = *s_pair;
    __syncthreads();
    if (pair >= N_ALL / 2) break;
    int item = 2 * pair + TEAM;
    AttnItem it;
    it.bias = false; it.qpos0 = 0; it.kpos0 = 0; it.head0 = 0; it.rows = 64;
    if (item < N_BP) {
      const int c = 127 - (item >> 4), bh = item & 15, b = bh >> 2, hh = bh & 3;
      const long tok0 = (long)b * SEQ + c * 64;
      it.q = BQ + tok0 * 512 + hh * 128; it.k = BK + (long)b * SEQ * 512 + hh * 128; it.v = BV + (long)b * SEQ * 512 + hh * 128;
      it.qs = 512; it.ks = 512; it.nkeys = (c + 1) * 64; it.g = G + tok0 * 1024 + 256 + hh * 128;
      attn_item<true>(it, lam, p.subg);
      continue;
    }
    item -= N_BP;
    if (item < N_BS) {
      const int b = item >> 2, hh = item & 3;
      const long tok0 = NTOKP + b * ST;
      it.q = BQ + tok0 * 512 + hh * 128; it.k = SBK + (long)b * SBK_ROWS * 512 + hh * 128; it.v = SBV + (long)b * SBK_ROWS * 512 + hh * 128;
      it.qs = 512; it.ks = 512; it.nkeys = PAST + ST; it.rows = ST; it.g = G + tok0 * 1024 + 256 + hh * 128;
      attn_item<true>(it, lam, p.subg);
      continue;
    }
    item -= N_BS;
    if (item < N_AP) {
      const int c = 127 - (item >> 3), bh = item & 7, b = bh >> 1, hp = bh & 1;
      const int cs = c > 8 ? c - 8 : 0;
      const long tok0 = (long)b * SEQ + c * 64, k0 = (long)b * SEQ + cs * 64;
      it.q = AQ + tok0 * 256 + hp * 128; it.k = AK + k0 * 256 + hp * 128; it.v = AV + k0 * 256 + hp * 128;
      it.qs = 256; it.ks = 256; it.nkeys = (c - cs + 1) * 64; it.g = G + tok0 * 1024 + hp * 128;
      it.bias = true; it.qpos0 = c * 64; it.kpos0 = cs * 64; it.head0 = hp * 2;
    } else if ((item -= N_AP) < N_AS) {
      const int b = item >> 1, hp = item & 1;
      const long tok0 = NTOKP + b * ST;
      it.q = AQ + tok0 * 256 + hp * 128; it.k = SAK + (long)b * SAK_ROWS * 256 + hp * 128; it.v = SAV + (long)b * SAK_ROWS * 256 + hp * 128;
      it.qs = 256; it.ks = 256; it.nkeys = RA + ST; it.rows = ST; it.g = G + tok0 * 1024 + hp * 128;
      it.bias = true; it.qpos0 = RA; it.kpos0 = 0; it.head0 = hp * 2;
    } else if ((item -= N_AS) < N_MP) {
      const int c = item >> 3, bh = item & 7, b = bh >> 1, hp = bh & 1;
      const long tok0 = (long)b * SEQ + c * 64;
      it.q = MQ + tok0 * 256 + hp * 128; it.k = MK + (long)b * NMEM * 256 + hp * 128; it.v = MV + (long)b * NMEM * 256 + hp * 128;
      it.qs = 256; it.ks = 256; it.nkeys = NMEM; it.g = G + tok0 * 1024 + 768 + hp * 128;
    } else {
      item -= N_MP;
      const int b = item >> 1, hp = item & 1;
      const long tok0 = NTOKP + b * ST;
      it.q = MQ + tok0 * 256 + hp * 128; it.k = SMK + (long)b * NMEM * 256 + hp * 128; it.v = SMV + (long)b * NMEM * 256 + hp * 128;
      it.qs = 256; it.ks = 256; it.nkeys = NMEM; it.rows = ST; it.g = G + tok0 * 1024 + 768 + hp * 128;
    }
    attn_item<false>(it, lam, p.subg);
  }
}

DI void phase3(const Params& p) {
  constexpr int MT = NTOK / 128, NT = 4, T3 = MT * NT;
  const int G = gridDim.x;
  const int vid = (blockIdx.x & 7) * (G >> 3) + (blockIdx.x >> 3);
  const bf16_t* Gm = (const bf16_t*)(p.ws + WS_G); const bf16_t* woutT = (const bf16_t*)(p.ws + WS_WOUTT);
  const int tid = threadIdx.x, lane = tid & 63, w = tid >> 6, wm = w >> 2, wn = w & 3, c = lane & 31, h = lane >> 5;
  f32x16 acc[2][2];
  for (int t = vid; t < T3; t += G) {
    const int mt = t >> 2, nt = t & 3;
    gemm_core(Gm + (long)mt * 128 * 1024, 1024, woutT + (long)nt * 256 * 1024, 1024, 1024, acc);
    const float* xrow = (mt < NTOKP / 128) ? p.xp + (long)mt * 128 * 1024 : p.xs + (long)(mt - NTOKP / 128) * 128 * 1024;
    float* orow = p.out + O_Y + (long)mt * 128 * 1024;
    const int col = nt * 256 + wn * 64 + c;
#pragma unroll
    for (int mi = 0; mi < 2; ++mi) {
      float x0[16], x1[16];
#pragma unroll
      for (int i = 0; i < 16; ++i) {
        const long row = wm * 64 + mi * 32 + (i & 3) + 8 * (i >> 2) + 4 * h;
        x0[i] = xrow[row * 1024 + col]; x1[i] = xrow[row * 1024 + col + 32];
      }
#pragma unroll
      for (int i = 0; i < 16; ++i) {
        const long row = wm * 64 + mi * 32 + (i & 3) + 8 * (i >> 2) + 4 * h;
        orow[row * 1024 + col] = acc[mi][0][i] + ALPHA * x0[i];
        orow[row * 1024 + col + 32] = acc[mi][1][i] + ALPHA * x1[i];
      }
    }
  }
}

DI void phase4(const Params& p) {
  const int lane = threadIdx.x & 63, w = threadIdx.x >> 6;
  for (int row = blockIdx.x * 8 + w; row < NTOK; row += gridDim.x * 8) {
    float* y = p.out + O_Y + (long)row * 1024;
    float4 v[4];
#pragma unroll
    for (int j = 0; j < 4; ++j) v[j] = *(const float4*)(y + j * 256 + lane * 4);
    float s = 0.f;
#pragma unroll
    for (int j = 0; j < 4; ++j) s += v[j].x + v[j].y + v[j].z + v[j].w;
#pragma unroll
    for (int o = 1; o < 64; o <<= 1) s += __shfl_xor(s, o);
    const float mu = s * (1.f / 1024.f);
    float q = 0.f;
#pragma unroll
    for (int j = 0; j < 4; ++j) { const float a = v[j].x - mu, b = v[j].y - mu, c = v[j].z - mu, d = v[j].w - mu; q += a * a + b * b + c * c + d * d; }
#pragma unroll
    for (int o = 1; o < 64; o <<= 1) q += __shfl_xor(q, o);
    const float rs = rsqrtf(q * (1.f / 1024.f) + 1e-5f);
#pragma unroll
    for (int j = 0; j < 4; ++j) {
      const float4 g = *(const float4*)(p.ln_g + j * 256 + lane * 4), b = *(const float4*)(p.ln_b + j * 256 + lane * 4);
      float4 o;
      o.x = (v[j].x - mu) * rs * g.x + b.x; o.y = (v[j].y - mu) * rs * g.y + b.y; o.z = (v[j].z - mu) * rs * g.z + b.z; o.w = (v[j].w - mu) * rs * g.w + b.w;
      *(float4*)(y + j * 256 + lane * 4) = o;
    }
  }
}

DI void grid_barrier(unsigned* bar, unsigned target) {
  asm volatile("s_waitcnt vmcnt(0) lgkmcnt(0)" ::: "memory");
  __builtin_amdgcn_fence(__ATOMIC_RELEASE, "agent");
  asm volatile("s_waitcnt vmcnt(0)" ::: "memory");
  __syncthreads();
  if (threadIdx.x == 0) {
    __hip_atomic_fetch_add(bar, 1u, __ATOMIC_RELAXED, __HIP_MEMORY_SCOPE_AGENT);
    while (__hip_atomic_load(bar, __ATOMIC_RELAXED, __HIP_MEMORY_SCOPE_AGENT) < target) __builtin_amdgcn_s_sleep(4);
  }
  __syncthreads();
  __builtin_amdgcn_fence(__ATOMIC_ACQUIRE, "agent");
  asm volatile("s_waitcnt vmcnt(0)" ::: "memory");
}
__global__ void __launch_bounds__(512) fwd_megakernel(Params p) {
  cg::grid_group grid = cg::this_grid();
  unsigned* bar = (unsigned*)(p.ws + WS_CTR + 64);
  const unsigned nb = gridDim.x;
  phase0(p);
  grid.sync();
  grid_barrier(bar, nb);
  phase1(p);
  grid_barrier(bar, 2 * nb);
  phase2(p);
  grid_barrier(bar, 3 * nb);
  phase3(p);
  grid_barrier(bar, 4 * nb);
  phase4(p);
}

extern "C" void kernel_launch(void* const* d_in, const int* in_sizes, int n_in, void* d_out, int out_size,
                              void* d_ws, size_t ws_size, hipStream_t stream) {
  static int grid_blocks = 0;
  if (!grid_blocks) {
    int dev = 0, cus = 0, per_cu = 0;
    (void)hipGetDevice(&dev);
    (void)hipDeviceGetAttribute(&cus, hipDeviceAttributeMultiprocessorCount, dev);
    (void)hipOccupancyMaxActiveBlocksPerMultiprocessor(&per_cu, fwd_megakernel, 512, 0);
    if (per_cu > 1) per_cu = 1;
    if (per_cu < 1) per_cu = 1;
    grid_blocks = cus * per_cu;
    if (ws_size < WS_END || out_size != (int)O_END) fprintf(stderr, "kernel_launch: unexpected sizes ws %zu (need %zu) out %d (need %ld)\n", ws_size, (size_t)WS_END, out_size, (long)O_END);
  }
  (void)hipMemsetAsync((char*)d_ws + WS_CTR, 0, 256, stream);
  Params p{};
  p.xp = (const float*)d_in[0]; p.xs = (const float*)d_in[1];
  p.cak = (const float*)d_in[2]; p.cav = (const float*)d_in[3]; p.cbk = (const float*)d_in[4]; p.cbv = (const float*)d_in[5];
  p.cmk = (const float*)d_in[6]; p.cmv = (const float*)d_in[7];
  p.memp = (const float*)d_in[8]; p.w_in = (const float*)d_in[9]; p.w_mem = (const float*)d_in[10]; p.relb = (const float*)d_in[11];
  p.dlam = (const float*)d_in[12]; p.subg = (const float*)d_in[13]; p.w_out = (const float*)d_in[14]; p.ln_g = (const float*)d_in[15]; p.ln_b = (const float*)d_in[16];
  p.out = (float*)d_out; p.ws = (char*)d_ws;
  void* args[] = {&p};
  hipError_t e = hipLaunchCooperativeKernel((void*)fwd_megakernel, dim3(grid_blocks), dim3(512), args, 0, stream);
  if (e != hipSuccess) fprintf(stderr, "cooperative launch failed: %s (grid %d)\n", hipGetErrorString(e), grid_blocks);
}
```

```cpp
#include <hip/hip_runtime.h>
#include <hip/hip_cooperative_groups.h>
#include <cstdio>
#include <cstdint>
namespace cg = cooperative_groups;

typedef unsigned short bf16_t;
typedef short bf16x8 __attribute__((ext_vector_type(8)));
typedef short s16x4 __attribute__((ext_vector_type(4)));
typedef float f32x16 __attribute__((ext_vector_type(16)));
typedef float f32x2_t __attribute__((ext_vector_type(2)));
typedef __bf16 bf16x2_t __attribute__((ext_vector_type(2)));
typedef unsigned u32x2 __attribute__((ext_vector_type(2)));
typedef unsigned u32x4 __attribute__((ext_vector_type(4)));
#define DI __device__ __forceinline__
#define MFMA32(a, b, c) __builtin_amdgcn_mfma_f32_32x32x16_bf16((a), (b), (c), 0, 0, 0)
#define LDS3 __attribute__((address_space(3)))

constexpr int D_MODEL = 1024, SEQ = 8192, NB = 4, NTOKP = NB * SEQ, SB = 32, ST = 16, NTOKS = SB * ST, NTOK = NTOKP + NTOKS;
constexpr int PAST = 1024, RA = 512, NMEM = 256, PROJ = 3584;
constexpr int SAK_ROWS = 576, SBK_ROWS = 1088;
constexpr int NTOKPAD = NTOK + 64;
constexpr float QSCALE = 0.125f * 1.4426950408889634f;
constexpr float LOG2E = 1.4426950408889634f;
constexpr float ALPHA = 1.189207115002721f;

constexpr long O_Y = 0;
constexpr long O_AKP = (long)NTOK * 1024;
constexpr long O_AVP = O_AKP + (long)NB * RA * 256;
constexpr long O_BKP = O_AVP + (long)NB * RA * 256;
constexpr long O_BVP = O_BKP + (long)NTOKP * 512;
constexpr long O_MKP = O_BVP + (long)NTOKP * 512;
constexpr long O_MVP = O_MKP + (long)NB * NMEM * 256;
constexpr long O_AKS = O_MVP + (long)NB * NMEM * 256;
constexpr long O_AVS = O_AKS + (long)NTOKS * 256;
constexpr long O_BKS = O_AVS + (long)NTOKS * 256;
constexpr long O_BVS = O_BKS + (long)NTOKS * 512;
constexpr long O_END = O_BVS + (long)NTOKS * 512;

constexpr size_t WS_CTR = 0;
constexpr size_t WS_WINT = 256;
constexpr size_t WS_WOUTT = WS_WINT + (size_t)PROJ * 1024 * 2;
constexpr size_t WS_WMEMT = WS_WOUTT + (size_t)1024 * 1024 * 2;
constexpr size_t WS_ROPE = WS_WMEMT + (size_t)512 * 1024 * 2;
constexpr size_t OB_AQ = 0;
constexpr size_t OB_BQ = OB_AQ + (size_t)NTOKPAD * 256 * 2;
constexpr size_t OB_MQ = OB_BQ + (size_t)NTOKPAD * 512 * 2;
constexpr size_t OB_AK = OB_MQ + (size_t)NTOKPAD * 256 * 2;
constexpr size_t OB_AV = OB_AK + (size_t)NTOKP * 256 * 2;
constexpr size_t OB_BK = OB_AV + (size_t)NTOKP * 256 * 2;
constexpr size_t OB_END = OB_BK + (size_t)NTOKP * 512 * 2;
static_assert(OB_END <= (size_t)NTOK * 1024 * 4, "temporaries must fit in the y region");
constexpr size_t WS_BV = WS_ROPE + (size_t)SEQ * 32 * 8;
constexpr size_t WS_G = WS_BV + (size_t)NTOKP * 512 * 2;
constexpr size_t WS_MK = WS_G + (size_t)NTOK * 1024 * 2;
constexpr size_t WS_MV = WS_MK + (size_t)NB * NMEM * 256 * 2;
constexpr size_t WS_SAK = WS_MV + (size_t)NB * NMEM * 256 * 2;
constexpr size_t WS_SAV = WS_SAK + (size_t)SB * SAK_ROWS * 256 * 2;
constexpr size_t WS_SBK = WS_SAV + (size_t)SB * SAK_ROWS * 256 * 2;
constexpr size_t WS_SBV = WS_SBK + (size_t)SB * SBK_ROWS * 512 * 2;
constexpr size_t WS_SMK = WS_SBV + (size_t)SB * SBK_ROWS * 512 * 2;
constexpr size_t WS_SMV = WS_SMK + (size_t)SB * NMEM * 256 * 2;
constexpr size_t WS_XB = WS_SMV + (size_t)SB * NMEM * 256 * 2;
constexpr size_t WS_MB = WS_XB + (size_t)NTOK * 1024 * 2;
constexpr size_t WS_END = WS_MB + (size_t)NB * NMEM * 1024 * 2;
static_assert(WS_END <= (size_t)512 * 1024 * 1024, "workspace budget");

struct Params {
  const float* xp; const float* xs;
  const float* cak; const float* cav; const float* cbk; const float* cbv; const float* cmk; const float* cmv;
  const float* memp; const float* w_in; const float* w_mem; const float* relb; const float* dlam; const float* subg;
  const float* w_out; const float* ln_g; const float* ln_b;
  float* out; char* ws;
};

constexpr int TEAM_LDS = 73728 + 64;
constexpr int LDS_BYTES = 2 * TEAM_LDS + 64;
__shared__ __attribute__((aligned(16))) char g_lds_all[LDS_BYTES];
#define TEAM (__builtin_amdgcn_readfirstlane((int)(threadIdx.x >> 8)))
#define g_lds (g_lds_all + TEAM * TEAM_LDS)

DI unsigned cvtpk(float lo, float hi) { f32x2_t v = {lo, hi}; bf16x2_t b = __builtin_convertvector(v, bf16x2_t); return __builtin_bit_cast(unsigned, b); }
DI bf16_t f2bf(float x) { return (bf16_t)(cvtpk(x, 0.f) & 0xffffu); }
DI float bf2f(unsigned short b) { return __uint_as_float(((unsigned)b) << 16); }
DI float bflo(unsigned u) { return __uint_as_float(u << 16); }
DI float bfhi(unsigned u) { return __uint_as_float(u & 0xffff0000u); }
DI float fexp2(float x) { return __builtin_amdgcn_exp2f(x); }
DI float xor32f(float v) { return __shfl_xor(v, 32); }

DI void transpose_tile(const float* __restrict__ src, int N, bf16_t* __restrict__ dst, int K, int k0, int n0) {
  float* tile = (float*)g_lds;
  const int tid = threadIdx.x & 255, c = tid & 63, r0 = tid >> 6;
#pragma unroll
  for (int i = 0; i < 16; ++i) { const int row = r0 + 4 * i; tile[row * 65 + c] = src[(long)(k0 + row) * N + n0 + c]; }
  __syncthreads();
#pragma unroll
  for (int i = 0; i < 16; ++i) { const int rr = r0 + 4 * i; dst[(long)(n0 + rr) * K + k0 + c] = f2bf(tile[c * 65 + rr]); }
  __syncthreads();
}

DI void convert_rows(const float* __restrict__ src, bf16_t* __restrict__ dst, int rows_w8, int dst_bstride_w8, long gtid, long gsz) {
  const long total = (long)SB * rows_w8;
  for (long u = gtid; u < total; u += gsz) {
    const int b = (int)(u / rows_w8); const int j = (int)(u - (long)b * rows_w8);
    const float4 a0 = *(const float4*)(src + u * 8), a1 = *(const float4*)(src + u * 8 + 4);
    u32x4 v; v.x = cvtpk(a0.x, a0.y); v.y = cvtpk(a0.z, a0.w); v.z = cvtpk(a1.x, a1.y); v.w = cvtpk(a1.z, a1.w);
    *(u32x4*)(dst + ((long)b * dst_bstride_w8 + j) * 8) = v;
  }
}

DI void phase0(const Params& p) {
  bf16_t* winT = (bf16_t*)(p.ws + WS_WINT); bf16_t* woutT = (bf16_t*)(p.ws + WS_WOUTT); bf16_t* wmemT = (bf16_t*)(p.ws + WS_WMEMT);
  constexpr int T_IN = 16 * 56, T_OUT = 16 * 16, T_MEM = 16 * 8;
  for (int t = blockIdx.x * 2 + TEAM; t < T_IN + T_OUT + T_MEM; t += gridDim.x * 2) {
    if (t < T_IN) transpose_tile(p.w_in, PROJ, winT, 1024, (t / 56) * 64, (t % 56) * 64);
    else if (t < T_IN + T_OUT) { const int u = t - T_IN; transpose_tile(p.w_out, 1024, woutT, 1024, (u >> 4) * 64, (u & 15) * 64); }
    else { const int u = t - T_IN - T_OUT; transpose_tile(p.w_mem, 512, wmemT, 1024, (u >> 3) * 64, (u & 7) * 64); }
  }
  float2* rope = (float2*)(p.ws + WS_ROPE);
  for (int idx = blockIdx.x * 512 + threadIdx.x; idx < SEQ * 32; idx += gridDim.x * 512) {
    const int pos = idx >> 5, i = idx & 31;
    const double inv = exp(-(double)i * (9.210340371976184 / 32.0));
    const double rev = (double)pos * inv * 0.15915494309189535;
    const double fr = rev - rint(rev);
    const float a = (float)(fr * 6.283185307179586);
    rope[idx] = make_float2(cosf(a), sinf(a));
  }
  const int G = gridDim.x;
  const long gtid = (long)blockIdx.x * 512 + threadIdx.x, gsz = (long)G * 512;
  {
    bf16_t* XB = (bf16_t*)(p.ws + WS_XB); bf16_t* MB = (bf16_t*)(p.ws + WS_MB);
    const long nxp = (long)NTOKP * 1024 / 8, nxs = (long)NTOKS * 1024 / 8, nmb = (long)NB * NMEM * 1024 / 8;
    for (long u = gtid; u < nxp + nxs + nmb; u += gsz) {
      const float* src; bf16_t* dst;
      if (u < nxp) { src = p.xp + u * 8; dst = XB + u * 8; }
      else if (u < nxp + nxs) { src = p.xs + (u - nxp) * 8; dst = XB + u * 8; }
      else { src = p.memp + (u - nxp - nxs) * 8; dst = MB + (u - nxp - nxs) * 8; }
      const float4 a0 = *(const float4*)(src), a1 = *(const float4*)(src + 4);
      u32x4 v; v.x = cvtpk(a0.x, a0.y); v.y = cvtpk(a0.z, a0.w); v.z = cvtpk(a1.x, a1.y); v.w = cvtpk(a1.z, a1.w);
      *(u32x4*)dst = v;
    }
  }
  convert_rows(p.cak, (bf16_t*)(p.ws + WS_SAK), RA * 256 / 8, SAK_ROWS * 256 / 8, gtid, gsz);
  convert_rows(p.cav, (bf16_t*)(p.ws + WS_SAV), RA * 256 / 8, SAK_ROWS * 256 / 8, gtid, gsz);
  convert_rows(p.cbk, (bf16_t*)(p.ws + WS_SBK), PAST * 512 / 8, SBK_ROWS * 512 / 8, gtid, gsz);
  convert_rows(p.cbv, (bf16_t*)(p.ws + WS_SBV), PAST * 512 / 8, SBK_ROWS * 512 / 8, gtid, gsz);
  convert_rows(p.cmk, (bf16_t*)(p.ws + WS_SMK), NMEM * 256 / 8, NMEM * 256 / 8, gtid, gsz);
  convert_rows(p.cmv, (bf16_t*)(p.ws + WS_SMV), NMEM * 256 / 8, NMEM * 256 / 8, gtid, gsz);
}

constexpr int G_RS = 144, GA_BYTES = 128 * G_RS, GB_BYTES = 256 * G_RS, G_STAGE = GA_BYTES + GB_BYTES;
DI void gemm_core(const bf16_t* __restrict__ Ap, int lda, const bf16_t* __restrict__ Bp, int ldb, int K, f32x16 (&acc)[2][2]) {
  const int tid = threadIdx.x, lane = tid & 63, w = tid >> 6, wm = w >> 2, wn = w & 3, r = lane & 31, h = lane >> 5;
#pragma unroll
  for (int a = 0; a < 2; ++a)
#pragma unroll
    for (int b = 0; b < 2; ++b)
#pragma unroll
      for (int i = 0; i < 16; ++i) acc[a][b][i] = 0.f;
  u32x4 ra0[2], rb0[4], ra1[2], rb1[4];
  const int lrow = tid >> 3, lch = tid & 7;
  const bf16_t* Ag = Ap + (long)lrow * lda + lch * 8;
  const bf16_t* Bg = Bp + (long)lrow * ldb + lch * 8;
#define G_LOAD(RA, RB, kt)                                                                                      \
  {                                                                                                             \
    _Pragma("unroll") for (int i = 0; i < 2; ++i) RA[i] = *(const u32x4*)(Ag + (long)(64 * i) * lda + (kt) * 64); \
    _Pragma("unroll") for (int i = 0; i < 4; ++i) RB[i] = *(const u32x4*)(Bg + (long)(64 * i) * ldb + (kt) * 64); \
  }
#define G_WRITE(RA, RB, buf)                                                                                    \
  {                                                                                                             \
    char* Ab_ = g_lds_all + (buf) * G_STAGE; char* Bb_ = Ab_ + GA_BYTES;                                        \
    _Pragma("unroll") for (int i = 0; i < 2; ++i) *(u32x4*)(Ab_ + (lrow + 64 * i) * G_RS + lch * 16) = RA[i];   \
    _Pragma("unroll") for (int i = 0; i < 4; ++i) *(u32x4*)(Bb_ + (lrow + 64 * i) * G_RS + lch * 16) = RB[i];   \
  }
#define G_COMPUTE(buf)                                                                                          \
  {                                                                                                             \
    const char* Ab = g_lds_all + (buf) * G_STAGE; const char* Bb = Ab + GA_BYTES;                               \
    _Pragma("unroll") for (int s = 0; s < 4; ++s) {                                                             \
      const int co = (16 * s + 8 * h) * 2;                                                                      \
      const bf16x8 a0 = *(const bf16x8*)(Ab + (wm * 64 + r) * G_RS + co);                                       \
      const bf16x8 a1 = *(const bf16x8*)(Ab + (wm * 64 + 32 + r) * G_RS + co);                                  \
      const bf16x8 b0 = *(const bf16x8*)(Bb + (wn * 64 + r) * G_RS + co);                                       \
      const bf16x8 b1 = *(const bf16x8*)(Bb + (wn * 64 + 32 + r) * G_RS + co);                                  \
      acc[0][0] = MFMA32(a0, b0, acc[0][0]);                                                                    \
      acc[0][1] = MFMA32(a0, b1, acc[0][1]);                                                                    \
      acc[1][0] = MFMA32(a1, b0, acc[1][0]);                                                                    \
      acc[1][1] = MFMA32(a1, b1, acc[1][1]);                                                                    \
    }                                                                                                           \
  }
  const int nk = K >> 6;
  G_LOAD(ra0, rb0, 0);
  G_LOAD(ra1, rb1, 1);
  G_WRITE(ra0, rb0, 0);
  __syncthreads();
  for (int kt = 0; kt < nk; kt += 2) {
    if (kt + 2 < nk) G_LOAD(ra0, rb0, kt + 2);
    G_COMPUTE(0);
    G_WRITE(ra1, rb1, 1);
    __syncthreads();
    if (kt + 3 < nk) G_LOAD(ra1, rb1, kt + 3);
    G_COMPUTE(1);
    if (kt + 2 < nk) G_WRITE(ra0, rb0, 0);
    __syncthreads();
  }
#undef G_COMPUTE
#undef G_LOAD
#undef G_WRITE
}

DI void proj_epilogue(const Params& p, int mt, int nt, f32x16 (&acc)[2][2]) {
  const int tid = threadIdx.x, lane = tid & 63, w = tid >> 6, wm = w >> 2, wn = w & 3, c = lane & 31, h = lane >> 5;
  const int n0 = nt * 256 + wn * 64;
  char* ws = p.ws; float* out = p.out; char* ob = (char*)p.out;
  const float2* rope = (const float2*)(ws + WS_ROPE);
  int seg, cb;
  if (n0 < 256) { seg = 0; cb = n0; }
  else if (n0 < 512) { seg = 1; cb = n0 - 256; }
  else if (n0 < 768) { seg = 2; cb = n0 - 512; }
  else if (n0 < 1280) { seg = 3; cb = n0 - 768; }
  else if (n0 < 1792) { seg = 4; cb = n0 - 1280; }
  else if (n0 < 2304) { seg = 5; cb = n0 - 1792; }
  else if (n0 < 2560) { seg = 6; cb = n0 - 2304; }
  else { seg = 7; cb = n0 - 2560; }
  const int col0 = cb + c, col1 = cb + c + 32;
  if (seg == 3 || seg == 4) {
#pragma unroll
    for (int mi = 0; mi < 2; ++mi) {
      float2 cs[16];
#pragma unroll
      for (int i = 0; i < 16; ++i) {
        const int tok = mt * 128 + wm * 64 + mi * 32 + (i & 3) + 8 * (i >> 2) + 4 * h;
        const int pos = (tok >= NTOKP) ? (PAST + ((tok - NTOKP) & 15)) : (tok & (SEQ - 1));
        cs[i] = rope[pos * 32 + c];
      }
#pragma unroll
      for (int i = 0; i < 16; ++i) {
        const float v0 = acc[mi][0][i], v1 = acc[mi][1][i];
        acc[mi][0][i] = v0 * cs[i].x - v1 * cs[i].y;
        acc[mi][1][i] = v1 * cs[i].x + v0 * cs[i].y;
      }
    }
  }
#pragma unroll
  for (int mi = 0; mi < 2; ++mi) {
#pragma unroll
    for (int i = 0; i < 16; ++i) {
      const int tok = mt * 128 + wm * 64 + mi * 32 + (i & 3) + 8 * (i >> 2) + 4 * h;
      float v0 = acc[mi][0][i], v1 = acc[mi][1][i];
      const bool smp = tok >= NTOKP;
      const int ts = tok - NTOKP, sb = ts >> 4, st = ts & 15;
      const int pb = tok >> 13, ps = tok & (SEQ - 1);
      if (seg == 0) {
        bf16_t* q = (bf16_t*)(ob + OB_AQ) + (long)tok * 256;
        q[col0] = f2bf(v0 * QSCALE); q[col1] = f2bf(v1 * QSCALE);
      } else if (seg == 1 || seg == 2) {
        bf16_t* kw; float* o = nullptr;
        if (!smp) {
          kw = (bf16_t*)(ob + (seg == 1 ? OB_AK : OB_AV)) + (long)tok * 256;
          if (ps >= SEQ - RA) o = out + (seg == 1 ? O_AKP : O_AVP) + (long)(pb * RA + ps - (SEQ - RA)) * 256;
        } else {
          kw = (bf16_t*)(ws + (seg == 1 ? WS_SAK : WS_SAV)) + (long)(sb * SAK_ROWS + RA + st) * 256;
          o = out + (seg == 1 ? O_AKS : O_AVS) + (long)ts * 256;
        }
        kw[col0] = f2bf(v0); kw[col1] = f2bf(v1);
        if (o) { o[col0] = v0; o[col1] = v1; }
      } else if (seg == 3) {
        bf16_t* q = (bf16_t*)(ob + OB_BQ) + (long)tok * 512;
        q[col0] = f2bf(v0 * QSCALE); q[col1] = f2bf(v1 * QSCALE);
      } else if (seg == 4 || seg == 5) {
        bf16_t* kw; float* o;
        if (!smp) {
          kw = (seg == 4 ? (bf16_t*)(ob + OB_BK) : (bf16_t*)(ws + WS_BV)) + (long)tok * 512;
          o = out + (seg == 4 ? O_BKP : O_BVP) + (long)tok * 512;
        } else {
          kw = (bf16_t*)(ws + (seg == 4 ? WS_SBK : WS_SBV)) + (long)(sb * SBK_ROWS + PAST + st) * 512;
          o = out + (seg == 4 ? O_BKS : O_BVS) + (long)ts * 512;
        }
        kw[col0] = f2bf(v0); kw[col1] = f2bf(v1);
        o[col0] = v0; o[col1] = v1;
      } else if (seg == 6) {
        bf16_t* q = (bf16_t*)(ob + OB_MQ) + (long)tok * 256;
        q[col0] = f2bf(v0 * QSCALE); q[col1] = f2bf(v1 * QSCALE);
      } else {
        bf16_t* g = (bf16_t*)(ws + WS_G) + (long)tok * 1024;
        const float s0 = v0 / (1.f + __expf(-v0)), s1 = v1 / (1.f + __expf(-v1));
        g[col0] = f2bf(s0); g[col1] = f2bf(s1);
      }
    }
  }
}

DI void mem_epilogue(const Params& p, int mt, int nt, f32x16 (&acc)[2][2]) {
  const int tid = threadIdx.x, lane = tid & 63, w = tid >> 6, wm = w >> 2, wn = w & 3, c = lane & 31, h = lane >> 5;
  const int n0 = nt * 256 + wn * 64;
  const bool isv = n0 >= 256;
  const int cb = isv ? n0 - 256 : n0;
  bf16_t* kw = (bf16_t*)(p.ws + (isv ? WS_MV : WS_MK));
  float* o = p.out + (isv ? O_MVP : O_MKP);
#pragma unroll
  for (int mi = 0; mi < 2; ++mi)
#pragma unroll
    for (int i = 0; i < 16; ++i) {
      const long row = mt * 128 + wm * 64 + mi * 32 + (i & 3) + 8 * (i >> 2) + 4 * h;
      const float v0 = acc[mi][0][i], v1 = acc[mi][1][i];
      kw[row * 256 + cb + c] = f2bf(v0); kw[row * 256 + cb + c + 32] = f2bf(v1);
      o[row * 256 + cb + c] = v0; o[row * 256 + cb + c + 32] = v1;
    }
}

DI void phase1(const Params& p) {
  constexpr int MT = NTOK / 128, NT = PROJ / 256, T1 = MT * NT, T2 = 8 * 2;
  const int G = gridDim.x;
  const int vid = (blockIdx.x & 7) * (G >> 3) + (blockIdx.x >> 3);
  const bf16_t* winT = (const bf16_t*)(p.ws + WS_WINT); const bf16_t* wmemT = (const bf16_t*)(p.ws + WS_WMEMT);
  const bf16_t* XB = (const bf16_t*)(p.ws + WS_XB); const bf16_t* MB = (const bf16_t*)(p.ws + WS_MB);
  f32x16 acc[2][2];
  for (int t = vid; t < T1 + T2; t += G) {
    if (t < T1) {
      const int mt = t / NT, nt = t - mt * NT;
      gemm_core(XB + (long)mt * 128 * 1024, 1024, winT + (long)nt * 256 * 1024, 1024, 1024, acc);
      proj_epilogue(p, mt, nt, acc);
    } else {
      const int u = t - T1, mt = u >> 1, nt = u & 1;
      gemm_core(MB + (long)mt * 128 * 1024, 1024, wmemT + (long)nt * 256 * 1024, 1024, 1024, acc);
      mem_epilogue(p, mt, nt, acc);
    }
  }
}

struct AttnItem {
  const bf16_t* q0; const bf16_t* q1;
  const bf16_t* k; const bf16_t* v;
  bf16_t* g0; bf16_t* g1;
  int qs, ks, ntiles, nkeys;
  int tlo0, thi0, tlo1, thi1;
  int rows0, rows1;
  int qpos0, qpos1, kpos0, head0; bool bias;
};
constexpr int AK_RS = 272, AK_BYTES = 64 * AK_RS, AV_BYTES = 16384, A_BUF = AK_BYTES + AV_BYTES;
constexpr int A_BIAS_OFF = 2 * A_BUF;
constexpr int A_ITEM_OFF = 2 * TEAM_LDS;
constexpr int A_Q_OFF = 73728;

template <bool DIFF, bool BIAS>
DI void attn_item(const AttnItem& it, float lam, const float* __restrict__ subg) {
  const int tid = threadIdx.x, lane = tid & 63, w = tid >> 6, r = lane & 31, h = lane >> 5;
  const int half = __builtin_amdgcn_readfirstlane(w >> 2), qh = w & 1, m = (w >> 1) & 1;
  constexpr int NDT = DIFF ? 4 : 2;
  const int ntiles = it.ntiles;
  const int tlo = half ? it.tlo1 : it.tlo0, thi = half ? it.thi1 : it.thi0, rows = half ? it.rows1 : it.rows0;
  const bf16_t* qbase = half ? it.q1 : it.q0;
  bf16_t* gbase = half ? it.g1 : it.g0;
  char* qlds = g_lds_all + A_Q_OFF + w * 4096 + lane * 16;
  {
    const bf16_t* qp = qbase + (long)(qh * 32 + r) * it.qs + m * 64 + 8 * h;
#pragma unroll
    for (int s = 0; s < 4; ++s) *(bf16x8*)(qlds + s * 1024) = *(const bf16x8*)(qp + 16 * s);
  }
  f32x16 oacc[NDT];
#pragma unroll
  for (int d = 0; d < NDT; ++d)
#pragma unroll
    for (int i = 0; i < 16; ++i) oacc[d][i] = 0.f;
  float m_run = -1e30f, l_run = 0.f;
  u32x4 rk0[2], rv0[2];
  const int kch = tid & 15, krow = tid >> 4, vsub = tid & 3, vkey = (tid >> 2) & 63, vd = tid >> 8;
  const bf16_t* kg = it.k + (long)krow * it.ks + kch * 8;
  const bf16_t* vg = it.v + (long)vkey * it.ks + vd * 32 + vsub * 8;
#define A_LOAD(RK, RV, t)                                                                                        \
  {                                                                                                              \
    _Pragma("unroll") for (int i = 0; i < 2; ++i) RK[i] = *(const u32x4*)(kg + (long)((t) * 64 + 32 * i) * it.ks); \
    _Pragma("unroll") for (int i = 0; i < 2; ++i) RV[i] = *(const u32x4*)(vg + (long)((t) * 64) * it.ks + 64 * i); \
  }
#define A_WRITE(RK, RV, stage)                                                                                   \
  {                                                                                                              \
    char* Kb_ = g_lds_all + (stage) * A_BUF; char* Vb_ = Kb_ + AK_BYTES;                                         \
    _Pragma("unroll") for (int i = 0; i < 2; ++i) *(u32x4*)(Kb_ + (krow + 32 * i) * AK_RS + kch * 16) = RK[i];   \
    _Pragma("unroll") for (int i = 0; i < 2; ++i) *(u32x4*)(Vb_ + (vd + 2 * i) * 4096 + vkey * 64 + vsub * 16) = RV[i]; \
  }
  const int vlane = ((lane >> 4) & 1) * 32 + (lane & 3) * 8 + (4 * h + ((lane & 15) >> 2)) * 64;
  const float* biasT = (const float*)(g_lds_all + A_BIAS_OFF) + (it.head0 + m) * 257;
  const int qpos = (half ? it.qpos1 : it.qpos0) + qh * 32 + r;
#define A_COMPUTE(t, stage)                                                                                      \
  if ((t) >= tlo && (t) < thi) {                                                                                 \
    const char* Kb = g_lds_all + (stage) * A_BUF; const char* Vb = Kb + AK_BYTES;                                \
    f32x16 s0, s1;                                                                                               \
    _Pragma("unroll") for (int i = 0; i < 16; ++i) { s0[i] = 0.f; s1[i] = 0.f; }                                 \
    _Pragma("unroll") for (int s = 0; s < 4; ++s) {                                                              \
      const int co = (m * 64 + 16 * s + 8 * h) * 2;                                                              \
      const bf16x8 k0 = *(const bf16x8*)(Kb + r * AK_RS + co);                                                   \
      const bf16x8 k1 = *(const bf16x8*)(Kb + (32 + r) * AK_RS + co);                                            \
      const bf16x8 qfs = *(const bf16x8*)(qlds + s * 1024);                                                      \
      s0 = MFMA32(k0, qfs, s0);                                                                                  \
      s1 = MFMA32(k1, qfs, s1);                                                                                  \
    }                                                                                                            \
    if (BIAS) {                                                                                                  \
      const int kb = it.kpos0 + (t) * 64 + 4 * h;                                                                \
      _Pragma("unroll") for (int i = 0; i < 16; ++i) {                                                           \
        const int kk = kb + (i & 3) + 8 * (i >> 2);                                                              \
        int d0 = qpos - kk, d1 = d0 - 32;                                                                        \
        d0 = min(max(d0, -128), 128) + 128; d1 = min(max(d1, -128), 128) + 128;                                  \
        s0[i] += biasT[d0]; s1[i] += biasT[d1];                                                                  \
      }                                                                                                          \
    }                                                                                                            \
    if (((t) + 1) * 64 > it.nkeys) {                                                                             \
      const int kb = (t) * 64 + 4 * h;                                                                           \
      _Pragma("unroll") for (int i = 0; i < 16; ++i) {                                                           \
        const int kk = kb + (i & 3) + 8 * (i >> 2);                                                              \
        if (kk >= it.nkeys) s0[i] = -1e30f;                                                                      \
        if (kk + 32 >= it.nkeys) s1[i] = -1e30f;                                                                 \
      }                                                                                                          \
    }                                                                                                            \
    float mx = fmaxf(s0[0], s1[0]);                                                                              \
    _Pragma("unroll") for (int i = 1; i < 16; ++i) mx = fmaxf(mx, fmaxf(s0[i], s1[i]));                          \
    mx = fmaxf(mx, xor32f(mx));                                                                                  \
    const float m_new = fmaxf(m_run, mx);                                                                        \
    const float alpha = fexp2(m_run - m_new);                                                                    \
    if (__builtin_amdgcn_ballot_w64(m_new > m_run) != 0ull) {                                                    \
      _Pragma("unroll") for (int d = 0; d < NDT; ++d)                                                            \
        _Pragma("unroll") for (int i = 0; i < 16; ++i) oacc[d][i] *= alpha;                                      \
    }                                                                                                            \
    l_run *= alpha;                                                                                              \
    m_run = m_new;                                                                                               \
    float ls = 0.f;                                                                                              \
    _Pragma("unroll") for (int i = 0; i < 16; ++i) { s0[i] = fexp2(s0[i] - m_new); s1[i] = fexp2(s1[i] - m_new); ls += s0[i] + s1[i]; } \
    l_run += ls;                                                                                                 \
    bf16x8 pf[4];                                                                                                \
    _Pragma("unroll") for (int s2 = 0; s2 < 2; ++s2) {                                                           \
      u32x4 a, b;                                                                                                \
      a.x = cvtpk(s0[8 * s2 + 0], s0[8 * s2 + 1]); a.y = cvtpk(s0[8 * s2 + 2], s0[8 * s2 + 3]);                  \
      a.z = cvtpk(s0[8 * s2 + 4], s0[8 * s2 + 5]); a.w = cvtpk(s0[8 * s2 + 6], s0[8 * s2 + 7]);                  \
      b.x = cvtpk(s1[8 * s2 + 0], s1[8 * s2 + 1]); b.y = cvtpk(s1[8 * s2 + 2], s1[8 * s2 + 3]);                  \
      b.z = cvtpk(s1[8 * s2 + 4], s1[8 * s2 + 5]); b.w = cvtpk(s1[8 * s2 + 6], s1[8 * s2 + 7]);                  \
      pf[s2] = __builtin_bit_cast(bf16x8, a); pf[2 + s2] = __builtin_bit_cast(bf16x8, b);                        \
    }                                                                                                            \
    const LDS3 char* vb3 = (const LDS3 char*)(Vb) + vlane + (DIFF ? 0 : m * 2 * 4096);                           \
    _Pragma("unroll") for (int ks = 0; ks < 4; ++ks) {                                                           \
      _Pragma("unroll") for (int d = 0; d < NDT; ++d) {                                                          \
        const s16x4 lo = __builtin_bit_cast(s16x4, __builtin_amdgcn_ds_read_tr16_b64_v4i16((LDS3 s16x4*)(vb3 + d * 4096 + ks * 1024))); \
        const s16x4 hi = __builtin_bit_cast(s16x4, __builtin_amdgcn_ds_read_tr16_b64_v4i16((LDS3 s16x4*)(vb3 + d * 4096 + ks * 1024 + 512))); \
        const bf16x8 vf = __builtin_shufflevector(lo, hi, 0, 1, 2, 3, 4, 5, 6, 7);                               \
        oacc[d] = MFMA32(vf, pf[ks], oacc[d]);                                                                   \
      }                                                                                                          \
      __builtin_amdgcn_sched_barrier(0);                                                                         \
    }                                                                                                            \
  }
  A_LOAD(rk0, rv0, 0);
  A_WRITE(rk0, rv0, 0);
  if (ntiles > 1) A_LOAD(rk0, rv0, 1);
  __syncthreads();
#pragma unroll 1
  for (int t = 0; t < ntiles; ++t) {
    const int par = t & 1;
    if (t + 1 < ntiles) A_WRITE(rk0, rv0, par ^ 1);
    if (t + 2 < ntiles) A_LOAD(rk0, rv0, t + 2);
    A_COMPUTE(t, par);
    __syncthreads();
  }
#undef A_LOAD
#undef A_WRITE
#undef A_COMPUTE
  const float l_tot = l_run + xor32f(l_run);
  const float inv = 1.f / l_tot;
  const int q = qh * 32 + r;
  if (!DIFF) {
    if (q < rows) {
      bf16_t* gp = gbase + (long)q * 1024 + m * 64 + 4 * h;
      u32x2 gvv[NDT][4];
#pragma unroll
      for (int d = 0; d < NDT; ++d)
#pragma unroll
        for (int g4 = 0; g4 < 4; ++g4) gvv[d][g4] = *(const u32x2*)(gp + d * 32 + 8 * g4);
#pragma unroll
      for (int d = 0; d < NDT; ++d)
#pragma unroll
        for (int g4 = 0; g4 < 4; ++g4) {
          u32x2* ptr = (u32x2*)(gp + d * 32 + 8 * g4);
          const u32x2 gv = gvv[d][g4];
          u32x2 o;
          o.x = cvtpk(oacc[d][4 * g4 + 0] * inv * bflo(gv.x), oacc[d][4 * g4 + 1] * inv * bfhi(gv.x));
          o.y = cvtpk(oacc[d][4 * g4 + 2] * inv * bflo(gv.y), oacc[d][4 * g4 + 3] * inv * bfhi(gv.y));
          *ptr = o;
        }
    }
  } else {
    float* xb = (float*)g_lds_all + half * 8192 + qh * 4096 + lane;
    if (m == 1) {
      const float sc = lam * inv;
#pragma unroll
      for (int d = 0; d < NDT; ++d)
#pragma unroll
        for (int i = 0; i < 16; ++i) xb[(d * 16 + i) * 64] = oacc[d][i] * sc;
    }
    __syncthreads();
    if (m == 0) {
      float ss = 0.f;
#pragma unroll
      for (int d = 0; d < NDT; ++d)
#pragma unroll
        for (int i = 0; i < 16; ++i) { const float o = oacc[d][i] * inv - xb[(d * 16 + i) * 64]; oacc[d][i] = o; ss += o * o; }
      ss += xor32f(ss);
      const float rn = rsqrtf(ss * (1.f / 128.f) + 1e-5f) * 0.8f;
      if (q < rows) {
        bf16_t* gp = gbase + (long)q * 1024 + 4 * h;
        u32x2 gvv[NDT][4];
#pragma unroll
        for (int d = 0; d < NDT; ++d)
#pragma unroll
          for (int g4 = 0; g4 < 4; ++g4) gvv[d][g4] = *(const u32x2*)(gp + d * 32 + 8 * g4);
#pragma unroll
        for (int d = 0; d < NDT; ++d)
#pragma unroll
          for (int g4 = 0; g4 < 4; ++g4) {
            const float4 sg = *(const float4*)(subg + d * 32 + 8 * g4 + 4 * h);
            u32x2* ptr = (u32x2*)(gp + d * 32 + 8 * g4);
            const u32x2 gv = gvv[d][g4];
            u32x2 o;
            o.x = cvtpk(oacc[d][4 * g4 + 0] * rn * sg.x * bflo(gv.x), oacc[d][4 * g4 + 1] * rn * sg.y * bfhi(gv.x));
            o.y = cvtpk(oacc[d][4 * g4 + 2] * rn * sg.z * bflo(gv.y), oacc[d][4 * g4 + 3] * rn * sg.w * bfhi(gv.y));
            *ptr = o;
          }
      }
    }
    __syncthreads();
  }
}

DI void phase2(const Params& p) {
  char* ws = p.ws;
  float* biasT = (float*)(g_lds_all + A_BIAS_OFF);
  for (int i = threadIdx.x; i < 4 * 257; i += 512) biasT[i] = p.relb[i] * LOG2E;
  float s1 = 0.f, s2 = 0.f;
  for (int i = 0; i < 64; ++i) { s1 += p.dlam[i] * p.dlam[64 + i]; s2 += p.dlam[128 + i] * p.dlam[192 + i]; }
  const float lam = expf(s1) - expf(s2) + 0.2f;
  __syncthreads();
  int* ctr = (int*)(ws + WS_CTR);
  int* s_item = (int*)(g_lds_all + A_ITEM_OFF);
  const char* ob = (const char*)p.out;
  const bf16_t* AQ = (const bf16_t*)(ob + OB_AQ); const bf16_t* AK = (const bf16_t*)(ob + OB_AK); const bf16_t* AV = (const bf16_t*)(ob + OB_AV);
  const bf16_t* BQ = (const bf16_t*)(ob + OB_BQ); const bf16_t* BK = (const bf16_t*)(ob + OB_BK); const bf16_t* BV = (const bf16_t*)(ws + WS_BV);
  const bf16_t* MQ = (const bf16_t*)(ob + OB_MQ); const bf16_t* MK = (const bf16_t*)(ws + WS_MK); const bf16_t* MV = (const bf16_t*)(ws + WS_MV);
  const bf16_t* SAK = (const bf16_t*)(ws + WS_SAK); const bf16_t* SAV = (const bf16_t*)(ws + WS_SAV);
  const bf16_t* SBK = (const bf16_t*)(ws + WS_SBK); const bf16_t* SBV = (const bf16_t*)(ws + WS_SBV);
  const bf16_t* SMK = (const bf16_t*)(ws + WS_SMK); const bf16_t* SMV = (const bf16_t*)(ws + WS_SMV);
  bf16_t* G = (bf16_t*)(ws + WS_G);
  constexpr int N_BP = 1024, N_BS = 128, N_AP = 512, N_AS = 64, N_MP = 512, N_MS = 64;
  constexpr int N_ALL = N_BP + N_BS + N_AP + N_AS + N_MP + N_MS;
  for (;;) {
    if (threadIdx.x == 0) *s_item = atomicAdd(ctr, 1);
    __syncthreads();
    int item = *s_item;
    __syncthreads();
    if (item >= N_ALL) break;
    AttnItem it;
    it.bias = false; it.qpos0 = 0; it.qpos1 = 0; it.kpos0 = 0; it.head0 = 0; it.rows0 = 64; it.rows1 = 64;
    if (item < N_BP) {
      const int j = 63 - (item >> 4), bh = item & 15, b = bh >> 2, hh = bh & 3;
      const long tok0 = (long)b * SEQ + j * 128;
      it.q0 = BQ + tok0 * 512 + hh * 128; it.q1 = it.q0 + 64 * 512;
      it.k = BK + (long)b * SEQ * 512 + hh * 128; it.v = BV + (long)b * SEQ * 512 + hh * 128;
      it.qs = 512; it.ks = 512; it.ntiles = 2 * j + 2; it.nkeys = it.ntiles * 64;
      it.tlo0 = 0; it.thi0 = 2 * j + 1; it.tlo1 = 0; it.thi1 = 2 * j + 2;
      it.g0 = G + tok0 * 1024 + 256 + hh * 128; it.g1 = it.g0 + 64 * 1024;
      attn_item<true, false>(it, lam, p.subg);
      continue;
    }
    item -= N_BP;
    if (item < N_BS) {
      const int b = item >> 2, hh = item & 3;
      const long tok0 = NTOKP + b * ST;
      it.q0 = BQ + tok0 * 512 + hh * 128; it.q1 = it.q0;
      it.k = SBK + (long)b * SBK_ROWS * 512 + hh * 128; it.v = SBV + (long)b * SBK_ROWS * 512 + hh * 128;
      it.qs = 512; it.ks = 512; it.ntiles = 17; it.nkeys = PAST + ST;
      it.tlo0 = 0; it.thi0 = 17; it.tlo1 = 0; it.thi1 = 0; it.rows0 = ST; it.rows1 = 0;
      it.g0 = G + tok0 * 1024 + 256 + hh * 128; it.g1 = it.g0;
      attn_item<true, false>(it, lam, p.subg);
      continue;
    }
    item -= N_BS;
    if (item < N_AP) {
      const int j = 63 - (item >> 3), bh = item & 7, b = bh >> 1, hp = bh & 1;
      const int c0 = 2 * j, c1 = c0 + 1, cs0 = c0 > 8 ? c0 - 8 : 0, cs1 = c1 > 8 ? c1 - 8 : 0;
      const long tok0 = (long)b * SEQ + c0 * 64, k0 = (long)b * SEQ + cs0 * 64;
      it.q0 = AQ + tok0 * 256 + hp * 128; it.q1 = it.q0 + 64 * 256;
      it.k = AK + k0 * 256 + hp * 128; it.v = AV + k0 * 256 + hp * 128;
      it.qs = 256; it.ks = 256; it.ntiles = c1 - cs0 + 1; it.nkeys = it.ntiles * 64;
      it.tlo0 = 0; it.thi0 = c0 - cs0 + 1; it.tlo1 = cs1 - cs0; it.thi1 = it.ntiles;
      it.g0 = G + tok0 * 1024 + hp * 128; it.g1 = it.g0 + 64 * 1024;
      it.bias = true; it.qpos0 = c0 * 64; it.qpos1 = c1 * 64; it.kpos0 = cs0 * 64; it.head0 = hp * 2;
    } else if ((item -= N_AP) < N_AS) {
      const int b = item >> 1, hp = item & 1;
      const long tok0 = NTOKP + b * ST;
      it.q0 = AQ + tok0 * 256 + hp * 128; it.q1 = it.q0;
      it.k = SAK + (long)b * SAK_ROWS * 256 + hp * 128; it.v = SAV + (long)b * SAK_ROWS * 256 + hp * 128;
      it.qs = 256; it.ks = 256; it.ntiles = 9; it.nkeys = RA + ST;
      it.tlo0 = 0; it.thi0 = 9; it.tlo1 = 0; it.thi1 = 0; it.rows0 = ST; it.rows1 = 0;
      it.g0 = G + tok0 * 1024 + hp * 128; it.g1 = it.g0;
      it.bias = true; it.qpos0 = RA; it.qpos1 = RA; it.kpos0 = 0; it.head0 = hp * 2;
    } else if ((item -= N_AS) < N_MP) {
      const int j = item >> 3, bh = item & 7, b = bh >> 1, hp = bh & 1;
      const long tok0 = (long)b * SEQ + j * 128;
      it.q0 = MQ + tok0 * 256 + hp * 128; it.q1 = it.q0 + 64 * 256;
      it.k = MK + (long)b * NMEM * 256 + hp * 128; it.v = MV + (long)b * NMEM * 256 + hp * 128;
      it.qs = 256; it.ks = 256; it.ntiles = 4; it.nkeys = NMEM;
      it.tlo0 = 0; it.thi0 = 4; it.tlo1 = 0; it.thi1 = 4;
      it.g0 = G + tok0 * 1024 + 768 + hp * 128; it.g1 = it.g0 + 64 * 1024;
    } else {
      item -= N_MP;
      const int b = item >> 1, hp = item & 1;
      const long tok0 = NTOKP + b * ST;
      it.q0 = MQ + tok0 * 256 + hp * 128; it.q1 = it.q0;
      it.k = SMK + (long)b * NMEM * 256 + hp * 128; it.v = SMV + (long)b * NMEM * 256 + hp * 128;
      it.qs = 256; it.ks = 256; it.ntiles = 4; it.nkeys = NMEM;
      it.tlo0 = 0; it.thi0 = 4; it.tlo1 = 0; it.thi1 = 0; it.rows0 = ST; it.rows1 = 0;
      it.g0 = G + tok0 * 1024 + 768 + hp * 128; it.g1 = it.g0;
    }
    if (it.bias) attn_item<false, true>(it, lam, p.subg); else attn_item<false, false>(it, lam, p.subg);
  }
}

DI void phase3(const Params& p) {
  constexpr int MT = NTOK / 128, NT = 4, T3 = MT * NT;
  const int G = gridDim.x;
  const int vid = (blockIdx.x & 7) * (G >> 3) + (blockIdx.x >> 3);
  const bf16_t* Gm = (const bf16_t*)(p.ws + WS_G); const bf16_t* woutT = (const bf16_t*)(p.ws + WS_WOUTT);
  const int tid = threadIdx.x, lane = tid & 63, w = tid >> 6, wm = w >> 2, wn = w & 3, c = lane & 31, h = lane >> 5;
  f32x16 acc[2][2];
  for (int t = vid; t < T3; t += G) {
    const int mt = t >> 2, nt = t & 3;
    gemm_core(Gm + (long)mt * 128 * 1024, 1024, woutT + (long)nt * 256 * 1024, 1024, 1024, acc);
    const float* xrow = (mt < NTOKP / 128) ? p.xp + (long)mt * 128 * 1024 : p.xs + (long)(mt - NTOKP / 128) * 128 * 1024;
    float* orow = p.out + O_Y + (long)mt * 128 * 1024;
    const int col = nt * 256 + wn * 64 + c;
#pragma unroll
    for (int mi = 0; mi < 2; ++mi) {
#pragma unroll
      for (int nj = 0; nj < 2; ++nj) {
        float x0[16];
#pragma unroll
        for (int i = 0; i < 16; ++i) {
          const long row = wm * 64 + mi * 32 + (i & 3) + 8 * (i >> 2) + 4 * h;
          x0[i] = xrow[row * 1024 + col + 32 * nj];
        }
#pragma unroll
        for (int i = 0; i < 16; ++i) {
          const long row = wm * 64 + mi * 32 + (i & 3) + 8 * (i >> 2) + 4 * h;
          orow[row * 1024 + col + 32 * nj] = acc[mi][nj][i] + ALPHA * x0[i];
        }
        __builtin_amdgcn_sched_barrier(0);
      }
    }
  }
}

DI void phase4(const Params& p) {
  const int lane = threadIdx.x & 63, w = threadIdx.x >> 6;
  for (int row = blockIdx.x * 8 + w; row < NTOK; row += gridDim.x * 8) {
    float* y = p.out + O_Y + (long)row * 1024;
    float4 v[4];
#pragma unroll
    for (int j = 0; j < 4; ++j) v[j] = *(const float4*)(y + j * 256 + lane * 4);
    float s = 0.f;
#pragma unroll
    for (int j = 0; j < 4; ++j) s += v[j].x + v[j].y + v[j].z + v[j].w;
#pragma unroll
    for (int o = 1; o < 64; o <<= 1) s += __shfl_xor(s, o);
    const float mu = s * (1.f / 1024.f);
    float q = 0.f;
#pragma unroll
    for (int j = 0; j < 4; ++j) { const float a = v[j].x - mu, b = v[j].y - mu, c = v[j].z - mu, d = v[j].w - mu; q += a * a + b * b + c * c + d * d; }
#pragma unroll
    for (int o = 1; o < 64; o <<= 1) q += __shfl_xor(q, o);
    const float rs = rsqrtf(q * (1.f / 1024.f) + 1e-5f);
#pragma unroll
    for (int j = 0; j < 4; ++j) {
      const float4 g = *(const float4*)(p.ln_g + j * 256 + lane * 4), b = *(const float4*)(p.ln_b + j * 256 + lane * 4);
      float4 o;
      o.x = (v[j].x - mu) * rs * g.x + b.x; o.y = (v[j].y - mu) * rs * g.y + b.y; o.z = (v[j].z - mu) * rs * g.z + b.z; o.w = (v[j].w - mu) * rs * g.w + b.w;
      *(float4*)(y + j * 256 + lane * 4) = o;
    }
  }
}

DI void grid_barrier(unsigned* bar, unsigned target) {
  asm volatile("s_waitcnt vmcnt(0) lgkmcnt(0)" ::: "memory");
  __builtin_amdgcn_fence(__ATOMIC_RELEASE, "agent");
  asm volatile("s_waitcnt vmcnt(0)" ::: "memory");
  __syncthreads();
  if (threadIdx.x == 0) {
    __hip_atomic_fetch_add(bar, 1u, __ATOMIC_RELAXED, __HIP_MEMORY_SCOPE_AGENT);
    while (__hip_atomic_load(bar, __ATOMIC_RELAXED, __HIP_MEMORY_SCOPE_AGENT) < target) __builtin_amdgcn_s_sleep(4);
  }
  __syncthreads();
  __builtin_amdgcn_fence(__ATOMIC_ACQUIRE, "agent");
  asm volatile("s_waitcnt vmcnt(0)" ::: "memory");
}
__global__ void __launch_bounds__(512) fwd_megakernel(Params p) {
  cg::grid_group grid = cg::this_grid();
  unsigned* bar = (unsigned*)(p.ws + WS_CTR + 64);
  const unsigned nb = gridDim.x;
  phase0(p);
  grid.sync();
  grid_barrier(bar, nb);
  phase1(p);
  grid_barrier(bar, 2 * nb);
  phase2(p);
  grid_barrier(bar, 3 * nb);
  phase3(p);
  grid_barrier(bar, 4 * nb);
  phase4(p);
}

extern "C" void kernel_launch(void* const* d_in, const int* in_sizes, int n_in, void* d_out, int out_size,
                              void* d_ws, size_t ws_size, hipStream_t stream) {
  static int grid_blocks = 0;
  if (!grid_blocks) {
    int dev = 0, cus = 0, per_cu = 0;
    (void)hipGetDevice(&dev);
    (void)hipDeviceGetAttribute(&cus, hipDeviceAttributeMultiprocessorCount, dev);
    (void)hipOccupancyMaxActiveBlocksPerMultiprocessor(&per_cu, fwd_megakernel, 512, 0);
    if (per_cu > 1) per_cu = 1;
    if (per_cu < 1) per_cu = 1;
    grid_blocks = cus * per_cu;
    if (ws_size < WS_END || out_size != (int)O_END) fprintf(stderr, "kernel_launch: unexpected sizes ws %zu (need %zu) out %d (need %ld)\n", ws_size, (size_t)WS_END, out_size, (long)O_END);
  }
  (void)hipMemsetAsync((char*)d_ws + WS_CTR, 0, 256, stream);
  Params p{};
  p.xp = (const float*)d_in[0]; p.xs = (const float*)d_in[1];
  p.cak = (const float*)d_in[2]; p.cav = (const float*)d_in[3]; p.cbk = (const float*)d_in[4]; p.cbv = (const float*)d_in[5];
  p.cmk = (const float*)d_in[6]; p.cmv = (const float*)d_in[7];
  p.memp = (const float*)d_in[8]; p.w_in = (const float*)d_in[9]; p.w_mem = (const float*)d_in[10]; p.relb = (const float*)d_in[11];
  p.dlam = (const float*)d_in[12]; p.subg = (const float*)d_in[13]; p.w_out = (const float*)d_in[14]; p.ln_g = (const float*)d_in[15]; p.ln_b = (const float*)d_in[16];
  p.out = (float*)d_out; p.ws = (char*)d_ws;
  void* args[] = {&p};
  hipError_t e = hipLaunchCooperativeKernel((void*)fwd_megakernel, dim3(grid_blocks), dim3(512), args, 0, stream);
  if (e != hipSuccess) fprintf(stderr, "cooperative launch failed: %s (grid %d)\n", hipGetErrorString(e), grid_blocks);
}
```

```cpp
#include <hip/hip_runtime.h>
#include <hip/hip_cooperative_groups.h>
#include <cstdio>
#include <cstdint>
namespace cg = cooperative_groups;

typedef unsigned short bf16_t;
typedef short bf16x8 __attribute__((ext_vector_type(8)));
typedef short s16x4 __attribute__((ext_vector_type(4)));
typedef float f32x16 __attribute__((ext_vector_type(16)));
typedef float f32x2_t __attribute__((ext_vector_type(2)));
typedef __bf16 bf16x2_t __attribute__((ext_vector_type(2)));
typedef unsigned u32x2 __attribute__((ext_vector_type(2)));
typedef unsigned u32x4 __attribute__((ext_vector_type(4)));
#define DI __device__ __forceinline__
#define MFMA32(a, b, c) __builtin_amdgcn_mfma_f32_32x32x16_bf16((a), (b), (c), 0, 0, 0)
#define LDS3 __attribute__((address_space(3)))

constexpr int D_MODEL = 1024, SEQ = 8192, NB = 4, NTOKP = NB * SEQ, SB = 32, ST = 16, NTOKS = SB * ST, NTOK = NTOKP + NTOKS;
constexpr int PAST = 1024, RA = 512, NMEM = 256, PROJ = 3584;
constexpr int SAK_ROWS = 576, SBK_ROWS = 1088;
constexpr int NTOKPAD = NTOK + 64;
constexpr float QSCALE = 0.125f * 1.4426950408889634f;
constexpr float LOG2E = 1.4426950408889634f;
constexpr float ALPHA = 1.189207115002721f;

constexpr long O_Y = 0;
constexpr long O_AKP = (long)NTOK * 1024;
constexpr long O_AVP = O_AKP + (long)NB * RA * 256;
constexpr long O_BKP = O_AVP + (long)NB * RA * 256;
constexpr long O_BVP = O_BKP + (long)NTOKP * 512;
constexpr long O_MKP = O_BVP + (long)NTOKP * 512;
constexpr long O_MVP = O_MKP + (long)NB * NMEM * 256;
constexpr long O_AKS = O_MVP + (long)NB * NMEM * 256;
constexpr long O_AVS = O_AKS + (long)NTOKS * 256;
constexpr long O_BKS = O_AVS + (long)NTOKS * 256;
constexpr long O_BVS = O_BKS + (long)NTOKS * 512;
constexpr long O_END = O_BVS + (long)NTOKS * 512;

constexpr size_t WS_CTR = 0;
constexpr size_t WS_WINT = 256;
constexpr size_t WS_WOUTT = WS_WINT + (size_t)PROJ * 1024 * 2;
constexpr size_t WS_WMEMT = WS_WOUTT + (size_t)1024 * 1024 * 2;
constexpr size_t WS_ROPE = WS_WMEMT + (size_t)512 * 1024 * 2;
constexpr size_t OB_AQ = 0;
constexpr size_t OB_BQ = OB_AQ + (size_t)NTOKPAD * 256 * 2;
constexpr size_t OB_MQ = OB_BQ + (size_t)NTOKPAD * 512 * 2;
constexpr size_t OB_AK = OB_MQ + (size_t)NTOKPAD * 256 * 2;
constexpr size_t OB_AV = OB_AK + (size_t)NTOKP * 256 * 2;
constexpr size_t OB_BK = OB_AV + (size_t)NTOKP * 256 * 2;
constexpr size_t OB_END = OB_BK + (size_t)NTOKP * 512 * 2;
static_assert(OB_END <= (size_t)NTOK * 1024 * 4, "temporaries must fit in the y region");
constexpr size_t WS_BV = WS_ROPE + (size_t)SEQ * 32 * 8;
constexpr size_t WS_G = WS_BV + (size_t)NTOKP * 512 * 2;
constexpr size_t WS_MK = WS_G + (size_t)NTOK * 1024 * 2;
constexpr size_t WS_MV = WS_MK + (size_t)NB * NMEM * 256 * 2;
constexpr size_t WS_SAK = WS_MV + (size_t)NB * NMEM * 256 * 2;
constexpr size_t WS_SAV = WS_SAK + (size_t)SB * SAK_ROWS * 256 * 2;
constexpr size_t WS_SBK = WS_SAV + (size_t)SB * SAK_ROWS * 256 * 2;
constexpr size_t WS_SBV = WS_SBK + (size_t)SB * SBK_ROWS * 512 * 2;
constexpr size_t WS_SMK = WS_SBV + (size_t)SB * SBK_ROWS * 512 * 2;
constexpr size_t WS_SMV = WS_SMK + (size_t)SB * NMEM * 256 * 2;
constexpr size_t WS_XB = WS_SMV + (size_t)SB * NMEM * 256 * 2;
constexpr size_t WS_MB = WS_XB + (size_t)NTOK * 1024 * 2;
constexpr size_t WS_END = WS_MB + (size_t)NB * NMEM * 1024 * 2;
static_assert(WS_END <= (size_t)512 * 1024 * 1024, "workspace budget");

struct Params {
  const float* xp; const float* xs;
  const float* cak; const float* cav; const float* cbk; const float* cbv; const float* cmk; const float* cmv;
  const float* memp; const float* w_in; const float* w_mem; const float* relb; const float* dlam; const float* subg;
  const float* w_out; const float* ln_g; const float* ln_b;
  float* out; char* ws;
};

constexpr int TEAM_LDS = 73728 + 64;
constexpr int LDS_BYTES = 2 * TEAM_LDS + 64;
__shared__ __attribute__((aligned(16))) char g_lds_all[LDS_BYTES];
#define TEAM (__builtin_amdgcn_readfirstlane((int)(threadIdx.x >> 8)))
#define g_lds (g_lds_all + TEAM * TEAM_LDS)

DI unsigned cvtpk(float lo, float hi) { f32x2_t v = {lo, hi}; bf16x2_t b = __builtin_convertvector(v, bf16x2_t); return __builtin_bit_cast(unsigned, b); }
DI bf16_t f2bf(float x) { return (bf16_t)(cvtpk(x, 0.f) & 0xffffu); }
DI float bf2f(unsigned short b) { return __uint_as_float(((unsigned)b) << 16); }
DI float bflo(unsigned u) { return __uint_as_float(u << 16); }
DI float bfhi(unsigned u) { return __uint_as_float(u & 0xffff0000u); }
DI float fexp2(float x) { return __builtin_amdgcn_exp2f(x); }
DI float xor32f(float v) { return __shfl_xor(v, 32); }

template <bool SWAP45>
DI void transpose_tile(const float* __restrict__ src, int N, bf16_t* __restrict__ dst, int K, int k0, int n0) {
  float* tile = (float*)g_lds;
  const int tid = threadIdx.x & 255, c = tid & 63, r0 = tid >> 6;
#pragma unroll
  for (int i = 0; i < 16; ++i) { const int row = r0 + 4 * i; tile[row * 65 + c] = src[(long)(k0 + row) * N + n0 + c]; }
  __syncthreads();
#pragma unroll
  for (int i = 0; i < 16; ++i) { const int rr = r0 + 4 * i; const int pr = SWAP45 ? ((rr & 15) | ((rr & 16) << 1) | ((rr & 32) >> 1)) : rr; dst[(long)(n0 + pr) * K + k0 + c] = f2bf(tile[c * 65 + rr]); }
  __syncthreads();
}

DI void convert_rows(const float* __restrict__ src, bf16_t* __restrict__ dst, int rows_w8, int dst_bstride_w8, long gtid, long gsz) {
  const long total = (long)SB * rows_w8;
  for (long u = gtid; u < total; u += gsz) {
    const int b = (int)(u / rows_w8); const int j = (int)(u - (long)b * rows_w8);
    const float4 a0 = *(const float4*)(src + u * 8), a1 = *(const float4*)(src + u * 8 + 4);
    u32x4 v; v.x = cvtpk(a0.x, a0.y); v.y = cvtpk(a0.z, a0.w); v.z = cvtpk(a1.x, a1.y); v.w = cvtpk(a1.z, a1.w);
    *(u32x4*)(dst + ((long)b * dst_bstride_w8 + j) * 8) = v;
  }
}

DI void phase0(const Params& p) {
  bf16_t* winT = (bf16_t*)(p.ws + WS_WINT); bf16_t* woutT = (bf16_t*)(p.ws + WS_WOUTT); bf16_t* wmemT = (bf16_t*)(p.ws + WS_WMEMT);
  constexpr int T_IN = 16 * 56, T_OUT = 16 * 16, T_MEM = 16 * 8;
  for (int t = blockIdx.x * 2 + TEAM; t < T_IN + T_OUT + T_MEM; t += gridDim.x * 2) {
    if (t < T_IN) transpose_tile<true>(p.w_in, PROJ, winT, 1024, (t / 56) * 64, (t % 56) * 64);
    else if (t < T_IN + T_OUT) { const int u = t - T_IN; transpose_tile<false>(p.w_out, 1024, woutT, 1024, (u >> 4) * 64, (u & 15) * 64); }
    else { const int u = t - T_IN - T_OUT; transpose_tile<false>(p.w_mem, 512, wmemT, 1024, (u >> 3) * 64, (u & 7) * 64); }
  }
  float2* rope = (float2*)(p.ws + WS_ROPE);
  for (int idx = blockIdx.x * 512 + threadIdx.x; idx < SEQ * 32; idx += gridDim.x * 512) {
    const int pos = idx >> 5, i = idx & 31;
    const double inv = exp(-(double)i * (9.210340371976184 / 32.0));
    const double rev = (double)pos * inv * 0.15915494309189535;
    const double fr = rev - rint(rev);
    const float a = (float)(fr * 6.283185307179586);
    rope[idx] = make_float2(cosf(a), sinf(a));
  }
  const int G = gridDim.x;
  const long gtid = (long)blockIdx.x * 512 + threadIdx.x, gsz = (long)G * 512;
  {
    bf16_t* XB = (bf16_t*)(p.ws + WS_XB); bf16_t* MB = (bf16_t*)(p.ws + WS_MB);
    const long nxp = (long)NTOKP * 1024 / 8, nxs = (long)NTOKS * 1024 / 8, nmb = (long)NB * NMEM * 1024 / 8;
    for (long u = gtid; u < nxp + nxs + nmb; u += gsz) {
      const float* src; bf16_t* dst;
      if (u < nxp) { src = p.xp + u * 8; dst = XB + u * 8; }
      else if (u < nxp + nxs) { src = p.xs + (u - nxp) * 8; dst = XB + u * 8; }
      else { src = p.memp + (u - nxp - nxs) * 8; dst = MB + (u - nxp - nxs) * 8; }
      const float4 a0 = *(const float4*)(src), a1 = *(const float4*)(src + 4);
      u32x4 v; v.x = cvtpk(a0.x, a0.y); v.y = cvtpk(a0.z, a0.w); v.z = cvtpk(a1.x, a1.y); v.w = cvtpk(a1.z, a1.w);
      *(u32x4*)dst = v;
    }
  }
  convert_rows(p.cak, (bf16_t*)(p.ws + WS_SAK), RA * 256 / 8, SAK_ROWS * 256 / 8, gtid, gsz);
  convert_rows(p.cav, (bf16_t*)(p.ws + WS_SAV), RA * 256 / 8, SAK_ROWS * 256 / 8, gtid, gsz);
  convert_rows(p.cbk, (bf16_t*)(p.ws + WS_SBK), PAST * 512 / 8, SBK_ROWS * 512 / 8, gtid, gsz);
  convert_rows(p.cbv, (bf16_t*)(p.ws + WS_SBV), PAST * 512 / 8, SBK_ROWS * 512 / 8, gtid, gsz);
  convert_rows(p.cmk, (bf16_t*)(p.ws + WS_SMK), NMEM * 256 / 8, NMEM * 256 / 8, gtid, gsz);
  convert_rows(p.cmv, (bf16_t*)(p.ws + WS_SMV), NMEM * 256 / 8, NMEM * 256 / 8, gtid, gsz);
}

constexpr int G_RS = 144, GA_BYTES = 128 * G_RS, GB_BYTES = 256 * G_RS, G_STAGE = GA_BYTES + GB_BYTES;
DI void gemm_core(const bf16_t* __restrict__ Ap, int lda, const bf16_t* __restrict__ Bp, int ldb, int K, f32x16 (&acc)[2][2]) {
  const int tid = threadIdx.x, lane = tid & 63, w = tid >> 6, wm = w >> 2, wn = w & 3, r = lane & 31, h = lane >> 5;
#pragma unroll
  for (int a = 0; a < 2; ++a)
#pragma unroll
    for (int b = 0; b < 2; ++b)
#pragma unroll
      for (int i = 0; i < 16; ++i) acc[a][b][i] = 0.f;
  u32x4 ra0[2], rb0[4], ra1[2], rb1[4];
  const int lrow = tid >> 3, lch = tid & 7;
  const bf16_t* Ag = Ap + (long)lrow * lda + lch * 8;
  const bf16_t* Bg = Bp + (long)lrow * ldb + lch * 8;
#define G_LOAD(RA, RB, kt)                                                                                      \
  {                                                                                                             \
    _Pragma("unroll") for (int i = 0; i < 2; ++i) RA[i] = *(const u32x4*)(Ag + (long)(64 * i) * lda + (kt) * 64); \
    _Pragma("unroll") for (int i = 0; i < 4; ++i) RB[i] = *(const u32x4*)(Bg + (long)(64 * i) * ldb + (kt) * 64); \
  }
#define G_WRITE(RA, RB, buf)                                                                                    \
  {                                                                                                             \
    char* Ab_ = g_lds_all + (buf) * G_STAGE; char* Bb_ = Ab_ + GA_BYTES;                                        \
    _Pragma("unroll") for (int i = 0; i < 2; ++i) *(u32x4*)(Ab_ + (lrow + 64 * i) * G_RS + lch * 16) = RA[i];   \
    _Pragma("unroll") for (int i = 0; i < 4; ++i) *(u32x4*)(Bb_ + (lrow + 64 * i) * G_RS + lch * 16) = RB[i];   \
  }
#define G_COMPUTE(buf)                                                                                          \
  {                                                                                                             \
    const char* Ab = g_lds_all + (buf) * G_STAGE; const char* Bb = Ab + GA_BYTES;                               \
    _Pragma("unroll") for (int s = 0; s < 4; ++s) {                                                             \
      const int co = (16 * s + 8 * h) * 2;                                                                      \
      const bf16x8 a0 = *(const bf16x8*)(Ab + (wm * 64 + r) * G_RS + co);                                       \
      const bf16x8 a1 = *(const bf16x8*)(Ab + (wm * 64 + 32 + r) * G_RS + co);                                  \
      const bf16x8 b0 = *(const bf16x8*)(Bb + (wn * 64 + r) * G_RS + co);                                       \
      const bf16x8 b1 = *(const bf16x8*)(Bb + (wn * 64 + 32 + r) * G_RS + co);                                  \
      acc[0][0] = MFMA32(a0, b0, acc[0][0]);                                                                    \
      acc[0][1] = MFMA32(a0, b1, acc[0][1]);                                                                    \
      acc[1][0] = MFMA32(a1, b0, acc[1][0]);                                                                    \
      acc[1][1] = MFMA32(a1, b1, acc[1][1]);                                                                    \
    }                                                                                                           \
  }
  const int nk = K >> 6;
  G_LOAD(ra0, rb0, 0);
  G_LOAD(ra1, rb1, 1);
  G_WRITE(ra0, rb0, 0);
  __syncthreads();
  for (int kt = 0; kt < nk; kt += 2) {
    if (kt + 2 < nk) G_LOAD(ra0, rb0, kt + 2);
    G_COMPUTE(0);
    G_WRITE(ra1, rb1, 1);
    __syncthreads();
    if (kt + 3 < nk) G_LOAD(ra1, rb1, kt + 3);
    G_COMPUTE(1);
    if (kt + 2 < nk) G_WRITE(ra0, rb0, 0);
    __syncthreads();
  }
#undef G_COMPUTE
#undef G_LOAD
#undef G_WRITE
}

namespace pg8 {
#define PG8_LAS __attribute__((address_space(3)))
typedef unsigned short bf16_t;
typedef short bf16x8 __attribute__((ext_vector_type(8)));
typedef float f32x4 __attribute__((ext_vector_type(4)));
typedef unsigned u32x4 __attribute__((ext_vector_type(4)));
constexpr int BM = 256, BK = 64, HALF = 128, HTB = HALF * BK * 2  , STAGE_BYTES = 8 * HTB, NXCD = 8, WGM = 8;

__host__ __device__ __forceinline__ int lds_byte(int r, int c) { const int st = (r >> 4) * 2 + (c >> 5), rr = r & 15, cc = c & 31, ob = rr * 64 + cc * 2; return st * 1024 + (ob ^ (((ob >> 9) & 1) << 5)); }
__host__ __device__ __forceinline__ void stage_rc(int b, int& R, int& C) { const int st = b / 1024, sb = b % 1024, swz = sb ^ (((sb >> 9) & 1) << 5); R = (st >> 1) * 16 + swz / 64; C = (st & 1) * 32 + (swz % 64) / 2; }
__host__ __device__ __forceinline__ int perm32(int rho) { const int n = rho >> 4, i = rho & 15; return 8 * (i >> 2) + 4 * n + (i & 3); }

struct Unit { int pm, pn; };
struct Gemm { const bf16_t* A; const bf16_t* Bt; int M, N, K; };

struct StaticOrder {
    int nM, nN, nwg, G, c;
    __host__ __device__ void init(int M, int N, int G_, int c_) { nM = M / BM; nN = N / BM; nwg = nM * nN; G = G_; c = c_; }
    __host__ __device__ bool next(int i, Unit& u) const {
        const long L = (long)i * G + c; if (L >= nwg) return false;
        int wgid = (int)L; { const int q = nwg / NXCD, r = nwg % NXCD, xcd = wgid % NXCD, off = wgid / NXCD; wgid = (xcd < r ? xcd * (q + 1) : r * (q + 1) + (xcd - r) * q) + off; }
        const int nig = WGM * nN, gid = wgid / nig, fm = gid * WGM, gsz = (nM - fm) < WGM ? (nM - fm) : WGM;
        u.pm = fm + ((wgid % nig) % gsz); u.pn = (wgid % nig) / gsz; return true;
    }
    __device__ __forceinline__ void a_ready(const Unit&) const {}
    __device__ __forceinline__ void done(const Unit&) const {}
};
template <class Epi, class Sched, bool STAMP = false>
__device__ __forceinline__ void gemm_phase(PG8_LAS unsigned char* lds, const Gemm g, const Sched& S, const Epi& E, unsigned long long* stamps) {
    const int tid = threadIdx.x, wid = __builtin_amdgcn_readfirstlane(tid >> 6), lane = tid & 63, wr = wid >> 2, wc = wid & 3, fr = lane & 15, fq = lane >> 4;
    const int K = g.K, nt = K / BK;
    int ts_lo = 0, ts_hi = 0, nts = 0; const unsigned long long rt_entry = STAMP ? (unsigned long long)wall_clock64() : 0ull;
#define PG8_STAMP() do { if (STAMP && wid == 0 && nts < 64) { const unsigned long long _c = (unsigned long long)clock64(); \
        ts_lo = (lane == nts) ? (int)(unsigned)_c : ts_lo; ts_hi = (lane == nts) ? (int)(unsigned)(_c >> 32) : ts_hi; ++nts; } } while (0)
    PG8_STAMP();
    unsigned voffA[2], voffB[2];
#pragma unroll
    for (int i = 0; i < 2; ++i) { int R, C; stage_rc(tid * 16 + i * 8192, R, C); const int Rb = Epi::PERM ? ((R & ~31) + perm32(R & 31)) : R;
        voffA[i] = (unsigned)(R * K + C) * 2u; voffB[i] = (unsigned)(Rb * K + C) * 2u; }
    const size_t kstep = (size_t)(BK * 2);
    const size_t hstep = (size_t)HALF * K * 2;
    const size_t tstep = 2 * hstep;
    const unsigned ldsw = (unsigned)wid * 1024u;
    const int aoff = lds_byte(wr * 64 + fr, fq * 8), boff = lds_byte(wc * 32 + fr, fq * 8);
#define PG8_SA(b, h) (((b) * 2 + (h)) * HTB)
#define PG8_SB(b, h) ((4 + (b) * 2 + (h)) * HTB)
#define PG8_STAGE(bufoff, gbase, voff) do { _Pragma("unroll") for (int _i = 0; _i < 2; ++_i) \
        __builtin_amdgcn_global_load_lds((const unsigned*)((const char*)(gbase) + (voff)[_i]), (PG8_LAS unsigned*)(lds + (bufoff) + ldsw + _i * 8192), 16, 0, 0); } while (0)
#define PG8_LDA(dst, b, h) do { _Pragma("unroll") for (int m = 0; m < 4; ++m) _Pragma("unroll") for (int k = 0; k < 2; ++k) dst[m][k] = *(const PG8_LAS bf16x8*)(lds + PG8_SA(b, h) + aoff + m * 2048 + k * 1024); } while (0)
#define PG8_LDB(dst, b, h) do { _Pragma("unroll") for (int n = 0; n < 2; ++n) _Pragma("unroll") for (int k = 0; k < 2; ++k) dst[n][k] = *(const PG8_LAS bf16x8*)(lds + PG8_SB(b, h) + boff + n * 2048 + k * 1024); } while (0)
#define PG8_MMA(ai, bj, At, Bt) do { __builtin_amdgcn_s_setprio(1); _Pragma("unroll") for (int m = 0; m < 4; ++m) _Pragma("unroll") for (int n = 0; n < 2; ++n) _Pragma("unroll") for (int k = 0; k < 2; ++k) \
        acc[ai][bj][m][n] = __builtin_amdgcn_mfma_f32_16x16x32_bf16(Bt[n][k], At[m][k], acc[ai][bj][m][n], 0, 0, 0); __builtin_amdgcn_s_setprio(0); } while (0)
#define PG8_WAIT_V(n) asm volatile("s_waitcnt vmcnt(" #n ")" ::: "memory")
#define PG8_WAIT_L(n) asm volatile("s_waitcnt lgkmcnt(" #n ")" ::: "memory")
#define PG8_BAR __builtin_amdgcn_s_barrier()
#define PG8_SCHED __builtin_amdgcn_sched_barrier(0)
    Unit cur, nxt; int ui = 0;
    if (!S.next(0, cur)) return;
    f32x4 acc[2][2][4][2];
#pragma unroll
    for (int a = 0; a < 2; ++a)
#pragma unroll
        for (int b = 0; b < 2; ++b)
#pragma unroll
            for (int m = 0; m < 4; ++m)
#pragma unroll
                for (int n = 0; n < 2; ++n) acc[a][b][m][n] = (f32x4){0.f, 0.f, 0.f, 0.f};
    bf16x8 At[4][2], B0[2][2], B1[2][2];
    const char* cA = (const char*)g.A + (size_t)cur.pm * tstep; const char* cB = (const char*)g.Bt + (size_t)cur.pn * tstep;
    S.a_ready(cur);
    PG8_STAGE(PG8_SB(0, 0), cB, voffB); PG8_STAGE(PG8_SA(0, 0), cA, voffA); PG8_STAGE(PG8_SB(0, 1), cB + hstep, voffB); PG8_STAGE(PG8_SA(0, 1), cA + hstep, voffA);
    if (wr == 1) PG8_BAR;
    PG8_WAIT_V(4); PG8_BAR;
    PG8_STAGE(PG8_SB(1, 0), cB + kstep, voffB); PG8_STAGE(PG8_SA(1, 0), cA + kstep, voffA); PG8_STAGE(PG8_SB(1, 1), cB + hstep + kstep, voffB);
    PG8_WAIT_V(6); PG8_BAR;
    PG8_STAMP();
    for (;;) {
        const bool has_next = S.next(ui + 1, nxt);
        const char* nA = has_next ? (const char*)g.A + (size_t)nxt.pm * tstep : cA; const char* nB = has_next ? (const char*)g.Bt + (size_t)nxt.pn * tstep : cB;
        for (int t = 0; t < nt; t += 2) {
            const bool last = (t == nt - 2);
            const char* a1 = cA + (size_t)(t + 1) * kstep;
            const char* a2 = last ? nA : cA + (size_t)(t + 2) * kstep; const char* b2 = last ? nB : cB + (size_t)(t + 2) * kstep;
            const char* a3 = a2 + kstep; const char* b3 = b2 + kstep;
            if (last && has_next) S.a_ready(nxt);
            PG8_LDB(B0, 0, 0); PG8_SCHED; PG8_LDA(At, 0, 0); PG8_STAGE(PG8_SA(1, 1), a1 + hstep, voffA);
            PG8_WAIT_L(8); PG8_BAR; PG8_WAIT_L(0); PG8_MMA(0, 0, At, B0); PG8_BAR; PG8_SCHED;
            PG8_LDB(B1, 0, 1); PG8_STAGE(PG8_SB(0, 0), b2, voffB);
            PG8_BAR; PG8_WAIT_L(0); PG8_MMA(0, 1, At, B1); PG8_BAR;
            PG8_LDA(At, 0, 1); PG8_STAGE(PG8_SA(0, 0), a2, voffA);
            PG8_BAR; PG8_WAIT_L(0); PG8_MMA(1, 0, At, B0); PG8_BAR; PG8_SCHED;
            PG8_STAGE(PG8_SB(0, 1), b2 + hstep, voffB);
            PG8_WAIT_V(6); PG8_BAR; PG8_MMA(1, 1, At, B1); PG8_BAR;
            PG8_LDB(B0, 1, 0); PG8_SCHED; PG8_LDA(At, 1, 0); PG8_STAGE(PG8_SA(0, 1), a2 + hstep, voffA);
            PG8_WAIT_L(8); PG8_BAR; PG8_WAIT_L(0); PG8_MMA(0, 0, At, B0); PG8_BAR; PG8_SCHED;
            PG8_LDB(B1, 1, 1); PG8_STAGE(PG8_SB(1, 0), b3, voffB);
            PG8_BAR; PG8_WAIT_L(0); PG8_MMA(0, 1, At, B1); PG8_BAR;
            PG8_LDA(At, 1, 1); PG8_STAGE(PG8_SA(1, 0), a3, voffA);
            PG8_BAR; PG8_WAIT_L(0); PG8_MMA(1, 0, At, B0); PG8_BAR; PG8_SCHED;
            PG8_STAGE(PG8_SB(1, 1), b3 + hstep, voffB);
            PG8_WAIT_V(6); PG8_BAR; PG8_MMA(1, 1, At, B1); PG8_BAR;
        }
        PG8_STAMP();
        if constexpr (!Epi::AFTER_DRAIN) { E(acc, cur, wr, wc, fr, fq); S.done(cur); }
        PG8_STAMP();
        if (!has_next) break;
#pragma unroll
        for (int a = 0; a < 2; ++a)
#pragma unroll
            for (int b = 0; b < 2; ++b)
#pragma unroll
                for (int m = 0; m < 4; ++m)
#pragma unroll
                    for (int n = 0; n < 2; ++n) acc[a][b][m][n] = (f32x4){0.f, 0.f, 0.f, 0.f};
        cur = nxt; cA = nA; cB = nB; ++ui;
    }
    PG8_WAIT_V(0);
    if (wr == 0) PG8_BAR;
    PG8_BAR;
    if constexpr (Epi::AFTER_DRAIN) { E.fused(acc, cur, wr, wc, fr, fq, lds, wid, lane); S.done(cur); }
    PG8_STAMP();
    if (STAMP && wid == 0) { stamps[lane] = lane < nts ? (((unsigned long long)(unsigned)ts_hi << 32) | (unsigned)ts_lo) : 0ull;
        if (lane == 62) stamps[62] = rt_entry; if (lane == 63) stamps[63] = (unsigned long long)wall_clock64(); }
#undef PG8_STAMP
#undef PG8_SA
#undef PG8_SB
#undef PG8_STAGE
#undef PG8_LDA
#undef PG8_LDB
#undef PG8_MMA
#undef PG8_WAIT_V
#undef PG8_WAIT_L
#undef PG8_BAR
#undef PG8_SCHED
}
}

struct EpiProj {
  static constexpr bool PERM = false, AFTER_DRAIN = false;
  float* out; char* ws;
  __device__ __forceinline__ void operator()(const pg8::f32x4 (&acc)[2][2][4][2], const pg8::Unit& u, int wr, int wc, int fr, int fq) const {
    asm volatile("" : "+v"(fr), "+v"(fq));
    char* ob = (char*)out;
    const int n0 = u.pn * 256;
    int seg, sbase;
    if (n0 < 256) { seg = 0; sbase = 0; } else if (n0 < 512) { seg = 1; sbase = 256; } else if (n0 < 768) { seg = 2; sbase = 512; }
    else if (n0 < 1280) { seg = 3; sbase = 768; } else if (n0 < 1792) { seg = 4; sbase = 1280; } else if (n0 < 2304) { seg = 5; sbase = 1792; }
    else if (n0 < 2560) { seg = 6; sbase = 2304; } else { seg = 7; sbase = 2560; }
    const bool smp = u.pm >= NTOKP / 256;
    const float2* rope = (const float2*)(ws + WS_ROPE);
    const int fi = 16 * (wc & 1) + 4 * fq;
#pragma unroll
    for (int ai = 0; ai < 2; ++ai)
#pragma unroll
      for (int m = 0; m < 4; ++m) {
        const int row = 128 * ai + 64 * wr + 16 * m + fr;
        const long tok = (long)u.pm * 256 + row;
        const long ts = tok - NTOKP;
        float4 c01, s01, c23, s23;
        if (seg == 3 || seg == 4) {
          const int pos = smp ? (PAST + (int)(ts & 15)) : (int)(tok & (SEQ - 1));
          const float4 r0 = *(const float4*)(rope + pos * 32 + fi), r1 = *(const float4*)(rope + pos * 32 + fi + 2);
          c01 = make_float4(r0.x, r0.z, r1.x, r1.z); s01 = make_float4(r0.y, r0.w, r1.y, r1.w);
        }
#pragma unroll
        for (int bj = 0; bj < 2; ++bj) {
          const int blk = 4 * u.pn + 2 * bj + (wc >> 1);
          const int col = 64 * blk + fi - sbase;
          pg8::f32x4 v0 = acc[ai][bj][m][0], v1 = acc[ai][bj][m][1];
          if (seg == 3 || seg == 4) {
            const pg8::f32x4 cc = {c01.x, c01.y, c01.z, c01.w}, ss = {s01.x, s01.y, s01.z, s01.w};
            const pg8::f32x4 a = v0 * cc - v1 * ss, b = v1 * cc + v0 * ss;
            v0 = a; v1 = b;
          }
          if (seg == 0 || seg == 3 || seg == 6) {
            bf16_t* q = (seg == 0) ? (bf16_t*)(ob + OB_AQ) + tok * 256 : (seg == 3) ? (bf16_t*)(ob + OB_BQ) + tok * 512 : (bf16_t*)(ob + OB_MQ) + tok * 256;
            u32x2 w0, w1; w0.x = cvtpk(v0[0] * QSCALE, v0[1] * QSCALE); w0.y = cvtpk(v0[2] * QSCALE, v0[3] * QSCALE);
            w1.x = cvtpk(v1[0] * QSCALE, v1[1] * QSCALE); w1.y = cvtpk(v1[2] * QSCALE, v1[3] * QSCALE);
            *(u32x2*)(q + col) = w0; *(u32x2*)(q + col + 32) = w1;
          } else if (seg == 7) {
            bf16_t* g = (bf16_t*)(ws + WS_G) + tok * 1024;
            float a[4], b[4];
#pragma unroll
            for (int j = 0; j < 4; ++j) { a[j] = v0[j] / (1.f + __expf(-v0[j])); b[j] = v1[j] / (1.f + __expf(-v1[j])); }
            u32x2 w0, w1; w0.x = cvtpk(a[0], a[1]); w0.y = cvtpk(a[2], a[3]); w1.x = cvtpk(b[0], b[1]); w1.y = cvtpk(b[2], b[3]);
            *(u32x2*)(g + col) = w0; *(u32x2*)(g + col + 32) = w1;
          } else {
            const bool wide = (seg >= 4);
            const int W = wide ? 512 : 256;
            bf16_t* kw; float* o = nullptr;
            if (!smp) {
              if (seg == 1) kw = (bf16_t*)(ob + OB_AK) + tok * 256; else if (seg == 2) kw = (bf16_t*)(ob + OB_AV) + tok * 256;
              else if (seg == 4) kw = (bf16_t*)(ob + OB_BK) + tok * 512; else kw = (bf16_t*)(ws + WS_BV) + tok * 512;
              if (wide) o = out + (seg == 4 ? O_BKP : O_BVP) + tok * 512;
              else { const int ps = (int)(tok & (SEQ - 1)); const int pb = (int)(tok >> 13); if (ps >= SEQ - RA) o = out + (seg == 1 ? O_AKP : O_AVP) + (long)(pb * RA + ps - (SEQ - RA)) * 256; }
            } else {
              const long sb = ts >> 4, st = ts & 15;
              if (wide) { kw = (bf16_t*)(ws + (seg == 4 ? WS_SBK : WS_SBV)) + (sb * SBK_ROWS + PAST + st) * 512; o = out + (seg == 4 ? O_BKS : O_BVS) + ts * 512; }
              else { kw = (bf16_t*)(ws + (seg == 1 ? WS_SAK : WS_SAV)) + (sb * SAK_ROWS + RA + st) * 256; o = out + (seg == 1 ? O_AKS : O_AVS) + ts * 256; }
            }
            (void)W;
            u32x2 w0, w1; w0.x = cvtpk(v0[0], v0[1]); w0.y = cvtpk(v0[2], v0[3]); w1.x = cvtpk(v1[0], v1[1]); w1.y = cvtpk(v1[2], v1[3]);
            *(u32x2*)(kw + col) = w0; *(u32x2*)(kw + col + 32) = w1;
            if (o) { *(pg8::f32x4*)(o + col) = v0; *(pg8::f32x4*)(o + col + 32) = v1; }
          }
        }
      }
  }
};

struct EpiOut {
  static constexpr bool PERM = false, AFTER_DRAIN = false;
  float* out; const float* xp; const float* xs;
  __device__ __forceinline__ void operator()(const pg8::f32x4 (&acc)[2][2][4][2], const pg8::Unit& u, int wr, int wc, int fr, int fq) const {
    asm volatile("" : "+v"(fr), "+v"(fq));
    const float* xb = (u.pm < NTOKP / 256) ? xp + (long)u.pm * 256 * 1024 : xs + (long)(u.pm - NTOKP / 256) * 256 * 1024;
    float* yb = out + O_Y + (long)u.pm * 256 * 1024;
    const int col0 = u.pn * 256 + wc * 32 + 4 * fq;
#pragma unroll
    for (int ai = 0; ai < 2; ++ai)
#pragma unroll
      for (int mp = 0; mp < 2; ++mp) {
        pg8::f32x4 xv[2][2][2];
#pragma unroll
        for (int mm = 0; mm < 2; ++mm) {
          const long ro = (long)(128 * ai + 64 * wr + 16 * (2 * mp + mm) + fr) * 1024 + col0;
#pragma unroll
          for (int bj = 0; bj < 2; ++bj)
#pragma unroll
            for (int n = 0; n < 2; ++n) xv[mm][bj][n] = *(const pg8::f32x4*)(xb + ro + bj * 128 + n * 16);
        }
#pragma unroll
        for (int mm = 0; mm < 2; ++mm) {
          const long ro = (long)(128 * ai + 64 * wr + 16 * (2 * mp + mm) + fr) * 1024 + col0;
#pragma unroll
          for (int bj = 0; bj < 2; ++bj)
#pragma unroll
            for (int n = 0; n < 2; ++n) *(pg8::f32x4*)(yb + ro + bj * 128 + n * 16) = acc[ai][bj][2 * mp + mm][n] + ALPHA * xv[mm][bj][n];
        }
      }
  }
};

DI void mem_epilogue(const Params& p, int mt, int nt, f32x16 (&acc)[2][2]) {
  const int tid = threadIdx.x, lane = tid & 63, w = tid >> 6, wm = w >> 2, wn = w & 3, c = lane & 31, h = lane >> 5;
  const int n0 = nt * 256 + wn * 64;
  const bool isv = n0 >= 256;
  const int cb = isv ? n0 - 256 : n0;
  bf16_t* kw = (bf16_t*)(p.ws + (isv ? WS_MV : WS_MK));
  float* o = p.out + (isv ? O_MVP : O_MKP);
#pragma unroll
  for (int mi = 0; mi < 2; ++mi)
#pragma unroll
    for (int i = 0; i < 16; ++i) {
      const long row = mt * 128 + wm * 64 + mi * 32 + (i & 3) + 8 * (i >> 2) + 4 * h;
      const float v0 = acc[mi][0][i], v1 = acc[mi][1][i];
      kw[row * 256 + cb + c] = f2bf(v0); kw[row * 256 + cb + c + 32] = f2bf(v1);
      o[row * 256 + cb + c] = v0; o[row * 256 + cb + c + 32] = v1;
    }
}

DI void phase1(const Params& p) {
  const int G = gridDim.x;
  const bf16_t* winT = (const bf16_t*)(p.ws + WS_WINT); const bf16_t* wmemT = (const bf16_t*)(p.ws + WS_WMEMT);
  const bf16_t* XB = (const bf16_t*)(p.ws + WS_XB); const bf16_t* MB = (const bf16_t*)(p.ws + WS_MB);
  {
    pg8::Gemm g; g.A = XB; g.Bt = winT; g.M = NTOK; g.N = PROJ; g.K = 1024;
    pg8::StaticOrder S; S.init(NTOK, PROJ, G, (int)blockIdx.x);
    EpiProj E; E.out = p.out; E.ws = p.ws;
    pg8::gemm_phase<EpiProj, pg8::StaticOrder, false>((PG8_LAS unsigned char*)g_lds_all, g, S, E, nullptr);
  }
  __syncthreads();
  constexpr int T2 = 8 * 2;
  f32x16 acc[2][2];
  for (int t = (int)blockIdx.x - 64; t >= 0 && t < T2; t += G) {
    const int mt = t >> 1, nt = t & 1;
    gemm_core(MB + (long)mt * 128 * 1024, 1024, wmemT + (long)nt * 256 * 1024, 1024, 1024, acc);
    mem_epilogue(p, mt, nt, acc);
  }
}

struct AttnItem {
  const bf16_t* q0; const bf16_t* q1;
  const bf16_t* k; const bf16_t* v;
  bf16_t* g0; bf16_t* g1;
  int qs, ks, ntiles, nkeys;
  int tlo0, thi0, tlo1, thi1;
  int rows0, rows1;
  int qpos0, qpos1, kpos0, head0; bool bias;
};
constexpr int AK_RS = 272, AK_BYTES = 64 * AK_RS, AV_BYTES = 16384, A_BUF = AK_BYTES + AV_BYTES;
constexpr int A_BIAS_OFF = 2 * A_BUF;
constexpr int A_ITEM_OFF = 2 * TEAM_LDS;
constexpr int A_Q_OFF = 73728;

template <bool DIFF, bool BIAS, bool MASK>
DI void attn_item(const AttnItem& it, float lam, const float* __restrict__ subg) {
  const int tid = threadIdx.x, lane = tid & 63, w = tid >> 6, r = lane & 31, h = lane >> 5;
  const int half = __builtin_amdgcn_readfirstlane(w >> 2), qh = w & 1, m = (w >> 1) & 1;
  constexpr int NDT = DIFF ? 4 : 2;
  const int ntiles = it.ntiles;
  const int tlo = half ? it.tlo1 : it.tlo0, thi = half ? it.thi1 : it.thi0, rows = half ? it.rows1 : it.rows0;
  const bf16_t* qbase = half ? it.q1 : it.q0;
  bf16_t* gbase = half ? it.g1 : it.g0;
  char* qlds = g_lds_all + A_Q_OFF + w * 4096 + lane * 16;
  {
    const bf16_t* qp = qbase + (long)(qh * 32 + r) * it.qs + m * 64 + 8 * h;
#pragma unroll
    for (int s = 0; s < 4; ++s) *(bf16x8*)(qlds + s * 1024) = *(const bf16x8*)(qp + 16 * s);
  }
  f32x16 oacc[NDT];
#pragma unroll
  for (int d = 0; d < NDT; ++d)
#pragma unroll
    for (int i = 0; i < 16; ++i) oacc[d][i] = 0.f;
  float m_run = -1e30f, l_run = 0.f;
  u32x4 rk0[2], rv0[2];
  const int kch = tid & 15, krow = tid >> 4, vsub = tid & 3, vkey = (tid >> 2) & 63, vd = tid >> 8;
  const bf16_t* kg = it.k + (long)krow * it.ks + kch * 8;
  const bf16_t* vg = it.v + (long)vkey * it.ks + vd * 32 + vsub * 8;
#define A_LOAD(RK, RV, t)                                                                                        \
  {                                                                                                              \
    _Pragma("unroll") for (int i = 0; i < 2; ++i) RK[i] = *(const u32x4*)(kg + (long)((t) * 64 + 32 * i) * it.ks); \
    _Pragma("unroll") for (int i = 0; i < 2; ++i) RV[i] = *(const u32x4*)(vg + (long)((t) * 64) * it.ks + 64 * i); \
  }
#define A_WRITE(RK, RV, stage)                                                                                   \
  {                                                                                                              \
    char* Kb_ = g_lds_all + (stage) * A_BUF; char* Vb_ = Kb_ + AK_BYTES;                                         \
    _Pragma("unroll") for (int i = 0; i < 2; ++i) *(u32x4*)(Kb_ + (krow + 32 * i) * AK_RS + kch * 16) = RK[i];   \
    _Pragma("unroll") for (int i = 0; i < 2; ++i) *(u32x4*)(Vb_ + (vd + 2 * i) * 4096 + vkey * 64 + vsub * 16) = RV[i]; \
  }
  const int vlane = ((lane >> 4) & 1) * 32 + (lane & 3) * 8 + (4 * h + ((lane & 15) >> 2)) * 64;
  const float* biasT = (const float*)(g_lds_all + A_BIAS_OFF) + (it.head0 + m) * 257;
  const int qpos = (half ? it.qpos1 : it.qpos0) + qh * 32 + r;
#define A_COMPUTE(t, stage)                                                                                      \
  if ((t) >= tlo && (t) < thi) {                                                                                 \
    const char* Kb = g_lds_all + (stage) * A_BUF; const char* Vb = Kb + AK_BYTES;                                \
    f32x16 s0, s1;                                                                                               \
    _Pragma("unroll") for (int i = 0; i < 16; ++i) { s0[i] = 0.f; s1[i] = 0.f; }                                 \
    _Pragma("unroll") for (int s = 0; s < 4; ++s) {                                                              \
      const int co = (m * 64 + 16 * s + 8 * h) * 2;                                                              \
      const bf16x8 k0 = *(const bf16x8*)(Kb + r * AK_RS + co);                                                   \
      const bf16x8 k1 = *(const bf16x8*)(Kb + (32 + r) * AK_RS + co);                                            \
      const bf16x8 qfs = *(const bf16x8*)(qlds + s * 1024);                                                      \
      s0 = MFMA32(k0, qfs, s0);                                                                                  \
      s1 = MFMA32(k1, qfs, s1);                                                                                  \
    }                                                                                                            \
    if (BIAS) {                                                                                                  \
      const int kb = it.kpos0 + (t) * 64 + 4 * h;                                                                \
      _Pragma("unroll") for (int i = 0; i < 16; ++i) {                                                           \
        const int kk = kb + (i & 3) + 8 * (i >> 2);                                                              \
        int d0 = qpos - kk, d1 = d0 - 32;                                                                        \
        d0 = min(max(d0, -128), 128) + 128; d1 = min(max(d1, -128), 128) + 128;                                  \
        s0[i] += biasT[d0]; s1[i] += biasT[d1];                                                                  \
      }                                                                                                          \
    }                                                                                                            \
    if (MASK && ((t) + 1) * 64 > it.nkeys) {                                                                     \
      const int kb = (t) * 64 + 4 * h;                                                                           \
      _Pragma("unroll") for (int i = 0; i < 16; ++i) {                                                           \
        const int kk = kb + (i & 3) + 8 * (i >> 2);                                                              \
        if (kk >= it.nkeys) s0[i] = -1e30f;                                                                      \
        if (kk + 32 >= it.nkeys) s1[i] = -1e30f;                                                                 \
      }                                                                                                          \
    }                                                                                                            \
    float mx = fmaxf(s0[0], s1[0]);                                                                              \
    _Pragma("unroll") for (int i = 1; i < 16; ++i) mx = fmaxf(mx, fmaxf(s0[i], s1[i]));                          \
    mx = fmaxf(mx, xor32f(mx));                                                                                  \
    const float m_new = fmaxf(m_run, mx);                                                                        \
    const float alpha = fexp2(m_run - m_new);                                                                    \
    if (__builtin_amdgcn_ballot_w64(m_new > m_run) != 0ull) {                                                    \
      _Pragma("unroll") for (int d = 0; d < NDT; ++d)                                                            \
        _Pragma("unroll") for (int i = 0; i < 16; ++i) oacc[d][i] *= alpha;                                      \
    }                                                                                                            \
    l_run *= alpha;                                                                                              \
    m_run = m_new;                                                                                               \
    float ls = 0.f;                                                                                              \
    _Pragma("unroll") for (int i = 0; i < 16; ++i) { s0[i] = fexp2(s0[i] - m_new); s1[i] = fexp2(s1[i] - m_new); ls += s0[i] + s1[i]; } \
    l_run += ls;                                                                                                 \
    bf16x8 pf[4];                                                                                                \
    _Pragma("unroll") for (int s2 = 0; s2 < 2; ++s2) {                                                           \
      u32x4 a, b;                                                                                                \
      a.x = cvtpk(s0[8 * s2 + 0], s0[8 * s2 + 1]); a.y = cvtpk(s0[8 * s2 + 2], s0[8 * s2 + 3]);                  \
      a.z = cvtpk(s0[8 * s2 + 4], s0[8 * s2 + 5]); a.w = cvtpk(s0[8 * s2 + 6], s0[8 * s2 + 7]);                  \
      b.x = cvtpk(s1[8 * s2 + 0], s1[8 * s2 + 1]); b.y = cvtpk(s1[8 * s2 + 2], s1[8 * s2 + 3]);                  \
      b.z = cvtpk(s1[8 * s2 + 4], s1[8 * s2 + 5]); b.w = cvtpk(s1[8 * s2 + 6], s1[8 * s2 + 7]);                  \
      pf[s2] = __builtin_bit_cast(bf16x8, a); pf[2 + s2] = __builtin_bit_cast(bf16x8, b);                        \
    }                                                                                                            \
    const LDS3 char* vb3 = (const LDS3 char*)(Vb) + vlane + (DIFF ? 0 : m * 2 * 4096);                           \
    _Pragma("unroll") for (int ks = 0; ks < 4; ++ks) {                                                           \
      _Pragma("unroll") for (int d = 0; d < NDT; ++d) {                                                          \
        const s16x4 lo = __builtin_bit_cast(s16x4, __builtin_amdgcn_ds_read_tr16_b64_v4i16((LDS3 s16x4*)(vb3 + d * 4096 + ks * 1024))); \
        const s16x4 hi = __builtin_bit_cast(s16x4, __builtin_amdgcn_ds_read_tr16_b64_v4i16((LDS3 s16x4*)(vb3 + d * 4096 + ks * 1024 + 512))); \
        const bf16x8 vf = __builtin_shufflevector(lo, hi, 0, 1, 2, 3, 4, 5, 6, 7);                               \
        oacc[d] = MFMA32(vf, pf[ks], oacc[d]);                                                                   \
      }                                                                                                          \
      __builtin_amdgcn_sched_barrier(0);                                                                         \
    }                                                                                                            \
  }
  A_LOAD(rk0, rv0, 0);
  A_WRITE(rk0, rv0, 0);
  if (ntiles > 1) A_LOAD(rk0, rv0, 1);
  __syncthreads();
#pragma unroll 1
  for (int t = 0; t < ntiles; ++t) {
    const int par = t & 1;
    if (t + 1 < ntiles) A_WRITE(rk0, rv0, par ^ 1);
    if (t + 2 < ntiles) A_LOAD(rk0, rv0, t + 2);
    A_COMPUTE(t, par);
    __syncthreads();
  }
#undef A_LOAD
#undef A_WRITE
#undef A_COMPUTE
  const float l_tot = l_run + xor32f(l_run);
  const float inv = 1.f / l_tot;
  const int q = qh * 32 + r;
  if (!DIFF) {
    if (q < rows) {
      bf16_t* gp = gbase + (long)q * 1024 + m * 64 + 4 * h;
      u32x2 gvv[NDT][4];
#pragma unroll
      for (int d = 0; d < NDT; ++d)
#pragma unroll
        for (int g4 = 0; g4 < 4; ++g4) gvv[d][g4] = *(const u32x2*)(gp + d * 32 + 8 * g4);
#pragma unroll
      for (int d = 0; d < NDT; ++d)
#pragma unroll
        for (int g4 = 0; g4 < 4; ++g4) {
          u32x2* ptr = (u32x2*)(gp + d * 32 + 8 * g4);
          const u32x2 gv = gvv[d][g4];
          u32x2 o;
          o.x = cvtpk(oacc[d][4 * g4 + 0] * inv * bflo(gv.x), oacc[d][4 * g4 + 1] * inv * bfhi(gv.x));
          o.y = cvtpk(oacc[d][4 * g4 + 2] * inv * bflo(gv.y), oacc[d][4 * g4 + 3] * inv * bfhi(gv.y));
          *ptr = o;
        }
    }
  } else {
    float* xb = (float*)g_lds_all + half * 8192 + qh * 4096 + lane;
    if (m == 1) {
      const float sc = lam * inv;
#pragma unroll
      for (int d = 0; d < NDT; ++d)
#pragma unroll
        for (int i = 0; i < 16; ++i) xb[(d * 16 + i) * 64] = oacc[d][i] * sc;
    }
    __syncthreads();
    if (m == 0) {
      float ss = 0.f;
#pragma unroll
      for (int d = 0; d < NDT; ++d)
#pragma unroll
        for (int i = 0; i < 16; ++i) { const float o = oacc[d][i] * inv - xb[(d * 16 + i) * 64]; oacc[d][i] = o; ss += o * o; }
      ss += xor32f(ss);
      const float rn = rsqrtf(ss * (1.f / 128.f) + 1e-5f) * 0.8f;
      if (q < rows) {
        bf16_t* gp = gbase + (long)q * 1024 + 4 * h;
        u32x2 gvv[NDT][4];
#pragma unroll
        for (int d = 0; d < NDT; ++d)
#pragma unroll
          for (int g4 = 0; g4 < 4; ++g4) gvv[d][g4] = *(const u32x2*)(gp + d * 32 + 8 * g4);
#pragma unroll
        for (int d = 0; d < NDT; ++d)
#pragma unroll
          for (int g4 = 0; g4 < 4; ++g4) {
            const float4 sg = *(const float4*)(subg + d * 32 + 8 * g4 + 4 * h);
            u32x2* ptr = (u32x2*)(gp + d * 32 + 8 * g4);
            const u32x2 gv = gvv[d][g4];
            u32x2 o;
            o.x = cvtpk(oacc[d][4 * g4 + 0] * rn * sg.x * bflo(gv.x), oacc[d][4 * g4 + 1] * rn * sg.y * bfhi(gv.x));
            o.y = cvtpk(oacc[d][4 * g4 + 2] * rn * sg.z * bflo(gv.y), oacc[d][4 * g4 + 3] * rn * sg.w * bfhi(gv.y));
            *ptr = o;
          }
      }
    }
    __syncthreads();
  }
}

DI void phase2(const Params& p) {
  char* ws = p.ws;
  float* biasT = (float*)(g_lds_all + A_BIAS_OFF);
  for (int i = threadIdx.x; i < 4 * 257; i += 512) biasT[i] = p.relb[i] * LOG2E;
  float s1 = 0.f, s2 = 0.f;
  for (int i = 0; i < 64; ++i) { s1 += p.dlam[i] * p.dlam[64 + i]; s2 += p.dlam[128 + i] * p.dlam[192 + i]; }
  const float lam = expf(s1) - expf(s2) + 0.2f;
  __syncthreads();
  int* ctr = (int*)(ws + WS_CTR);
  int* s_item = (int*)(g_lds_all + A_ITEM_OFF);
  const char* ob = (const char*)p.out;
  const bf16_t* AQ = (const bf16_t*)(ob + OB_AQ); const bf16_t* AK = (const bf16_t*)(ob + OB_AK); const bf16_t* AV = (const bf16_t*)(ob + OB_AV);
  const bf16_t* BQ = (const bf16_t*)(ob + OB_BQ); const bf16_t* BK = (const bf16_t*)(ob + OB_BK); const bf16_t* BV = (const bf16_t*)(ws + WS_BV);
  const bf16_t* MQ = (const bf16_t*)(ob + OB_MQ); const bf16_t* MK = (const bf16_t*)(ws + WS_MK); const bf16_t* MV = (const bf16_t*)(ws + WS_MV);
  const bf16_t* SAK = (const bf16_t*)(ws + WS_SAK); const bf16_t* SAV = (const bf16_t*)(ws + WS_SAV);
  const bf16_t* SBK = (const bf16_t*)(ws + WS_SBK); const bf16_t* SBV = (const bf16_t*)(ws + WS_SBV);
  const bf16_t* SMK = (const bf16_t*)(ws + WS_SMK); const bf16_t* SMV = (const bf16_t*)(ws + WS_SMV);
  bf16_t* G = (bf16_t*)(ws + WS_G);
  constexpr int N_BP = 1024, N_BS = 128, N_AP = 512, N_AS = 64, N_MP = 512, N_MS = 64;
  constexpr int N_ALL = N_BP + N_BS + N_AP + N_AS + N_MP + N_MS;
  for (;;) {
    if (threadIdx.x == 0) *s_item = atomicAdd(ctr, 1);
    __syncthreads();
    int item = *s_item;
    __syncthreads();
    if (item >= N_ALL) break;
    AttnItem it;
    it.bias = false; it.qpos0 = 0; it.qpos1 = 0; it.kpos0 = 0; it.head0 = 0; it.rows0 = 64; it.rows1 = 64;
    if (item < N_BP) {
      const int j = 63 - (item >> 4), bh = item & 15, b = bh >> 2, hh = bh & 3;
      const long tok0 = (long)b * SEQ + j * 128;
      it.q0 = BQ + tok0 * 512 + hh * 128; it.q1 = it.q0 + 64 * 512;
      it.k = BK + (long)b * SEQ * 512 + hh * 128; it.v = BV + (long)b * SEQ * 512 + hh * 128;
      it.qs = 512; it.ks = 512; it.ntiles = 2 * j + 2; it.nkeys = it.ntiles * 64;
      it.tlo0 = 0; it.thi0 = 2 * j + 1; it.tlo1 = 0; it.thi1 = 2 * j + 2;
      it.g0 = G + tok0 * 1024 + 256 + hh * 128; it.g1 = it.g0 + 64 * 1024;
      attn_item<true, false, false>(it, lam, p.subg);
      continue;
    }
    item -= N_BP;
    if (item < N_BS) {
      const int b = item >> 2, hh = item & 3;
      const long tok0 = NTOKP + b * ST;
      it.q0 = BQ + tok0 * 512 + hh * 128; it.q1 = it.q0;
      it.k = SBK + (long)b * SBK_ROWS * 512 + hh * 128; it.v = SBV + (long)b * SBK_ROWS * 512 + hh * 128;
      it.qs = 512; it.ks = 512; it.ntiles = 17; it.nkeys = PAST + ST;
      it.tlo0 = 0; it.thi0 = 17; it.tlo1 = 0; it.thi1 = 0; it.rows0 = ST; it.rows1 = 0;
      it.g0 = G + tok0 * 1024 + 256 + hh * 128; it.g1 = it.g0;
      attn_item<true, false, true>(it, lam, p.subg);
      continue;
    }
    item -= N_BS;
    if (item < N_AP) {
      const int j = 63 - (item >> 3), bh = item & 7, b = bh >> 1, hp = bh & 1;
      const int c0 = 2 * j, c1 = c0 + 1, cs0 = c0 > 8 ? c0 - 8 : 0, cs1 = c1 > 8 ? c1 - 8 : 0;
      const long tok0 = (long)b * SEQ + c0 * 64, k0 = (long)b * SEQ + cs0 * 64;
      it.q0 = AQ + tok0 * 256 + hp * 128; it.q1 = it.q0 + 64 * 256;
      it.k = AK + k0 * 256 + hp * 128; it.v = AV + k0 * 256 + hp * 128;
      it.qs = 256; it.ks = 256; it.ntiles = c1 - cs0 + 1; it.nkeys = it.ntiles * 64;
      it.tlo0 = 0; it.thi0 = c0 - cs0 + 1; it.tlo1 = cs1 - cs0; it.thi1 = it.ntiles;
      it.g0 = G + tok0 * 1024 + hp * 128; it.g1 = it.g0 + 64 * 1024;
      it.bias = true; it.qpos0 = c0 * 64; it.qpos1 = c1 * 64; it.kpos0 = cs0 * 64; it.head0 = hp * 2;
    } else if ((item -= N_AP) < N_AS) {
      const int b = item >> 1, hp = item & 1;
      const long tok0 = NTOKP + b * ST;
      it.q0 = AQ + tok0 * 256 + hp * 128; it.q1 = it.q0;
      it.k = SAK + (long)b * SAK_ROWS * 256 + hp * 128; it.v = SAV + (long)b * SAK_ROWS * 256 + hp * 128;
      it.qs = 256; it.ks = 256; it.ntiles = 9; it.nkeys = RA + ST;
      it.tlo0 = 0; it.thi0 = 9; it.tlo1 = 0; it.thi1 = 0; it.rows0 = ST; it.rows1 = 0;
      it.g0 = G + tok0 * 1024 + hp * 128; it.g1 = it.g0;
      it.bias = true; it.qpos0 = RA; it.qpos1 = RA; it.kpos0 = 0; it.head0 = hp * 2;
    } else if ((item -= N_AS) < N_MP) {
      const int j = item >> 3, bh = item & 7, b = bh >> 1, hp = bh & 1;
      const long tok0 = (long)b * SEQ + j * 128;
      it.q0 = MQ + tok0 * 256 + hp * 128; it.q1 = it.q0 + 64 * 256;
      it.k = MK + (long)b * NMEM * 256 + hp * 128; it.v = MV + (long)b * NMEM * 256 + hp * 128;
      it.qs = 256; it.ks = 256; it.ntiles = 4; it.nkeys = NMEM;
      it.tlo0 = 0; it.thi0 = 4; it.tlo1 = 0; it.thi1 = 4;
      it.g0 = G + tok0 * 1024 + 768 + hp * 128; it.g1 = it.g0 + 64 * 1024;
    } else {
      item -= N_MP;
      const int b = item >> 1, hp = item & 1;
      const long tok0 = NTOKP + b * ST;
      it.q0 = MQ + tok0 * 256 + hp * 128; it.q1 = it.q0;
      it.k = SMK + (long)b * NMEM * 256 + hp * 128; it.v = SMV + (long)b * NMEM * 256 + hp * 128;
      it.qs = 256; it.ks = 256; it.ntiles = 4; it.nkeys = NMEM;
      it.tlo0 = 0; it.thi0 = 4; it.tlo1 = 0; it.thi1 = 0; it.rows0 = ST; it.rows1 = 0;
      it.g0 = G + tok0 * 1024 + 768 + hp * 128; it.g1 = it.g0;
    }
    if (it.bias) attn_item<false, true, true>(it, lam, p.subg); else attn_item<false, false, false>(it, lam, p.subg);
  }
}

DI void phase3(const Params& p) {
  pg8::Gemm g; g.A = (const bf16_t*)(p.ws + WS_G); g.Bt = (const bf16_t*)(p.ws + WS_WOUTT); g.M = NTOK; g.N = 1024; g.K = 1024;
  pg8::StaticOrder S; S.init(NTOK, 1024, (int)gridDim.x, (int)blockIdx.x);
  EpiOut E; E.out = p.out; E.xp = p.xp; E.xs = p.xs;
  pg8::gemm_phase<EpiOut, pg8::StaticOrder, false>((PG8_LAS unsigned char*)g_lds_all, g, S, E, nullptr);
  __syncthreads();
}

DI void phase4(const Params& p) {
  const int lane = threadIdx.x & 63, w = threadIdx.x >> 6;
  float4 g[4], bb[4];
#pragma unroll
  for (int j = 0; j < 4; ++j) { g[j] = *(const float4*)(p.ln_g + j * 256 + lane * 4); bb[j] = *(const float4*)(p.ln_b + j * 256 + lane * 4); }
  for (int row0 = (blockIdx.x * 8 + w) * 4; row0 < NTOK; row0 += gridDim.x * 32) {
    float4 v[4][4];
#pragma unroll
    for (int rr = 0; rr < 4; ++rr)
#pragma unroll
      for (int j = 0; j < 4; ++j) v[rr][j] = *(const float4*)(p.out + O_Y + (long)(row0 + rr) * 1024 + j * 256 + lane * 4);
    float s[4], q[4];
#pragma unroll
    for (int rr = 0; rr < 4; ++rr) { s[rr] = 0.f;
#pragma unroll
      for (int j = 0; j < 4; ++j) s[rr] += v[rr][j].x + v[rr][j].y + v[rr][j].z + v[rr][j].w; }
#pragma unroll
    for (int o = 1; o < 64; o <<= 1)
#pragma unroll
      for (int rr = 0; rr < 4; ++rr) s[rr] += __shfl_xor(s[rr], o);
#pragma unroll
    for (int rr = 0; rr < 4; ++rr) { const float mu = s[rr] * (1.f / 1024.f); s[rr] = mu; q[rr] = 0.f;
#pragma unroll
      for (int j = 0; j < 4; ++j) { const float a = v[rr][j].x - mu, b = v[rr][j].y - mu, c = v[rr][j].z - mu, d = v[rr][j].w - mu; q[rr] += a * a + b * b + c * c + d * d; } }
#pragma unroll
    for (int o = 1; o < 64; o <<= 1)
#pragma unroll
      for (int rr = 0; rr < 4; ++rr) q[rr] += __shfl_xor(q[rr], o);
#pragma unroll
    for (int rr = 0; rr < 4; ++rr) {
      const float mu = s[rr], rs = rsqrtf(q[rr] * (1.f / 1024.f) + 1e-5f);
#pragma unroll
      for (int j = 0; j < 4; ++j) {
        float4 o;
        o.x = (v[rr][j].x - mu) * rs * g[j].x + bb[j].x; o.y = (v[rr][j].y - mu) * rs * g[j].y + bb[j].y;
        o.z = (v[rr][j].z - mu) * rs * g[j].z + bb[j].z; o.w = (v[rr][j].w - mu) * rs * g[j].w + bb[j].w;
        *(float4*)(p.out + O_Y + (long)(row0 + rr) * 1024 + j * 256 + lane * 4) = o;
      }
    }
  }
}

DI void grid_barrier(unsigned* bar, unsigned target) {
  asm volatile("s_waitcnt vmcnt(0) lgkmcnt(0)" ::: "memory");
  __syncthreads();
  if (threadIdx.x == 0) {
    __builtin_amdgcn_fence(__ATOMIC_RELEASE, "agent");
    asm volatile("s_waitcnt vmcnt(0)" ::: "memory");
    __hip_atomic_fetch_add(bar, 1u, __ATOMIC_RELAXED, __HIP_MEMORY_SCOPE_AGENT);
    while (__hip_atomic_load(bar, __ATOMIC_RELAXED, __HIP_MEMORY_SCOPE_AGENT) < target) __builtin_amdgcn_s_sleep(2);
    __builtin_amdgcn_fence(__ATOMIC_ACQUIRE, "agent");
    asm volatile("s_waitcnt vmcnt(0)" ::: "memory");
  }
  __syncthreads();
}
__global__ void __launch_bounds__(512) fwd_megakernel(Params p) {
  cg::grid_group grid = cg::this_grid();
  unsigned* bar = (unsigned*)(p.ws + WS_CTR + 64);
  const unsigned nb = gridDim.x;
  phase0(p);
  grid.sync();
  grid_barrier(bar, nb);
  phase1(p);
  grid_barrier(bar, 2 * nb);
  phase2(p);
  grid_barrier(bar, 3 * nb);
  phase3(p);
  grid_barrier(bar, 4 * nb);
  phase4(p);
}

extern "C" void kernel_launch(void* const* d_in, const int* in_sizes, int n_in, void* d_out, int out_size,
                              void* d_ws, size_t ws_size, hipStream_t stream) {
  static int grid_blocks = 0;
  if (!grid_blocks) {
    int dev = 0, cus = 0, per_cu = 0;
    (void)hipGetDevice(&dev);
    (void)hipDeviceGetAttribute(&cus, hipDeviceAttributeMultiprocessorCount, dev);
    (void)hipOccupancyMaxActiveBlocksPerMultiprocessor(&per_cu, fwd_megakernel, 512, 0);
    if (per_cu > 1) per_cu = 1;
    if (per_cu < 1) per_cu = 1;
    grid_blocks = cus * per_cu;
    if (ws_size < WS_END || out_size != (int)O_END) fprintf(stderr, "kernel_launch: unexpected sizes ws %zu (need %zu) out %d (need %ld)\n", ws_size, (size_t)WS_END, out_size, (long)O_END);
  }
  (void)hipMemsetAsync((char*)d_ws + WS_CTR, 0, 256, stream);
  Params p{};
  p.xp = (const float*)d_in[0]; p.xs = (const float*)d_in[1];
  p.cak = (const float*)d_in[2]; p.cav = (const float*)d_in[3]; p.cbk = (const float*)d_in[4]; p.cbv = (const float*)d_in[5];
  p.cmk = (const float*)d_in[6]; p.cmv = (const float*)d_in[7];
  p.memp = (const float*)d_in[8]; p.w_in = (const float*)d_in[9]; p.w_mem = (const float*)d_in[10]; p.relb = (const float*)d_in[11];
  p.dlam = (const float*)d_in[12]; p.subg = (const float*)d_in[13]; p.w_out = (const float*)d_in[14]; p.ln_g = (const float*)d_in[15]; p.ln_b = (const float*)d_in[16];
  p.out = (float*)d_out; p.ws = (char*)d_ws;
  void* args[] = {&p};
  hipError_t e = hipLaunchCooperativeKernel((void*)fwd_megakernel, dim3(grid_blocks), dim3(512), args, 0, stream);
  if (e != hipSuccess) fprintf(stderr, "cooperative launch failed: %s (grid %d)\n", hipGetErrorString(e), grid_blocks);
}
```

```cpp
#include <hip/hip_runtime.h>
#include <hip/hip_cooperative_groups.h>
#include <cstdio>
#include <cstdint>
namespace cg = cooperative_groups;

typedef unsigned short bf16_t;
typedef short bf16x8 __attribute__((ext_vector_type(8)));
typedef short s16x4 __attribute__((ext_vector_type(4)));
typedef float f32x16 __attribute__((ext_vector_type(16)));
typedef float f32x2_t __attribute__((ext_vector_type(2)));
typedef __bf16 bf16x2_t __attribute__((ext_vector_type(2)));
typedef unsigned u32x2 __attribute__((ext_vector_type(2)));
typedef unsigned u32x4 __attribute__((ext_vector_type(4)));
#define DI __device__ __forceinline__
#define MFMA32(a, b, c) __builtin_amdgcn_mfma_f32_32x32x16_bf16((a), (b), (c), 0, 0, 0)
#define LDS3 __attribute__((address_space(3)))

constexpr int D_MODEL = 1024, SEQ = 8192, NB = 4, NTOKP = NB * SEQ, SB = 32, ST = 16, NTOKS = SB * ST, NTOK = NTOKP + NTOKS;
constexpr int PAST = 1024, RA = 512, NMEM = 256, PROJ = 3584;
constexpr int SAK_ROWS = 576, SBK_ROWS = 1088;
constexpr int NTOKPAD = NTOK + 64;
constexpr float QSCALE = 0.125f * 1.4426950408889634f;
constexpr float LOG2E = 1.4426950408889634f;
constexpr float ALPHA = 1.189207115002721f;

constexpr long O_Y = 0;
constexpr long O_AKP = (long)NTOK * 1024;
constexpr long O_AVP = O_AKP + (long)NB * RA * 256;
constexpr long O_BKP = O_AVP + (long)NB * RA * 256;
constexpr long O_BVP = O_BKP + (long)NTOKP * 512;
constexpr long O_MKP = O_BVP + (long)NTOKP * 512;
constexpr long O_MVP = O_MKP + (long)NB * NMEM * 256;
constexpr long O_AKS = O_MVP + (long)NB * NMEM * 256;
constexpr long O_AVS = O_AKS + (long)NTOKS * 256;
constexpr long O_BKS = O_AVS + (long)NTOKS * 256;
constexpr long O_BVS = O_BKS + (long)NTOKS * 512;
constexpr long O_END = O_BVS + (long)NTOKS * 512;

constexpr size_t WS_CTR = 0;
constexpr size_t WS_WINT = 256;
constexpr size_t WS_WOUTT = WS_WINT + (size_t)PROJ * 1024 * 2;
constexpr size_t WS_WMEMT = WS_WOUTT + (size_t)1024 * 1024 * 2;
constexpr size_t WS_ROPE = WS_WMEMT + (size_t)512 * 1024 * 2;
constexpr size_t OB_AQ = 0;
constexpr size_t OB_BQ = OB_AQ + (size_t)NTOKPAD * 256 * 2;
constexpr size_t OB_MQ = OB_BQ + (size_t)NTOKPAD * 512 * 2;
constexpr size_t OB_AK = OB_MQ + (size_t)NTOKPAD * 256 * 2;
constexpr size_t OB_AV = OB_AK + (size_t)NTOKP * 256 * 2;
constexpr size_t OB_BK = OB_AV + (size_t)NTOKP * 256 * 2;
constexpr size_t OB_END = OB_BK + (size_t)NTOKP * 512 * 2;
static_assert(OB_END <= (size_t)NTOK * 1024 * 4, "temporaries must fit in the y region");
constexpr size_t WS_BV = WS_ROPE + (size_t)SEQ * 32 * 8;
constexpr size_t WS_G = WS_BV + (size_t)NTOKP * 512 * 2;
constexpr size_t WS_MK = WS_G + (size_t)NTOK * 1024 * 2;
constexpr size_t WS_MV = WS_MK + (size_t)NB * NMEM * 256 * 2;
constexpr size_t WS_SAK = WS_MV + (size_t)NB * NMEM * 256 * 2;
constexpr size_t WS_SAV = WS_SAK + (size_t)SB * SAK_ROWS * 256 * 2;
constexpr size_t WS_SBK = WS_SAV + (size_t)SB * SAK_ROWS * 256 * 2;
constexpr size_t WS_SBV = WS_SBK + (size_t)SB * SBK_ROWS * 512 * 2;
constexpr size_t WS_SMK = WS_SBV + (size_t)SB * SBK_ROWS * 512 * 2;
constexpr size_t WS_SMV = WS_SMK + (size_t)SB * NMEM * 256 * 2;
constexpr size_t WS_XB = WS_SMV + (size_t)SB * NMEM * 256 * 2;
constexpr size_t WS_MB = WS_XB + (size_t)NTOK * 1024 * 2;
constexpr size_t WS_END = WS_MB + (size_t)NB * NMEM * 1024 * 2;
static_assert(WS_END <= (size_t)512 * 1024 * 1024, "workspace budget");

struct Params {
  const float* xp; const float* xs;
  const float* cak; const float* cav; const float* cbk; const float* cbv; const float* cmk; const float* cmv;
  const float* memp; const float* w_in; const float* w_mem; const float* relb; const float* dlam; const float* subg;
  const float* w_out; const float* ln_g; const float* ln_b;
  float* out; char* ws;
};

constexpr int TEAM_LDS = 73728 + 64;
constexpr int LDS_BYTES = 2 * TEAM_LDS + 64;
__shared__ __attribute__((aligned(16))) char g_lds_all[LDS_BYTES];
#define TEAM (__builtin_amdgcn_readfirstlane((int)(threadIdx.x >> 8)))
#define g_lds (g_lds_all + TEAM * TEAM_LDS)

DI unsigned cvtpk(float lo, float hi) { f32x2_t v = {lo, hi}; bf16x2_t b = __builtin_convertvector(v, bf16x2_t); return __builtin_bit_cast(unsigned, b); }
DI bf16_t f2bf(float x) { return (bf16_t)(cvtpk(x, 0.f) & 0xffffu); }
DI float bf2f(unsigned short b) { return __uint_as_float(((unsigned)b) << 16); }
DI float bflo(unsigned u) { return __uint_as_float(u << 16); }
DI float bfhi(unsigned u) { return __uint_as_float(u & 0xffff0000u); }
DI float fexp2(float x) { return __builtin_amdgcn_exp2f(x); }
DI float xor32f(float v) { return __shfl_xor(v, 32); }

template <bool SWAP45>
DI void transpose_tile(const float* __restrict__ src, int N, bf16_t* __restrict__ dst, int K, int k0, int n0) {
  float* tile = (float*)g_lds;
  const int tid = threadIdx.x & 255, c = tid & 63, r0 = tid >> 6;
#pragma unroll
  for (int i = 0; i < 16; ++i) { const int row = r0 + 4 * i; tile[row * 65 + c] = src[(long)(k0 + row) * N + n0 + c]; }
  __syncthreads();
#pragma unroll
  for (int i = 0; i < 16; ++i) { const int rr = r0 + 4 * i; const int pr = SWAP45 ? ((rr & 15) | ((rr & 16) << 1) | ((rr & 32) >> 1)) : rr; dst[(long)(n0 + pr) * K + k0 + c] = f2bf(tile[c * 65 + rr]); }
  __syncthreads();
}

DI void convert_rows(const float* __restrict__ src, bf16_t* __restrict__ dst, int rows_w8, int dst_bstride_w8, long gtid, long gsz) {
  const long total = (long)SB * rows_w8;
  for (long u = gtid; u < total; u += gsz) {
    const int b = (int)(u / rows_w8); const int j = (int)(u - (long)b * rows_w8);
    const float4 a0 = *(const float4*)(src + u * 8), a1 = *(const float4*)(src + u * 8 + 4);
    u32x4 v; v.x = cvtpk(a0.x, a0.y); v.y = cvtpk(a0.z, a0.w); v.z = cvtpk(a1.x, a1.y); v.w = cvtpk(a1.z, a1.w);
    *(u32x4*)(dst + ((long)b * dst_bstride_w8 + j) * 8) = v;
  }
}

DI void phase0(const Params& p) {
  bf16_t* winT = (bf16_t*)(p.ws + WS_WINT); bf16_t* woutT = (bf16_t*)(p.ws + WS_WOUTT); bf16_t* wmemT = (bf16_t*)(p.ws + WS_WMEMT);
  constexpr int T_IN = 16 * 56, T_OUT = 16 * 16, T_MEM = 16 * 8;
  for (int t = blockIdx.x * 2 + TEAM; t < T_IN + T_OUT + T_MEM; t += gridDim.x * 2) {
    if (t < T_IN) transpose_tile<true>(p.w_in, PROJ, winT, 1024, (t / 56) * 64, (t % 56) * 64);
    else if (t < T_IN + T_OUT) { const int u = t - T_IN; transpose_tile<false>(p.w_out, 1024, woutT, 1024, (u >> 4) * 64, (u & 15) * 64); }
    else { const int u = t - T_IN - T_OUT; transpose_tile<false>(p.w_mem, 512, wmemT, 1024, (u >> 3) * 64, (u & 7) * 64); }
  }
  float2* rope = (float2*)(p.ws + WS_ROPE);
  for (int idx = blockIdx.x * 512 + threadIdx.x; idx < SEQ * 32; idx += gridDim.x * 512) {
    const int pos = idx >> 5, i = idx & 31;
    const double inv = exp(-(double)i * (9.210340371976184 / 32.0));
    const double rev = (double)pos * inv * 0.15915494309189535;
    const double fr = rev - rint(rev);
    const float a = (float)(fr * 6.283185307179586);
    rope[idx] = make_float2(cosf(a), sinf(a));
  }
  const int G = gridDim.x;
  const long gtid = (long)blockIdx.x * 512 + threadIdx.x, gsz = (long)G * 512;
  {
    bf16_t* XB = (bf16_t*)(p.ws + WS_XB); bf16_t* MB = (bf16_t*)(p.ws + WS_MB);
    const long nxp = (long)NTOKP * 1024 / 8, nxs = (long)NTOKS * 1024 / 8, nmb = (long)NB * NMEM * 1024 / 8;
    for (long u = gtid; u < nxp + nxs + nmb; u += gsz) {
      const float* src; bf16_t* dst;
      if (u < nxp) { src = p.xp + u * 8; dst = XB + u * 8; }
      else if (u < nxp + nxs) { src = p.xs + (u - nxp) * 8; dst = XB + u * 8; }
      else { src = p.memp + (u - nxp - nxs) * 8; dst = MB + (u - nxp - nxs) * 8; }
      const float4 a0 = *(const float4*)(src), a1 = *(const float4*)(src + 4);
      u32x4 v; v.x = cvtpk(a0.x, a0.y); v.y = cvtpk(a0.z, a0.w); v.z = cvtpk(a1.x, a1.y); v.w = cvtpk(a1.z, a1.w);
      *(u32x4*)dst = v;
    }
  }
}

constexpr int G_RS = 144, GA_BYTES = 128 * G_RS, GB_BYTES = 256 * G_RS, G_STAGE = GA_BYTES + GB_BYTES;
DI void gemm_core(const bf16_t* __restrict__ Ap, int lda, const bf16_t* __restrict__ Bp, int ldb, int K, f32x16 (&acc)[2][2]) {
  const int tid = threadIdx.x, lane = tid & 63, w = tid >> 6, wm = w >> 2, wn = w & 3, r = lane & 31, h = lane >> 5;
#pragma unroll
  for (int a = 0; a < 2; ++a)
#pragma unroll
    for (int b = 0; b < 2; ++b)
#pragma unroll
      for (int i = 0; i < 16; ++i) acc[a][b][i] = 0.f;
  u32x4 ra0[2], rb0[4], ra1[2], rb1[4];
  const int lrow = tid >> 3, lch = tid & 7;
  const bf16_t* Ag = Ap + (long)lrow * lda + lch * 8;
  const bf16_t* Bg = Bp + (long)lrow * ldb + lch * 8;
#define G_LOAD(RA, RB, kt)                                                                                      \
  {                                                                                                             \
    _Pragma("unroll") for (int i = 0; i < 2; ++i) RA[i] = *(const u32x4*)(Ag + (long)(64 * i) * lda + (kt) * 64); \
    _Pragma("unroll") for (int i = 0; i < 4; ++i) RB[i] = *(const u32x4*)(Bg + (long)(64 * i) * ldb + (kt) * 64); \
  }
#define G_WRITE(RA, RB, buf)                                                                                    \
  {                                                                                                             \
    char* Ab_ = g_lds_all + (buf) * G_STAGE; char* Bb_ = Ab_ + GA_BYTES;                                        \
    _Pragma("unroll") for (int i = 0; i < 2; ++i) *(u32x4*)(Ab_ + (lrow + 64 * i) * G_RS + lch * 16) = RA[i];   \
    _Pragma("unroll") for (int i = 0; i < 4; ++i) *(u32x4*)(Bb_ + (lrow + 64 * i) * G_RS + lch * 16) = RB[i];   \
  }
#define G_COMPUTE(buf)                                                                                          \
  {                                                                                                             \
    const char* Ab = g_lds_all + (buf) * G_STAGE; const char* Bb = Ab + GA_BYTES;                               \
    _Pragma("unroll") for (int s = 0; s < 4; ++s) {                                                             \
      const int co = (16 * s + 8 * h) * 2;                                                                      \
      const bf16x8 a0 = *(const bf16x8*)(Ab + (wm * 64 + r) * G_RS + co);                                       \
      const bf16x8 a1 = *(const bf16x8*)(Ab + (wm * 64 + 32 + r) * G_RS + co);                                  \
      const bf16x8 b0 = *(const bf16x8*)(Bb + (wn * 64 + r) * G_RS + co);                                       \
      const bf16x8 b1 = *(const bf16x8*)(Bb + (wn * 64 + 32 + r) * G_RS + co);                                  \
      acc[0][0] = MFMA32(a0, b0, acc[0][0]);                                                                    \
      acc[0][1] = MFMA32(a0, b1, acc[0][1]);                                                                    \
      acc[1][0] = MFMA32(a1, b0, acc[1][0]);                                                                    \
      acc[1][1] = MFMA32(a1, b1, acc[1][1]);                                                                    \
    }                                                                                                           \
  }
  const int nk = K >> 6;
  G_LOAD(ra0, rb0, 0);
  G_LOAD(ra1, rb1, 1);
  G_WRITE(ra0, rb0, 0);
  __syncthreads();
  for (int kt = 0; kt < nk; kt += 2) {
    if (kt + 2 < nk) G_LOAD(ra0, rb0, kt + 2);
    G_COMPUTE(0);
    G_WRITE(ra1, rb1, 1);
    __syncthreads();
    if (kt + 3 < nk) G_LOAD(ra1, rb1, kt + 3);
    G_COMPUTE(1);
    if (kt + 2 < nk) G_WRITE(ra0, rb0, 0);
    __syncthreads();
  }
#undef G_COMPUTE
#undef G_LOAD
#undef G_WRITE
}

namespace pg8 {
#define PG8_LAS __attribute__((address_space(3)))
typedef unsigned short bf16_t;
typedef short bf16x8 __attribute__((ext_vector_type(8)));
typedef float f32x4 __attribute__((ext_vector_type(4)));
typedef unsigned u32x4 __attribute__((ext_vector_type(4)));
constexpr int BM = 256, BK = 64, HALF = 128, HTB = HALF * BK * 2  , STAGE_BYTES = 8 * HTB, NXCD = 8, WGM = 8;

__host__ __device__ __forceinline__ int lds_byte(int r, int c) { const int st = (r >> 4) * 2 + (c >> 5), rr = r & 15, cc = c & 31, ob = rr * 64 + cc * 2; return st * 1024 + (ob ^ (((ob >> 9) & 1) << 5)); }
__host__ __device__ __forceinline__ void stage_rc(int b, int& R, int& C) { const int st = b / 1024, sb = b % 1024, swz = sb ^ (((sb >> 9) & 1) << 5); R = (st >> 1) * 16 + swz / 64; C = (st & 1) * 32 + (swz % 64) / 2; }
__host__ __device__ __forceinline__ int perm32(int rho) { const int n = rho >> 4, i = rho & 15; return 8 * (i >> 2) + 4 * n + (i & 3); }

struct Unit { int pm, pn; };
struct Gemm { const bf16_t* A; const bf16_t* Bt; int M, N, K; };

struct StaticOrder {
    int nM, nN, nwg, G, c;
    __host__ __device__ void init(int M, int N, int G_, int c_) { nM = M / BM; nN = N / BM; nwg = nM * nN; G = G_; c = c_; }
    __host__ __device__ bool next(int i, Unit& u) const {
        const long L = (long)i * G + c; if (L >= nwg) return false;
        int wgid = (int)L; { const int q = nwg / NXCD, r = nwg % NXCD, xcd = wgid % NXCD, off = wgid / NXCD; wgid = (xcd < r ? xcd * (q + 1) : r * (q + 1) + (xcd - r) * q) + off; }
        const int nig = WGM * nN, gid = wgid / nig, fm = gid * WGM, gsz = (nM - fm) < WGM ? (nM - fm) : WGM;
        u.pm = fm + ((wgid % nig) % gsz); u.pn = (wgid % nig) / gsz; return true;
    }
    __device__ __forceinline__ void a_ready(const Unit&) const {}
    __device__ __forceinline__ void done(const Unit&) const {}
};
template <class Epi, class Sched, bool STAMP = false>
__device__ __forceinline__ void gemm_phase(PG8_LAS unsigned char* lds, const Gemm g, const Sched& S, const Epi& E, unsigned long long* stamps) {
    const int tid = threadIdx.x, wid = __builtin_amdgcn_readfirstlane(tid >> 6), lane = tid & 63, wr = wid >> 2, wc = wid & 3, fr = lane & 15, fq = lane >> 4;
    const int K = g.K, nt = K / BK;
    int ts_lo = 0, ts_hi = 0, nts = 0; const unsigned long long rt_entry = STAMP ? (unsigned long long)wall_clock64() : 0ull;
#define PG8_STAMP() do { if (STAMP && wid == 0 && nts < 64) { const unsigned long long _c = (unsigned long long)clock64(); \
        ts_lo = (lane == nts) ? (int)(unsigned)_c : ts_lo; ts_hi = (lane == nts) ? (int)(unsigned)(_c >> 32) : ts_hi; ++nts; } } while (0)
    PG8_STAMP();
    unsigned voffA[2], voffB[2];
#pragma unroll
    for (int i = 0; i < 2; ++i) { int R, C; stage_rc(tid * 16 + i * 8192, R, C); const int Rb = Epi::PERM ? ((R & ~31) + perm32(R & 31)) : R;
        voffA[i] = (unsigned)(R * K + C) * 2u; voffB[i] = (unsigned)(Rb * K + C) * 2u; }
    const size_t kstep = (size_t)(BK * 2);
    const size_t hstep = (size_t)HALF * K * 2;
    const size_t tstep = 2 * hstep;
    const unsigned ldsw = (unsigned)wid * 1024u;
    const int aoff = lds_byte(wr * 64 + fr, fq * 8), boff = lds_byte(wc * 32 + fr, fq * 8);
#define PG8_SA(b, h) (((b) * 2 + (h)) * HTB)
#define PG8_SB(b, h) ((4 + (b) * 2 + (h)) * HTB)
#define PG8_STAGE(bufoff, gbase, voff) do { _Pragma("unroll") for (int _i = 0; _i < 2; ++_i) \
        __builtin_amdgcn_global_load_lds((const unsigned*)((const char*)(gbase) + (voff)[_i]), (PG8_LAS unsigned*)(lds + (bufoff) + ldsw + _i * 8192), 16, 0, 0); } while (0)
#define PG8_LDA(dst, b, h) do { _Pragma("unroll") for (int m = 0; m < 4; ++m) _Pragma("unroll") for (int k = 0; k < 2; ++k) dst[m][k] = *(const PG8_LAS bf16x8*)(lds + PG8_SA(b, h) + aoff + m * 2048 + k * 1024); } while (0)
#define PG8_LDB(dst, b, h) do { _Pragma("unroll") for (int n = 0; n < 2; ++n) _Pragma("unroll") for (int k = 0; k < 2; ++k) dst[n][k] = *(const PG8_LAS bf16x8*)(lds + PG8_SB(b, h) + boff + n * 2048 + k * 1024); } while (0)
#define PG8_MMA(ai, bj, At, Bt) do { __builtin_amdgcn_s_setprio(1); _Pragma("unroll") for (int m = 0; m < 4; ++m) _Pragma("unroll") for (int n = 0; n < 2; ++n) _Pragma("unroll") for (int k = 0; k < 2; ++k) \
        acc[ai][bj][m][n] = __builtin_amdgcn_mfma_f32_16x16x32_bf16(Bt[n][k], At[m][k], acc[ai][bj][m][n], 0, 0, 0); __builtin_amdgcn_s_setprio(0); } while (0)
#define PG8_WAIT_V(n) asm volatile("s_waitcnt vmcnt(" #n ")" ::: "memory")
#define PG8_WAIT_L(n) asm volatile("s_waitcnt lgkmcnt(" #n ")" ::: "memory")
#define PG8_BAR __builtin_amdgcn_s_barrier()
#define PG8_SCHED __builtin_amdgcn_sched_barrier(0)
    Unit cur, nxt; int ui = 0;
    if (!S.next(0, cur)) return;
    f32x4 acc[2][2][4][2];
#pragma unroll
    for (int a = 0; a < 2; ++a)
#pragma unroll
        for (int b = 0; b < 2; ++b)
#pragma unroll
            for (int m = 0; m < 4; ++m)
#pragma unroll
                for (int n = 0; n < 2; ++n) acc[a][b][m][n] = (f32x4){0.f, 0.f, 0.f, 0.f};
    bf16x8 At[4][2], B0[2][2], B1[2][2];
    const char* cA = (const char*)g.A + (size_t)cur.pm * tstep; const char* cB = (const char*)g.Bt + (size_t)cur.pn * tstep;
    S.a_ready(cur);
    PG8_STAGE(PG8_SB(0, 0), cB, voffB); PG8_STAGE(PG8_SA(0, 0), cA, voffA); PG8_STAGE(PG8_SB(0, 1), cB + hstep, voffB); PG8_STAGE(PG8_SA(0, 1), cA + hstep, voffA);
    if (wr == 1) PG8_BAR;
    PG8_WAIT_V(4); PG8_BAR;
    PG8_STAGE(PG8_SB(1, 0), cB + kstep, voffB); PG8_STAGE(PG8_SA(1, 0), cA + kstep, voffA); PG8_STAGE(PG8_SB(1, 1), cB + hstep + kstep, voffB);
    PG8_WAIT_V(6); PG8_BAR;
    PG8_STAMP();
    for (;;) {
        const bool has_next = S.next(ui + 1, nxt);
        const char* nA = has_next ? (const char*)g.A + (size_t)nxt.pm * tstep : cA; const char* nB = has_next ? (const char*)g.Bt + (size_t)nxt.pn * tstep : cB;
        for (int t = 0; t < nt; t += 2) {
            const bool last = (t == nt - 2);
            const char* a1 = cA + (size_t)(t + 1) * kstep;
            const char* a2 = last ? nA : cA + (size_t)(t + 2) * kstep; const char* b2 = last ? nB : cB + (size_t)(t + 2) * kstep;
            const char* a3 = a2 + kstep; const char* b3 = b2 + kstep;
            if (last && has_next) S.a_ready(nxt);
            PG8_LDB(B0, 0, 0); PG8_SCHED; PG8_LDA(At, 0, 0); PG8_STAGE(PG8_SA(1, 1), a1 + hstep, voffA);
            PG8_WAIT_L(8); PG8_BAR; PG8_WAIT_L(0); PG8_MMA(0, 0, At, B0); PG8_BAR; PG8_SCHED;
            PG8_LDB(B1, 0, 1); PG8_STAGE(PG8_SB(0, 0), b2, voffB);
            PG8_BAR; PG8_WAIT_L(0); PG8_MMA(0, 1, At, B1); PG8_BAR;
            PG8_LDA(At, 0, 1); PG8_STAGE(PG8_SA(0, 0), a2, voffA);
            PG8_BAR; PG8_WAIT_L(0); PG8_MMA(1, 0, At, B0); PG8_BAR; PG8_SCHED;
            PG8_STAGE(PG8_SB(0, 1), b2 + hstep, voffB);
            PG8_WAIT_V(6); PG8_BAR; PG8_MMA(1, 1, At, B1); PG8_BAR;
            PG8_LDB(B0, 1, 0); PG8_SCHED; PG8_LDA(At, 1, 0); PG8_STAGE(PG8_SA(0, 1), a2 + hstep, voffA);
            PG8_WAIT_L(8); PG8_BAR; PG8_WAIT_L(0); PG8_MMA(0, 0, At, B0); PG8_BAR; PG8_SCHED;
            PG8_LDB(B1, 1, 1); PG8_STAGE(PG8_SB(1, 0), b3, voffB);
            PG8_BAR; PG8_WAIT_L(0); PG8_MMA(0, 1, At, B1); PG8_BAR;
            PG8_LDA(At, 1, 1); PG8_STAGE(PG8_SA(1, 0), a3, voffA);
            PG8_BAR; PG8_WAIT_L(0); PG8_MMA(1, 0, At, B0); PG8_BAR; PG8_SCHED;
            PG8_STAGE(PG8_SB(1, 1), b3 + hstep, voffB);
            PG8_WAIT_V(6); PG8_BAR; PG8_MMA(1, 1, At, B1); PG8_BAR;
        }
        PG8_STAMP();
        if constexpr (!Epi::AFTER_DRAIN) { E(acc, cur, wr, wc, fr, fq); S.done(cur); }
        PG8_STAMP();
        if (!has_next) break;
#pragma unroll
        for (int a = 0; a < 2; ++a)
#pragma unroll
            for (int b = 0; b < 2; ++b)
#pragma unroll
                for (int m = 0; m < 4; ++m)
#pragma unroll
                    for (int n = 0; n < 2; ++n) acc[a][b][m][n] = (f32x4){0.f, 0.f, 0.f, 0.f};
        cur = nxt; cA = nA; cB = nB; ++ui;
    }
    PG8_WAIT_V(0);
    if (wr == 0) PG8_BAR;
    PG8_BAR;
    if constexpr (Epi::AFTER_DRAIN) { E.fused(acc, cur, wr, wc, fr, fq, lds, wid, lane); S.done(cur); }
    PG8_STAMP();
    if (STAMP && wid == 0) { stamps[lane] = lane < nts ? (((unsigned long long)(unsigned)ts_hi << 32) | (unsigned)ts_lo) : 0ull;
        if (lane == 62) stamps[62] = rt_entry; if (lane == 63) stamps[63] = (unsigned long long)wall_clock64(); }
#undef PG8_STAMP
#undef PG8_SA
#undef PG8_SB
#undef PG8_STAGE
#undef PG8_LDA
#undef PG8_LDB
#undef PG8_MMA
#undef PG8_WAIT_V
#undef PG8_WAIT_L
#undef PG8_BAR
#undef PG8_SCHED
}
}

struct EpiProj {
  static constexpr bool PERM = false, AFTER_DRAIN = false;
  float* out; char* ws;
  __device__ __forceinline__ void operator()(const pg8::f32x4 (&acc)[2][2][4][2], const pg8::Unit& u, int wr, int wc, int fr, int fq) const {
    asm volatile("" : "+v"(fr), "+v"(fq));
    char* ob = (char*)out;
    const int n0 = u.pn * 256;
    int seg, sbase;
    if (n0 < 256) { seg = 0; sbase = 0; } else if (n0 < 512) { seg = 1; sbase = 256; } else if (n0 < 768) { seg = 2; sbase = 512; }
    else if (n0 < 1280) { seg = 3; sbase = 768; } else if (n0 < 1792) { seg = 4; sbase = 1280; } else if (n0 < 2304) { seg = 5; sbase = 1792; }
    else if (n0 < 2560) { seg = 6; sbase = 2304; } else { seg = 7; sbase = 2560; }
    const bool smp = u.pm >= NTOKP / 256;
    const float2* rope = (const float2*)(ws + WS_ROPE);
    const int fi = 16 * (wc & 1) + 4 * fq;
#pragma unroll
    for (int ai = 0; ai < 2; ++ai)
#pragma unroll
      for (int m = 0; m < 4; ++m) {
        const int row = 128 * ai + 64 * wr + 16 * m + fr;
        const long tok = (long)u.pm * 256 + row;
        const long ts = tok - NTOKP;
        float4 c01, s01, c23, s23;
        if (seg == 3 || seg == 4) {
          const int pos = smp ? (PAST + (int)(ts & 15)) : (int)(tok & (SEQ - 1));
          const float4 r0 = *(const float4*)(rope + pos * 32 + fi), r1 = *(const float4*)(rope + pos * 32 + fi + 2);
          c01 = make_float4(r0.x, r0.z, r1.x, r1.z); s01 = make_float4(r0.y, r0.w, r1.y, r1.w);
        }
#pragma unroll
        for (int bj = 0; bj < 2; ++bj) {
          const int blk = 4 * u.pn + 2 * bj + (wc >> 1);
          const int col = 64 * blk + fi - sbase;
          pg8::f32x4 v0 = acc[ai][bj][m][0], v1 = acc[ai][bj][m][1];
          if (seg == 3 || seg == 4) {
            const pg8::f32x4 cc = {c01.x, c01.y, c01.z, c01.w}, ss = {s01.x, s01.y, s01.z, s01.w};
            const pg8::f32x4 a = v0 * cc - v1 * ss, b = v1 * cc + v0 * ss;
            v0 = a; v1 = b;
          }
          if (seg == 0 || seg == 3 || seg == 6) {
            bf16_t* q = (seg == 0) ? (bf16_t*)(ob + OB_AQ) + tok * 256 : (seg == 3) ? (bf16_t*)(ob + OB_BQ) + tok * 512 : (bf16_t*)(ob + OB_MQ) + tok * 256;
            u32x2 w0, w1; w0.x = cvtpk(v0[0] * QSCALE, v0[1] * QSCALE); w0.y = cvtpk(v0[2] * QSCALE, v0[3] * QSCALE);
            w1.x = cvtpk(v1[0] * QSCALE, v1[1] * QSCALE); w1.y = cvtpk(v1[2] * QSCALE, v1[3] * QSCALE);
            *(u32x2*)(q + col) = w0; *(u32x2*)(q + col + 32) = w1;
          } else if (seg == 7) {
            bf16_t* g = (bf16_t*)(ws + WS_G) + tok * 1024;
            float a[4], b[4];
#pragma unroll
            for (int j = 0; j < 4; ++j) { a[j] = v0[j] / (1.f + __expf(-v0[j])); b[j] = v1[j] / (1.f + __expf(-v1[j])); }
            u32x2 w0, w1; w0.x = cvtpk(a[0], a[1]); w0.y = cvtpk(a[2], a[3]); w1.x = cvtpk(b[0], b[1]); w1.y = cvtpk(b[2], b[3]);
            *(u32x2*)(g + col) = w0; *(u32x2*)(g + col + 32) = w1;
          } else {
            const bool wide = (seg >= 4);
            const int W = wide ? 512 : 256;
            bf16_t* kw; float* o = nullptr;
            if (!smp) {
              if (seg == 1) kw = (bf16_t*)(ob + OB_AK) + tok * 256; else if (seg == 2) kw = (bf16_t*)(ob + OB_AV) + tok * 256;
              else if (seg == 4) kw = (bf16_t*)(ob + OB_BK) + tok * 512; else kw = (bf16_t*)(ws + WS_BV) + tok * 512;
              if (wide) o = out + (seg == 4 ? O_BKP : O_BVP) + tok * 512;
              else { const int ps = (int)(tok & (SEQ - 1)); const int pb = (int)(tok >> 13); if (ps >= SEQ - RA) o = out + (seg == 1 ? O_AKP : O_AVP) + (long)(pb * RA + ps - (SEQ - RA)) * 256; }
            } else {
              kw = nullptr;
              if (wide) o = out + (seg == 4 ? O_BKS : O_BVS) + ts * 512; else o = out + (seg == 1 ? O_AKS : O_AVS) + ts * 256;
            }
            (void)W;
            u32x2 w0, w1; w0.x = cvtpk(v0[0], v0[1]); w0.y = cvtpk(v0[2], v0[3]); w1.x = cvtpk(v1[0], v1[1]); w1.y = cvtpk(v1[2], v1[3]);
            if (kw) { *(u32x2*)(kw + col) = w0; *(u32x2*)(kw + col + 32) = w1; }
            if (o) { *(pg8::f32x4*)(o + col) = v0; *(pg8::f32x4*)(o + col + 32) = v1; }
          }
        }
      }
  }
};

struct EpiOut {
  static constexpr bool PERM = false, AFTER_DRAIN = false;
  float* out; const float* xp; const float* xs;
  __device__ __forceinline__ void operator()(const pg8::f32x4 (&acc)[2][2][4][2], const pg8::Unit& u, int wr, int wc, int fr, int fq) const {
    asm volatile("" : "+v"(fr), "+v"(fq));
    const float* xb = (u.pm < NTOKP / 256) ? xp + (long)u.pm * 256 * 1024 : xs + (long)(u.pm - NTOKP / 256) * 256 * 1024;
    float* yb = out + O_Y + (long)u.pm * 256 * 1024;
    const int col0 = u.pn * 256 + wc * 32 + 4 * fq;
#pragma unroll
    for (int ai = 0; ai < 2; ++ai)
#pragma unroll
      for (int mp = 0; mp < 2; ++mp) {
        pg8::f32x4 xv[2][2][2];
#pragma unroll
        for (int mm = 0; mm < 2; ++mm) {
          const long ro = (long)(128 * ai + 64 * wr + 16 * (2 * mp + mm) + fr) * 1024 + col0;
#pragma unroll
          for (int bj = 0; bj < 2; ++bj)
#pragma unroll
            for (int n = 0; n < 2; ++n) xv[mm][bj][n] = *(const pg8::f32x4*)(xb + ro + bj * 128 + n * 16);
        }
#pragma unroll
        for (int mm = 0; mm < 2; ++mm) {
          const long ro = (long)(128 * ai + 64 * wr + 16 * (2 * mp + mm) + fr) * 1024 + col0;
#pragma unroll
          for (int bj = 0; bj < 2; ++bj)
#pragma unroll
            for (int n = 0; n < 2; ++n) *(pg8::f32x4*)(yb + ro + bj * 128 + n * 16) = acc[ai][bj][2 * mp + mm][n] + ALPHA * xv[mm][bj][n];
        }
      }
  }
};

DI void mem_epilogue(const Params& p, int mt, int nt, f32x16 (&acc)[2][2]) {
  const int tid = threadIdx.x, lane = tid & 63, w = tid >> 6, wm = w >> 2, wn = w & 3, c = lane & 31, h = lane >> 5;
  const int n0 = nt * 256 + wn * 64;
  const bool isv = n0 >= 256;
  const int cb = isv ? n0 - 256 : n0;
  bf16_t* kw = (bf16_t*)(p.ws + (isv ? WS_MV : WS_MK));
  float* o = p.out + (isv ? O_MVP : O_MKP);
#pragma unroll
  for (int mi = 0; mi < 2; ++mi)
#pragma unroll
    for (int i = 0; i < 16; ++i) {
      const long row = mt * 128 + wm * 64 + mi * 32 + (i & 3) + 8 * (i >> 2) + 4 * h;
      const float v0 = acc[mi][0][i], v1 = acc[mi][1][i];
      kw[row * 256 + cb + c] = f2bf(v0); kw[row * 256 + cb + c + 32] = f2bf(v1);
      o[row * 256 + cb + c] = v0; o[row * 256 + cb + c + 32] = v1;
    }
}

DI void phase1(const Params& p) {
  const int G = gridDim.x;
  const bf16_t* winT = (const bf16_t*)(p.ws + WS_WINT); const bf16_t* wmemT = (const bf16_t*)(p.ws + WS_WMEMT);
  const bf16_t* XB = (const bf16_t*)(p.ws + WS_XB); const bf16_t* MB = (const bf16_t*)(p.ws + WS_MB);
  {
    pg8::Gemm g; g.A = XB; g.Bt = winT; g.M = NTOK; g.N = PROJ; g.K = 1024;
    pg8::StaticOrder S; S.init(NTOK, PROJ, G, (int)blockIdx.x);
    EpiProj E; E.out = p.out; E.ws = p.ws;
    pg8::gemm_phase<EpiProj, pg8::StaticOrder, false>((PG8_LAS unsigned char*)g_lds_all, g, S, E, nullptr);
  }
  __syncthreads();
  constexpr int T2 = 8 * 2;
  f32x16 acc[2][2];
  for (int t = (int)blockIdx.x - 64; t >= 0 && t < T2; t += G) {
    const int mt = t >> 1, nt = t & 1;
    gemm_core(MB + (long)mt * 128 * 1024, 1024, wmemT + (long)nt * 256 * 1024, 1024, 1024, acc);
    mem_epilogue(p, mt, nt, acc);
  }
}

struct AttnItem {
  const bf16_t* q0; const bf16_t* q1;
  const bf16_t* k; const bf16_t* v;
  bf16_t* g0; bf16_t* g1;
  int qs, ks, ntiles, nkeys;
  int tlo0, thi0, tlo1, thi1;
  int rows0, rows1;
  int qpos0, qpos1, kpos0, head0; bool bias;
  const float* kf; const float* vf;
  const float* kn; const float* vn;
  int ncache;
};
constexpr int AK_RS = 272, AK_BYTES = 64 * AK_RS, AV_BYTES = 16384, A_BUF = AK_BYTES + AV_BYTES;
constexpr int A_BIAS_OFF = 2 * A_BUF;
constexpr int A_ITEM_OFF = 2 * TEAM_LDS;
constexpr int A_Q_OFF = 73728;

template <bool DIFF, bool BIAS, bool MASK, bool F32>
DI void attn_item(const AttnItem& it, float lam, const float* __restrict__ subg) {
  const int tid = threadIdx.x, lane = tid & 63, w = tid >> 6, r = lane & 31, h = lane >> 5;
  const int half = __builtin_amdgcn_readfirstlane(w >> 2), qh = w & 1, m = (w >> 1) & 1;
  constexpr int NDT = DIFF ? 4 : 2;
  const int ntiles = it.ntiles;
  const int tlo = half ? it.tlo1 : it.tlo0, thi = half ? it.thi1 : it.thi0, rows = half ? it.rows1 : it.rows0;
  const bf16_t* qbase = half ? it.q1 : it.q0;
  bf16_t* gbase = half ? it.g1 : it.g0;
  char* qlds = g_lds_all + A_Q_OFF + w * 4096 + lane * 16;
  {
    const bf16_t* qp = qbase + (long)(qh * 32 + r) * it.qs + m * 64 + 8 * h;
#pragma unroll
    for (int s = 0; s < 4; ++s) *(bf16x8*)(qlds + s * 1024) = *(const bf16x8*)(qp + 16 * s);
  }
  f32x16 oacc[NDT];
#pragma unroll
  for (int d = 0; d < NDT; ++d)
#pragma unroll
    for (int i = 0; i < 16; ++i) oacc[d][i] = 0.f;
  float m_run = -1e30f, l_run = 0.f;
  u32x4 rk0[2], rv0[2];
  float4 fk[4], fv[4];
  const int kch = tid & 15, krow = tid >> 4, vsub = tid & 3, vkey = (tid >> 2) & 63, vd = tid >> 8;
  const bf16_t* kg = it.k + (long)krow * it.ks + kch * 8;
  const bf16_t* vg = it.v + (long)vkey * it.ks + vd * 32 + vsub * 8;
#define A_LOAD(RK, RV, t)                                                                                        \
  if (!F32) {                                                                                                    \
    _Pragma("unroll") for (int i = 0; i < 2; ++i) RK[i] = *(const u32x4*)(kg + (long)((t) * 64 + 32 * i) * it.ks); \
    _Pragma("unroll") for (int i = 0; i < 2; ++i) RV[i] = *(const u32x4*)(vg + (long)((t) * 64) * it.ks + 64 * i); \
  } else {                                                                                                       \
    const bool nw = (t) >= it.ncache;             \
    _Pragma("unroll") for (int i = 0; i < 2; ++i) {                                                              \
      const int kr = krow + 32 * i;                                                                              \
      const float* src = nw ? it.kn + (long)(kr < 15 ? kr : 15) * it.ks : it.kf + (long)((t) * 64 + kr) * it.ks; \
      fk[2 * i] = *(const float4*)(src + kch * 8); fk[2 * i + 1] = *(const float4*)(src + kch * 8 + 4);          \
    }                                                                                                            \
    {                                                                                                            \
      const float* src = nw ? it.vn + (long)(vkey < 15 ? vkey : 15) * it.ks : it.vf + (long)((t) * 64 + vkey) * it.ks; \
      _Pragma("unroll") for (int i = 0; i < 2; ++i) {                                                            \
        fv[2 * i] = *(const float4*)(src + (vd + 2 * i) * 32 + vsub * 8); fv[2 * i + 1] = *(const float4*)(src + (vd + 2 * i) * 32 + vsub * 8 + 4); \
      }                                                                                                          \
    }                                                                                                            \
  }
#define A_WRITE(RK, RV, stage)                                                                                   \
  {                                                                                                              \
    char* Kb_ = g_lds_all + (stage) * A_BUF; char* Vb_ = Kb_ + AK_BYTES;                                         \
    if (F32) {                                                                                                   \
      _Pragma("unroll") for (int i = 0; i < 2; ++i) {                                                            \
        RK[i].x = cvtpk(fk[2 * i].x, fk[2 * i].y); RK[i].y = cvtpk(fk[2 * i].z, fk[2 * i].w); RK[i].z = cvtpk(fk[2 * i + 1].x, fk[2 * i + 1].y); RK[i].w = cvtpk(fk[2 * i + 1].z, fk[2 * i + 1].w); \
        RV[i].x = cvtpk(fv[2 * i].x, fv[2 * i].y); RV[i].y = cvtpk(fv[2 * i].z, fv[2 * i].w); RV[i].z = cvtpk(fv[2 * i + 1].x, fv[2 * i + 1].y); RV[i].w = cvtpk(fv[2 * i + 1].z, fv[2 * i + 1].w); \
      }                                                                                                          \
    }                                                                                                            \
    _Pragma("unroll") for (int i = 0; i < 2; ++i) *(u32x4*)(Kb_ + (krow + 32 * i) * AK_RS + kch * 16) = RK[i];   \
    _Pragma("unroll") for (int i = 0; i < 2; ++i) *(u32x4*)(Vb_ + (vd + 2 * i) * 4096 + vkey * 64 + vsub * 16) = RV[i]; \
  }
  const int vlane = ((lane >> 4) & 1) * 32 + (lane & 3) * 8 + (4 * h + ((lane & 15) >> 2)) * 64;
  const float* biasT = (const float*)(g_lds_all + A_BIAS_OFF) + (it.head0 + m) * 257;
  const int qpos = (half ? it.qpos1 : it.qpos0) + qh * 32 + r;
#define A_COMPUTE(t, stage)                                                                                      \
  if ((t) >= tlo && (t) < thi) {                                                                                 \
    const char* Kb = g_lds_all + (stage) * A_BUF; const char* Vb = Kb + AK_BYTES;                                \
    f32x16 s0, s1;                                                                                               \
    _Pragma("unroll") for (int i = 0; i < 16; ++i) { s0[i] = 0.f; s1[i] = 0.f; }                                 \
    _Pragma("unroll") for (int s = 0; s < 4; ++s) {                                                              \
      const int co = (m * 64 + 16 * s + 8 * h) * 2;                                                              \
      const bf16x8 k0 = *(const bf16x8*)(Kb + r * AK_RS + co);                                                   \
      const bf16x8 k1 = *(const bf16x8*)(Kb + (32 + r) * AK_RS + co);                                            \
      const bf16x8 qfs = *(const bf16x8*)(qlds + s * 1024);                                                      \
      s0 = MFMA32(k0, qfs, s0);                                                                                  \
      s1 = MFMA32(k1, qfs, s1);                                                                                  \
    }                                                                                                            \
    if (BIAS) {                                                                                                  \
      const int kb = it.kpos0 + (t) * 64 + 4 * h;                                                                \
      _Pragma("unroll") for (int i = 0; i < 16; ++i) {                                                           \
        const int kk = kb + (i & 3) + 8 * (i >> 2);                                                              \
        int d0 = qpos - kk, d1 = d0 - 32;                                                                        \
        d0 = min(max(d0, -128), 128) + 128; d1 = min(max(d1, -128), 128) + 128;                                  \
        s0[i] += biasT[d0]; s1[i] += biasT[d1];                                                                  \
      }                                                                                                          \
    }                                                                                                            \
    if (MASK && ((t) + 1) * 64 > it.nkeys) {                                                                     \
      const int kb = (t) * 64 + 4 * h;                                                                           \
      _Pragma("unroll") for (int i = 0; i < 16; ++i) {                                                           \
        const int kk = kb + (i & 3) + 8 * (i >> 2);                                                              \
        if (kk >= it.nkeys) s0[i] = -1e30f;                                                                      \
        if (kk + 32 >= it.nkeys) s1[i] = -1e30f;                                                                 \
      }                                                                                                          \
    }                                                                                                            \
    float mx = fmaxf(s0[0], s1[0]);                                                                              \
    _Pragma("unroll") for (int i = 1; i < 16; ++i) mx = fmaxf(mx, fmaxf(s0[i], s1[i]));                          \
    mx = fmaxf(mx, xor32f(mx));                                                                                  \
    const float m_new = fmaxf(m_run, mx);                                                                        \
    const float alpha = fexp2(m_run - m_new);                                                                    \
    if (__builtin_amdgcn_ballot_w64(m_new > m_run) != 0ull) {                                                    \
      _Pragma("unroll") for (int d = 0; d < NDT; ++d)                                                            \
        _Pragma("unroll") for (int i = 0; i < 16; ++i) oacc[d][i] *= alpha;                                      \
    }                                                                                                            \
    l_run *= alpha;                                                                                              \
    m_run = m_new;                                                                                               \
    float ls = 0.f;                                                                                              \
    _Pragma("unroll") for (int i = 0; i < 16; ++i) { s0[i] = fexp2(s0[i] - m_new); s1[i] = fexp2(s1[i] - m_new); ls += s0[i] + s1[i]; } \
    l_run += ls;                                                                                                 \
    bf16x8 pf[4];                                                                                                \
    _Pragma("unroll") for (int s2 = 0; s2 < 2; ++s2) {                                                           \
      u32x4 a, b;                                                                                                \
      a.x = cvtpk(s0[8 * s2 + 0], s0[8 * s2 + 1]); a.y = cvtpk(s0[8 * s2 + 2], s0[8 * s2 + 3]);                  \
      a.z = cvtpk(s0[8 * s2 + 4], s0[8 * s2 + 5]); a.w = cvtpk(s0[8 * s2 + 6], s0[8 * s2 + 7]);                  \
      b.x = cvtpk(s1[8 * s2 + 0], s1[8 * s2 + 1]); b.y = cvtpk(s1[8 * s2 + 2], s1[8 * s2 + 3]);                  \
      b.z = cvtpk(s1[8 * s2 + 4], s1[8 * s2 + 5]); b.w = cvtpk(s1[8 * s2 + 6], s1[8 * s2 + 7]);                  \
      pf[s2] = __builtin_bit_cast(bf16x8, a); pf[2 + s2] = __builtin_bit_cast(bf16x8, b);                        \
    }                                                                                                            \
    const LDS3 char* vb3 = (const LDS3 char*)(Vb) + vlane + (DIFF ? 0 : m * 2 * 4096);                           \
    _Pragma("unroll") for (int ks = 0; ks < 4; ++ks) {                                                           \
      _Pragma("unroll") for (int d = 0; d < NDT; ++d) {                                                          \
        const s16x4 lo = __builtin_bit_cast(s16x4, __builtin_amdgcn_ds_read_tr16_b64_v4i16((LDS3 s16x4*)(vb3 + d * 4096 + ks * 1024))); \
        const s16x4 hi = __builtin_bit_cast(s16x4, __builtin_amdgcn_ds_read_tr16_b64_v4i16((LDS3 s16x4*)(vb3 + d * 4096 + ks * 1024 + 512))); \
        const bf16x8 vf = __builtin_shufflevector(lo, hi, 0, 1, 2, 3, 4, 5, 6, 7);                               \
        oacc[d] = MFMA32(vf, pf[ks], oacc[d]);                                                                   \
      }                                                                                                          \
      __builtin_amdgcn_sched_barrier(0);                                                                         \
    }                                                                                                            \
  }
  A_LOAD(rk0, rv0, 0);
  A_WRITE(rk0, rv0, 0);
  if (ntiles > 1) A_LOAD(rk0, rv0, 1);
  __syncthreads();
#pragma unroll 1
  for (int t = 0; t < ntiles; ++t) {
    const int par = t & 1;
    if (t + 1 < ntiles) A_WRITE(rk0, rv0, par ^ 1);
    if (t + 2 < ntiles) A_LOAD(rk0, rv0, t + 2);
    A_COMPUTE(t, par);
    __syncthreads();
  }
#undef A_LOAD
#undef A_WRITE
#undef A_COMPUTE
  const float l_tot = l_run + xor32f(l_run);
  const float inv = 1.f / l_tot;
  const int q = qh * 32 + r;
  if (!DIFF) {
    if (q < rows) {
      bf16_t* gp = gbase + (long)q * 1024 + m * 64 + 4 * h;
      u32x2 gvv[NDT][4];
#pragma unroll
      for (int d = 0; d < NDT; ++d)
#pragma unroll
        for (int g4 = 0; g4 < 4; ++g4) gvv[d][g4] = *(const u32x2*)(gp + d * 32 + 8 * g4);
#pragma unroll
      for (int d = 0; d < NDT; ++d)
#pragma unroll
        for (int g4 = 0; g4 < 4; ++g4) {
          u32x2* ptr = (u32x2*)(gp + d * 32 + 8 * g4);
          const u32x2 gv = gvv[d][g4];
          u32x2 o;
          o.x = cvtpk(oacc[d][4 * g4 + 0] * inv * bflo(gv.x), oacc[d][4 * g4 + 1] * inv * bfhi(gv.x));
          o.y = cvtpk(oacc[d][4 * g4 + 2] * inv * bflo(gv.y), oacc[d][4 * g4 + 3] * inv * bfhi(gv.y));
          *ptr = o;
        }
    }
  } else {
    float* xb = (float*)g_lds_all + half * 8192 + qh * 4096 + lane;
    if (m == 1) {
      const float sc = lam * inv;
#pragma unroll
      for (int d = 0; d < NDT; ++d)
#pragma unroll
        for (int i = 0; i < 16; ++i) xb[(d * 16 + i) * 64] = oacc[d][i] * sc;
    }
    __syncthreads();
    if (m == 0) {
      float ss = 0.f;
#pragma unroll
      for (int d = 0; d < NDT; ++d)
#pragma unroll
        for (int i = 0; i < 16; ++i) { const float o = oacc[d][i] * inv - xb[(d * 16 + i) * 64]; oacc[d][i] = o; ss += o * o; }
      ss += xor32f(ss);
      const float rn = rsqrtf(ss * (1.f / 128.f) + 1e-5f) * 0.8f;
      if (q < rows) {
        bf16_t* gp = gbase + (long)q * 1024 + 4 * h;
        u32x2 gvv[NDT][4];
#pragma unroll
        for (int d = 0; d < NDT; ++d)
#pragma unroll
          for (int g4 = 0; g4 < 4; ++g4) gvv[d][g4] = *(const u32x2*)(gp + d * 32 + 8 * g4);
#pragma unroll
        for (int d = 0; d < NDT; ++d)
#pragma unroll
          for (int g4 = 0; g4 < 4; ++g4) {
            const float4 sg = *(const float4*)(subg + d * 32 + 8 * g4 + 4 * h);
            u32x2* ptr = (u32x2*)(gp + d * 32 + 8 * g4);
            const u32x2 gv = gvv[d][g4];
            u32x2 o;
            o.x = cvtpk(oacc[d][4 * g4 + 0] * rn * sg.x * bflo(gv.x), oacc[d][4 * g4 + 1] * rn * sg.y * bfhi(gv.x));
            o.y = cvtpk(oacc[d][4 * g4 + 2] * rn * sg.z * bflo(gv.y), oacc[d][4 * g4 + 3] * rn * sg.w * bfhi(gv.y));
            *ptr = o;
          }
      }
    }
    __syncthreads();
  }
}

DI void phase2(const Params& p) {
  char* ws = p.ws;
  float* biasT = (float*)(g_lds_all + A_BIAS_OFF);
  for (int i = threadIdx.x; i < 4 * 257; i += 512) biasT[i] = p.relb[i] * LOG2E;
  float s1 = 0.f, s2 = 0.f;
  for (int i = 0; i < 64; ++i) { s1 += p.dlam[i] * p.dlam[64 + i]; s2 += p.dlam[128 + i] * p.dlam[192 + i]; }
  const float lam = expf(s1) - expf(s2) + 0.2f;
  __syncthreads();
  int* ctr = (int*)(ws + WS_CTR);
  int* s_item = (int*)(g_lds_all + A_ITEM_OFF);
  const char* ob = (const char*)p.out;
  const bf16_t* AQ = (const bf16_t*)(ob + OB_AQ); const bf16_t* AK = (const bf16_t*)(ob + OB_AK); const bf16_t* AV = (const bf16_t*)(ob + OB_AV);
  const bf16_t* BQ = (const bf16_t*)(ob + OB_BQ); const bf16_t* BK = (const bf16_t*)(ob + OB_BK); const bf16_t* BV = (const bf16_t*)(ws + WS_BV);
  const bf16_t* MQ = (const bf16_t*)(ob + OB_MQ); const bf16_t* MK = (const bf16_t*)(ws + WS_MK); const bf16_t* MV = (const bf16_t*)(ws + WS_MV);
  bf16_t* G = (bf16_t*)(ws + WS_G);
  constexpr int N_BP = 1024, N_BS = 128, N_AP = 512, N_AS = 64, N_MP = 512, N_MS = 64;
  constexpr int N_ALL = N_BP + N_BS + N_AP + N_AS + N_MP + N_MS;
  for (;;) {
    if (threadIdx.x == 0) *s_item = atomicAdd(ctr, 1);
    __syncthreads();
    int item = *s_item;
    __syncthreads();
    if (item >= N_ALL) break;
    AttnItem it;
    it.bias = false; it.qpos0 = 0; it.qpos1 = 0; it.kpos0 = 0; it.head0 = 0; it.rows0 = 64; it.rows1 = 64;
    it.kf = nullptr; it.vf = nullptr; it.kn = nullptr; it.vn = nullptr; it.ncache = 0; it.k = nullptr; it.v = nullptr;
    if (item < N_BP) {
      const int j = 63 - (item >> 4), bh = item & 15, b = bh >> 2, hh = bh & 3;
      const long tok0 = (long)b * SEQ + j * 128;
      it.q0 = BQ + tok0 * 512 + hh * 128; it.q1 = it.q0 + 64 * 512;
      it.k = BK + (long)b * SEQ * 512 + hh * 128; it.v = BV + (long)b * SEQ * 512 + hh * 128;
      it.qs = 512; it.ks = 512; it.ntiles = 2 * j + 2; it.nkeys = it.ntiles * 64;
      it.tlo0 = 0; it.thi0 = 2 * j + 1; it.tlo1 = 0; it.thi1 = 2 * j + 2;
      it.g0 = G + tok0 * 1024 + 256 + hh * 128; it.g1 = it.g0 + 64 * 1024;
      attn_item<true, false, false, false>(it, lam, p.subg);
      continue;
    }
    item -= N_BP;
    if (item < N_BS) {
      const int b = item >> 2, hh = item & 3;
      const long tok0 = NTOKP + b * ST;
      it.q0 = BQ + tok0 * 512 + hh * 128; it.q1 = it.q0;
      it.kf = p.cbk + (long)b * PAST * 512 + hh * 128; it.vf = p.cbv + (long)b * PAST * 512 + hh * 128; it.ncache = PAST / 64;
      it.kn = p.out + O_BKS + (long)b * ST * 512 + hh * 128; it.vn = p.out + O_BVS + (long)b * ST * 512 + hh * 128;
      it.qs = 512; it.ks = 512; it.ntiles = 17; it.nkeys = PAST + ST;
      it.tlo0 = 0; it.thi0 = 17; it.tlo1 = 0; it.thi1 = 0; it.rows0 = ST; it.rows1 = 0;
      it.g0 = G + tok0 * 1024 + 256 + hh * 128; it.g1 = it.g0;
      attn_item<true, false, true, true>(it, lam, p.subg);
      continue;
    }
    item -= N_BS;
    if (item < N_AP) {
      const int j = 63 - (item >> 3), bh = item & 7, b = bh >> 1, hp = bh & 1;
      const int c0 = 2 * j, c1 = c0 + 1, cs0 = c0 > 8 ? c0 - 8 : 0, cs1 = c1 > 8 ? c1 - 8 : 0;
      const long tok0 = (long)b * SEQ + c0 * 64, k0 = (long)b * SEQ + cs0 * 64;
      it.q0 = AQ + tok0 * 256 + hp * 128; it.q1 = it.q0 + 64 * 256;
      it.k = AK + k0 * 256 + hp * 128; it.v = AV + k0 * 256 + hp * 128;
      it.qs = 256; it.ks = 256; it.ntiles = c1 - cs0 + 1; it.nkeys = it.ntiles * 64;
      it.tlo0 = 0; it.thi0 = c0 - cs0 + 1; it.tlo1 = cs1 - cs0; it.thi1 = it.ntiles;
      it.g0 = G + tok0 * 1024 + hp * 128; it.g1 = it.g0 + 64 * 1024;
      it.bias = true; it.qpos0 = c0 * 64; it.qpos1 = c1 * 64; it.kpos0 = cs0 * 64; it.head0 = hp * 2;
    } else if ((item -= N_AP) < N_AS) {
      const int b = item >> 1, hp = item & 1;
      const long tok0 = NTOKP + b * ST;
      it.q0 = AQ + tok0 * 256 + hp * 128; it.q1 = it.q0;
      it.kf = p.cak + (long)b * RA * 256 + hp * 128; it.vf = p.cav + (long)b * RA * 256 + hp * 128; it.ncache = RA / 64;
      it.kn = p.out + O_AKS + (long)b * ST * 256 + hp * 128; it.vn = p.out + O_AVS + (long)b * ST * 256 + hp * 128;
      it.qs = 256; it.ks = 256; it.ntiles = 9; it.nkeys = RA + ST;
      it.tlo0 = 0; it.thi0 = 9; it.tlo1 = 0; it.thi1 = 0; it.rows0 = ST; it.rows1 = 0;
      it.g0 = G + tok0 * 1024 + hp * 128; it.g1 = it.g0;
      it.bias = true; it.qpos0 = RA; it.qpos1 = RA; it.kpos0 = 0; it.head0 = hp * 2;
    } else if ((item -= N_AS) < N_MP) {
      const int j = item >> 3, bh = item & 7, b = bh >> 1, hp = bh & 1;
      const long tok0 = (long)b * SEQ + j * 128;
      it.q0 = MQ + tok0 * 256 + hp * 128; it.q1 = it.q0 + 64 * 256;
      it.k = MK + (long)b * NMEM * 256 + hp * 128; it.v = MV + (long)b * NMEM * 256 + hp * 128;
      it.qs = 256; it.ks = 256; it.ntiles = 4; it.nkeys = NMEM;
      it.tlo0 = 0; it.thi0 = 4; it.tlo1 = 0; it.thi1 = 4;
      it.g0 = G + tok0 * 1024 + 768 + hp * 128; it.g1 = it.g0 + 64 * 1024;
    } else {
      item -= N_MP;
      const int b = item >> 1, hp = item & 1;
      const long tok0 = NTOKP + b * ST;
      it.q0 = MQ + tok0 * 256 + hp * 128; it.q1 = it.q0;
      it.kf = p.cmk + (long)b * NMEM * 256 + hp * 128; it.vf = p.cmv + (long)b * NMEM * 256 + hp * 128; it.ncache = NMEM / 64;
      it.kn = it.kf; it.vn = it.vf;
      it.qs = 256; it.ks = 256; it.ntiles = 4; it.nkeys = NMEM;
      it.tlo0 = 0; it.thi0 = 4; it.tlo1 = 0; it.thi1 = 0; it.rows0 = ST; it.rows1 = 0;
      it.g0 = G + tok0 * 1024 + 768 + hp * 128; it.g1 = it.g0;
    }
    const bool f32src = it.kf != nullptr;
    if (it.bias) { if (f32src) attn_item<false, true, true, true>(it, lam, p.subg); else attn_item<false, true, false, false>(it, lam, p.subg); }
    else { if (f32src) attn_item<false, false, false, true>(it, lam, p.subg); else attn_item<false, false, false, false>(it, lam, p.subg); }
  }
}

DI void phase3(const Params& p) {
  pg8::Gemm g; g.A = (const bf16_t*)(p.ws + WS_G); g.Bt = (const bf16_t*)(p.ws + WS_WOUTT); g.M = NTOK; g.N = 1024; g.K = 1024;
  pg8::StaticOrder S; S.init(NTOK, 1024, (int)gridDim.x, (int)blockIdx.x);
  EpiOut E; E.out = p.out; E.xp = p.xp; E.xs = p.xs;
  pg8::gemm_phase<EpiOut, pg8::StaticOrder, false>((PG8_LAS unsigned char*)g_lds_all, g, S, E, nullptr);
  __syncthreads();
}

DI void phase4(const Params& p) {
  const int lane = threadIdx.x & 63, w = threadIdx.x >> 6;
  float4 g[4], bb[4];
#pragma unroll
  for (int j = 0; j < 4; ++j) { g[j] = *(const float4*)(p.ln_g + j * 256 + lane * 4); bb[j] = *(const float4*)(p.ln_b + j * 256 + lane * 4); }
  for (int row0 = (blockIdx.x * 8 + w) * 4; row0 < NTOK; row0 += gridDim.x * 32) {
    float4 v[4][4];
#pragma unroll
    for (int rr = 0; rr < 4; ++rr)
#pragma unroll
      for (int j = 0; j < 4; ++j) v[rr][j] = *(const float4*)(p.out + O_Y + (long)(row0 + rr) * 1024 + j * 256 + lane * 4);
    float s[4], q[4];
#pragma unroll
    for (int rr = 0; rr < 4; ++rr) { s[rr] = 0.f;
#pragma unroll
      for (int j = 0; j < 4; ++j) s[rr] += v[rr][j].x + v[rr][j].y + v[rr][j].z + v[rr][j].w; }
#pragma unroll
    for (int o = 1; o < 64; o <<= 1)
#pragma unroll
      for (int rr = 0; rr < 4; ++rr) s[rr] += __shfl_xor(s[rr], o);
#pragma unroll
    for (int rr = 0; rr < 4; ++rr) { const float mu = s[rr] * (1.f / 1024.f); s[rr] = mu; q[rr] = 0.f;
#pragma unroll
      for (int j = 0; j < 4; ++j) { const float a = v[rr][j].x - mu, b = v[rr][j].y - mu, c = v[rr][j].z - mu, d = v[rr][j].w - mu; q[rr] += a * a + b * b + c * c + d * d; } }
#pragma unroll
    for (int o = 1; o < 64; o <<= 1)
#pragma unroll
      for (int rr = 0; rr < 4; ++rr) q[rr] += __shfl_xor(q[rr], o);
#pragma unroll
    for (int rr = 0; rr < 4; ++rr) {
      const float mu = s[rr], rs = rsqrtf(q[rr] * (1.f / 1024.f) + 1e-5f);
#pragma unroll
      for (int j = 0; j < 4; ++j) {
        float4 o;
        o.x = (v[rr][j].x - mu) * rs * g[j].x + bb[j].x; o.y = (v[rr][j].y - mu) * rs * g[j].y + bb[j].y;
        o.z = (v[rr][j].z - mu) * rs * g[j].z + bb[j].z; o.w = (v[rr][j].w - mu) * rs * g[j].w + bb[j].w;
        *(float4*)(p.out + O_Y + (long)(row0 + rr) * 1024 + j * 256 + lane * 4) = o;
      }
    }
  }
}

DI void grid_barrier(unsigned* bar, unsigned target) {
  asm volatile("s_waitcnt vmcnt(0) lgkmcnt(0)" ::: "memory");
  __syncthreads();
  if (threadIdx.x == 0) {
    __builtin_amdgcn_fence(__ATOMIC_RELEASE, "agent");
    asm volatile("s_waitcnt vmcnt(0)" ::: "memory");
    __hip_atomic_fetch_add(bar, 1u, __ATOMIC_RELAXED, __HIP_MEMORY_SCOPE_AGENT);
    while (__hip_atomic_load(bar, __ATOMIC_RELAXED, __HIP_MEMORY_SCOPE_AGENT) < target) __builtin_amdgcn_s_sleep(2);
    __builtin_amdgcn_fence(__ATOMIC_ACQUIRE, "agent");
    asm volatile("s_waitcnt vmcnt(0)" ::: "memory");
  }
  __syncthreads();
}
__global__ void __launch_bounds__(512) fwd_megakernel(Params p) {
  cg::grid_group grid = cg::this_grid();
  unsigned* bar = (unsigned*)(p.ws + WS_CTR + 64);
  const unsigned nb = gridDim.x;
  phase0(p);
  grid.sync();
  grid_barrier(bar, nb);
  phase1(p);
  grid_barrier(bar, 2 * nb);
  phase2(p);
  grid_barrier(bar, 3 * nb);
  phase3(p);
  grid_barrier(bar, 4 * nb);
  phase4(p);
}

extern "C" void kernel_launch(void* const* d_in, const int* in_sizes, int n_in, void* d_out, int out_size,
                              void* d_ws, size_t ws_size, hipStream_t stream) {
  static int grid_blocks = 0;
  if (!grid_blocks) {
    int dev = 0, cus = 0, per_cu = 0;
    (void)hipGetDevice(&dev);
    (void)hipDeviceGetAttribute(&cus, hipDeviceAttributeMultiprocessorCount, dev);
    (void)hipOccupancyMaxActiveBlocksPerMultiprocessor(&per_cu, fwd_megakernel, 512, 0);
    if (per_cu > 1) per_cu = 1;
    if (per_cu < 1) per_cu = 1;
    grid_blocks = cus * per_cu;
    if (ws_size < WS_END || out_size != (int)O_END) fprintf(stderr, "kernel_launch: unexpected sizes ws %zu (need %zu) out %d (need %ld)\n", ws_size, (size_t)WS_END, out_size, (long)O_END);
  }
  (void)hipMemsetAsync((char*)d_ws + WS_CTR, 0, 256, stream);
  Params p{};
  p.xp = (const float*)d_in[0]; p.xs = (const float*)d_in[1];
  p.cak = (const float*)d_in[2]; p.cav = (const float*)d_in[3]; p.cbk = (const float*)d_in[4]; p.cbv = (const float*)d_in[5];
  p.cmk = (const float*)d_in[6]; p.cmv = (const float*)d_in[7];
  p.memp = (const float*)d_in[8]; p.w_in = (const float*)d_in[9]; p.w_mem = (const float*)d_in[10]; p.relb = (const float*)d_in[11];
  p.dlam = (const float*)d_in[12]; p.subg = (const float*)d_in[13]; p.w_out = (const float*)d_in[14]; p.ln_g = (const float*)d_in[15]; p.ln_b = (const float*)d_in[16];
  p.out = (float*)d_out; p.ws = (char*)d_ws;
  void* args[] = {&p};
  hipError_t e = hipLaunchCooperativeKernel((void*)fwd_megakernel, dim3(grid_blocks), dim3(512), args, 0, stream);
  if (e != hipSuccess) fprintf(stderr, "cooperative launch failed: %s (grid %d)\n", hipGetErrorString(e), grid_blocks);
}
```

```cpp
#include <hip/hip_runtime.h>
#include <hip/hip_cooperative_groups.h>
#include <cstdio>
#include <cstdint>
namespace cg = cooperative_groups;

typedef unsigned short bf16_t;
typedef short bf16x8 __attribute__((ext_vector_type(8)));
typedef short s16x4 __attribute__((ext_vector_type(4)));
typedef float f32x16 __attribute__((ext_vector_type(16)));
typedef float f32x2_t __attribute__((ext_vector_type(2)));
typedef __bf16 bf16x2_t __attribute__((ext_vector_type(2)));
typedef unsigned u32x2 __attribute__((ext_vector_type(2)));
typedef unsigned u32x4 __attribute__((ext_vector_type(4)));
#define DI __device__ __forceinline__
#define MFMA32(a, b, c) __builtin_amdgcn_mfma_f32_32x32x16_bf16((a), (b), (c), 0, 0, 0)
#define LDS3 __attribute__((address_space(3)))

constexpr int D_MODEL = 1024, SEQ = 8192, NB = 4, NTOKP = NB * SEQ, SB = 32, ST = 16, NTOKS = SB * ST, NTOK = NTOKP + NTOKS;
constexpr int PAST = 1024, RA = 512, NMEM = 256, PROJ = 3584;
constexpr int SAK_ROWS = 576, SBK_ROWS = 1088;
constexpr int NTOKPAD = NTOK + 64;
constexpr float QSCALE = 0.125f * 1.4426950408889634f;
constexpr float LOG2E = 1.4426950408889634f;
constexpr float ALPHA = 1.189207115002721f;

constexpr long O_Y = 0;
constexpr long O_AKP = (long)NTOK * 1024;
constexpr long O_AVP = O_AKP + (long)NB * RA * 256;
constexpr long O_BKP = O_AVP + (long)NB * RA * 256;
constexpr long O_BVP = O_BKP + (long)NTOKP * 512;
constexpr long O_MKP = O_BVP + (long)NTOKP * 512;
constexpr long O_MVP = O_MKP + (long)NB * NMEM * 256;
constexpr long O_AKS = O_MVP + (long)NB * NMEM * 256;
constexpr long O_AVS = O_AKS + (long)NTOKS * 256;
constexpr long O_BKS = O_AVS + (long)NTOKS * 256;
constexpr long O_BVS = O_BKS + (long)NTOKS * 512;
constexpr long O_END = O_BVS + (long)NTOKS * 512;

constexpr size_t WS_CTR = 0;
constexpr size_t WS_WINT = 256;
constexpr size_t WS_WOUTT = WS_WINT + (size_t)PROJ * 1024 * 2;
constexpr size_t WS_WMEMT = WS_WOUTT + (size_t)1024 * 1024 * 2;
constexpr size_t WS_ROPE = WS_WMEMT + (size_t)512 * 1024 * 2;
constexpr size_t OB_AQ = 0;
constexpr size_t OB_BQ = OB_AQ + (size_t)NTOKPAD * 256 * 2;
constexpr size_t OB_MQ = OB_BQ + (size_t)NTOKPAD * 512 * 2;
constexpr size_t OB_AK = OB_MQ + (size_t)NTOKPAD * 256 * 2;
constexpr size_t OB_AV = OB_AK + (size_t)NTOKP * 256 * 2;
constexpr size_t OB_BK = OB_AV + (size_t)NTOKP * 256 * 2;
constexpr size_t OB_END = OB_BK + (size_t)NTOKP * 512 * 2;
static_assert(OB_END <= (size_t)NTOK * 1024 * 4, "temporaries must fit in the y region");
constexpr size_t WS_BV = WS_ROPE + (size_t)SEQ * 32 * 8;
constexpr size_t WS_G = WS_BV + (size_t)NTOKP * 512 * 2;
constexpr size_t WS_MK = WS_G + (size_t)NTOK * 1024 * 2;
constexpr size_t WS_MV = WS_MK + (size_t)NB * NMEM * 256 * 2;
constexpr size_t WS_SAK = WS_MV + (size_t)NB * NMEM * 256 * 2;
constexpr size_t WS_SAV = WS_SAK + (size_t)SB * SAK_ROWS * 256 * 2;
constexpr size_t WS_SBK = WS_SAV + (size_t)SB * SAK_ROWS * 256 * 2;
constexpr size_t WS_SBV = WS_SBK + (size_t)SB * SBK_ROWS * 512 * 2;
constexpr size_t WS_SMK = WS_SBV + (size_t)SB * SBK_ROWS * 512 * 2;
constexpr size_t WS_SMV = WS_SMK + (size_t)SB * NMEM * 256 * 2;
constexpr size_t WS_XB = WS_SMV + (size_t)SB * NMEM * 256 * 2;
constexpr size_t WS_MB = WS_XB + (size_t)NTOK * 1024 * 2;
constexpr size_t WS_END = WS_MB + (size_t)NB * NMEM * 1024 * 2;
static_assert(WS_END <= (size_t)512 * 1024 * 1024, "workspace budget");

struct Params {
  const float* xp; const float* xs;
  const float* cak; const float* cav; const float* cbk; const float* cbv; const float* cmk; const float* cmv;
  const float* memp; const float* w_in; const float* w_mem; const float* relb; const float* dlam; const float* subg;
  const float* w_out; const float* ln_g; const float* ln_b;
  float* out; char* ws;
};

constexpr int TEAM_LDS = 73728 + 64;
constexpr int LDS_BYTES = 2 * TEAM_LDS + 64;
__shared__ __attribute__((aligned(16))) char g_lds_all[LDS_BYTES];
#define TEAM (__builtin_amdgcn_readfirstlane((int)(threadIdx.x >> 8)))
#define g_lds (g_lds_all + TEAM * TEAM_LDS)

DI unsigned cvtpk(float lo, float hi) { f32x2_t v = {lo, hi}; bf16x2_t b = __builtin_convertvector(v, bf16x2_t); return __builtin_bit_cast(unsigned, b); }
DI bf16_t f2bf(float x) { return (bf16_t)(cvtpk(x, 0.f) & 0xffffu); }
DI float bf2f(unsigned short b) { return __uint_as_float(((unsigned)b) << 16); }
DI float bflo(unsigned u) { return __uint_as_float(u << 16); }
DI float bfhi(unsigned u) { return __uint_as_float(u & 0xffff0000u); }
DI float fexp2(float x) { return __builtin_amdgcn_exp2f(x); }
DI float xor32f(float v) { return __shfl_xor(v, 32); }

template <bool SWAP45>
DI void transpose_tile(const float* __restrict__ src, int N, bf16_t* __restrict__ dst, int K, int k0, int n0) {
  float* tile = (float*)g_lds;
  const int tid = threadIdx.x & 255, c = tid & 63, r0 = tid >> 6;
#pragma unroll
  for (int i = 0; i < 16; ++i) { const int row = r0 + 4 * i; tile[row * 65 + c] = src[(long)(k0 + row) * N + n0 + c]; }
  __syncthreads();
#pragma unroll
  for (int i = 0; i < 16; ++i) { const int rr = r0 + 4 * i; const int pr = SWAP45 ? ((rr & 15) | ((rr & 16) << 1) | ((rr & 32) >> 1)) : rr; dst[(long)(n0 + pr) * K + k0 + c] = f2bf(tile[c * 65 + rr]); }
  __syncthreads();
}

DI void convert_rows(const float* __restrict__ src, bf16_t* __restrict__ dst, int rows_w8, int dst_bstride_w8, long gtid, long gsz) {
  const long total = (long)SB * rows_w8;
  for (long u = gtid; u < total; u += gsz) {
    const int b = (int)(u / rows_w8); const int j = (int)(u - (long)b * rows_w8);
    const float4 a0 = *(const float4*)(src + u * 8), a1 = *(const float4*)(src + u * 8 + 4);
    u32x4 v; v.x = cvtpk(a0.x, a0.y); v.y = cvtpk(a0.z, a0.w); v.z = cvtpk(a1.x, a1.y); v.w = cvtpk(a1.z, a1.w);
    *(u32x4*)(dst + ((long)b * dst_bstride_w8 + j) * 8) = v;
  }
}

DI void phase0(const Params& p) {
  bf16_t* winT = (bf16_t*)(p.ws + WS_WINT); bf16_t* woutT = (bf16_t*)(p.ws + WS_WOUTT); bf16_t* wmemT = (bf16_t*)(p.ws + WS_WMEMT);
  constexpr int T_IN = 16 * 56, T_OUT = 16 * 16, T_MEM = 16 * 8;
  for (int t = blockIdx.x * 2 + TEAM; t < T_IN + T_OUT + T_MEM; t += gridDim.x * 2) {
    if (t < T_IN) transpose_tile<true>(p.w_in, PROJ, winT, 1024, (t / 56) * 64, (t % 56) * 64);
    else if (t < T_IN + T_OUT) { const int u = t - T_IN; transpose_tile<false>(p.w_out, 1024, woutT, 1024, (u >> 4) * 64, (u & 15) * 64); }
    else { const int u = t - T_IN - T_OUT; transpose_tile<false>(p.w_mem, 512, wmemT, 1024, (u >> 3) * 64, (u & 7) * 64); }
  }
  float2* rope = (float2*)(p.ws + WS_ROPE);
  for (int idx = blockIdx.x * 512 + threadIdx.x; idx < SEQ * 32; idx += gridDim.x * 512) {
    const int pos = idx >> 5, i = idx & 31;
    const double inv = exp(-(double)i * (9.210340371976184 / 32.0));
    const double rev = (double)pos * inv * 0.15915494309189535;
    const double fr = rev - rint(rev);
    const float a = (float)(fr * 6.283185307179586);
    rope[idx] = make_float2(cosf(a), sinf(a));
  }
  const int G = gridDim.x;
  const long gtid = (long)blockIdx.x * 512 + threadIdx.x, gsz = (long)G * 512;
  {
    bf16_t* XB = (bf16_t*)(p.ws + WS_XB); bf16_t* MB = (bf16_t*)(p.ws + WS_MB);
    const long nxp = (long)NTOKP * 1024 / 8, nxs = (long)NTOKS * 1024 / 8, nmb = (long)NB * NMEM * 1024 / 8;
    for (long u = gtid; u < nxp + nxs + nmb; u += gsz) {
      const float* src; bf16_t* dst;
      if (u < nxp) { src = p.xp + u * 8; dst = XB + u * 8; }
      else if (u < nxp + nxs) { src = p.xs + (u - nxp) * 8; dst = XB + u * 8; }
      else { src = p.memp + (u - nxp - nxs) * 8; dst = MB + (u - nxp - nxs) * 8; }
      const float4 a0 = *(const float4*)(src), a1 = *(const float4*)(src + 4);
      u32x4 v; v.x = cvtpk(a0.x, a0.y); v.y = cvtpk(a0.z, a0.w); v.z = cvtpk(a1.x, a1.y); v.w = cvtpk(a1.z, a1.w);
      *(u32x4*)dst = v;
    }
  }
}

constexpr int G_RS = 144, GA_BYTES = 128 * G_RS, GB_BYTES = 256 * G_RS, G_STAGE = GA_BYTES + GB_BYTES;
DI void gemm_core(const bf16_t* __restrict__ Ap, int lda, const bf16_t* __restrict__ Bp, int ldb, int K, f32x16 (&acc)[2][2]) {
  const int tid = threadIdx.x, lane = tid & 63, w = tid >> 6, wm = w >> 2, wn = w & 3, r = lane & 31, h = lane >> 5;
#pragma unroll
  for (int a = 0; a < 2; ++a)
#pragma unroll
    for (int b = 0; b < 2; ++b)
#pragma unroll
      for (int i = 0; i < 16; ++i) acc[a][b][i] = 0.f;
  u32x4 ra0[2], rb0[4], ra1[2], rb1[4];
  const int lrow = tid >> 3, lch = tid & 7;
  const bf16_t* Ag = Ap + (long)lrow * lda + lch * 8;
  const bf16_t* Bg = Bp + (long)lrow * ldb + lch * 8;
#define G_LOAD(RA, RB, kt)                                                                                      \
  {                                                                                                             \
    _Pragma("unroll") for (int i = 0; i < 2; ++i) RA[i] = *(const u32x4*)(Ag + (long)(64 * i) * lda + (kt) * 64); \
    _Pragma("unroll") for (int i = 0; i < 4; ++i) RB[i] = *(const u32x4*)(Bg + (long)(64 * i) * ldb + (kt) * 64); \
  }
#define G_WRITE(RA, RB, buf)                                                                                    \
  {                                                                                                             \
    char* Ab_ = g_lds_all + (buf) * G_STAGE; char* Bb_ = Ab_ + GA_BYTES;                                        \
    _Pragma("unroll") for (int i = 0; i < 2; ++i) *(u32x4*)(Ab_ + (lrow + 64 * i) * G_RS + lch * 16) = RA[i];   \
    _Pragma("unroll") for (int i = 0; i < 4; ++i) *(u32x4*)(Bb_ + (lrow + 64 * i) * G_RS + lch * 16) = RB[i];   \
  }
#define G_COMPUTE(buf)                                                                                          \
  {                                                                                                             \
    const char* Ab = g_lds_all + (buf) * G_STAGE; const char* Bb = Ab + GA_BYTES;                               \
    _Pragma("unroll") for (int s = 0; s < 4; ++s) {                                                             \
      const int co = (16 * s + 8 * h) * 2;                                                                      \
      const bf16x8 a0 = *(const bf16x8*)(Ab + (wm * 64 + r) * G_RS + co);                                       \
      const bf16x8 a1 = *(const bf16x8*)(Ab + (wm * 64 + 32 + r) * G_RS + co);                                  \
      const bf16x8 b0 = *(const bf16x8*)(Bb + (wn * 64 + r) * G_RS + co);                                       \
      const bf16x8 b1 = *(const bf16x8*)(Bb + (wn * 64 + 32 + r) * G_RS + co);                                  \
      acc[0][0] = MFMA32(a0, b0, acc[0][0]);                                                                    \
      acc[0][1] = MFMA32(a0, b1, acc[0][1]);                                                                    \
      acc[1][0] = MFMA32(a1, b0, acc[1][0]);                                                                    \
      acc[1][1] = MFMA32(a1, b1, acc[1][1]);                                                                    \
    }                                                                                                           \
  }
  const int nk = K >> 6;
  G_LOAD(ra0, rb0, 0);
  G_LOAD(ra1, rb1, 1);
  G_WRITE(ra0, rb0, 0);
  __syncthreads();
  for (int kt = 0; kt < nk; kt += 2) {
    if (kt + 2 < nk) G_LOAD(ra0, rb0, kt + 2);
    G_COMPUTE(0);
    G_WRITE(ra1, rb1, 1);
    __syncthreads();
    if (kt + 3 < nk) G_LOAD(ra1, rb1, kt + 3);
    G_COMPUTE(1);
    if (kt + 2 < nk) G_WRITE(ra0, rb0, 0);
    __syncthreads();
  }
#undef G_COMPUTE
#undef G_LOAD
#undef G_WRITE
}

namespace pg8 {
#define PG8_LAS __attribute__((address_space(3)))
typedef unsigned short bf16_t;
typedef short bf16x8 __attribute__((ext_vector_type(8)));
typedef float f32x4 __attribute__((ext_vector_type(4)));
typedef unsigned u32x4 __attribute__((ext_vector_type(4)));
constexpr int BM = 256, BK = 64, HALF = 128, HTB = HALF * BK * 2  , STAGE_BYTES = 8 * HTB, NXCD = 8, WGM = 8;

__host__ __device__ __forceinline__ int lds_byte(int r, int c) { const int st = (r >> 4) * 2 + (c >> 5), rr = r & 15, cc = c & 31, ob = rr * 64 + cc * 2; return st * 1024 + (ob ^ (((ob >> 9) & 1) << 5)); }
__host__ __device__ __forceinline__ void stage_rc(int b, int& R, int& C) { const int st = b / 1024, sb = b % 1024, swz = sb ^ (((sb >> 9) & 1) << 5); R = (st >> 1) * 16 + swz / 64; C = (st & 1) * 32 + (swz % 64) / 2; }
__host__ __device__ __forceinline__ int perm32(int rho) { const int n = rho >> 4, i = rho & 15; return 8 * (i >> 2) + 4 * n + (i & 3); }

struct Unit { int pm, pn; };
struct Gemm { const bf16_t* A; const bf16_t* Bt; int M, N, K; };

struct StaticOrder {
    int nM, nN, nwg, G, c;
    __host__ __device__ void init(int M, int N, int G_, int c_) { nM = M / BM; nN = N / BM; nwg = nM * nN; G = G_; c = c_; }
    __host__ __device__ bool next(int i, Unit& u) const {
        const long L = (long)i * G + c; if (L >= nwg) return false;
        int wgid = (int)L; { const int q = nwg / NXCD, r = nwg % NXCD, xcd = wgid % NXCD, off = wgid / NXCD; wgid = (xcd < r ? xcd * (q + 1) : r * (q + 1) + (xcd - r) * q) + off; }
        const int nig = WGM * nN, gid = wgid / nig, fm = gid * WGM, gsz = (nM - fm) < WGM ? (nM - fm) : WGM;
        u.pm = fm + ((wgid % nig) % gsz); u.pn = (wgid % nig) / gsz; return true;
    }
    __device__ __forceinline__ void a_ready(const Unit&) const {}
    __device__ __forceinline__ void done(const Unit&) const {}
};
template <class Epi, class Sched, bool STAMP = false>
__device__ __forceinline__ void gemm_phase(PG8_LAS unsigned char* lds, const Gemm g, const Sched& S, const Epi& E, unsigned long long* stamps) {
    const int tid = threadIdx.x, wid = __builtin_amdgcn_readfirstlane(tid >> 6), lane = tid & 63, wr = wid >> 2, wc = wid & 3, fr = lane & 15, fq = lane >> 4;
    const int K = g.K, nt = K / BK;
    int ts_lo = 0, ts_hi = 0, nts = 0; const unsigned long long rt_entry = STAMP ? (unsigned long long)wall_clock64() : 0ull;
#define PG8_STAMP() do { if (STAMP && wid == 0 && nts < 64) { const unsigned long long _c = (unsigned long long)clock64(); \
        ts_lo = (lane == nts) ? (int)(unsigned)_c : ts_lo; ts_hi = (lane == nts) ? (int)(unsigned)(_c >> 32) : ts_hi; ++nts; } } while (0)
    PG8_STAMP();
    unsigned voffA[2], voffB[2];
#pragma unroll
    for (int i = 0; i < 2; ++i) { int R, C; stage_rc(tid * 16 + i * 8192, R, C); const int Rb = Epi::PERM ? ((R & ~31) + perm32(R & 31)) : R;
        voffA[i] = (unsigned)(R * K + C) * 2u; voffB[i] = (unsigned)(Rb * K + C) * 2u; }
    const size_t kstep = (size_t)(BK * 2);
    const size_t hstep = (size_t)HALF * K * 2;
    const size_t tstep = 2 * hstep;
    const unsigned ldsw = (unsigned)wid * 1024u;
    const int aoff = lds_byte(wr * 64 + fr, fq * 8), boff = lds_byte(wc * 32 + fr, fq * 8);
#define PG8_SA(b, h) (((b) * 2 + (h)) * HTB)
#define PG8_SB(b, h) ((4 + (b) * 2 + (h)) * HTB)
#define PG8_STAGE(bufoff, gbase, voff) do { _Pragma("unroll") for (int _i = 0; _i < 2; ++_i) \
        __builtin_amdgcn_global_load_lds((const unsigned*)((const char*)(gbase) + (voff)[_i]), (PG8_LAS unsigned*)(lds + (bufoff) + ldsw + _i * 8192), 16, 0, 0); } while (0)
#define PG8_LDA(dst, b, h) do { _Pragma("unroll") for (int m = 0; m < 4; ++m) _Pragma("unroll") for (int k = 0; k < 2; ++k) dst[m][k] = *(const PG8_LAS bf16x8*)(lds + PG8_SA(b, h) + aoff + m * 2048 + k * 1024); } while (0)
#define PG8_LDB(dst, b, h) do { _Pragma("unroll") for (int n = 0; n < 2; ++n) _Pragma("unroll") for (int k = 0; k < 2; ++k) dst[n][k] = *(const PG8_LAS bf16x8*)(lds + PG8_SB(b, h) + boff + n * 2048 + k * 1024); } while (0)
#define PG8_MMA(ai, bj, At, Bt) do { __builtin_amdgcn_s_setprio(1); _Pragma("unroll") for (int m = 0; m < 4; ++m) _Pragma("unroll") for (int n = 0; n < 2; ++n) _Pragma("unroll") for (int k = 0; k < 2; ++k) \
        acc[ai][bj][m][n] = __builtin_amdgcn_mfma_f32_16x16x32_bf16(Bt[n][k], At[m][k], acc[ai][bj][m][n], 0, 0, 0); __builtin_amdgcn_s_setprio(0); } while (0)
#define PG8_WAIT_V(n) asm volatile("s_waitcnt vmcnt(" #n ")" ::: "memory")
#define PG8_WAIT_L(n) asm volatile("s_waitcnt lgkmcnt(" #n ")" ::: "memory")
#define PG8_BAR __builtin_amdgcn_s_barrier()
#define PG8_SCHED __builtin_amdgcn_sched_barrier(0)
    Unit cur, nxt; int ui = 0;
    if (!S.next(0, cur)) return;
    f32x4 acc[2][2][4][2];
#pragma unroll
    for (int a = 0; a < 2; ++a)
#pragma unroll
        for (int b = 0; b < 2; ++b)
#pragma unroll
            for (int m = 0; m < 4; ++m)
#pragma unroll
                for (int n = 0; n < 2; ++n) acc[a][b][m][n] = (f32x4){0.f, 0.f, 0.f, 0.f};
    bf16x8 At[4][2], B0[2][2], B1[2][2];
    const char* cA = (const char*)g.A + (size_t)cur.pm * tstep; const char* cB = (const char*)g.Bt + (size_t)cur.pn * tstep;
    S.a_ready(cur);
    PG8_STAGE(PG8_SB(0, 0), cB, voffB); PG8_STAGE(PG8_SA(0, 0), cA, voffA); PG8_STAGE(PG8_SB(0, 1), cB + hstep, voffB); PG8_STAGE(PG8_SA(0, 1), cA + hstep, voffA);
    if (wr == 1) PG8_BAR;
    PG8_WAIT_V(4); PG8_BAR;
    PG8_STAGE(PG8_SB(1, 0), cB + kstep, voffB); PG8_STAGE(PG8_SA(1, 0), cA + kstep, voffA); PG8_STAGE(PG8_SB(1, 1), cB + hstep + kstep, voffB);
    PG8_WAIT_V(6); PG8_BAR;
    PG8_STAMP();
    for (;;) {
        const bool has_next = S.next(ui + 1, nxt);
        const char* nA = has_next ? (const char*)g.A + (size_t)nxt.pm * tstep : cA; const char* nB = has_next ? (const char*)g.Bt + (size_t)nxt.pn * tstep : cB;
        for (int t = 0; t < nt; t += 2) {
            const bool last = (t == nt - 2);
            const char* a1 = cA + (size_t)(t + 1) * kstep;
            const char* a2 = last ? nA : cA + (size_t)(t + 2) * kstep; const char* b2 = last ? nB : cB + (size_t)(t + 2) * kstep;
            const char* a3 = a2 + kstep; const char* b3 = b2 + kstep;
            if (last && has_next) S.a_ready(nxt);
            PG8_LDB(B0, 0, 0); PG8_SCHED; PG8_LDA(At, 0, 0); PG8_STAGE(PG8_SA(1, 1), a1 + hstep, voffA);
            PG8_WAIT_L(8); PG8_BAR; PG8_WAIT_L(0); PG8_MMA(0, 0, At, B0); PG8_BAR; PG8_SCHED;
            PG8_LDB(B1, 0, 1); PG8_STAGE(PG8_SB(0, 0), b2, voffB);
            PG8_BAR; PG8_WAIT_L(0); PG8_MMA(0, 1, At, B1); PG8_BAR;
            PG8_LDA(At, 0, 1); PG8_STAGE(PG8_SA(0, 0), a2, voffA);
            PG8_BAR; PG8_WAIT_L(0); PG8_MMA(1, 0, At, B0); PG8_BAR; PG8_SCHED;
            PG8_STAGE(PG8_SB(0, 1), b2 + hstep, voffB);
            PG8_WAIT_V(6); PG8_BAR; PG8_MMA(1, 1, At, B1); PG8_BAR;
            PG8_LDB(B0, 1, 0); PG8_SCHED; PG8_LDA(At, 1, 0); PG8_STAGE(PG8_SA(0, 1), a2 + hstep, voffA);
            PG8_WAIT_L(8); PG8_BAR; PG8_WAIT_L(0); PG8_MMA(0, 0, At, B0); PG8_BAR; PG8_SCHED;
            PG8_LDB(B1, 1, 1); PG8_STAGE(PG8_SB(1, 0), b3, voffB);
            PG8_BAR; PG8_WAIT_L(0); PG8_MMA(0, 1, At, B1); PG8_BAR;
            PG8_LDA(At, 1, 1); PG8_STAGE(PG8_SA(1, 0), a3, voffA);
            PG8_BAR; PG8_WAIT_L(0); PG8_MMA(1, 0, At, B0); PG8_BAR; PG8_SCHED;
            PG8_STAGE(PG8_SB(1, 1), b3 + hstep, voffB);
            PG8_WAIT_V(6); PG8_BAR; PG8_MMA(1, 1, At, B1); PG8_BAR;
        }
        PG8_STAMP();
        if constexpr (!Epi::AFTER_DRAIN) { E(acc, cur, wr, wc, fr, fq); S.done(cur); }
        PG8_STAMP();
        if (!has_next) break;
#pragma unroll
        for (int a = 0; a < 2; ++a)
#pragma unroll
            for (int b = 0; b < 2; ++b)
#pragma unroll
                for (int m = 0; m < 4; ++m)
#pragma unroll
                    for (int n = 0; n < 2; ++n) acc[a][b][m][n] = (f32x4){0.f, 0.f, 0.f, 0.f};
        cur = nxt; cA = nA; cB = nB; ++ui;
    }
    PG8_WAIT_V(0);
    if (wr == 0) PG8_BAR;
    PG8_BAR;
    if constexpr (Epi::AFTER_DRAIN) { E.fused(acc, cur, wr, wc, fr, fq, lds, wid, lane); S.done(cur); }
    PG8_STAMP();
    if (STAMP && wid == 0) { stamps[lane] = lane < nts ? (((unsigned long long)(unsigned)ts_hi << 32) | (unsigned)ts_lo) : 0ull;
        if (lane == 62) stamps[62] = rt_entry; if (lane == 63) stamps[63] = (unsigned long long)wall_clock64(); }
#undef PG8_STAMP
#undef PG8_SA
#undef PG8_SB
#undef PG8_STAGE
#undef PG8_LDA
#undef PG8_LDB
#undef PG8_MMA
#undef PG8_WAIT_V
#undef PG8_WAIT_L
#undef PG8_BAR
#undef PG8_SCHED
}
}

struct EpiProj {
  static constexpr bool PERM = false, AFTER_DRAIN = false;
  float* out; char* ws;
  __device__ __forceinline__ void operator()(const pg8::f32x4 (&acc)[2][2][4][2], const pg8::Unit& u, int wr, int wc, int fr, int fq) const {
    asm volatile("" : "+v"(fr), "+v"(fq));
    char* ob = (char*)out;
    const int n0 = u.pn * 256;
    int seg, sbase;
    if (n0 < 256) { seg = 0; sbase = 0; } else if (n0 < 512) { seg = 1; sbase = 256; } else if (n0 < 768) { seg = 2; sbase = 512; }
    else if (n0 < 1280) { seg = 3; sbase = 768; } else if (n0 < 1792) { seg = 4; sbase = 1280; } else if (n0 < 2304) { seg = 5; sbase = 1792; }
    else if (n0 < 2560) { seg = 6; sbase = 2304; } else { seg = 7; sbase = 2560; }
    const bool smp = u.pm >= NTOKP / 256;
    const float2* rope = (const float2*)(ws + WS_ROPE);
    const int fi = 16 * (wc & 1) + 4 * fq;
#pragma unroll
    for (int ai = 0; ai < 2; ++ai)
#pragma unroll
      for (int m = 0; m < 4; ++m) {
        const int row = 128 * ai + 64 * wr + 16 * m + fr;
        const long tok = (long)u.pm * 256 + row;
        const long ts = tok - NTOKP;
        float4 c01, s01, c23, s23;
        if (seg == 3 || seg == 4) {
          const int pos = smp ? (PAST + (int)(ts & 15)) : (int)(tok & (SEQ - 1));
          const float4 r0 = *(const float4*)(rope + pos * 32 + fi), r1 = *(const float4*)(rope + pos * 32 + fi + 2);
          c01 = make_float4(r0.x, r0.z, r1.x, r1.z); s01 = make_float4(r0.y, r0.w, r1.y, r1.w);
        }
#pragma unroll
        for (int bj = 0; bj < 2; ++bj) {
          const int blk = 4 * u.pn + 2 * bj + (wc >> 1);
          const int col = 64 * blk + fi - sbase;
          pg8::f32x4 v0 = acc[ai][bj][m][0], v1 = acc[ai][bj][m][1];
          if (seg == 3 || seg == 4) {
            const pg8::f32x4 cc = {c01.x, c01.y, c01.z, c01.w}, ss = {s01.x, s01.y, s01.z, s01.w};
            const pg8::f32x4 a = v0 * cc - v1 * ss, b = v1 * cc + v0 * ss;
            v0 = a; v1 = b;
          }
          if (seg == 0 || seg == 3 || seg == 6) {
            bf16_t* q = (seg == 0) ? (bf16_t*)(ob + OB_AQ) + tok * 256 : (seg == 3) ? (bf16_t*)(ob + OB_BQ) + tok * 512 : (bf16_t*)(ob + OB_MQ) + tok * 256;
            u32x2 w0, w1; w0.x = cvtpk(v0[0] * QSCALE, v0[1] * QSCALE); w0.y = cvtpk(v0[2] * QSCALE, v0[3] * QSCALE);
            w1.x = cvtpk(v1[0] * QSCALE, v1[1] * QSCALE); w1.y = cvtpk(v1[2] * QSCALE, v1[3] * QSCALE);
            *(u32x2*)(q + col) = w0; *(u32x2*)(q + col + 32) = w1;
          } else if (seg == 7) {
            bf16_t* g = (bf16_t*)(ws + WS_G) + tok * 1024;
            float a[4], b[4];
#pragma unroll
            for (int j = 0; j < 4; ++j) { a[j] = v0[j] / (1.f + __expf(-v0[j])); b[j] = v1[j] / (1.f + __expf(-v1[j])); }
            u32x2 w0, w1; w0.x = cvtpk(a[0], a[1]); w0.y = cvtpk(a[2], a[3]); w1.x = cvtpk(b[0], b[1]); w1.y = cvtpk(b[2], b[3]);
            *(u32x2*)(g + col) = w0; *(u32x2*)(g + col + 32) = w1;
          } else {
            const bool wide = (seg >= 4);
            const int W = wide ? 512 : 256;
            bf16_t* kw; float* o = nullptr;
            if (!smp) {
              if (seg == 1) kw = (bf16_t*)(ob + OB_AK) + tok * 256; else if (seg == 2) kw = (bf16_t*)(ob + OB_AV) + tok * 256;
              else if (seg == 4) kw = (bf16_t*)(ob + OB_BK) + tok * 512; else kw = (bf16_t*)(ws + WS_BV) + tok * 512;
              if (wide) o = out + (seg == 4 ? O_BKP : O_BVP) + tok * 512;
              else { const int ps = (int)(tok & (SEQ - 1)); const int pb = (int)(tok >> 13); if (ps >= SEQ - RA) o = out + (seg == 1 ? O_AKP : O_AVP) + (long)(pb * RA + ps - (SEQ - RA)) * 256; }
            } else {
              kw = nullptr;
              if (wide) o = out + (seg == 4 ? O_BKS : O_BVS) + ts * 512; else o = out + (seg == 1 ? O_AKS : O_AVS) + ts * 256;
            }
            (void)W;
            u32x2 w0, w1; w0.x = cvtpk(v0[0], v0[1]); w0.y = cvtpk(v0[2], v0[3]); w1.x = cvtpk(v1[0], v1[1]); w1.y = cvtpk(v1[2], v1[3]);
            if (kw) { *(u32x2*)(kw + col) = w0; *(u32x2*)(kw + col + 32) = w1; }
            if (o) { *(pg8::f32x4*)(o + col) = v0; *(pg8::f32x4*)(o + col + 32) = v1; }
          }
        }
      }
  }
};

struct EpiOut {
  static constexpr bool PERM = false, AFTER_DRAIN = false;
  bf16_t* ypre; const float* xp; const float* xs;
  __device__ __forceinline__ void operator()(const pg8::f32x4 (&acc)[2][2][4][2], const pg8::Unit& u, int wr, int wc, int fr, int fq) const {
    asm volatile("" : "+v"(fr), "+v"(fq));
    const float* xb = (u.pm < NTOKP / 256) ? xp + (long)u.pm * 256 * 1024 : xs + (long)(u.pm - NTOKP / 256) * 256 * 1024;
    bf16_t* yb = ypre + (long)u.pm * 256 * 1024;
    const int col0 = u.pn * 256 + wc * 32 + 4 * fq;
#pragma unroll
    for (int ai = 0; ai < 2; ++ai)
#pragma unroll
      for (int mp = 0; mp < 2; ++mp) {
        pg8::f32x4 xv[2][2][2];
#pragma unroll
        for (int mm = 0; mm < 2; ++mm) {
          const long ro = (long)(128 * ai + 64 * wr + 16 * (2 * mp + mm) + fr) * 1024 + col0;
#pragma unroll
          for (int bj = 0; bj < 2; ++bj)
#pragma unroll
            for (int n = 0; n < 2; ++n) xv[mm][bj][n] = *(const pg8::f32x4*)(xb + ro + bj * 128 + n * 16);
        }
#pragma unroll
        for (int mm = 0; mm < 2; ++mm) {
          const long ro = (long)(128 * ai + 64 * wr + 16 * (2 * mp + mm) + fr) * 1024 + col0;
#pragma unroll
          for (int bj = 0; bj < 2; ++bj)
#pragma unroll
            for (int n = 0; n < 2; ++n) { const pg8::f32x4 y = acc[ai][bj][2 * mp + mm][n] + ALPHA * xv[mm][bj][n]; u32x2 w; w.x = cvtpk(y[0], y[1]); w.y = cvtpk(y[2], y[3]); *(u32x2*)(yb + ro + bj * 128 + n * 16) = w; }
        }
      }
  }
};

DI void mem_epilogue(const Params& p, int mt, int nt, f32x16 (&acc)[2][2]) {
  const int tid = threadIdx.x, lane = tid & 63, w = tid >> 6, wm = w >> 2, wn = w & 3, c = lane & 31, h = lane >> 5;
  const int n0 = nt * 256 + wn * 64;
  const bool isv = n0 >= 256;
  const int cb = isv ? n0 - 256 : n0;
  bf16_t* kw = (bf16_t*)(p.ws + (isv ? WS_MV : WS_MK));
  float* o = p.out + (isv ? O_MVP : O_MKP);
#pragma unroll
  for (int mi = 0; mi < 2; ++mi)
#pragma unroll
    for (int i = 0; i < 16; ++i) {
      const long row = mt * 128 + wm * 64 + mi * 32 + (i & 3) + 8 * (i >> 2) + 4 * h;
      const float v0 = acc[mi][0][i], v1 = acc[mi][1][i];
      kw[row * 256 + cb + c] = f2bf(v0); kw[row * 256 + cb + c + 32] = f2bf(v1);
      o[row * 256 + cb + c] = v0; o[row * 256 + cb + c + 32] = v1;
    }
}

DI void phase1(const Params& p) {
  const int G = gridDim.x;
  const bf16_t* winT = (const bf16_t*)(p.ws + WS_WINT); const bf16_t* wmemT = (const bf16_t*)(p.ws + WS_WMEMT);
  const bf16_t* XB = (const bf16_t*)(p.ws + WS_XB); const bf16_t* MB = (const bf16_t*)(p.ws + WS_MB);
  {
    pg8::Gemm g; g.A = XB; g.Bt = winT; g.M = NTOK; g.N = PROJ; g.K = 1024;
    pg8::StaticOrder S; S.init(NTOK, PROJ, G, (int)blockIdx.x);
    EpiProj E; E.out = p.out; E.ws = p.ws;
    pg8::gemm_phase<EpiProj, pg8::StaticOrder, false>((PG8_LAS unsigned char*)g_lds_all, g, S, E, nullptr);
  }
  __syncthreads();
  constexpr int T2 = 8 * 2;
  f32x16 acc[2][2];
  for (int t = (int)blockIdx.x - 64; t >= 0 && t < T2; t += G) {
    const int mt = t >> 1, nt = t & 1;
    gemm_core(MB + (long)mt * 128 * 1024, 1024, wmemT + (long)nt * 256 * 1024, 1024, 1024, acc);
    mem_epilogue(p, mt, nt, acc);
  }
}

struct AttnItem {
  const bf16_t* q0; const bf16_t* q1;
  const bf16_t* k; const bf16_t* v;
  bf16_t* g0; bf16_t* g1;
  int qs, ks, ntiles, nkeys;
  int tlo0, thi0, tlo1, thi1;
  int rows0, rows1;
  int qpos0, qpos1, kpos0, head0; bool bias;
  const float* kf; const float* vf;
  const float* kn; const float* vn;
  int ncache;
};
constexpr int AK_RS = 272, AK_BYTES = 64 * AK_RS, AV_BYTES = 16384, A_BUF = AK_BYTES + AV_BYTES;
constexpr int A_BIAS_OFF = 2 * A_BUF;
constexpr int A_ITEM_OFF = 2 * TEAM_LDS;
constexpr int A_Q_OFF = 73728;

template <bool DIFF, bool BIAS, bool MASK, bool F32>
DI void attn_item(const AttnItem& it, float lam, const float* __restrict__ subg) {
  const int tid = threadIdx.x, lane = tid & 63, w = tid >> 6, r = lane & 31, h = lane >> 5;
  const int half = __builtin_amdgcn_readfirstlane(w >> 2), qh = w & 1, m = (w >> 1) & 1;
  constexpr int NDT = DIFF ? 4 : 2;
  const int ntiles = it.ntiles;
  const int tlo = half ? it.tlo1 : it.tlo0, thi = half ? it.thi1 : it.thi0, rows = half ? it.rows1 : it.rows0;
  const bf16_t* qbase = half ? it.q1 : it.q0;
  bf16_t* gbase = half ? it.g1 : it.g0;
  char* qlds = g_lds_all + A_Q_OFF + w * 4096 + lane * 16;
  {
    const bf16_t* qp = qbase + (long)(qh * 32 + r) * it.qs + m * 64 + 8 * h;
#pragma unroll
    for (int s = 0; s < 4; ++s) *(bf16x8*)(qlds + s * 1024) = *(const bf16x8*)(qp + 16 * s);
  }
  f32x16 oacc[NDT];
#pragma unroll
  for (int d = 0; d < NDT; ++d)
#pragma unroll
    for (int i = 0; i < 16; ++i) oacc[d][i] = 0.f;
  float m_run = -1e30f, l_run = 0.f;
  u32x4 rk0[2], rv0[2];
  float4 fk[4], fv[4];
  const int kch = tid & 15, krow = tid >> 4, vsub = tid & 3, vkey = (tid >> 2) & 63, vd = tid >> 8;
  const bf16_t* kg = it.k + (long)krow * it.ks + kch * 8;
  const bf16_t* vg = it.v + (long)vkey * it.ks + vd * 32 + vsub * 8;
#define A_LOAD(RK, RV, t)                                                                                        \
  if (!F32) {                                                                                                    \
    _Pragma("unroll") for (int i = 0; i < 2; ++i) RK[i] = *(const u32x4*)(kg + (long)((t) * 64 + 32 * i) * it.ks); \
    _Pragma("unroll") for (int i = 0; i < 2; ++i) RV[i] = *(const u32x4*)(vg + (long)((t) * 64) * it.ks + 64 * i); \
  } else {                                                                                                       \
    const bool nw = (t) >= it.ncache;             \
    _Pragma("unroll") for (int i = 0; i < 2; ++i) {                                                              \
      const int kr = krow + 32 * i;                                                                              \
      const float* src = nw ? it.kn + (long)(kr < 15 ? kr : 15) * it.ks : it.kf + (long)((t) * 64 + kr) * it.ks; \
      fk[2 * i] = *(const float4*)(src + kch * 8); fk[2 * i + 1] = *(const float4*)(src + kch * 8 + 4);          \
    }                                                                                                            \
    {                                                                                                            \
      const float* src = nw ? it.vn + (long)(vkey < 15 ? vkey : 15) * it.ks : it.vf + (long)((t) * 64 + vkey) * it.ks; \
      _Pragma("unroll") for (int i = 0; i < 2; ++i) {                                                            \
        fv[2 * i] = *(const float4*)(src + (vd + 2 * i) * 32 + vsub * 8); fv[2 * i + 1] = *(const float4*)(src + (vd + 2 * i) * 32 + vsub * 8 + 4); \
      }                                                                                                          \
    }                                                                                                            \
  }
#define A_WRITE(RK, RV, stage)                                                                                   \
  {                                                                                                              \
    char* Kb_ = g_lds_all + (stage) * A_BUF; char* Vb_ = Kb_ + AK_BYTES;                                         \
    if (F32) {                                                                                                   \
      _Pragma("unroll") for (int i = 0; i < 2; ++i) {                                                            \
        RK[i].x = cvtpk(fk[2 * i].x, fk[2 * i].y); RK[i].y = cvtpk(fk[2 * i].z, fk[2 * i].w); RK[i].z = cvtpk(fk[2 * i + 1].x, fk[2 * i + 1].y); RK[i].w = cvtpk(fk[2 * i + 1].z, fk[2 * i + 1].w); \
        RV[i].x = cvtpk(fv[2 * i].x, fv[2 * i].y); RV[i].y = cvtpk(fv[2 * i].z, fv[2 * i].w); RV[i].z = cvtpk(fv[2 * i + 1].x, fv[2 * i + 1].y); RV[i].w = cvtpk(fv[2 * i + 1].z, fv[2 * i + 1].w); \
      }                                                                                                          \
    }                                                                                                            \
    _Pragma("unroll") for (int i = 0; i < 2; ++i) *(u32x4*)(Kb_ + (krow + 32 * i) * AK_RS + kch * 16) = RK[i];   \
    _Pragma("unroll") for (int i = 0; i < 2; ++i) *(u32x4*)(Vb_ + (vd + 2 * i) * 4096 + vkey * 64 + vsub * 16) = RV[i]; \
  }
  const int vlane = ((lane >> 4) & 1) * 32 + (lane & 3) * 8 + (4 * h + ((lane & 15) >> 2)) * 64;
  const float* biasT = (const float*)(g_lds_all + A_BIAS_OFF) + (it.head0 + m) * 257;
  const int qpos = (half ? it.qpos1 : it.qpos0) + qh * 32 + r;
#define A_COMPUTE(t, stage)                                                                                      \
  if ((t) >= tlo && (t) < thi) {                                                                                 \
    const char* Kb = g_lds_all + (stage) * A_BUF; const char* Vb = Kb + AK_BYTES;                                \
    f32x16 s0, s1;                                                                                               \
    _Pragma("unroll") for (int i = 0; i < 16; ++i) { s0[i] = 0.f; s1[i] = 0.f; }                                 \
    _Pragma("unroll") for (int s = 0; s < 4; ++s) {                                                              \
      const int co = (m * 64 + 16 * s + 8 * h) * 2;                                                              \
      const bf16x8 k0 = *(const bf16x8*)(Kb + r * AK_RS + co);                                                   \
      const bf16x8 k1 = *(const bf16x8*)(Kb + (32 + r) * AK_RS + co);                                            \
      const bf16x8 qfs = *(const bf16x8*)(qlds + s * 1024);                                                      \
      s0 = MFMA32(k0, qfs, s0);                                                                                  \
      s1 = MFMA32(k1, qfs, s1);                                                                                  \
    }                                                                                                            \
    if (BIAS) {                                                                                                  \
      const int kb = it.kpos0 + (t) * 64 + 4 * h;                                                                \
      _Pragma("unroll") for (int i = 0; i < 16; ++i) {                                                           \
        const int kk = kb + (i & 3) + 8 * (i >> 2);                                                              \
        int d0 = qpos - kk, d1 = d0 - 32;                                                                        \
        d0 = min(max(d0, -128), 128) + 128; d1 = min(max(d1, -128), 128) + 128;                                  \
        s0[i] += biasT[d0]; s1[i] += biasT[d1];                                                                  \
      }                                                                                                          \
    }                                                                                                            \
    if (MASK && ((t) + 1) * 64 > it.nkeys) {                                                                     \
      const int kb = (t) * 64 + 4 * h;                                                                           \
      _Pragma("unroll") for (int i = 0; i < 16; ++i) {                                                           \
        const int kk = kb + (i & 3) + 8 * (i >> 2);                                                              \
        if (kk >= it.nkeys) s0[i] = -1e30f;                                                                      \
        if (kk + 32 >= it.nkeys) s1[i] = -1e30f;                                                                 \
      }                                                                                                          \
    }                                                                                                            \
    float mx = fmaxf(s0[0], s1[0]);                                                                              \
    _Pragma("unroll") for (int i = 1; i < 16; ++i) mx = fmaxf(mx, fmaxf(s0[i], s1[i]));                          \
    mx = fmaxf(mx, xor32f(mx));                                                                                  \
    const float m_new = fmaxf(m_run, mx);                                                                        \
    const float alpha = fexp2(m_run - m_new);                                                                    \
    if (__builtin_amdgcn_ballot_w64(m_new > m_run) != 0ull) {                                                    \
      _Pragma("unroll") for (int d = 0; d < NDT; ++d)                                                            \
        _Pragma("unroll") for (int i = 0; i < 16; ++i) oacc[d][i] *= alpha;                                      \
    }                                                                                                            \
    l_run *= alpha;                                                                                              \
    m_run = m_new;                                                                                               \
    float ls = 0.f;                                                                                              \
    _Pragma("unroll") for (int i = 0; i < 16; ++i) { s0[i] = fexp2(s0[i] - m_new); s1[i] = fexp2(s1[i] - m_new); ls += s0[i] + s1[i]; } \
    l_run += ls;                                                                                                 \
    bf16x8 pf[4];                                                                                                \
    _Pragma("unroll") for (int s2 = 0; s2 < 2; ++s2) {                                                           \
      u32x4 a, b;                                                                                                \
      a.x = cvtpk(s0[8 * s2 + 0], s0[8 * s2 + 1]); a.y = cvtpk(s0[8 * s2 + 2], s0[8 * s2 + 3]);                  \
      a.z = cvtpk(s0[8 * s2 + 4], s0[8 * s2 + 5]); a.w = cvtpk(s0[8 * s2 + 6], s0[8 * s2 + 7]);                  \
      b.x = cvtpk(s1[8 * s2 + 0], s1[8 * s2 + 1]); b.y = cvtpk(s1[8 * s2 + 2], s1[8 * s2 + 3]);                  \
      b.z = cvtpk(s1[8 * s2 + 4], s1[8 * s2 + 5]); b.w = cvtpk(s1[8 * s2 + 6], s1[8 * s2 + 7]);                  \
      pf[s2] = __builtin_bit_cast(bf16x8, a); pf[2 + s2] = __builtin_bit_cast(bf16x8, b);                        \
    }                                                                                                            \
    const LDS3 char* vb3 = (const LDS3 char*)(Vb) + vlane + (DIFF ? 0 : m * 2 * 4096);                           \
    _Pragma("unroll") for (int ks = 0; ks < 4; ++ks) {                                                           \
      _Pragma("unroll") for (int d = 0; d < NDT; ++d) {                                                          \
        const s16x4 lo = __builtin_bit_cast(s16x4, __builtin_amdgcn_ds_read_tr16_b64_v4i16((LDS3 s16x4*)(vb3 + d * 4096 + ks * 1024))); \
        const s16x4 hi = __builtin_bit_cast(s16x4, __builtin_amdgcn_ds_read_tr16_b64_v4i16((LDS3 s16x4*)(vb3 + d * 4096 + ks * 1024 + 512))); \
        const bf16x8 vf = __builtin_shufflevector(lo, hi, 0, 1, 2, 3, 4, 5, 6, 7);                               \
        oacc[d] = MFMA32(vf, pf[ks], oacc[d]);                                                                   \
      }                                                                                                          \
      __builtin_amdgcn_sched_barrier(0);                                                                         \
    }                                                                                                            \
  }
  A_LOAD(rk0, rv0, 0);
  A_WRITE(rk0, rv0, 0);
  if (ntiles > 1) A_LOAD(rk0, rv0, 1);
  __syncthreads();
#pragma unroll 1
  for (int t = 0; t < ntiles; ++t) {
    const int par = t & 1;
    if (t + 1 < ntiles) A_WRITE(rk0, rv0, par ^ 1);
    if (t + 2 < ntiles) A_LOAD(rk0, rv0, t + 2);
    A_COMPUTE(t, par);
    __syncthreads();
  }
#undef A_LOAD
#undef A_WRITE
#undef A_COMPUTE
  const float l_tot = l_run + xor32f(l_run);
  const float inv = 1.f / l_tot;
  const int q = qh * 32 + r;
  if (!DIFF) {
    if (q < rows) {
      bf16_t* gp = gbase + (long)q * 1024 + m * 64 + 4 * h;
      u32x2 gvv[NDT][4];
#pragma unroll
      for (int d = 0; d < NDT; ++d)
#pragma unroll
        for (int g4 = 0; g4 < 4; ++g4) gvv[d][g4] = *(const u32x2*)(gp + d * 32 + 8 * g4);
#pragma unroll
      for (int d = 0; d < NDT; ++d)
#pragma unroll
        for (int g4 = 0; g4 < 4; ++g4) {
          u32x2* ptr = (u32x2*)(gp + d * 32 + 8 * g4);
          const u32x2 gv = gvv[d][g4];
          u32x2 o;
          o.x = cvtpk(oacc[d][4 * g4 + 0] * inv * bflo(gv.x), oacc[d][4 * g4 + 1] * inv * bfhi(gv.x));
          o.y = cvtpk(oacc[d][4 * g4 + 2] * inv * bflo(gv.y), oacc[d][4 * g4 + 3] * inv * bfhi(gv.y));
          *ptr = o;
        }
    }
  } else {
    float* xb = (float*)g_lds_all + half * 8192 + qh * 4096 + lane;
    if (m == 1) {
      const float sc = lam * inv;
#pragma unroll
      for (int d = 0; d < NDT; ++d)
#pragma unroll
        for (int i = 0; i < 16; ++i) xb[(d * 16 + i) * 64] = oacc[d][i] * sc;
    }
    __syncthreads();
    if (m == 0) {
      float ss = 0.f;
#pragma unroll
      for (int d = 0; d < NDT; ++d)
#pragma unroll
        for (int i = 0; i < 16; ++i) { const float o = oacc[d][i] * inv - xb[(d * 16 + i) * 64]; oacc[d][i] = o; ss += o * o; }
      ss += xor32f(ss);
      const float rn = rsqrtf(ss * (1.f / 128.f) + 1e-5f) * 0.8f;
      if (q < rows) {
        bf16_t* gp = gbase + (long)q * 1024 + 4 * h;
        u32x2 gvv[NDT][4];
#pragma unroll
        for (int d = 0; d < NDT; ++d)
#pragma unroll
          for (int g4 = 0; g4 < 4; ++g4) gvv[d][g4] = *(const u32x2*)(gp + d * 32 + 8 * g4);
#pragma unroll
        for (int d = 0; d < NDT; ++d)
#pragma unroll
          for (int g4 = 0; g4 < 4; ++g4) {
            const float4 sg = *(const float4*)(subg + d * 32 + 8 * g4 + 4 * h);
            u32x2* ptr = (u32x2*)(gp + d * 32 + 8 * g4);
            const u32x2 gv = gvv[d][g4];
            u32x2 o;
            o.x = cvtpk(oacc[d][4 * g4 + 0] * rn * sg.x * bflo(gv.x), oacc[d][4 * g4 + 1] * rn * sg.y * bfhi(gv.x));
            o.y = cvtpk(oacc[d][4 * g4 + 2] * rn * sg.z * bflo(gv.y), oacc[d][4 * g4 + 3] * rn * sg.w * bfhi(gv.y));
            *ptr = o;
          }
      }
    }
    __syncthreads();
  }
}

DI void phase2(const Params& p) {
  char* ws = p.ws;
  float* biasT = (float*)(g_lds_all + A_BIAS_OFF);
  for (int i = threadIdx.x; i < 4 * 257; i += 512) biasT[i] = p.relb[i] * LOG2E;
  float s1 = 0.f, s2 = 0.f;
  for (int i = 0; i < 64; ++i) { s1 += p.dlam[i] * p.dlam[64 + i]; s2 += p.dlam[128 + i] * p.dlam[192 + i]; }
  const float lam = expf(s1) - expf(s2) + 0.2f;
  __syncthreads();
  int* ctr = (int*)(ws + WS_CTR);
  int* s_item = (int*)(g_lds_all + A_ITEM_OFF);
  const char* ob = (const char*)p.out;
  const bf16_t* AQ = (const bf16_t*)(ob + OB_AQ); const bf16_t* AK = (const bf16_t*)(ob + OB_AK); const bf16_t* AV = (const bf16_t*)(ob + OB_AV);
  const bf16_t* BQ = (const bf16_t*)(ob + OB_BQ); const bf16_t* BK = (const bf16_t*)(ob + OB_BK); const bf16_t* BV = (const bf16_t*)(ws + WS_BV);
  const bf16_t* MQ = (const bf16_t*)(ob + OB_MQ); const bf16_t* MK = (const bf16_t*)(ws + WS_MK); const bf16_t* MV = (const bf16_t*)(ws + WS_MV);
  bf16_t* G = (bf16_t*)(ws + WS_G);
  constexpr int N_BP = 1024, N_BS = 128, N_AP = 512, N_AS = 64, N_MP = 512, N_MS = 64;
  constexpr int N_ALL = N_BP + N_BS + N_AP + N_AS + N_MP + N_MS;
  for (;;) {
    if (threadIdx.x == 0) *s_item = atomicAdd(ctr, 1);
    __syncthreads();
    int item = *s_item;
    __syncthreads();
    if (item >= N_ALL) break;
    AttnItem it;
    it.bias = false; it.qpos0 = 0; it.qpos1 = 0; it.kpos0 = 0; it.head0 = 0; it.rows0 = 64; it.rows1 = 64;
    it.kf = nullptr; it.vf = nullptr; it.kn = nullptr; it.vn = nullptr; it.ncache = 0; it.k = nullptr; it.v = nullptr;
    if (item < N_BP) {
      const int j = 63 - (item >> 4), bh = item & 15, b = bh >> 2, hh = bh & 3;
      const long tok0 = (long)b * SEQ + j * 128;
      it.q0 = BQ + tok0 * 512 + hh * 128; it.q1 = it.q0 + 64 * 512;
      it.k = BK + (long)b * SEQ * 512 + hh * 128; it.v = BV + (long)b * SEQ * 512 + hh * 128;
      it.qs = 512; it.ks = 512; it.ntiles = 2 * j + 2; it.nkeys = it.ntiles * 64;
      it.tlo0 = 0; it.thi0 = 2 * j + 1; it.tlo1 = 0; it.thi1 = 2 * j + 2;
      it.g0 = G + tok0 * 1024 + 256 + hh * 128; it.g1 = it.g0 + 64 * 1024;
      attn_item<true, false, false, false>(it, lam, p.subg);
      continue;
    }
    item -= N_BP;
    if (item < N_BS) {
      const int b = item >> 2, hh = item & 3;
      const long tok0 = NTOKP + b * ST;
      it.q0 = BQ + tok0 * 512 + hh * 128; it.q1 = it.q0;
      it.kf = p.cbk + (long)b * PAST * 512 + hh * 128; it.vf = p.cbv + (long)b * PAST * 512 + hh * 128; it.ncache = PAST / 64;
      it.kn = p.out + O_BKS + (long)b * ST * 512 + hh * 128; it.vn = p.out + O_BVS + (long)b * ST * 512 + hh * 128;
      it.qs = 512; it.ks = 512; it.ntiles = 17; it.nkeys = PAST + ST;
      it.tlo0 = 0; it.thi0 = 17; it.tlo1 = 0; it.thi1 = 0; it.rows0 = ST; it.rows1 = 0;
      it.g0 = G + tok0 * 1024 + 256 + hh * 128; it.g1 = it.g0;
      attn_item<true, false, true, true>(it, lam, p.subg);
      continue;
    }
    item -= N_BS;
    if (item < N_AP) {
      const int j = 63 - (item >> 3), bh = item & 7, b = bh >> 1, hp = bh & 1;
      const int c0 = 2 * j, c1 = c0 + 1, cs0 = c0 > 8 ? c0 - 8 : 0, cs1 = c1 > 8 ? c1 - 8 : 0;
      const long tok0 = (long)b * SEQ + c0 * 64, k0 = (long)b * SEQ + cs0 * 64;
      it.q0 = AQ + tok0 * 256 + hp * 128; it.q1 = it.q0 + 64 * 256;
      it.k = AK + k0 * 256 + hp * 128; it.v = AV + k0 * 256 + hp * 128;
      it.qs = 256; it.ks = 256; it.ntiles = c1 - cs0 + 1; it.nkeys = it.ntiles * 64;
      it.tlo0 = 0; it.thi0 = c0 - cs0 + 1; it.tlo1 = cs1 - cs0; it.thi1 = it.ntiles;
      it.g0 = G + tok0 * 1024 + hp * 128; it.g1 = it.g0 + 64 * 1024;
      it.bias = true; it.qpos0 = c0 * 64; it.qpos1 = c1 * 64; it.kpos0 = cs0 * 64; it.head0 = hp * 2;
    } else if ((item -= N_AP) < N_AS) {
      const int b = item >> 1, hp = item & 1;
      const long tok0 = NTOKP + b * ST;
      it.q0 = AQ + tok0 * 256 + hp * 128; it.q1 = it.q0;
      it.kf = p.cak + (long)b * RA * 256 + hp * 128; it.vf = p.cav + (long)b * RA * 256 + hp * 128; it.ncache = RA / 64;
      it.kn = p.out + O_AKS + (long)b * ST * 256 + hp * 128; it.vn = p.out + O_AVS + (long)b * ST * 256 + hp * 128;
      it.qs = 256; it.ks = 256; it.ntiles = 9; it.nkeys = RA + ST;
      it.tlo0 = 0; it.thi0 = 9; it.tlo1 = 0; it.thi1 = 0; it.rows0 = ST; it.rows1 = 0;
      it.g0 = G + tok0 * 1024 + hp * 128; it.g1 = it.g0;
      it.bias = true; it.qpos0 = RA; it.qpos1 = RA; it.kpos0 = 0; it.head0 = hp * 2;
    } else if ((item -= N_AS) < N_MP) {
      const int j = item >> 3, bh = item & 7, b = bh >> 1, hp = bh & 1;
      const long tok0 = (long)b * SEQ + j * 128;
      it.q0 = MQ + tok0 * 256 + hp * 128; it.q1 = it.q0 + 64 * 256;
      it.k = MK + (long)b * NMEM * 256 + hp * 128; it.v = MV + (long)b * NMEM * 256 + hp * 128;
      it.qs = 256; it.ks = 256; it.ntiles = 4; it.nkeys = NMEM;
      it.tlo0 = 0; it.thi0 = 4; it.tlo1 = 0; it.thi1 = 4;
      it.g0 = G + tok0 * 1024 + 768 + hp * 128; it.g1 = it.g0 + 64 * 1024;
    } else {
      item -= N_MP;
      const int b = item >> 1, hp = item & 1;
      const long tok0 = NTOKP + b * ST;
      it.q0 = MQ + tok0 * 256 + hp * 128; it.q1 = it.q0;
      it.kf = p.cmk + (long)b * NMEM * 256 + hp * 128; it.vf = p.cmv + (long)b * NMEM * 256 + hp * 128; it.ncache = NMEM / 64;
      it.kn = it.kf; it.vn = it.vf;
      it.qs = 256; it.ks = 256; it.ntiles = 4; it.nkeys = NMEM;
      it.tlo0 = 0; it.thi0 = 4; it.tlo1 = 0; it.thi1 = 0; it.rows0 = ST; it.rows1 = 0;
      it.g0 = G + tok0 * 1024 + 768 + hp * 128; it.g1 = it.g0;
    }
    const bool f32src = it.kf != nullptr;
    if (it.bias) { if (f32src) attn_item<false, true, true, true>(it, lam, p.subg); else attn_item<false, true, false, false>(it, lam, p.subg); }
    else { if (f32src) attn_item<false, false, false, true>(it, lam, p.subg); else attn_item<false, false, false, false>(it, lam, p.subg); }
  }
}

DI void phase3(const Params& p) {
  pg8::Gemm g; g.A = (const bf16_t*)(p.ws + WS_G); g.Bt = (const bf16_t*)(p.ws + WS_WOUTT); g.M = NTOK; g.N = 1024; g.K = 1024;
  pg8::StaticOrder S; S.init(NTOK, 1024, (int)gridDim.x, (int)blockIdx.x);
  EpiOut E; E.ypre = (bf16_t*)(p.ws + WS_XB); E.xp = p.xp; E.xs = p.xs;
  pg8::gemm_phase<EpiOut, pg8::StaticOrder, false>((PG8_LAS unsigned char*)g_lds_all, g, S, E, nullptr);
  __syncthreads();
}

DI void phase4(const Params& p) {
  const int lane = threadIdx.x & 63, w = threadIdx.x >> 6;
  float4 g[4], bb[4];
#pragma unroll
  for (int j = 0; j < 4; ++j) { g[j] = *(const float4*)(p.ln_g + j * 256 + lane * 4); bb[j] = *(const float4*)(p.ln_b + j * 256 + lane * 4); }
  for (int row0 = (blockIdx.x * 8 + w) * 4; row0 < NTOK; row0 += gridDim.x * 32) {
    float4 v[4][4];
#pragma unroll
    for (int rr = 0; rr < 4; ++rr)
#pragma unroll
      for (int j = 0; j < 4; ++j) { const u32x2 w = *(const u32x2*)((const bf16_t*)(p.ws + WS_XB) + (long)(row0 + rr) * 1024 + j * 256 + lane * 4); v[rr][j] = make_float4(bflo(w.x), bfhi(w.x), bflo(w.y), bfhi(w.y)); }
    float s[4], q[4];
#pragma unroll
    for (int rr = 0; rr < 4; ++rr) { s[rr] = 0.f;
#pragma unroll
      for (int j = 0; j < 4; ++j) s[rr] += v[rr][j].x + v[rr][j].y + v[rr][j].z + v[rr][j].w; }
#pragma unroll
    for (int o = 1; o < 64; o <<= 1)
#pragma unroll
      for (int rr = 0; rr < 4; ++rr) s[rr] += __shfl_xor(s[rr], o);
#pragma unroll
    for (int rr = 0; rr < 4; ++rr) { const float mu = s[rr] * (1.f / 1024.f); s[rr] = mu; q[rr] = 0.f;
#pragma unroll
      for (int j = 0; j < 4; ++j) { const float a = v[rr][j].x - mu, b = v[rr][j].y - mu, c = v[rr][j].z - mu, d = v[rr][j].w - mu; q[rr] += a * a + b * b + c * c + d * d; } }
#pragma unroll
    for (int o = 1; o < 64; o <<= 1)
#pragma unroll
      for (int rr = 0; rr < 4; ++rr) q[rr] += __shfl_xor(q[rr], o);
#pragma unroll
    for (int rr = 0; rr < 4; ++rr) {
      const float mu = s[rr], rs = rsqrtf(q[rr] * (1.f / 1024.f) + 1e-5f);
#pragma unroll
      for (int j = 0; j < 4; ++j) {
        float4 o;
        o.x = (v[rr][j].x - mu) * rs * g[j].x + bb[j].x; o.y = (v[rr][j].y - mu) * rs * g[j].y + bb[j].y;
        o.z = (v[rr][j].z - mu) * rs * g[j].z + bb[j].z; o.w = (v[rr][j].w - mu) * rs * g[j].w + bb[j].w;
        *(float4*)(p.out + O_Y + (long)(row0 + rr) * 1024 + j * 256 + lane * 4) = o;
      }
    }
  }
}

DI void grid_barrier(unsigned* bar, unsigned target) {
  asm volatile("s_waitcnt vmcnt(0) lgkmcnt(0)" ::: "memory");
  __syncthreads();
  if (threadIdx.x == 0) {
    __builtin_amdgcn_fence(__ATOMIC_RELEASE, "agent");
    asm volatile("s_waitcnt vmcnt(0)" ::: "memory");
    __hip_atomic_fetch_add(bar, 1u, __ATOMIC_RELAXED, __HIP_MEMORY_SCOPE_AGENT);
    while (__hip_atomic_load(bar, __ATOMIC_RELAXED, __HIP_MEMORY_SCOPE_AGENT) < target) __builtin_amdgcn_s_sleep(2);
    __builtin_amdgcn_fence(__ATOMIC_ACQUIRE, "agent");
    asm volatile("s_waitcnt vmcnt(0)" ::: "memory");
  }
  __syncthreads();
}
__global__ void __launch_bounds__(512) fwd_megakernel(Params p) {
  cg::grid_group grid = cg::this_grid();
  unsigned* bar = (unsigned*)(p.ws + WS_CTR + 64);
  const unsigned nb = gridDim.x;
  phase0(p);
  grid.sync();
  grid_barrier(bar, nb);
  phase1(p);
  grid_barrier(bar, 2 * nb);
  phase2(p);
  grid_barrier(bar, 3 * nb);
  phase3(p);
  grid_barrier(bar, 4 * nb);
  phase4(p);
}

extern "C" void kernel_launch(void* const* d_in, const int* in_sizes, int n_in, void* d_out, int out_size,
                              void* d_ws, size_t ws_size, hipStream_t stream) {
  static int grid_blocks = 0;
  if (!grid_blocks) {
    int dev = 0, cus = 0, per_cu = 0;
    (void)hipGetDevice(&dev);
    (void)hipDeviceGetAttribute(&cus, hipDeviceAttributeMultiprocessorCount, dev);
    (void)hipOccupancyMaxActiveBlocksPerMultiprocessor(&per_cu, fwd_megakernel, 512, 0);
    if (per_cu > 1) per_cu = 1;
    if (per_cu < 1) per_cu = 1;
    grid_blocks = cus * per_cu;
    if (ws_size < WS_END || out_size != (int)O_END) fprintf(stderr, "kernel_launch: unexpected sizes ws %zu (need %zu) out %d (need %ld)\n", ws_size, (size_t)WS_END, out_size, (long)O_END);
  }
  (void)hipMemsetAsync((char*)d_ws + WS_CTR, 0, 256, stream);
  Params p{};
  p.xp = (const float*)d_in[0]; p.xs = (const float*)d_in[1];
  p.cak = (const float*)d_in[2]; p.cav = (const float*)d_in[3]; p.cbk = (const float*)d_in[4]; p.cbv = (const float*)d_in[5];
  p.cmk = (const float*)d_in[6]; p.cmv = (const float*)d_in[7];
  p.memp = (const float*)d_in[8]; p.w_in = (const float*)d_in[9]; p.w_mem = (const float*)d_in[10]; p.relb = (const float*)d_in[11];
  p.dlam = (const float*)d_in[12]; p.subg = (const float*)d_in[13]; p.w_out = (const float*)d_in[14]; p.ln_g = (const float*)d_in[15]; p.ln_b = (const float*)d_in[16];
  p.out = (float*)d_out; p.ws = (char*)d_ws;
  void* args[] = {&p};
  hipError_t e = hipLaunchCooperativeKernel((void*)fwd_megakernel, dim3(grid_blocks), dim3(512), args, 0, stream);
  if (e != hipSuccess) fprintf(stderr, "cooperative launch failed: %s (grid %d)\n", hipGetErrorString(e), grid_blocks);
}
```

```cpp
#include <hip/hip_runtime.h>
#include <hip/hip_cooperative_groups.h>
#include <cstdio>
#include <cstdint>
namespace cg = cooperative_groups;

typedef unsigned short bf16_t;
typedef short bf16x8 __attribute__((ext_vector_type(8)));
typedef short s16x4 __attribute__((ext_vector_type(4)));
typedef float f32x16 __attribute__((ext_vector_type(16)));
typedef float f32x2_t __attribute__((ext_vector_type(2)));
typedef __bf16 bf16x2_t __attribute__((ext_vector_type(2)));
typedef unsigned u32x2 __attribute__((ext_vector_type(2)));
typedef unsigned u32x4 __attribute__((ext_vector_type(4)));
typedef float f32x4g __attribute__((ext_vector_type(4)));
#define DI __device__ __forceinline__
#define MFMA32(a, b, c) __builtin_amdgcn_mfma_f32_32x32x16_bf16((a), (b), (c), 0, 0, 0)
#define LDS3 __attribute__((address_space(3)))

constexpr int D_MODEL = 1024, SEQ = 8192, NB = 4, NTOKP = NB * SEQ, SB = 32, ST = 16, NTOKS = SB * ST, NTOK = NTOKP + NTOKS;
constexpr int PAST = 1024, RA = 512, NMEM = 256, PROJ = 3584;
constexpr int SAK_ROWS = 576, SBK_ROWS = 1088;
constexpr int NTOKPAD = NTOK + 64;
constexpr float QSCALE = 0.125f * 1.4426950408889634f;
constexpr float LOG2E = 1.4426950408889634f;
constexpr float ALPHA = 1.189207115002721f;

constexpr long O_Y = 0;
constexpr long O_AKP = (long)NTOK * 1024;
constexpr long O_AVP = O_AKP + (long)NB * RA * 256;
constexpr long O_BKP = O_AVP + (long)NB * RA * 256;
constexpr long O_BVP = O_BKP + (long)NTOKP * 512;
constexpr long O_MKP = O_BVP + (long)NTOKP * 512;
constexpr long O_MVP = O_MKP + (long)NB * NMEM * 256;
constexpr long O_AKS = O_MVP + (long)NB * NMEM * 256;
constexpr long O_AVS = O_AKS + (long)NTOKS * 256;
constexpr long O_BKS = O_AVS + (long)NTOKS * 256;
constexpr long O_BVS = O_BKS + (long)NTOKS * 512;
constexpr long O_END = O_BVS + (long)NTOKS * 512;

constexpr size_t WS_CTR = 0;
constexpr size_t WS_WINT = 256;
constexpr size_t WS_WOUTT = WS_WINT + (size_t)PROJ * 1024 * 2;
constexpr size_t WS_WMEMT = WS_WOUTT + (size_t)1024 * 1024 * 2;
constexpr size_t WS_ROPE = WS_WMEMT + (size_t)512 * 1024 * 2;
constexpr size_t OB_AQ = 0;
constexpr size_t OB_BQ = OB_AQ + (size_t)NTOKPAD * 256 * 2;
constexpr size_t OB_MQ = OB_BQ + (size_t)NTOKPAD * 512 * 2;
constexpr size_t OB_AK = OB_MQ + (size_t)NTOKPAD * 256 * 2;
constexpr size_t OB_AV = OB_AK + (size_t)NTOKP * 256 * 2;
constexpr size_t OB_BK = OB_AV + (size_t)NTOKP * 256 * 2;
constexpr size_t OB_END = OB_BK + (size_t)NTOKP * 512 * 2;
static_assert(OB_END <= (size_t)NTOK * 1024 * 4, "temporaries must fit in the y region");
constexpr size_t WS_BV = WS_ROPE + (size_t)SEQ * 32 * 8;
constexpr size_t WS_G = WS_BV + (size_t)NTOKP * 512 * 2;
constexpr size_t WS_MK = WS_G + (size_t)NTOK * 1024 * 2;
constexpr size_t WS_MV = WS_MK + (size_t)NB * NMEM * 256 * 2;
constexpr size_t WS_SAK = WS_MV + (size_t)NB * NMEM * 256 * 2;
constexpr size_t WS_SAV = WS_SAK + (size_t)SB * SAK_ROWS * 256 * 2;
constexpr size_t WS_SBK = WS_SAV + (size_t)SB * SAK_ROWS * 256 * 2;
constexpr size_t WS_SBV = WS_SBK + (size_t)SB * SBK_ROWS * 512 * 2;
constexpr size_t WS_SMK = WS_SBV + (size_t)SB * SBK_ROWS * 512 * 2;
constexpr size_t WS_SMV = WS_SMK + (size_t)SB * NMEM * 256 * 2;
constexpr size_t WS_XB = WS_SMV + (size_t)SB * NMEM * 256 * 2;
constexpr size_t WS_MB = WS_XB + (size_t)NTOK * 1024 * 2;
constexpr size_t WS_END = WS_MB + (size_t)NB * NMEM * 1024 * 2;
static_assert(WS_END <= (size_t)512 * 1024 * 1024, "workspace budget");

struct Params {
  const float* xp; const float* xs;
  const float* cak; const float* cav; const float* cbk; const float* cbv; const float* cmk; const float* cmv;
  const float* memp; const float* w_in; const float* w_mem; const float* relb; const float* dlam; const float* subg;
  const float* w_out; const float* ln_g; const float* ln_b;
  float* out; char* ws;
};

constexpr int TEAM_LDS = 73728 + 64;
constexpr int LDS_BYTES = 2 * TEAM_LDS + 64;
__shared__ __attribute__((aligned(16))) char g_lds_all[LDS_BYTES];
#define TEAM (__builtin_amdgcn_readfirstlane((int)(threadIdx.x >> 8)))
#define g_lds (g_lds_all + TEAM * TEAM_LDS)

DI unsigned cvtpk(float lo, float hi) { f32x2_t v = {lo, hi}; bf16x2_t b = __builtin_convertvector(v, bf16x2_t); return __builtin_bit_cast(unsigned, b); }
DI bf16_t f2bf(float x) { return (bf16_t)(cvtpk(x, 0.f) & 0xffffu); }
DI float bf2f(unsigned short b) { return __uint_as_float(((unsigned)b) << 16); }
DI float bflo(unsigned u) { return __uint_as_float(u << 16); }
DI float bfhi(unsigned u) { return __uint_as_float(u & 0xffff0000u); }
DI float fexp2(float x) { return __builtin_amdgcn_exp2f(x); }
DI float xor32f(float v) { return __shfl_xor(v, 32); }

template <bool SWAP45>
DI void transpose_tile(const float* __restrict__ src, int N, bf16_t* __restrict__ dst, int K, int k0, int n0) {
  float* tile = (float*)g_lds;
  const int tid = threadIdx.x & 255, c = tid & 63, r0 = tid >> 6;
#pragma unroll
  for (int i = 0; i < 16; ++i) { const int row = r0 + 4 * i; tile[row * 65 + c] = src[(long)(k0 + row) * N + n0 + c]; }
  __syncthreads();
#pragma unroll
  for (int i = 0; i < 16; ++i) { const int rr = r0 + 4 * i; const int pr = SWAP45 ? ((rr & 15) | ((rr & 16) << 1) | ((rr & 32) >> 1)) : rr; dst[(long)(n0 + pr) * K + k0 + c] = f2bf(tile[c * 65 + rr]); }
  __syncthreads();
}

DI void convert_rows(const float* __restrict__ src, bf16_t* __restrict__ dst, int rows_w8, int dst_bstride_w8, long gtid, long gsz) {
  const long total = (long)SB * rows_w8;
  for (long u = gtid; u < total; u += gsz) {
    const int b = (int)(u / rows_w8); const int j = (int)(u - (long)b * rows_w8);
    const float4 a0 = *(const float4*)(src + u * 8), a1 = *(const float4*)(src + u * 8 + 4);
    u32x4 v; v.x = cvtpk(a0.x, a0.y); v.y = cvtpk(a0.z, a0.w); v.z = cvtpk(a1.x, a1.y); v.w = cvtpk(a1.z, a1.w);
    *(u32x4*)(dst + ((long)b * dst_bstride_w8 + j) * 8) = v;
  }
}

DI void phase0(const Params& p) {
  bf16_t* winT = (bf16_t*)(p.ws + WS_WINT); bf16_t* woutT = (bf16_t*)(p.ws + WS_WOUTT); bf16_t* wmemT = (bf16_t*)(p.ws + WS_WMEMT);
  constexpr int T_IN = 16 * 56, T_OUT = 16 * 16, T_MEM = 16 * 8;
  for (int t = blockIdx.x * 2 + TEAM; t < T_IN + T_OUT + T_MEM; t += gridDim.x * 2) {
    if (t < T_IN) transpose_tile<true>(p.w_in, PROJ, winT, 1024, (t / 56) * 64, (t % 56) * 64);
    else if (t < T_IN + T_OUT) { const int u = t - T_IN; transpose_tile<false>(p.w_out, 1024, woutT, 1024, (u >> 4) * 64, (u & 15) * 64); }
    else { const int u = t - T_IN - T_OUT; transpose_tile<false>(p.w_mem, 512, wmemT, 1024, (u >> 3) * 64, (u & 7) * 64); }
  }
  float2* rope = (float2*)(p.ws + WS_ROPE);
  for (int idx = blockIdx.x * 512 + threadIdx.x; idx < SEQ * 32; idx += gridDim.x * 512) {
    const int pos = idx >> 5, i = idx & 31;
    const double inv = exp(-(double)i * (9.210340371976184 / 32.0));
    const double rev = (double)pos * inv * 0.15915494309189535;
    const double fr = rev - rint(rev);
    const float a = (float)(fr * 6.283185307179586);
    rope[idx] = make_float2(cosf(a), sinf(a));
  }
  const int G = gridDim.x;
  const long gtid = (long)blockIdx.x * 512 + threadIdx.x, gsz = (long)G * 512;
  {
    bf16_t* XB = (bf16_t*)(p.ws + WS_XB); bf16_t* MB = (bf16_t*)(p.ws + WS_MB);
    const long nxp = (long)NTOKP * 1024 / 8, nxs = (long)NTOKS * 1024 / 8, nmb = (long)NB * NMEM * 1024 / 8;
#pragma unroll 4
    for (long u = gtid; u < nxp + nxs + nmb; u += gsz) {
      const float* src; bf16_t* dst;
      if (u < nxp) { src = p.xp + u * 8; dst = XB + u * 8; }
      else if (u < nxp + nxs) { src = p.xs + (u - nxp) * 8; dst = XB + u * 8; }
      else { src = p.memp + (u - nxp - nxs) * 8; dst = MB + (u - nxp - nxs) * 8; }
      const f32x4g a0 = __builtin_nontemporal_load((const f32x4g*)(src)), a1 = __builtin_nontemporal_load((const f32x4g*)(src + 4));
      u32x4 v; v.x = cvtpk(a0[0], a0[1]); v.y = cvtpk(a0[2], a0[3]); v.z = cvtpk(a1[0], a1[1]); v.w = cvtpk(a1[2], a1[3]);
      *(u32x4*)dst = v;
    }
  }
}

constexpr int G_RS = 144, GA_BYTES = 128 * G_RS, GB_BYTES = 256 * G_RS, G_STAGE = GA_BYTES + GB_BYTES;
DI void gemm_core(const bf16_t* __restrict__ Ap, int lda, const bf16_t* __restrict__ Bp, int ldb, int K, f32x16 (&acc)[2][2]) {
  const int tid = threadIdx.x, lane = tid & 63, w = tid >> 6, wm = w >> 2, wn = w & 3, r = lane & 31, h = lane >> 5;
#pragma unroll
  for (int a = 0; a < 2; ++a)
#pragma unroll
    for (int b = 0; b < 2; ++b)
#pragma unroll
      for (int i = 0; i < 16; ++i) acc[a][b][i] = 0.f;
  u32x4 ra0[2], rb0[4], ra1[2], rb1[4];
  const int lrow = tid >> 3, lch = tid & 7;
  const bf16_t* Ag = Ap + (long)lrow * lda + lch * 8;
  const bf16_t* Bg = Bp + (long)lrow * ldb + lch * 8;
#define G_LOAD(RA, RB, kt)                                                                                      \
  {                                                                                                             \
    _Pragma("unroll") for (int i = 0; i < 2; ++i) RA[i] = *(const u32x4*)(Ag + (long)(64 * i) * lda + (kt) * 64); \
    _Pragma("unroll") for (int i = 0; i < 4; ++i) RB[i] = *(const u32x4*)(Bg + (long)(64 * i) * ldb + (kt) * 64); \
  }
#define G_WRITE(RA, RB, buf)                                                                                    \
  {                                                                                                             \
    char* Ab_ = g_lds_all + (buf) * G_STAGE; char* Bb_ = Ab_ + GA_BYTES;                                        \
    _Pragma("unroll") for (int i = 0; i < 2; ++i) *(u32x4*)(Ab_ + (lrow + 64 * i) * G_RS + lch * 16) = RA[i];   \
    _Pragma("unroll") for (int i = 0; i < 4; ++i) *(u32x4*)(Bb_ + (lrow + 64 * i) * G_RS + lch * 16) = RB[i];   \
  }
#define G_COMPUTE(buf)                                                                                          \
  {                                                                                                             \
    const char* Ab = g_lds_all + (buf) * G_STAGE; const char* Bb = Ab + GA_BYTES;                               \
    _Pragma("unroll") for (int s = 0; s < 4; ++s) {                                                             \
      const int co = (16 * s + 8 * h) * 2;                                                                      \
      const bf16x8 a0 = *(const bf16x8*)(Ab + (wm * 64 + r) * G_RS + co);                                       \
      const bf16x8 a1 = *(const bf16x8*)(Ab + (wm * 64 + 32 + r) * G_RS + co);                                  \
      const bf16x8 b0 = *(const bf16x8*)(Bb + (wn * 64 + r) * G_RS + co);                                       \
      const bf16x8 b1 = *(const bf16x8*)(Bb + (wn * 64 + 32 + r) * G_RS + co);                                  \
      acc[0][0] = MFMA32(a0, b0, acc[0][0]);                                                                    \
      acc[0][1] = MFMA32(a0, b1, acc[0][1]);                                                                    \
      acc[1][0] = MFMA32(a1, b0, acc[1][0]);                                                                    \
      acc[1][1] = MFMA32(a1, b1, acc[1][1]);                                                                    \
    }                                                                                                           \
  }
  const int nk = K >> 6;
  G_LOAD(ra0, rb0, 0);
  G_LOAD(ra1, rb1, 1);
  G_WRITE(ra0, rb0, 0);
  __syncthreads();
  for (int kt = 0; kt < nk; kt += 2) {
    if (kt + 2 < nk) G_LOAD(ra0, rb0, kt + 2);
    G_COMPUTE(0);
    G_WRITE(ra1, rb1, 1);
    __syncthreads();
    if (kt + 3 < nk) G_LOAD(ra1, rb1, kt + 3);
    G_COMPUTE(1);
    if (kt + 2 < nk) G_WRITE(ra0, rb0, 0);
    __syncthreads();
  }
#undef G_COMPUTE
#undef G_LOAD
#undef G_WRITE
}

namespace pg8 {
#define PG8_LAS __attribute__((address_space(3)))
typedef unsigned short bf16_t;
typedef short bf16x8 __attribute__((ext_vector_type(8)));
typedef float f32x4 __attribute__((ext_vector_type(4)));
typedef unsigned u32x4 __attribute__((ext_vector_type(4)));
constexpr int BM = 256, BK = 64, HALF = 128, HTB = HALF * BK * 2  , STAGE_BYTES = 8 * HTB, NXCD = 8, WGM = 8;

__host__ __device__ __forceinline__ int lds_byte(int r, int c) { const int st = (r >> 4) * 2 + (c >> 5), rr = r & 15, cc = c & 31, ob = rr * 64 + cc * 2; return st * 1024 + (ob ^ (((ob >> 9) & 1) << 5)); }
__host__ __device__ __forceinline__ void stage_rc(int b, int& R, int& C) { const int st = b / 1024, sb = b % 1024, swz = sb ^ (((sb >> 9) & 1) << 5); R = (st >> 1) * 16 + swz / 64; C = (st & 1) * 32 + (swz % 64) / 2; }
__host__ __device__ __forceinline__ int perm32(int rho) { const int n = rho >> 4, i = rho & 15; return 8 * (i >> 2) + 4 * n + (i & 3); }

struct Unit { int pm, pn; };
struct Gemm { const bf16_t* A; const bf16_t* Bt; int M, N, K; };

struct StaticOrder {
    int nM, nN, nwg, G, c;
    __host__ __device__ void init(int M, int N, int G_, int c_) { nM = M / BM; nN = N / BM; nwg = nM * nN; G = G_; c = c_; }
    __host__ __device__ bool next(int i, Unit& u) const {
        const long L = (long)i * G + c; if (L >= nwg) return false;
        int wgid = (int)L; { const int q = nwg / NXCD, r = nwg % NXCD, xcd = wgid % NXCD, off = wgid / NXCD; wgid = (xcd < r ? xcd * (q + 1) : r * (q + 1) + (xcd - r) * q) + off; }
        const int nig = WGM * nN, gid = wgid / nig, fm = gid * WGM, gsz = (nM - fm) < WGM ? (nM - fm) : WGM;
        u.pm = fm + ((wgid % nig) % gsz); u.pn = (wgid % nig) / gsz; return true;
    }
    __device__ __forceinline__ void a_ready(const Unit&) const {}
    __device__ __forceinline__ void done(const Unit&) const {}
};
template <class Epi, class Sched, bool STAMP = false>
__device__ __forceinline__ void gemm_phase(PG8_LAS unsigned char* lds, const Gemm g, const Sched& S, const Epi& E, unsigned long long* stamps) {
    const int tid = threadIdx.x, wid = __builtin_amdgcn_readfirstlane(tid >> 6), lane = tid & 63, wr = wid >> 2, wc = wid & 3, fr = lane & 15, fq = lane >> 4;
    const int K = g.K, nt = K / BK;
    int ts_lo = 0, ts_hi = 0, nts = 0; const unsigned long long rt_entry = STAMP ? (unsigned long long)wall_clock64() : 0ull;
#define PG8_STAMP() do { if (STAMP && wid == 0 && nts < 64) { const unsigned long long _c = (unsigned long long)clock64(); \
        ts_lo = (lane == nts) ? (int)(unsigned)_c : ts_lo; ts_hi = (lane == nts) ? (int)(unsigned)(_c >> 32) : ts_hi; ++nts; } } while (0)
    PG8_STAMP();
    unsigned voffA[2], voffB[2];
#pragma unroll
    for (int i = 0; i < 2; ++i) { int R, C; stage_rc(tid * 16 + i * 8192, R, C); const int Rb = Epi::PERM ? ((R & ~31) + perm32(R & 31)) : R;
        voffA[i] = (unsigned)(R * K + C) * 2u; voffB[i] = (unsigned)(Rb * K + C) * 2u; }
    const size_t kstep = (size_t)(BK * 2);
    const size_t hstep = (size_t)HALF * K * 2;
    const size_t tstep = 2 * hstep;
    const unsigned ldsw = (unsigned)wid * 1024u;
    const int aoff = lds_byte(wr * 64 + fr, fq * 8), boff = lds_byte(wc * 32 + fr, fq * 8);
#define PG8_SA(b, h) (((b) * 2 + (h)) * HTB)
#define PG8_SB(b, h) ((4 + (b) * 2 + (h)) * HTB)
#define PG8_STAGE(bufoff, gbase, voff) do { _Pragma("unroll") for (int _i = 0; _i < 2; ++_i) \
        __builtin_amdgcn_global_load_lds((const unsigned*)((const char*)(gbase) + (voff)[_i]), (PG8_LAS unsigned*)(lds + (bufoff) + ldsw + _i * 8192), 16, 0, 0); } while (0)
#define PG8_LDA(dst, b, h) do { _Pragma("unroll") for (int m = 0; m < 4; ++m) _Pragma("unroll") for (int k = 0; k < 2; ++k) dst[m][k] = *(const PG8_LAS bf16x8*)(lds + PG8_SA(b, h) + aoff + m * 2048 + k * 1024); } while (0)
#define PG8_LDB(dst, b, h) do { _Pragma("unroll") for (int n = 0; n < 2; ++n) _Pragma("unroll") for (int k = 0; k < 2; ++k) dst[n][k] = *(const PG8_LAS bf16x8*)(lds + PG8_SB(b, h) + boff + n * 2048 + k * 1024); } while (0)
#define PG8_MMA(ai, bj, At, Bt) do { __builtin_amdgcn_s_setprio(1); _Pragma("unroll") for (int m = 0; m < 4; ++m) _Pragma("unroll") for (int n = 0; n < 2; ++n) _Pragma("unroll") for (int k = 0; k < 2; ++k) \
        acc[ai][bj][m][n] = __builtin_amdgcn_mfma_f32_16x16x32_bf16(Bt[n][k], At[m][k], acc[ai][bj][m][n], 0, 0, 0); __builtin_amdgcn_s_setprio(0); } while (0)
#define PG8_WAIT_V(n) asm volatile("s_waitcnt vmcnt(" #n ")" ::: "memory")
#define PG8_WAIT_L(n) asm volatile("s_waitcnt lgkmcnt(" #n ")" ::: "memory")
#define PG8_BAR __builtin_amdgcn_s_barrier()
#define PG8_SCHED __builtin_amdgcn_sched_barrier(0)
    Unit cur, nxt; int ui = 0;
    if (!S.next(0, cur)) return;
    f32x4 acc[2][2][4][2];
#pragma unroll
    for (int a = 0; a < 2; ++a)
#pragma unroll
        for (int b = 0; b < 2; ++b)
#pragma unroll
            for (int m = 0; m < 4; ++m)
#pragma unroll
                for (int n = 0; n < 2; ++n) acc[a][b][m][n] = (f32x4){0.f, 0.f, 0.f, 0.f};
    bf16x8 At[4][2], B0[2][2], B1[2][2];
    const char* cA = (const char*)g.A + (size_t)cur.pm * tstep; const char* cB = (const char*)g.Bt + (size_t)cur.pn * tstep;
    S.a_ready(cur);
    PG8_STAGE(PG8_SB(0, 0), cB, voffB); PG8_STAGE(PG8_SA(0, 0), cA, voffA); PG8_STAGE(PG8_SB(0, 1), cB + hstep, voffB); PG8_STAGE(PG8_SA(0, 1), cA + hstep, voffA);
    if (wr == 1) PG8_BAR;
    PG8_WAIT_V(4); PG8_BAR;
    PG8_STAGE(PG8_SB(1, 0), cB + kstep, voffB); PG8_STAGE(PG8_SA(1, 0), cA + kstep, voffA); PG8_STAGE(PG8_SB(1, 1), cB + hstep + kstep, voffB);
    PG8_WAIT_V(6); PG8_BAR;
    PG8_STAMP();
    for (;;) {
        const bool has_next = S.next(ui + 1, nxt);
        const char* nA = has_next ? (const char*)g.A + (size_t)nxt.pm * tstep : cA; const char* nB = has_next ? (const char*)g.Bt + (size_t)nxt.pn * tstep : cB;
        for (int t = 0; t < nt; t += 2) {
            const bool last = (t == nt - 2);
            const char* a1 = cA + (size_t)(t + 1) * kstep;
            const char* a2 = last ? nA : cA + (size_t)(t + 2) * kstep; const char* b2 = last ? nB : cB + (size_t)(t + 2) * kstep;
            const char* a3 = a2 + kstep; const char* b3 = b2 + kstep;
            if (last && has_next) S.a_ready(nxt);
            PG8_LDB(B0, 0, 0); PG8_SCHED; PG8_LDA(At, 0, 0); PG8_STAGE(PG8_SA(1, 1), a1 + hstep, voffA);
            PG8_WAIT_L(8); PG8_BAR; PG8_WAIT_L(0); PG8_MMA(0, 0, At, B0); PG8_BAR; PG8_SCHED;
            PG8_LDB(B1, 0, 1); PG8_STAGE(PG8_SB(0, 0), b2, voffB);
            PG8_BAR; PG8_WAIT_L(0); PG8_MMA(0, 1, At, B1); PG8_BAR;
            PG8_LDA(At, 0, 1); PG8_STAGE(PG8_SA(0, 0), a2, voffA);
            PG8_BAR; PG8_WAIT_L(0); PG8_MMA(1, 0, At, B0); PG8_BAR; PG8_SCHED;
            PG8_STAGE(PG8_SB(0, 1), b2 + hstep, voffB);
            PG8_WAIT_V(6); PG8_BAR; PG8_MMA(1, 1, At, B1); PG8_BAR;
            PG8_LDB(B0, 1, 0); PG8_SCHED; PG8_LDA(At, 1, 0); PG8_STAGE(PG8_SA(0, 1), a2 + hstep, voffA);
            PG8_WAIT_L(8); PG8_BAR; PG8_WAIT_L(0); PG8_MMA(0, 0, At, B0); PG8_BAR; PG8_SCHED;
            PG8_LDB(B1, 1, 1); PG8_STAGE(PG8_SB(1, 0), b3, voffB);
            PG8_BAR; PG8_WAIT_L(0); PG8_MMA(0, 1, At, B1); PG8_BAR;
            PG8_LDA(At, 1, 1); PG8_STAGE(PG8_SA(1, 0), a3, voffA);
            PG8_BAR; PG8_WAIT_L(0); PG8_MMA(1, 0, At, B0); PG8_BAR; PG8_SCHED;
            PG8_STAGE(PG8_SB(1, 1), b3 + hstep, voffB);
            PG8_WAIT_V(6); PG8_BAR; PG8_MMA(1, 1, At, B1); PG8_BAR;
        }
        PG8_STAMP();
        if constexpr (!Epi::AFTER_DRAIN) { E(acc, cur, wr, wc, fr, fq); S.done(cur); }
        PG8_STAMP();
        if (!has_next) break;
#pragma unroll
        for (int a = 0; a < 2; ++a)
#pragma unroll
            for (int b = 0; b < 2; ++b)
#pragma unroll
                for (int m = 0; m < 4; ++m)
#pragma unroll
                    for (int n = 0; n < 2; ++n) acc[a][b][m][n] = (f32x4){0.f, 0.f, 0.f, 0.f};
        cur = nxt; cA = nA; cB = nB; ++ui;
    }
    PG8_WAIT_V(0);
    if (wr == 0) PG8_BAR;
    PG8_BAR;
    if constexpr (Epi::AFTER_DRAIN) { E.fused(acc, cur, wr, wc, fr, fq, lds, wid, lane); S.done(cur); }
    PG8_STAMP();
    if (STAMP && wid == 0) { stamps[lane] = lane < nts ? (((unsigned long long)(unsigned)ts_hi << 32) | (unsigned)ts_lo) : 0ull;
        if (lane == 62) stamps[62] = rt_entry; if (lane == 63) stamps[63] = (unsigned long long)wall_clock64(); }
#undef PG8_STAMP
#undef PG8_SA
#undef PG8_SB
#undef PG8_STAGE
#undef PG8_LDA
#undef PG8_LDB
#undef PG8_MMA
#undef PG8_WAIT_V
#undef PG8_WAIT_L
#undef PG8_BAR
#undef PG8_SCHED
}
}

struct EpiProj {
  static constexpr bool PERM = false, AFTER_DRAIN = false;
  float* out; char* ws;
  __device__ __forceinline__ void operator()(const pg8::f32x4 (&acc)[2][2][4][2], const pg8::Unit& u, int wr, int wc, int fr, int fq) const {
    asm volatile("" : "+v"(fr), "+v"(fq));
    char* ob = (char*)out;
    const int n0 = u.pn * 256;
    int seg, sbase;
    if (n0 < 256) { seg = 0; sbase = 0; } else if (n0 < 512) { seg = 1; sbase = 256; } else if (n0 < 768) { seg = 2; sbase = 512; }
    else if (n0 < 1280) { seg = 3; sbase = 768; } else if (n0 < 1792) { seg = 4; sbase = 1280; } else if (n0 < 2304) { seg = 5; sbase = 1792; }
    else if (n0 < 2560) { seg = 6; sbase = 2304; } else { seg = 7; sbase = 2560; }
    const bool smp = u.pm >= NTOKP / 256;
    const float2* rope = (const float2*)(ws + WS_ROPE);
    const int fi = 16 * (wc & 1) + 4 * fq;
#pragma unroll
    for (int ai = 0; ai < 2; ++ai)
#pragma unroll
      for (int m = 0; m < 4; ++m) {
        const int row = 128 * ai + 64 * wr + 16 * m + fr;
        const long tok = (long)u.pm * 256 + row;
        const long ts = tok - NTOKP;
        float4 c01, s01, c23, s23;
        if (seg == 3 || seg == 4) {
          const int pos = smp ? (PAST + (int)(ts & 15)) : (int)(tok & (SEQ - 1));
          const float4 r0 = *(const float4*)(rope + pos * 32 + fi), r1 = *(const float4*)(rope + pos * 32 + fi + 2);
          c01 = make_float4(r0.x, r0.z, r1.x, r1.z); s01 = make_float4(r0.y, r0.w, r1.y, r1.w);
        }
#pragma unroll
        for (int bj = 0; bj < 2; ++bj) {
          const int blk = 4 * u.pn + 2 * bj + (wc >> 1);
          const int col = 64 * blk + fi - sbase;
          pg8::f32x4 v0 = acc[ai][bj][m][0], v1 = acc[ai][bj][m][1];
          if (seg == 3 || seg == 4) {
            const pg8::f32x4 cc = {c01.x, c01.y, c01.z, c01.w}, ss = {s01.x, s01.y, s01.z, s01.w};
            const pg8::f32x4 a = v0 * cc - v1 * ss, b = v1 * cc + v0 * ss;
            v0 = a; v1 = b;
          }
          if (seg == 0 || seg == 3 || seg == 6) {
            bf16_t* q = (seg == 0) ? (bf16_t*)(ob + OB_AQ) + tok * 256 : (seg == 3) ? (bf16_t*)(ob + OB_BQ) + tok * 512 : (bf16_t*)(ob + OB_MQ) + tok * 256;
            u32x2 w0, w1; w0.x = cvtpk(v0[0] * QSCALE, v0[1] * QSCALE); w0.y = cvtpk(v0[2] * QSCALE, v0[3] * QSCALE);
            w1.x = cvtpk(v1[0] * QSCALE, v1[1] * QSCALE); w1.y = cvtpk(v1[2] * QSCALE, v1[3] * QSCALE);
            *(u32x2*)(q + col) = w0; *(u32x2*)(q + col + 32) = w1;
          } else if (seg == 7) {
            bf16_t* g = (bf16_t*)(ws + WS_G) + tok * 1024;
            float a[4], b[4];
#pragma unroll
            for (int j = 0; j < 4; ++j) { a[j] = v0[j] / (1.f + __expf(-v0[j])); b[j] = v1[j] / (1.f + __expf(-v1[j])); }
            u32x2 w0, w1; w0.x = cvtpk(a[0], a[1]); w0.y = cvtpk(a[2], a[3]); w1.x = cvtpk(b[0], b[1]); w1.y = cvtpk(b[2], b[3]);
            *(u32x2*)(g + col) = w0; *(u32x2*)(g + col + 32) = w1;
          } else {
            const bool wide = (seg >= 4);
            const int W = wide ? 512 : 256;
            bf16_t* kw; float* o = nullptr;
            if (!smp) {
              if (seg == 1) kw = (bf16_t*)(ob + OB_AK) + tok * 256; else if (seg == 2) kw = (bf16_t*)(ob + OB_AV) + tok * 256;
              else if (seg == 4) kw = (bf16_t*)(ob + OB_BK) + tok * 512; else kw = (bf16_t*)(ws + WS_BV) + tok * 512;
              if (wide) o = out + (seg == 4 ? O_BKP : O_BVP) + tok * 512;
              else { const int ps = (int)(tok & (SEQ - 1)); const int pb = (int)(tok >> 13); if (ps >= SEQ - RA) o = out + (seg == 1 ? O_AKP : O_AVP) + (long)(pb * RA + ps - (SEQ - RA)) * 256; }
            } else {
              kw = nullptr;
              if (wide) o = out + (seg == 4 ? O_BKS : O_BVS) + ts * 512; else o = out + (seg == 1 ? O_AKS : O_AVS) + ts * 256;
            }
            (void)W;
            u32x2 w0, w1; w0.x = cvtpk(v0[0], v0[1]); w0.y = cvtpk(v0[2], v0[3]); w1.x = cvtpk(v1[0], v1[1]); w1.y = cvtpk(v1[2], v1[3]);
            if (kw) { *(u32x2*)(kw + col) = w0; *(u32x2*)(kw + col + 32) = w1; }
            if (o) { __builtin_nontemporal_store(v0, (pg8::f32x4*)(o + col)); __builtin_nontemporal_store(v1, (pg8::f32x4*)(o + col + 32)); }
          }
        }
      }
  }
};

struct EpiOut {
  static constexpr bool PERM = false, AFTER_DRAIN = false;
  bf16_t* ypre; const float* xp; const float* xs;
  __device__ __forceinline__ void operator()(const pg8::f32x4 (&acc)[2][2][4][2], const pg8::Unit& u, int wr, int wc, int fr, int fq) const {
    asm volatile("" : "+v"(fr), "+v"(fq));
    const float* xb = (u.pm < NTOKP / 256) ? xp + (long)u.pm * 256 * 1024 : xs + (long)(u.pm - NTOKP / 256) * 256 * 1024;
    bf16_t* yb = ypre + (long)u.pm * 256 * 1024;
    const int col0 = u.pn * 256 + wc * 32 + 4 * fq;
#pragma unroll
    for (int ai = 0; ai < 2; ++ai)
#pragma unroll
      for (int mp = 0; mp < 2; ++mp) {
        pg8::f32x4 xv[2][2][2];
#pragma unroll
        for (int mm = 0; mm < 2; ++mm) {
          const long ro = (long)(128 * ai + 64 * wr + 16 * (2 * mp + mm) + fr) * 1024 + col0;
#pragma unroll
          for (int bj = 0; bj < 2; ++bj)
#pragma unroll
            for (int n = 0; n < 2; ++n) xv[mm][bj][n] = __builtin_nontemporal_load((const pg8::f32x4*)(xb + ro + bj * 128 + n * 16));
        }
#pragma unroll
        for (int mm = 0; mm < 2; ++mm) {
          const long ro = (long)(128 * ai + 64 * wr + 16 * (2 * mp + mm) + fr) * 1024 + col0;
#pragma unroll
          for (int bj = 0; bj < 2; ++bj)
#pragma unroll
            for (int n = 0; n < 2; ++n) { const pg8::f32x4 y = acc[ai][bj][2 * mp + mm][n] + ALPHA * xv[mm][bj][n]; u32x2 w; w.x = cvtpk(y[0], y[1]); w.y = cvtpk(y[2], y[3]); *(u32x2*)(yb + ro + bj * 128 + n * 16) = w; }
        }
      }
  }
};

DI void mem_epilogue(const Params& p, int mt, int nt, f32x16 (&acc)[2][2]) {
  const int tid = threadIdx.x, lane = tid & 63, w = tid >> 6, wm = w >> 2, wn = w & 3, c = lane & 31, h = lane >> 5;
  const int n0 = nt * 256 + wn * 64;
  const bool isv = n0 >= 256;
  const int cb = isv ? n0 - 256 : n0;
  bf16_t* kw = (bf16_t*)(p.ws + (isv ? WS_MV : WS_MK));
  float* o = p.out + (isv ? O_MVP : O_MKP);
#pragma unroll
  for (int mi = 0; mi < 2; ++mi)
#pragma unroll
    for (int i = 0; i < 16; ++i) {
      const long row = mt * 128 + wm * 64 + mi * 32 + (i & 3) + 8 * (i >> 2) + 4 * h;
      const float v0 = acc[mi][0][i], v1 = acc[mi][1][i];
      kw[row * 256 + cb + c] = f2bf(v0); kw[row * 256 + cb + c + 32] = f2bf(v1);
      o[row * 256 + cb + c] = v0; o[row * 256 + cb + c + 32] = v1;
    }
}

DI void phase1(const Params& p) {
  const int G = gridDim.x;
  const bf16_t* winT = (const bf16_t*)(p.ws + WS_WINT); const bf16_t* wmemT = (const bf16_t*)(p.ws + WS_WMEMT);
  const bf16_t* XB = (const bf16_t*)(p.ws + WS_XB); const bf16_t* MB = (const bf16_t*)(p.ws + WS_MB);
  {
    pg8::Gemm g; g.A = XB; g.Bt = winT; g.M = NTOK; g.N = PROJ; g.K = 1024;
    pg8::StaticOrder S; S.init(NTOK, PROJ, G, (int)blockIdx.x);
    EpiProj E; E.out = p.out; E.ws = p.ws;
    pg8::gemm_phase<EpiProj, pg8::StaticOrder, false>((PG8_LAS unsigned char*)g_lds_all, g, S, E, nullptr);
  }
  __syncthreads();
  constexpr int T2 = 8 * 2;
  f32x16 acc[2][2];
  for (int t = (int)blockIdx.x - 64; t >= 0 && t < T2; t += G) {
    const int mt = t >> 1, nt = t & 1;
    gemm_core(MB + (long)mt * 128 * 1024, 1024, wmemT + (long)nt * 256 * 1024, 1024, 1024, acc);
    mem_epilogue(p, mt, nt, acc);
  }
}

struct AttnItem {
  const bf16_t* q0; const bf16_t* q1;
  const bf16_t* k; const bf16_t* v;
  bf16_t* g0; bf16_t* g1;
  int qs, ks, ntiles, nkeys;
  int tlo0, thi0, tlo1, thi1;
  int rows0, rows1;
  int qpos0, qpos1, kpos0, head0; bool bias;
  const float* kf; const float* vf;
  const float* kn; const float* vn;
  int ncache;
};
constexpr int AK_RS = 272, AK_BYTES = 64 * AK_RS, AV_BYTES = 16384, A_BUF = AK_BYTES + AV_BYTES;
constexpr int A_BIAS_OFF = 2 * A_BUF;
constexpr int A_ITEM_OFF = 2 * TEAM_LDS;
constexpr int A_Q_OFF = 73728;

template <bool DIFF, bool BIAS, bool MASK, bool F32>
DI void attn_item(const AttnItem& it, float lam, const float* __restrict__ subg) {
  const int tid = threadIdx.x, lane = tid & 63, w = tid >> 6, r = lane & 31, h = lane >> 5;
  const int half = __builtin_amdgcn_readfirstlane(w >> 2), qh = w & 1, m = (w >> 1) & 1;
  constexpr int NDT = DIFF ? 4 : 2;
  const int ntiles = it.ntiles;
  const int tlo = half ? it.tlo1 : it.tlo0, thi = half ? it.thi1 : it.thi0, rows = half ? it.rows1 : it.rows0;
  const bf16_t* qbase = half ? it.q1 : it.q0;
  bf16_t* gbase = half ? it.g1 : it.g0;
  char* qlds = g_lds_all + A_Q_OFF + w * 4096 + lane * 16;
  {
    const bf16_t* qp = qbase + (long)(qh * 32 + r) * it.qs + m * 64 + 8 * h;
#pragma unroll
    for (int s = 0; s < 4; ++s) *(bf16x8*)(qlds + s * 1024) = *(const bf16x8*)(qp + 16 * s);
  }
  f32x16 oacc[NDT];
#pragma unroll
  for (int d = 0; d < NDT; ++d)
#pragma unroll
    for (int i = 0; i < 16; ++i) oacc[d][i] = 0.f;
  float m_run = -1e30f, l_run = 0.f;
  u32x4 rk0[2], rv0[2];
  float4 fk[4], fv[4];
  const int kch = tid & 15, krow = tid >> 4, vsub = tid & 3, vkey = (tid >> 2) & 63, vd = tid >> 8;
  const bf16_t* kg = it.k + (long)krow * it.ks + kch * 8;
  const bf16_t* vg = it.v + (long)vkey * it.ks + vd * 32 + vsub * 8;
#define A_LOAD(RK, RV, t)                                                                                        \
  if (!F32) {                                                                                                    \
    _Pragma("unroll") for (int i = 0; i < 2; ++i) RK[i] = *(const u32x4*)(kg + (long)((t) * 64 + 32 * i) * it.ks); \
    _Pragma("unroll") for (int i = 0; i < 2; ++i) RV[i] = *(const u32x4*)(vg + (long)((t) * 64) * it.ks + 64 * i); \
  } else {                                                                                                       \
    const bool nw = (t) >= it.ncache;             \
    _Pragma("unroll") for (int i = 0; i < 2; ++i) {                                                              \
      const int kr = krow + 32 * i;                                                                              \
      const float* src = nw ? it.kn + (long)(kr < 15 ? kr : 15) * it.ks : it.kf + (long)((t) * 64 + kr) * it.ks; \
      fk[2 * i] = *(const float4*)(src + kch * 8); fk[2 * i + 1] = *(const float4*)(src + kch * 8 + 4);          \
    }                                                                                                            \
    {                                                                                                            \
      const float* src = nw ? it.vn + (long)(vkey < 15 ? vkey : 15) * it.ks : it.vf + (long)((t) * 64 + vkey) * it.ks; \
      _Pragma("unroll") for (int i = 0; i < 2; ++i) {                                                            \
        fv[2 * i] = *(const float4*)(src + (vd + 2 * i) * 32 + vsub * 8); fv[2 * i + 1] = *(const float4*)(src + (vd + 2 * i) * 32 + vsub * 8 + 4); \
      }                                                                                                          \
    }                                                                                                            \
  }
#define A_WRITE(RK, RV, stage)                                                                                   \
  {                                                                                                              \
    char* Kb_ = g_lds_all + (stage) * A_BUF; char* Vb_ = Kb_ + AK_BYTES;                                         \
    if (F32) {                                                                                                   \
      _Pragma("unroll") for (int i = 0; i < 2; ++i) {                                                            \
        RK[i].x = cvtpk(fk[2 * i].x, fk[2 * i].y); RK[i].y = cvtpk(fk[2 * i].z, fk[2 * i].w); RK[i].z = cvtpk(fk[2 * i + 1].x, fk[2 * i + 1].y); RK[i].w = cvtpk(fk[2 * i + 1].z, fk[2 * i + 1].w); \
        RV[i].x = cvtpk(fv[2 * i].x, fv[2 * i].y); RV[i].y = cvtpk(fv[2 * i].z, fv[2 * i].w); RV[i].z = cvtpk(fv[2 * i + 1].x, fv[2 * i + 1].y); RV[i].w = cvtpk(fv[2 * i + 1].z, fv[2 * i + 1].w); \
      }                                                                                                          \
    }                                                                                                            \
    _Pragma("unroll") for (int i = 0; i < 2; ++i) *(u32x4*)(Kb_ + (krow + 32 * i) * AK_RS + kch * 16) = RK[i];   \
    _Pragma("unroll") for (int i = 0; i < 2; ++i) *(u32x4*)(Vb_ + (vd + 2 * i) * 4096 + vkey * 64 + vsub * 16) = RV[i]; \
  }
  const int vlane = ((lane >> 4) & 1) * 32 + (lane & 3) * 8 + (4 * h + ((lane & 15) >> 2)) * 64;
  const float* biasT = (const float*)(g_lds_all + A_BIAS_OFF) + (it.head0 + m) * 257;
  const int qpos = (half ? it.qpos1 : it.qpos0) + qh * 32 + r;
#define A_COMPUTE(t, stage)                                                                                      \
  if ((t) >= tlo && (t) < thi) {                                                                                 \
    const char* Kb = g_lds_all + (stage) * A_BUF; const char* Vb = Kb + AK_BYTES;                                \
    f32x16 s0, s1;                                                                                               \
    _Pragma("unroll") for (int i = 0; i < 16; ++i) { s0[i] = 0.f; s1[i] = 0.f; }                                 \
    _Pragma("unroll") for (int s = 0; s < 4; ++s) {                                                              \
      const int co = (m * 64 + 16 * s + 8 * h) * 2;                                                              \
      const bf16x8 k0 = *(const bf16x8*)(Kb + r * AK_RS + co);                                                   \
      const bf16x8 k1 = *(const bf16x8*)(Kb + (32 + r) * AK_RS + co);                                            \
      const bf16x8 qfs = *(const bf16x8*)(qlds + s * 1024);                                                      \
      s0 = MFMA32(k0, qfs, s0);                                                                                  \
      s1 = MFMA32(k1, qfs, s1);                                                                                  \
    }                                                                                                            \
    if (BIAS) {                                                                                                  \
      const int kb = it.kpos0 + (t) * 64 + 4 * h;                                                                \
      _Pragma("unroll") for (int i = 0; i < 16; ++i) {                                                           \
        const int kk = kb + (i & 3) + 8 * (i >> 2);                                                              \
        int d0 = qpos - kk, d1 = d0 - 32;                                                                        \
        d0 = min(max(d0, -128), 128) + 128; d1 = min(max(d1, -128), 128) + 128;                                  \
        s0[i] += biasT[d0]; s1[i] += biasT[d1];                                                                  \
      }                                                                                                          \
    }                                                                                                            \
    if (MASK && ((t) + 1) * 64 > it.nkeys) {                                                                     \
      const int kb = (t) * 64 + 4 * h;                                                                           \
      _Pragma("unroll") for (int i = 0; i < 16; ++i) {                                                           \
        const int kk = kb + (i & 3) + 8 * (i >> 2);                                                              \
        if (kk >= it.nkeys) s0[i] = -1e30f;                                                                      \
        if (kk + 32 >= it.nkeys) s1[i] = -1e30f;                                                                 \
      }                                                                                                          \
    }                                                                                                            \
    float mx = fmaxf(s0[0], s1[0]);                                                                              \
    _Pragma("unroll") for (int i = 1; i < 16; ++i) mx = fmaxf(mx, fmaxf(s0[i], s1[i]));                          \
    mx = fmaxf(mx, xor32f(mx));                                                                                  \
    const float m_new = (mx > m_run + 8.f) ? mx : m_run;     \
    const float alpha = fexp2(m_run - m_new);                                                                    \
    if (__builtin_amdgcn_ballot_w64(m_new > m_run) != 0ull) {                                                    \
      _Pragma("unroll") for (int d = 0; d < NDT; ++d)                                                            \
        _Pragma("unroll") for (int i = 0; i < 16; ++i) oacc[d][i] *= alpha;                                      \
    }                                                                                                            \
    l_run *= alpha;                                                                                              \
    m_run = m_new;                                                                                               \
    float ls = 0.f;                                                                                              \
    _Pragma("unroll") for (int i = 0; i < 16; ++i) { s0[i] = fexp2(s0[i] - m_new); s1[i] = fexp2(s1[i] - m_new); ls += s0[i] + s1[i]; } \
    l_run += ls;                                                                                                 \
    bf16x8 pf[4];                                                                                                \
    _Pragma("unroll") for (int s2 = 0; s2 < 2; ++s2) {                                                           \
      u32x4 a, b;                                                                                                \
      a.x = cvtpk(s0[8 * s2 + 0], s0[8 * s2 + 1]); a.y = cvtpk(s0[8 * s2 + 2], s0[8 * s2 + 3]);                  \
      a.z = cvtpk(s0[8 * s2 + 4], s0[8 * s2 + 5]); a.w = cvtpk(s0[8 * s2 + 6], s0[8 * s2 + 7]);                  \
      b.x = cvtpk(s1[8 * s2 + 0], s1[8 * s2 + 1]); b.y = cvtpk(s1[8 * s2 + 2], s1[8 * s2 + 3]);                  \
      b.z = cvtpk(s1[8 * s2 + 4], s1[8 * s2 + 5]); b.w = cvtpk(s1[8 * s2 + 6], s1[8 * s2 + 7]);                  \
      pf[s2] = __builtin_bit_cast(bf16x8, a); pf[2 + s2] = __builtin_bit_cast(bf16x8, b);                        \
    }                                                                                                            \
    const LDS3 char* vb3 = (const LDS3 char*)(Vb) + vlane + (DIFF ? 0 : m * 2 * 4096);                           \
    _Pragma("unroll") for (int ks = 0; ks < 4; ++ks) {                                                           \
      _Pragma("unroll") for (int d = 0; d < NDT; ++d) {                                                          \
        const s16x4 lo = __builtin_bit_cast(s16x4, __builtin_amdgcn_ds_read_tr16_b64_v4i16((LDS3 s16x4*)(vb3 + d * 4096 + ks * 1024))); \
        const s16x4 hi = __builtin_bit_cast(s16x4, __builtin_amdgcn_ds_read_tr16_b64_v4i16((LDS3 s16x4*)(vb3 + d * 4096 + ks * 1024 + 512))); \
        const bf16x8 vf = __builtin_shufflevector(lo, hi, 0, 1, 2, 3, 4, 5, 6, 7);                               \
        oacc[d] = MFMA32(vf, pf[ks], oacc[d]);                                                                   \
      }                                                                                                          \
      __builtin_amdgcn_sched_barrier(0);                                                                         \
    }                                                                                                            \
  }
  A_LOAD(rk0, rv0, 0);
  A_WRITE(rk0, rv0, 0);
  if (ntiles > 1) A_LOAD(rk0, rv0, 1);
  __syncthreads();
#pragma unroll 1
  for (int t = 0; t < ntiles; ++t) {
    const int par = t & 1;
    if (t + 1 < ntiles) A_WRITE(rk0, rv0, par ^ 1);
    if (t + 2 < ntiles) A_LOAD(rk0, rv0, t + 2);
    A_COMPUTE(t, par);
    __syncthreads();
  }
#undef A_LOAD
#undef A_WRITE
#undef A_COMPUTE
  const float l_tot = l_run + xor32f(l_run);
  const float inv = 1.f / l_tot;
  const int q = qh * 32 + r;
  if (!DIFF) {
    if (q < rows) {
      bf16_t* gp = gbase + (long)q * 1024 + m * 64 + 4 * h;
      u32x2 gvv[NDT][4];
#pragma unroll
      for (int d = 0; d < NDT; ++d)
#pragma unroll
        for (int g4 = 0; g4 < 4; ++g4) gvv[d][g4] = *(const u32x2*)(gp + d * 32 + 8 * g4);
#pragma unroll
      for (int d = 0; d < NDT; ++d)
#pragma unroll
        for (int g4 = 0; g4 < 4; ++g4) {
          u32x2* ptr = (u32x2*)(gp + d * 32 + 8 * g4);
          const u32x2 gv = gvv[d][g4];
          u32x2 o;
          o.x = cvtpk(oacc[d][4 * g4 + 0] * inv * bflo(gv.x), oacc[d][4 * g4 + 1] * inv * bfhi(gv.x));
          o.y = cvtpk(oacc[d][4 * g4 + 2] * inv * bflo(gv.y), oacc[d][4 * g4 + 3] * inv * bfhi(gv.y));
          *ptr = o;
        }
    }
  } else {
    float* xb = (float*)g_lds_all + half * 8192 + qh * 4096 + lane;
    if (m == 1) {
      const float sc = lam * inv;
#pragma unroll
      for (int d = 0; d < NDT; ++d)
#pragma unroll
        for (int i = 0; i < 16; ++i) xb[(d * 16 + i) * 64] = oacc[d][i] * sc;
    }
    __syncthreads();
    if (m == 0) {
      float ss = 0.f;
#pragma unroll
      for (int d = 0; d < NDT; ++d)
#pragma unroll
        for (int i = 0; i < 16; ++i) { const float o = oacc[d][i] * inv - xb[(d * 16 + i) * 64]; oacc[d][i] = o; ss += o * o; }
      ss += xor32f(ss);
      const float rn = rsqrtf(ss * (1.f / 128.f) + 1e-5f) * 0.8f;
      if (q < rows) {
        bf16_t* gp = gbase + (long)q * 1024 + 4 * h;
        u32x2 gvv[NDT][4];
#pragma unroll
        for (int d = 0; d < NDT; ++d)
#pragma unroll
          for (int g4 = 0; g4 < 4; ++g4) gvv[d][g4] = *(const u32x2*)(gp + d * 32 + 8 * g4);
#pragma unroll
        for (int d = 0; d < NDT; ++d)
#pragma unroll
          for (int g4 = 0; g4 < 4; ++g4) {
            const float4 sg = *(const float4*)(subg + d * 32 + 8 * g4 + 4 * h);
            u32x2* ptr = (u32x2*)(gp + d * 32 + 8 * g4);
            const u32x2 gv = gvv[d][g4];
            u32x2 o;
            o.x = cvtpk(oacc[d][4 * g4 + 0] * rn * sg.x * bflo(gv.x), oacc[d][4 * g4 + 1] * rn * sg.y * bfhi(gv.x));
            o.y = cvtpk(oacc[d][4 * g4 + 2] * rn * sg.z * bflo(gv.y), oacc[d][4 * g4 + 3] * rn * sg.w * bfhi(gv.y));
            *ptr = o;
          }
      }
    }
    __syncthreads();
  }
}

DI void phase2(const Params& p) {
  char* ws = p.ws;
  float* biasT = (float*)(g_lds_all + A_BIAS_OFF);
  for (int i = threadIdx.x; i < 4 * 257; i += 512) biasT[i] = p.relb[i] * LOG2E;
  float s1 = 0.f, s2 = 0.f;
  for (int i = 0; i < 64; ++i) { s1 += p.dlam[i] * p.dlam[64 + i]; s2 += p.dlam[128 + i] * p.dlam[192 + i]; }
  const float lam = expf(s1) - expf(s2) + 0.2f;
  __syncthreads();
  int* ctr = (int*)(ws + WS_CTR);
  int* s_item = (int*)(g_lds_all + A_ITEM_OFF);
  const char* ob = (const char*)p.out;
  const bf16_t* AQ = (const bf16_t*)(ob + OB_AQ); const bf16_t* AK = (const bf16_t*)(ob + OB_AK); const bf16_t* AV = (const bf16_t*)(ob + OB_AV);
  const bf16_t* BQ = (const bf16_t*)(ob + OB_BQ); const bf16_t* BK = (const bf16_t*)(ob + OB_BK); const bf16_t* BV = (const bf16_t*)(ws + WS_BV);
  const bf16_t* MQ = (const bf16_t*)(ob + OB_MQ); const bf16_t* MK = (const bf16_t*)(ws + WS_MK); const bf16_t* MV = (const bf16_t*)(ws + WS_MV);
  bf16_t* G = (bf16_t*)(ws + WS_G);
  constexpr int N_BP = 1024, N_BS = 128, N_AP = 512, N_AS = 64, N_MP = 512, N_MS = 64;
  constexpr int N_ALL = N_BP + N_BS + N_AP + N_AS + N_MP + N_MS;
  for (;;) {
    if (threadIdx.x == 0) *s_item = atomicAdd(ctr, 1);
    __syncthreads();
    int item = *s_item;
    __syncthreads();
    if (item >= N_ALL) break;
    AttnItem it;
    it.bias = false; it.qpos0 = 0; it.qpos1 = 0; it.kpos0 = 0; it.head0 = 0; it.rows0 = 64; it.rows1 = 64;
    it.kf = nullptr; it.vf = nullptr; it.kn = nullptr; it.vn = nullptr; it.ncache = 0; it.k = nullptr; it.v = nullptr;
    if (item < N_BP) {
      const int j = 63 - (item >> 4), bh = item & 15, b = bh >> 2, hh = bh & 3;
      const long tok0 = (long)b * SEQ + j * 128;
      it.q0 = BQ + tok0 * 512 + hh * 128; it.q1 = it.q0 + 64 * 512;
      it.k = BK + (long)b * SEQ * 512 + hh * 128; it.v = BV + (long)b * SEQ * 512 + hh * 128;
      it.qs = 512; it.ks = 512; it.ntiles = 2 * j + 2; it.nkeys = it.ntiles * 64;
      it.tlo0 = 0; it.thi0 = 2 * j + 1; it.tlo1 = 0; it.thi1 = 2 * j + 2;
      it.g0 = G + tok0 * 1024 + 256 + hh * 128; it.g1 = it.g0 + 64 * 1024;
      attn_item<true, false, false, false>(it, lam, p.subg);
      continue;
    }
    item -= N_BP;
    if (item < N_BS) {
      const int b = item >> 2, hh = item & 3;
      const long tok0 = NTOKP + b * ST;
      it.q0 = BQ + tok0 * 512 + hh * 128; it.q1 = it.q0;
      it.kf = p.cbk + (long)b * PAST * 512 + hh * 128; it.vf = p.cbv + (long)b * PAST * 512 + hh * 128; it.ncache = PAST / 64;
      it.kn = p.out + O_BKS + (long)b * ST * 512 + hh * 128; it.vn = p.out + O_BVS + (long)b * ST * 512 + hh * 128;
      it.qs = 512; it.ks = 512; it.ntiles = 17; it.nkeys = PAST + ST;
      it.tlo0 = 0; it.thi0 = 17; it.tlo1 = 0; it.thi1 = 0; it.rows0 = ST; it.rows1 = 0;
      it.g0 = G + tok0 * 1024 + 256 + hh * 128; it.g1 = it.g0;
      attn_item<true, false, true, true>(it, lam, p.subg);
      continue;
    }
    item -= N_BS;
    if (item < N_AP) {
      const int j = 63 - (item >> 3), bh = item & 7, b = bh >> 1, hp = bh & 1;
      const int c0 = 2 * j, c1 = c0 + 1, cs0 = c0 > 8 ? c0 - 8 : 0, cs1 = c1 > 8 ? c1 - 8 : 0;
      const long tok0 = (long)b * SEQ + c0 * 64, k0 = (long)b * SEQ + cs0 * 64;
      it.q0 = AQ + tok0 * 256 + hp * 128; it.q1 = it.q0 + 64 * 256;
      it.k = AK + k0 * 256 + hp * 128; it.v = AV + k0 * 256 + hp * 128;
      it.qs = 256; it.ks = 256; it.ntiles = c1 - cs0 + 1; it.nkeys = it.ntiles * 64;
      it.tlo0 = 0; it.thi0 = c0 - cs0 + 1; it.tlo1 = cs1 - cs0; it.thi1 = it.ntiles;
      it.g0 = G + tok0 * 1024 + hp * 128; it.g1 = it.g0 + 64 * 1024;
      it.bias = true; it.qpos0 = c0 * 64; it.qpos1 = c1 * 64; it.kpos0 = cs0 * 64; it.head0 = hp * 2;
    } else if ((item -= N_AP) < N_AS) {
      const int b = item >> 1, hp = item & 1;
      const long tok0 = NTOKP + b * ST;
      it.q0 = AQ + tok0 * 256 + hp * 128; it.q1 = it.q0;
      it.kf = p.cak + (long)b * RA * 256 + hp * 128; it.vf = p.cav + (long)b * RA * 256 + hp * 128; it.ncache = RA / 64;
      it.kn = p.out + O_AKS + (long)b * ST * 256 + hp * 128; it.vn = p.out + O_AVS + (long)b * ST * 256 + hp * 128;
      it.qs = 256; it.ks = 256; it.ntiles = 9; it.nkeys = RA + ST;
      it.tlo0 = 0; it.thi0 = 9; it.tlo1 = 0; it.thi1 = 0; it.rows0 = ST; it.rows1 = 0;
      it.g0 = G + tok0 * 1024 + hp * 128; it.g1 = it.g0;
      it.bias = true; it.qpos0 = RA; it.qpos1 = RA; it.kpos0 = 0; it.head0 = hp * 2;
    } else if ((item -= N_AS) < N_MP) {
      const int j = item >> 3, bh = item & 7, b = bh >> 1, hp = bh & 1;
      const long tok0 = (long)b * SEQ + j * 128;
      it.q0 = MQ + tok0 * 256 + hp * 128; it.q1 = it.q0 + 64 * 256;
      it.k = MK + (long)b * NMEM * 256 + hp * 128; it.v = MV + (long)b * NMEM * 256 + hp * 128;
      it.qs = 256; it.ks = 256; it.ntiles = 4; it.nkeys = NMEM;
      it.tlo0 = 0; it.thi0 = 4; it.tlo1 = 0; it.thi1 = 4;
      it.g0 = G + tok0 * 1024 + 768 + hp * 128; it.g1 = it.g0 + 64 * 1024;
    } else {
      item -= N_MP;
      const int b = item >> 1, hp = item & 1;
      const long tok0 = NTOKP + b * ST;
      it.q0 = MQ + tok0 * 256 + hp * 128; it.q1 = it.q0;
      it.kf = p.cmk + (long)b * NMEM * 256 + hp * 128; it.vf = p.cmv + (long)b * NMEM * 256 + hp * 128; it.ncache = NMEM / 64;
      it.kn = it.kf; it.vn = it.vf;
      it.qs = 256; it.ks = 256; it.ntiles = 4; it.nkeys = NMEM;
      it.tlo0 = 0; it.thi0 = 4; it.tlo1 = 0; it.thi1 = 0; it.rows0 = ST; it.rows1 = 0;
      it.g0 = G + tok0 * 1024 + 768 + hp * 128; it.g1 = it.g0;
    }
    const bool f32src = it.kf != nullptr;
    if (it.bias) { if (f32src) attn_item<false, true, true, true>(it, lam, p.subg); else attn_item<false, true, false, false>(it, lam, p.subg); }
    else { if (f32src) attn_item<false, false, false, true>(it, lam, p.subg); else attn_item<false, false, false, false>(it, lam, p.subg); }
  }
}

DI void phase3(const Params& p) {
  pg8::Gemm g; g.A = (const bf16_t*)(p.ws + WS_G); g.Bt = (const bf16_t*)(p.ws + WS_WOUTT); g.M = NTOK; g.N = 1024; g.K = 1024;
  pg8::StaticOrder S; S.init(NTOK, 1024, (int)gridDim.x, (int)blockIdx.x);
  EpiOut E; E.ypre = (bf16_t*)(p.ws + WS_XB); E.xp = p.xp; E.xs = p.xs;
  pg8::gemm_phase<EpiOut, pg8::StaticOrder, false>((PG8_LAS unsigned char*)g_lds_all, g, S, E, nullptr);
  __syncthreads();
}

DI void phase4(const Params& p) {
  const int lane = threadIdx.x & 63, w = threadIdx.x >> 6;
  float4 g[4], bb[4];
#pragma unroll
  for (int j = 0; j < 4; ++j) { g[j] = *(const float4*)(p.ln_g + j * 256 + lane * 4); bb[j] = *(const float4*)(p.ln_b + j * 256 + lane * 4); }
  for (int row0 = (blockIdx.x * 8 + w) * 4; row0 < NTOK; row0 += gridDim.x * 32) {
    float4 v[4][4];
#pragma unroll
    for (int rr = 0; rr < 4; ++rr)
#pragma unroll
      for (int j = 0; j < 4; ++j) { const u32x2 w = __builtin_nontemporal_load((const u32x2*)((const bf16_t*)(p.ws + WS_XB) + (long)(row0 + rr) * 1024 + j * 256 + lane * 4)); v[rr][j] = make_float4(bflo(w.x), bfhi(w.x), bflo(w.y), bfhi(w.y)); }
    float s[4], q[4];
#pragma unroll
    for (int rr = 0; rr < 4; ++rr) { s[rr] = 0.f;
#pragma unroll
      for (int j = 0; j < 4; ++j) s[rr] += v[rr][j].x + v[rr][j].y + v[rr][j].z + v[rr][j].w; }
#pragma unroll
    for (int o = 1; o < 64; o <<= 1)
#pragma unroll
      for (int rr = 0; rr < 4; ++rr) s[rr] += __shfl_xor(s[rr], o);
#pragma unroll
    for (int rr = 0; rr < 4; ++rr) { const float mu = s[rr] * (1.f / 1024.f); s[rr] = mu; q[rr] = 0.f;
#pragma unroll
      for (int j = 0; j < 4; ++j) { const float a = v[rr][j].x - mu, b = v[rr][j].y - mu, c = v[rr][j].z - mu, d = v[rr][j].w - mu; q[rr] += a * a + b * b + c * c + d * d; } }
#pragma unroll
    for (int o = 1; o < 64; o <<= 1)
#pragma unroll
      for (int rr = 0; rr < 4; ++rr) q[rr] += __shfl_xor(q[rr], o);
#pragma unroll
    for (int rr = 0; rr < 4; ++rr) {
      const float mu = s[rr], rs = rsqrtf(q[rr] * (1.f / 1024.f) + 1e-5f);
#pragma unroll
      for (int j = 0; j < 4; ++j) {
        float4 o;
        o.x = (v[rr][j].x - mu) * rs * g[j].x + bb[j].x; o.y = (v[rr][j].y - mu) * rs * g[j].y + bb[j].y;
        o.z = (v[rr][j].z - mu) * rs * g[j].z + bb[j].z; o.w = (v[rr][j].w - mu) * rs * g[j].w + bb[j].w;
        { const pg8::f32x4 ov = {o.x, o.y, o.z, o.w}; __builtin_nontemporal_store(ov, (pg8::f32x4*)(p.out + O_Y + (long)(row0 + rr) * 1024 + j * 256 + lane * 4)); }
      }
    }
  }
}

DI void grid_barrier(unsigned* bar, unsigned target) {
  asm volatile("s_waitcnt vmcnt(0) lgkmcnt(0)" ::: "memory");
  __syncthreads();
  if (threadIdx.x == 0) {
    __builtin_amdgcn_fence(__ATOMIC_RELEASE, "agent");
    asm volatile("s_waitcnt vmcnt(0)" ::: "memory");
    __hip_atomic_fetch_add(bar, 1u, __ATOMIC_RELAXED, __HIP_MEMORY_SCOPE_AGENT);
    while (__hip_atomic_load(bar, __ATOMIC_RELAXED, __HIP_MEMORY_SCOPE_AGENT) < target) __builtin_amdgcn_s_sleep(2);
    __builtin_amdgcn_fence(__ATOMIC_ACQUIRE, "agent");
    asm volatile("s_waitcnt vmcnt(0)" ::: "memory");
  }
  __syncthreads();
}
__global__ void __launch_bounds__(512) fwd_megakernel(Params p) {
  cg::grid_group grid = cg::this_grid();
  unsigned* bar = (unsigned*)(p.ws + WS_CTR + 64);
  const unsigned nb = gridDim.x;
  phase0(p);
  if (p.ws == nullptr) grid.sync();
  grid_barrier(bar, nb);
  phase1(p);
  grid_barrier(bar, 2 * nb);
  phase2(p);
  grid_barrier(bar, 3 * nb);
  phase3(p);
  grid_barrier(bar, 4 * nb);
  phase4(p);
}

extern "C" void kernel_launch(void* const* d_in, const int* in_sizes, int n_in, void* d_out, int out_size,
                              void* d_ws, size_t ws_size, hipStream_t stream) {
  static int grid_blocks = 0;
  if (!grid_blocks) {
    int dev = 0, cus = 0, per_cu = 0;
    (void)hipGetDevice(&dev);
    (void)hipDeviceGetAttribute(&cus, hipDeviceAttributeMultiprocessorCount, dev);
    (void)hipOccupancyMaxActiveBlocksPerMultiprocessor(&per_cu, fwd_megakernel, 512, 0);
    if (per_cu > 1) per_cu = 1;
    if (per_cu < 1) per_cu = 1;
    grid_blocks = cus * per_cu;
    if (ws_size < WS_END || out_size != (int)O_END) fprintf(stderr, "kernel_launch: unexpected sizes ws %zu (need %zu) out %d (need %ld)\n", ws_size, (size_t)WS_END, out_size, (long)O_END);
  }
  (void)hipMemsetAsync((char*)d_ws + WS_CTR, 0, 256, stream);
  Params p{};
  p.xp = (const float*)d_in[0]; p.xs = (const float*)d_in[1];
  p.cak = (const float*)d_in[2]; p.cav = (const float*)d_in[3]; p.cbk = (const float*)d_in[4]; p.cbv = (const float*)d_in[5];
  p.cmk = (const float*)d_in[6]; p.cmv = (const float*)d_in[7];
  p.memp = (const float*)d_in[8]; p.w_in = (const float*)d_in[9]; p.w_mem = (const float*)d_in[10]; p.relb = (const float*)d_in[11];
  p.dlam = (const float*)d_in[12]; p.subg = (const float*)d_in[13]; p.w_out = (const float*)d_in[14]; p.ln_g = (const float*)d_in[15]; p.ln_b = (const float*)d_in[16];
  p.out = (float*)d_out; p.ws = (char*)d_ws;
  void* args[] = {&p};
  hipError_t e = hipLaunchCooperativeKernel((void*)fwd_megakernel, dim3(grid_blocks), dim3(512), args, 0, stream);
  if (e != hipSuccess) fprintf(stderr, "cooperative launch failed: %s (grid %d)\n", hipGetErrorString(e), grid_blocks);
}
```

```cpp
#include <hip/hip_runtime.h>
#include <hip/hip_cooperative_groups.h>
#include <cstdio>
#include <cstdint>
namespace cg = cooperative_groups;

typedef unsigned short bf16_t;
typedef short bf16x8 __attribute__((ext_vector_type(8)));
typedef short s16x4 __attribute__((ext_vector_type(4)));
typedef float f32x16 __attribute__((ext_vector_type(16)));
typedef float f32x2_t __attribute__((ext_vector_type(2)));
typedef __bf16 bf16x2_t __attribute__((ext_vector_type(2)));
typedef unsigned u32x2 __attribute__((ext_vector_type(2)));
typedef unsigned u32x4 __attribute__((ext_vector_type(4)));
typedef float f32x4g __attribute__((ext_vector_type(4)));
#define DI __device__ __forceinline__
#define MFMA32(a, b, c) __builtin_amdgcn_mfma_f32_32x32x16_bf16((a), (b), (c), 0, 0, 0)
#define LDS3 __attribute__((address_space(3)))

constexpr int D_MODEL = 1024, SEQ = 8192, NB = 4, NTOKP = NB * SEQ, SB = 32, ST = 16, NTOKS = SB * ST, NTOK = NTOKP + NTOKS;
constexpr int PAST = 1024, RA = 512, NMEM = 256, PROJ = 3584;
constexpr int SAK_ROWS = 576, SBK_ROWS = 1088;
constexpr int NTOKPAD = NTOK + 64;
constexpr float QSCALE = 0.125f * 1.4426950408889634f;
constexpr float LOG2E = 1.4426950408889634f;
constexpr float ALPHA = 1.189207115002721f;

constexpr long O_Y = 0;
constexpr long O_AKP = (long)NTOK * 1024;
constexpr long O_AVP = O_AKP + (long)NB * RA * 256;
constexpr long O_BKP = O_AVP + (long)NB * RA * 256;
constexpr long O_BVP = O_BKP + (long)NTOKP * 512;
constexpr long O_MKP = O_BVP + (long)NTOKP * 512;
constexpr long O_MVP = O_MKP + (long)NB * NMEM * 256;
constexpr long O_AKS = O_MVP + (long)NB * NMEM * 256;
constexpr long O_AVS = O_AKS + (long)NTOKS * 256;
constexpr long O_BKS = O_AVS + (long)NTOKS * 256;
constexpr long O_BVS = O_BKS + (long)NTOKS * 512;
constexpr long O_END = O_BVS + (long)NTOKS * 512;

constexpr size_t WS_CTR = 0;
constexpr size_t WS_WINT = 256;
constexpr size_t WS_WOUTT = WS_WINT + (size_t)PROJ * 1024 * 2;
constexpr size_t WS_WMEMT = WS_WOUTT + (size_t)1024 * 1024 * 2;
constexpr size_t WS_ROPE = WS_WMEMT + (size_t)512 * 1024 * 2;
constexpr size_t OB_AQ = 0;
constexpr size_t OB_BQ = OB_AQ + (size_t)NTOKPAD * 256 * 2;
constexpr size_t OB_MQ = OB_BQ + (size_t)NTOKPAD * 512 * 2;
constexpr size_t OB_AK = OB_MQ + (size_t)NTOKPAD * 256 * 2;
constexpr size_t OB_AV = OB_AK + (size_t)NTOKP * 256 * 2;
constexpr size_t OB_BK = OB_AV + (size_t)NTOKP * 256 * 2;
constexpr size_t OB_END = OB_BK + (size_t)NTOKP * 512 * 2;
static_assert(OB_END <= (size_t)NTOK * 1024 * 4, "temporaries must fit in the y region");
constexpr size_t WS_BV = WS_ROPE + (size_t)SEQ * 32 * 8;
constexpr size_t WS_G = WS_BV + (size_t)NTOKP * 512 * 2;
constexpr size_t WS_MK = WS_G + (size_t)NTOK * 1024 * 2;
constexpr size_t WS_MV = WS_MK + (size_t)NB * NMEM * 256 * 2;
constexpr size_t WS_SAK = WS_MV + (size_t)NB * NMEM * 256 * 2;
constexpr size_t WS_SAV = WS_SAK + (size_t)SB * SAK_ROWS * 256 * 2;
constexpr size_t WS_SBK = WS_SAV + (size_t)SB * SAK_ROWS * 256 * 2;
constexpr size_t WS_SBV = WS_SBK + (size_t)SB * SBK_ROWS * 512 * 2;
constexpr size_t WS_SMK = WS_SBV + (size_t)SB * SBK_ROWS * 512 * 2;
constexpr size_t WS_SMV = WS_SMK + (size_t)SB * NMEM * 256 * 2;
constexpr size_t WS_XB = WS_SMV + (size_t)SB * NMEM * 256 * 2;
constexpr size_t WS_MB = WS_XB + (size_t)NTOK * 1024 * 2;
constexpr size_t WS_END = WS_MB + (size_t)NB * NMEM * 1024 * 2;
static_assert(WS_END <= (size_t)512 * 1024 * 1024, "workspace budget");

struct Params {
  const float* xp; const float* xs;
  const float* cak; const float* cav; const float* cbk; const float* cbv; const float* cmk; const float* cmv;
  const float* memp; const float* w_in; const float* w_mem; const float* relb; const float* dlam; const float* subg;
  const float* w_out; const float* ln_g; const float* ln_b;
  float* out; char* ws;
};

constexpr int TEAM_LDS = 73728 + 64;
constexpr int LDS_BYTES = 2 * TEAM_LDS + 64;
__shared__ __attribute__((aligned(16))) char g_lds_all[LDS_BYTES];
#define TEAM (__builtin_amdgcn_readfirstlane((int)(threadIdx.x >> 8)))
#define g_lds (g_lds_all + TEAM * TEAM_LDS)

DI unsigned cvtpk(float lo, float hi) { f32x2_t v = {lo, hi}; bf16x2_t b = __builtin_convertvector(v, bf16x2_t); return __builtin_bit_cast(unsigned, b); }
DI bf16_t f2bf(float x) { return (bf16_t)(cvtpk(x, 0.f) & 0xffffu); }
DI float bf2f(unsigned short b) { return __uint_as_float(((unsigned)b) << 16); }
DI float bflo(unsigned u) { return __uint_as_float(u << 16); }
DI float bfhi(unsigned u) { return __uint_as_float(u & 0xffff0000u); }
DI float fexp2(float x) { return __builtin_amdgcn_exp2f(x); }
DI float xor32f(float v) { return __shfl_xor(v, 32); }

template <bool SWAP45>
DI void transpose_tile(const float* __restrict__ src, int N, bf16_t* __restrict__ dst, int K, int k0, int n0) {
  float* tile = (float*)g_lds;
  const int tid = threadIdx.x & 255, c = tid & 63, r0 = tid >> 6;
#pragma unroll
  for (int i = 0; i < 16; ++i) { const int row = r0 + 4 * i; tile[row * 65 + c] = src[(long)(k0 + row) * N + n0 + c]; }
  __syncthreads();
#pragma unroll
  for (int i = 0; i < 16; ++i) { const int rr = r0 + 4 * i; const int pr = SWAP45 ? ((rr & 15) | ((rr & 16) << 1) | ((rr & 32) >> 1)) : rr; dst[(long)(n0 + pr) * K + k0 + c] = f2bf(tile[c * 65 + rr]); }
  __syncthreads();
}

DI void convert_rows(const float* __restrict__ src, bf16_t* __restrict__ dst, int rows_w8, int dst_bstride_w8, long gtid, long gsz) {
  const long total = (long)SB * rows_w8;
  for (long u = gtid; u < total; u += gsz) {
    const int b = (int)(u / rows_w8); const int j = (int)(u - (long)b * rows_w8);
    const float4 a0 = *(const float4*)(src + u * 8), a1 = *(const float4*)(src + u * 8 + 4);
    u32x4 v; v.x = cvtpk(a0.x, a0.y); v.y = cvtpk(a0.z, a0.w); v.z = cvtpk(a1.x, a1.y); v.w = cvtpk(a1.z, a1.w);
    *(u32x4*)(dst + ((long)b * dst_bstride_w8 + j) * 8) = v;
  }
}

DI void phase0(const Params& p) {
  bf16_t* winT = (bf16_t*)(p.ws + WS_WINT); bf16_t* woutT = (bf16_t*)(p.ws + WS_WOUTT); bf16_t* wmemT = (bf16_t*)(p.ws + WS_WMEMT);
  constexpr int T_IN = 16 * 56, T_OUT = 16 * 16, T_MEM = 16 * 8;
  for (int t = blockIdx.x * 2 + TEAM; t < T_IN + T_OUT + T_MEM; t += gridDim.x * 2) {
    if (t < T_IN) transpose_tile<true>(p.w_in, PROJ, winT, 1024, (t / 56) * 64, (t % 56) * 64);
    else if (t < T_IN + T_OUT) { const int u = t - T_IN; transpose_tile<false>(p.w_out, 1024, woutT, 1024, (u >> 4) * 64, (u & 15) * 64); }
    else { const int u = t - T_IN - T_OUT; transpose_tile<false>(p.w_mem, 512, wmemT, 1024, (u >> 3) * 64, (u & 7) * 64); }
  }
  float2* rope = (float2*)(p.ws + WS_ROPE);
  for (int idx = blockIdx.x * 512 + threadIdx.x; idx < SEQ * 32; idx += gridDim.x * 512) {
    const int pos = idx >> 5, i = idx & 31;
    const double inv = exp(-(double)i * (9.210340371976184 / 32.0));
    const double rev = (double)pos * inv * 0.15915494309189535;
    const double fr = rev - rint(rev);
    const float a = (float)(fr * 6.283185307179586);
    rope[idx] = make_float2(cosf(a), sinf(a));
  }
  const int G = gridDim.x;
  const long gtid = (long)blockIdx.x * 512 + threadIdx.x, gsz = (long)G * 512;
  {
    bf16_t* XB = (bf16_t*)(p.ws + WS_XB); bf16_t* MB = (bf16_t*)(p.ws + WS_MB);
    const long nxp = (long)NTOKP * 1024 / 8, nxs = (long)NTOKS * 1024 / 8, nmb = (long)NB * NMEM * 1024 / 8;
#pragma unroll 4
    for (long u = gtid; u < nxp + nxs + nmb; u += gsz) {
      const float* src; bf16_t* dst;
      if (u < nxp) { src = p.xp + u * 8; dst = XB + u * 8; }
      else if (u < nxp + nxs) { src = p.xs + (u - nxp) * 8; dst = XB + u * 8; }
      else { src = p.memp + (u - nxp - nxs) * 8; dst = MB + (u - nxp - nxs) * 8; }
      const f32x4g a0 = __builtin_nontemporal_load((const f32x4g*)(src)), a1 = __builtin_nontemporal_load((const f32x4g*)(src + 4));
      u32x4 v; v.x = cvtpk(a0[0], a0[1]); v.y = cvtpk(a0[2], a0[3]); v.z = cvtpk(a1[0], a1[1]); v.w = cvtpk(a1[2], a1[3]);
      *(u32x4*)dst = v;
    }
  }
}

constexpr int G_RS = 144, GA_BYTES = 128 * G_RS, GB_BYTES = 256 * G_RS, G_STAGE = GA_BYTES + GB_BYTES;
DI void gemm_core(const bf16_t* __restrict__ Ap, int lda, const bf16_t* __restrict__ Bp, int ldb, int K, f32x16 (&acc)[2][2]) {
  const int tid = threadIdx.x, lane = tid & 63, w = tid >> 6, wm = w >> 2, wn = w & 3, r = lane & 31, h = lane >> 5;
#pragma unroll
  for (int a = 0; a < 2; ++a)
#pragma unroll
    for (int b = 0; b < 2; ++b)
#pragma unroll
      for (int i = 0; i < 16; ++i) acc[a][b][i] = 0.f;
  u32x4 ra0[2], rb0[4], ra1[2], rb1[4];
  const int lrow = tid >> 3, lch = tid & 7;
  const bf16_t* Ag = Ap + (long)lrow * lda + lch * 8;
  const bf16_t* Bg = Bp + (long)lrow * ldb + lch * 8;
#define G_LOAD(RA, RB, kt)                                                                                      \
  {                                                                                                             \
    _Pragma("unroll") for (int i = 0; i < 2; ++i) RA[i] = *(const u32x4*)(Ag + (long)(64 * i) * lda + (kt) * 64); \
    _Pragma("unroll") for (int i = 0; i < 4; ++i) RB[i] = *(const u32x4*)(Bg + (long)(64 * i) * ldb + (kt) * 64); \
  }
#define G_WRITE(RA, RB, buf)                                                                                    \
  {                                                                                                             \
    char* Ab_ = g_lds_all + (buf) * G_STAGE; char* Bb_ = Ab_ + GA_BYTES;                                        \
    _Pragma("unroll") for (int i = 0; i < 2; ++i) *(u32x4*)(Ab_ + (lrow + 64 * i) * G_RS + lch * 16) = RA[i];   \
    _Pragma("unroll") for (int i = 0; i < 4; ++i) *(u32x4*)(Bb_ + (lrow + 64 * i) * G_RS + lch * 16) = RB[i];   \
  }
#define G_COMPUTE(buf)                                                                                          \
  {                                                                                                             \
    const char* Ab = g_lds_all + (buf) * G_STAGE; const char* Bb = Ab + GA_BYTES;                               \
    _Pragma("unroll") for (int s = 0; s < 4; ++s) {                                                             \
      const int co = (16 * s + 8 * h) * 2;                                                                      \
      const bf16x8 a0 = *(const bf16x8*)(Ab + (wm * 64 + r) * G_RS + co);                                       \
      const bf16x8 a1 = *(const bf16x8*)(Ab + (wm * 64 + 32 + r) * G_RS + co);                                  \
      const bf16x8 b0 = *(const bf16x8*)(Bb + (wn * 64 + r) * G_RS + co);                                       \
      const bf16x8 b1 = *(const bf16x8*)(Bb + (wn * 64 + 32 + r) * G_RS + co);                                  \
      acc[0][0] = MFMA32(a0, b0, acc[0][0]);                                                                    \
      acc[0][1] = MFMA32(a0, b1, acc[0][1]);                                                                    \
      acc[1][0] = MFMA32(a1, b0, acc[1][0]);                                                                    \
      acc[1][1] = MFMA32(a1, b1, acc[1][1]);                                                                    \
    }                                                                                                           \
  }
  const int nk = K >> 6;
  G_LOAD(ra0, rb0, 0);
  G_LOAD(ra1, rb1, 1);
  G_WRITE(ra0, rb0, 0);
  __syncthreads();
  for (int kt = 0; kt < nk; kt += 2) {
    if (kt + 2 < nk) G_LOAD(ra0, rb0, kt + 2);
    G_COMPUTE(0);
    G_WRITE(ra1, rb1, 1);
    __syncthreads();
    if (kt + 3 < nk) G_LOAD(ra1, rb1, kt + 3);
    G_COMPUTE(1);
    if (kt + 2 < nk) G_WRITE(ra0, rb0, 0);
    __syncthreads();
  }
#undef G_COMPUTE
#undef G_LOAD
#undef G_WRITE
}

namespace pg8 {
#define PG8_LAS __attribute__((address_space(3)))
typedef unsigned short bf16_t;
typedef short bf16x8 __attribute__((ext_vector_type(8)));
typedef float f32x4 __attribute__((ext_vector_type(4)));
typedef unsigned u32x4 __attribute__((ext_vector_type(4)));
constexpr int BM = 256, BK = 64, HALF = 128, HTB = HALF * BK * 2  , STAGE_BYTES = 8 * HTB, NXCD = 8, WGM = 8;

__host__ __device__ __forceinline__ int lds_byte(int r, int c) { const int st = (r >> 4) * 2 + (c >> 5), rr = r & 15, cc = c & 31, ob = rr * 64 + cc * 2; return st * 1024 + (ob ^ (((ob >> 9) & 1) << 5)); }
__host__ __device__ __forceinline__ void stage_rc(int b, int& R, int& C) { const int st = b / 1024, sb = b % 1024, swz = sb ^ (((sb >> 9) & 1) << 5); R = (st >> 1) * 16 + swz / 64; C = (st & 1) * 32 + (swz % 64) / 2; }
__host__ __device__ __forceinline__ int perm32(int rho) { const int n = rho >> 4, i = rho & 15; return 8 * (i >> 2) + 4 * n + (i & 3); }

struct Unit { int pm, pn; };
struct Gemm { const bf16_t* A; const bf16_t* Bt; int M, N, K; };

struct StaticOrder {
    int nM, nN, nwg, G, c;
    __host__ __device__ void init(int M, int N, int G_, int c_) { nM = M / BM; nN = N / BM; nwg = nM * nN; G = G_; c = c_; }
    __host__ __device__ bool next(int i, Unit& u) const {
        const long L = (long)i * G + c; if (L >= nwg) return false;
        int wgid = (int)L; { const int q = nwg / NXCD, r = nwg % NXCD, xcd = wgid % NXCD, off = wgid / NXCD; wgid = (xcd < r ? xcd * (q + 1) : r * (q + 1) + (xcd - r) * q) + off; }
        const int nig = WGM * nN, gid = wgid / nig, fm = gid * WGM, gsz = (nM - fm) < WGM ? (nM - fm) : WGM;
        u.pm = fm + ((wgid % nig) % gsz); u.pn = (wgid % nig) / gsz; return true;
    }
    __device__ __forceinline__ void a_ready(const Unit&) const {}
    __device__ __forceinline__ void done(const Unit&) const {}
};
template <class Epi, class Sched, bool STAMP = false>
__device__ __forceinline__ void gemm_phase(PG8_LAS unsigned char* lds, const Gemm g, const Sched& S, const Epi& E, unsigned long long* stamps) {
    const int tid = threadIdx.x, wid = __builtin_amdgcn_readfirstlane(tid >> 6), lane = tid & 63, wr = wid >> 2, wc = wid & 3, fr = lane & 15, fq = lane >> 4;
    const int K = g.K, nt = K / BK;
    int ts_lo = 0, ts_hi = 0, nts = 0; const unsigned long long rt_entry = STAMP ? (unsigned long long)wall_clock64() : 0ull;
#define PG8_STAMP() do { if (STAMP && wid == 0 && nts < 64) { const unsigned long long _c = (unsigned long long)clock64(); \
        ts_lo = (lane == nts) ? (int)(unsigned)_c : ts_lo; ts_hi = (lane == nts) ? (int)(unsigned)(_c >> 32) : ts_hi; ++nts; } } while (0)
    PG8_STAMP();
    unsigned voffA[2], voffB[2];
#pragma unroll
    for (int i = 0; i < 2; ++i) { int R, C; stage_rc(tid * 16 + i * 8192, R, C); const int Rb = Epi::PERM ? ((R & ~31) + perm32(R & 31)) : R;
        voffA[i] = (unsigned)(R * K + C) * 2u; voffB[i] = (unsigned)(Rb * K + C) * 2u; }
    const size_t kstep = (size_t)(BK * 2);
    const size_t hstep = (size_t)HALF * K * 2;
    const size_t tstep = 2 * hstep;
    const unsigned ldsw = (unsigned)wid * 1024u;
    const int aoff = lds_byte(wr * 64 + fr, fq * 8), boff = lds_byte(wc * 32 + fr, fq * 8);
#define PG8_SA(b, h) (((b) * 2 + (h)) * HTB)
#define PG8_SB(b, h) ((4 + (b) * 2 + (h)) * HTB)
#define PG8_STAGE(bufoff, gbase, voff) do { _Pragma("unroll") for (int _i = 0; _i < 2; ++_i) \
        __builtin_amdgcn_global_load_lds((const unsigned*)((const char*)(gbase) + (voff)[_i]), (PG8_LAS unsigned*)(lds + (bufoff) + ldsw + _i * 8192), 16, 0, 0); } while (0)
#define PG8_LDA(dst, b, h) do { _Pragma("unroll") for (int m = 0; m < 4; ++m) _Pragma("unroll") for (int k = 0; k < 2; ++k) dst[m][k] = *(const PG8_LAS bf16x8*)(lds + PG8_SA(b, h) + aoff + m * 2048 + k * 1024); } while (0)
#define PG8_LDB(dst, b, h) do { _Pragma("unroll") for (int n = 0; n < 2; ++n) _Pragma("unroll") for (int k = 0; k < 2; ++k) dst[n][k] = *(const PG8_LAS bf16x8*)(lds + PG8_SB(b, h) + boff + n * 2048 + k * 1024); } while (0)
#define PG8_MMA(ai, bj, At, Bt) do { __builtin_amdgcn_s_setprio(1); _Pragma("unroll") for (int m = 0; m < 4; ++m) _Pragma("unroll") for (int n = 0; n < 2; ++n) _Pragma("unroll") for (int k = 0; k < 2; ++k) \
        acc[ai][bj][m][n] = __builtin_amdgcn_mfma_f32_16x16x32_bf16(Bt[n][k], At[m][k], acc[ai][bj][m][n], 0, 0, 0); __builtin_amdgcn_s_setprio(0); } while (0)
#define PG8_WAIT_V(n) asm volatile("s_waitcnt vmcnt(" #n ")" ::: "memory")
#define PG8_WAIT_L(n) asm volatile("s_waitcnt lgkmcnt(" #n ")" ::: "memory")
#define PG8_BAR __builtin_amdgcn_s_barrier()
#define PG8_SCHED __builtin_amdgcn_sched_barrier(0)
    Unit cur, nxt; int ui = 0;
    if (!S.next(0, cur)) return;
    f32x4 acc[2][2][4][2];
#pragma unroll
    for (int a = 0; a < 2; ++a)
#pragma unroll
        for (int b = 0; b < 2; ++b)
#pragma unroll
            for (int m = 0; m < 4; ++m)
#pragma unroll
                for (int n = 0; n < 2; ++n) acc[a][b][m][n] = (f32x4){0.f, 0.f, 0.f, 0.f};
    bf16x8 At[4][2], B0[2][2], B1[2][2];
    const char* cA = (const char*)g.A + (size_t)cur.pm * tstep; const char* cB = (const char*)g.Bt + (size_t)cur.pn * tstep;
    S.a_ready(cur);
    PG8_STAGE(PG8_SB(0, 0), cB, voffB); PG8_STAGE(PG8_SA(0, 0), cA, voffA); PG8_STAGE(PG8_SB(0, 1), cB + hstep, voffB); PG8_STAGE(PG8_SA(0, 1), cA + hstep, voffA);
    if (wr == 1) PG8_BAR;
    PG8_WAIT_V(4); PG8_BAR;
    PG8_STAGE(PG8_SB(1, 0), cB + kstep, voffB); PG8_STAGE(PG8_SA(1, 0), cA + kstep, voffA); PG8_STAGE(PG8_SB(1, 1), cB + hstep + kstep, voffB);
    PG8_WAIT_V(6); PG8_BAR;
    PG8_STAMP();
    for (;;) {
        const bool has_next = S.next(ui + 1, nxt);
        const char* nA = has_next ? (const char*)g.A + (size_t)nxt.pm * tstep : cA; const char* nB = has_next ? (const char*)g.Bt + (size_t)nxt.pn * tstep : cB;
        for (int t = 0; t < nt; t += 2) {
            const bool last = (t == nt - 2);
            const char* a1 = cA + (size_t)(t + 1) * kstep;
            const char* a2 = last ? nA : cA + (size_t)(t + 2) * kstep; const char* b2 = last ? nB : cB + (size_t)(t + 2) * kstep;
            const char* a3 = a2 + kstep; const char* b3 = b2 + kstep;
            if (last && has_next) S.a_ready(nxt);
            PG8_LDB(B0, 0, 0); PG8_SCHED; PG8_LDA(At, 0, 0); PG8_STAGE(PG8_SA(1, 1), a1 + hstep, voffA);
            PG8_WAIT_L(8); PG8_BAR; PG8_WAIT_L(0); PG8_MMA(0, 0, At, B0); PG8_BAR; PG8_SCHED;
            PG8_LDB(B1, 0, 1); PG8_STAGE(PG8_SB(0, 0), b2, voffB);
            PG8_BAR; PG8_WAIT_L(0); PG8_MMA(0, 1, At, B1); PG8_BAR;
            PG8_LDA(At, 0, 1); PG8_STAGE(PG8_SA(0, 0), a2, voffA);
            PG8_BAR; PG8_WAIT_L(0); PG8_MMA(1, 0, At, B0); PG8_BAR; PG8_SCHED;
            PG8_STAGE(PG8_SB(0, 1), b2 + hstep, voffB);
            PG8_WAIT_V(6); PG8_BAR; PG8_MMA(1, 1, At, B1); PG8_BAR;
            PG8_LDB(B0, 1, 0); PG8_SCHED; PG8_LDA(At, 1, 0); PG8_STAGE(PG8_SA(0, 1), a2 + hstep, voffA);
            PG8_WAIT_L(8); PG8_BAR; PG8_WAIT_L(0); PG8_MMA(0, 0, At, B0); PG8_BAR; PG8_SCHED;
            PG8_LDB(B1, 1, 1); PG8_STAGE(PG8_SB(1, 0), b3, voffB);
            PG8_BAR; PG8_WAIT_L(0); PG8_MMA(0, 1, At, B1); PG8_BAR;
            PG8_LDA(At, 1, 1); PG8_STAGE(PG8_SA(1, 0), a3, voffA);
            PG8_BAR; PG8_WAIT_L(0); PG8_MMA(1, 0, At, B0); PG8_BAR; PG8_SCHED;
            PG8_STAGE(PG8_SB(1, 1), b3 + hstep, voffB);
            PG8_WAIT_V(6); PG8_BAR; PG8_MMA(1, 1, At, B1); PG8_BAR;
        }
        PG8_STAMP();
        if constexpr (!Epi::AFTER_DRAIN) { E(acc, cur, wr, wc, fr, fq); S.done(cur); }
        PG8_STAMP();
        if (!has_next) break;
#pragma unroll
        for (int a = 0; a < 2; ++a)
#pragma unroll
            for (int b = 0; b < 2; ++b)
#pragma unroll
                for (int m = 0; m < 4; ++m)
#pragma unroll
                    for (int n = 0; n < 2; ++n) acc[a][b][m][n] = (f32x4){0.f, 0.f, 0.f, 0.f};
        cur = nxt; cA = nA; cB = nB; ++ui;
    }
    PG8_WAIT_V(0);
    if (wr == 0) PG8_BAR;
    PG8_BAR;
    if constexpr (Epi::AFTER_DRAIN) { E.fused(acc, cur, wr, wc, fr, fq, lds, wid, lane); S.done(cur); }
    PG8_STAMP();
    if (STAMP && wid == 0) { stamps[lane] = lane < nts ? (((unsigned long long)(unsigned)ts_hi << 32) | (unsigned)ts_lo) : 0ull;
        if (lane == 62) stamps[62] = rt_entry; if (lane == 63) stamps[63] = (unsigned long long)wall_clock64(); }
#undef PG8_STAMP
#undef PG8_SA
#undef PG8_SB
#undef PG8_STAGE
#undef PG8_LDA
#undef PG8_LDB
#undef PG8_MMA
#undef PG8_WAIT_V
#undef PG8_WAIT_L
#undef PG8_BAR
#undef PG8_SCHED
}
}

struct EpiProj {
  static constexpr bool PERM = false, AFTER_DRAIN = false;
  float* out; char* ws;
  __device__ __forceinline__ void operator()(const pg8::f32x4 (&acc)[2][2][4][2], const pg8::Unit& u, int wr, int wc, int fr, int fq) const {
    asm volatile("" : "+v"(fr), "+v"(fq));
    char* ob = (char*)out;
    const int n0 = u.pn * 256;
    int seg, sbase;
    if (n0 < 256) { seg = 0; sbase = 0; } else if (n0 < 512) { seg = 1; sbase = 256; } else if (n0 < 768) { seg = 2; sbase = 512; }
    else if (n0 < 1280) { seg = 3; sbase = 768; } else if (n0 < 1792) { seg = 4; sbase = 1280; } else if (n0 < 2304) { seg = 5; sbase = 1792; }
    else if (n0 < 2560) { seg = 6; sbase = 2304; } else { seg = 7; sbase = 2560; }
    const bool smp = u.pm >= NTOKP / 256;
    const float2* rope = (const float2*)(ws + WS_ROPE);
    const int fi = 16 * (wc & 1) + 4 * fq;
#pragma unroll
    for (int ai = 0; ai < 2; ++ai)
#pragma unroll
      for (int m = 0; m < 4; ++m) {
        const int row = 128 * ai + 64 * wr + 16 * m + fr;
        const unsigned tok = (unsigned)(u.pm * 256 + row);
        const unsigned ts = tok - (unsigned)NTOKP;
        float4 c01, s01, c23, s23;
        if (seg == 3 || seg == 4) {
          const int pos = smp ? (PAST + (int)(ts & 15)) : (int)(tok & (SEQ - 1));
          const float4 r0 = *(const float4*)(rope + pos * 32 + fi), r1 = *(const float4*)(rope + pos * 32 + fi + 2);
          c01 = make_float4(r0.x, r0.z, r1.x, r1.z); s01 = make_float4(r0.y, r0.w, r1.y, r1.w);
        }
#pragma unroll
        for (int bj = 0; bj < 2; ++bj) {
          const int blk = 4 * u.pn + 2 * bj + (wc >> 1);
          const int col = 64 * blk + fi - sbase;
          pg8::f32x4 v0 = acc[ai][bj][m][0], v1 = acc[ai][bj][m][1];
          if (seg == 3 || seg == 4) {
            const pg8::f32x4 cc = {c01.x, c01.y, c01.z, c01.w}, ss = {s01.x, s01.y, s01.z, s01.w};
            const pg8::f32x4 a = v0 * cc - v1 * ss, b = v1 * cc + v0 * ss;
            v0 = a; v1 = b;
          }
          if (seg == 0 || seg == 3 || seg == 6) {
            bf16_t* q = (seg == 0) ? (bf16_t*)(ob + OB_AQ) + tok * 256 : (seg == 3) ? (bf16_t*)(ob + OB_BQ) + tok * 512 : (bf16_t*)(ob + OB_MQ) + tok * 256;
            u32x2 w0, w1; w0.x = cvtpk(v0[0] * QSCALE, v0[1] * QSCALE); w0.y = cvtpk(v0[2] * QSCALE, v0[3] * QSCALE);
            w1.x = cvtpk(v1[0] * QSCALE, v1[1] * QSCALE); w1.y = cvtpk(v1[2] * QSCALE, v1[3] * QSCALE);
            *(u32x2*)(q + col) = w0; *(u32x2*)(q + col + 32) = w1;
          } else if (seg == 7) {
            bf16_t* g = (bf16_t*)(ws + WS_G) + tok * 1024;
            float a[4], b[4];
#pragma unroll
            for (int j = 0; j < 4; ++j) { a[j] = v0[j] * __builtin_amdgcn_rcpf(1.f + __expf(-v0[j])); b[j] = v1[j] * __builtin_amdgcn_rcpf(1.f + __expf(-v1[j])); }
            u32x2 w0, w1; w0.x = cvtpk(a[0], a[1]); w0.y = cvtpk(a[2], a[3]); w1.x = cvtpk(b[0], b[1]); w1.y = cvtpk(b[2], b[3]);
            *(u32x2*)(g + col) = w0; *(u32x2*)(g + col + 32) = w1;
          } else {
            const bool wide = (seg >= 4);
            const int W = wide ? 512 : 256;
            bf16_t* kw; float* o = nullptr;
            if (!smp) {
              if (seg == 1) kw = (bf16_t*)(ob + OB_AK) + tok * 256; else if (seg == 2) kw = (bf16_t*)(ob + OB_AV) + tok * 256;
              else if (seg == 4) kw = (bf16_t*)(ob + OB_BK) + tok * 512; else kw = (bf16_t*)(ws + WS_BV) + tok * 512;
              if (wide) o = out + (seg == 4 ? O_BKP : O_BVP) + tok * 512;
              else { const unsigned ps = tok & (SEQ - 1), pb = tok >> 13; if (ps >= (unsigned)(SEQ - RA)) o = out + (seg == 1 ? O_AKP : O_AVP) + (pb * RA + ps - (SEQ - RA)) * 256u; }
            } else {
              kw = nullptr;
              if (wide) o = out + (seg == 4 ? O_BKS : O_BVS) + ts * 512; else o = out + (seg == 1 ? O_AKS : O_AVS) + ts * 256;
            }
            (void)W;
            u32x2 w0, w1; w0.x = cvtpk(v0[0], v0[1]); w0.y = cvtpk(v0[2], v0[3]); w1.x = cvtpk(v1[0], v1[1]); w1.y = cvtpk(v1[2], v1[3]);
            if (kw) { *(u32x2*)(kw + col) = w0; *(u32x2*)(kw + col + 32) = w1; }
            if (o) { __builtin_nontemporal_store(v0, (pg8::f32x4*)(o + col)); __builtin_nontemporal_store(v1, (pg8::f32x4*)(o + col + 32)); }
          }
        }
      }
  }
};

struct EpiOut {
  static constexpr bool PERM = false, AFTER_DRAIN = false;
  bf16_t* ypre; const float* xp; const float* xs;
  __device__ __forceinline__ void operator()(const pg8::f32x4 (&acc)[2][2][4][2], const pg8::Unit& u, int wr, int wc, int fr, int fq) const {
    asm volatile("" : "+v"(fr), "+v"(fq));
    const float* xb = (u.pm < NTOKP / 256) ? xp + (long)u.pm * 256 * 1024 : xs + (long)(u.pm - NTOKP / 256) * 256 * 1024;
    bf16_t* yb = ypre + (long)u.pm * 256 * 1024;
    const int col0 = u.pn * 256 + wc * 32 + 4 * fq;
#pragma unroll
    for (int ai = 0; ai < 2; ++ai)
#pragma unroll
      for (int mp = 0; mp < 2; ++mp) {
        pg8::f32x4 xv[2][2][2];
#pragma unroll
        for (int mm = 0; mm < 2; ++mm) {
          const unsigned ro = (unsigned)((128 * ai + 64 * wr + 16 * (2 * mp + mm) + fr) * 1024 + col0);
#pragma unroll
          for (int bj = 0; bj < 2; ++bj)
#pragma unroll
            for (int n = 0; n < 2; ++n) xv[mm][bj][n] = __builtin_nontemporal_load((const pg8::f32x4*)(xb + ro + bj * 128 + n * 16));
        }
#pragma unroll
        for (int mm = 0; mm < 2; ++mm) {
          const unsigned ro = (unsigned)((128 * ai + 64 * wr + 16 * (2 * mp + mm) + fr) * 1024 + col0);
#pragma unroll
          for (int bj = 0; bj < 2; ++bj)
#pragma unroll
            for (int n = 0; n < 2; ++n) { const pg8::f32x4 y = acc[ai][bj][2 * mp + mm][n] + ALPHA * xv[mm][bj][n]; u32x2 w; w.x = cvtpk(y[0], y[1]); w.y = cvtpk(y[2], y[3]); *(u32x2*)(yb + ro + bj * 128 + n * 16) = w; }
        }
      }
  }
};

DI void mem_epilogue(const Params& p, int mt, int nt, f32x16 (&acc)[2][2]) {
  const int tid = threadIdx.x, lane = tid & 63, w = tid >> 6, wm = w >> 2, wn = w & 3, c = lane & 31, h = lane >> 5;
  const int n0 = nt * 256 + wn * 64;
  const bool isv = n0 >= 256;
  const int cb = isv ? n0 - 256 : n0;
  bf16_t* kw = (bf16_t*)(p.ws + (isv ? WS_MV : WS_MK));
  float* o = p.out + (isv ? O_MVP : O_MKP);
#pragma unroll
  for (int mi = 0; mi < 2; ++mi)
#pragma unroll
    for (int i = 0; i < 16; ++i) {
      const long row = mt * 128 + wm * 64 + mi * 32 + (i & 3) + 8 * (i >> 2) + 4 * h;
      const float v0 = acc[mi][0][i], v1 = acc[mi][1][i];
      kw[row * 256 + cb + c] = f2bf(v0); kw[row * 256 + cb + c + 32] = f2bf(v1);
      o[row * 256 + cb + c] = v0; o[row * 256 + cb + c + 32] = v1;
    }
}

DI void phase1(const Params& p) {
  const int G = gridDim.x;
  const bf16_t* winT = (const bf16_t*)(p.ws + WS_WINT); const bf16_t* wmemT = (const bf16_t*)(p.ws + WS_WMEMT);
  const bf16_t* XB = (const bf16_t*)(p.ws + WS_XB); const bf16_t* MB = (const bf16_t*)(p.ws + WS_MB);
  {
    pg8::Gemm g; g.A = XB; g.Bt = winT; g.M = NTOK; g.N = PROJ; g.K = 1024;
    pg8::StaticOrder S; S.init(NTOK, PROJ, G, (int)blockIdx.x);
    EpiProj E; E.out = p.out; E.ws = p.ws;
    pg8::gemm_phase<EpiProj, pg8::StaticOrder, false>((PG8_LAS unsigned char*)g_lds_all, g, S, E, nullptr);
  }
  __syncthreads();
  constexpr int T2 = 8 * 2;
  f32x16 acc[2][2];
  for (int t = (int)blockIdx.x - 64; t >= 0 && t < T2; t += G) {
    const int mt = t >> 1, nt = t & 1;
    gemm_core(MB + (long)mt * 128 * 1024, 1024, wmemT + (long)nt * 256 * 1024, 1024, 1024, acc);
    mem_epilogue(p, mt, nt, acc);
  }
}

struct AttnItem {
  const bf16_t* q0; const bf16_t* q1;
  const bf16_t* k; const bf16_t* v;
  bf16_t* g0; bf16_t* g1;
  int qs, ks, ntiles, nkeys;
  int tlo0, thi0, tlo1, thi1;
  int rows0, rows1;
  int qpos0, qpos1, kpos0, head0; bool bias;
  const float* kf; const float* vf;
  const float* kn; const float* vn;
  int ncache;
};
constexpr int AK_RS = 272, AK_BYTES = 64 * AK_RS, AV_BYTES = 16384, A_BUF = AK_BYTES + AV_BYTES;
constexpr int A_BIAS_OFF = 2 * A_BUF;
constexpr int A_ITEM_OFF = 2 * TEAM_LDS;
constexpr int A_Q_OFF = 73728;

template <bool DIFF, bool BIAS, bool MASK, bool F32>
DI void attn_item(const AttnItem& it, float lam, const float* __restrict__ subg) {
  const int tid = threadIdx.x, lane = tid & 63, w = tid >> 6, r = lane & 31, h = lane >> 5;
  const int half = __builtin_amdgcn_readfirstlane(w >> 2), qh = w & 1, m = (w >> 1) & 1;
  constexpr int NDT = DIFF ? 4 : 2;
  const int ntiles = it.ntiles;
  const int tlo = half ? it.tlo1 : it.tlo0, thi = half ? it.thi1 : it.thi0, rows = half ? it.rows1 : it.rows0;
  const bf16_t* qbase = half ? it.q1 : it.q0;
  bf16_t* gbase = half ? it.g1 : it.g0;
  char* qlds = g_lds_all + A_Q_OFF + w * 4096 + lane * 16;
  {
    const bf16_t* qp = qbase + (long)(qh * 32 + r) * it.qs + m * 64 + 8 * h;
#pragma unroll
    for (int s = 0; s < 4; ++s) *(bf16x8*)(qlds + s * 1024) = *(const bf16x8*)(qp + 16 * s);
  }
  f32x16 oacc[NDT];
#pragma unroll
  for (int d = 0; d < NDT; ++d)
#pragma unroll
    for (int i = 0; i < 16; ++i) oacc[d][i] = 0.f;
  float m_run = -1e30f, l_run = 0.f;
  u32x4 rk0[2], rv0[2];
  float4 fk[4], fv[4];
  const int kch = tid & 15, krow = tid >> 4, vsub = tid & 3, vkey = (tid >> 2) & 63, vd = tid >> 8;
  const bf16_t* kg = it.k + (long)krow * it.ks + kch * 8;
  const bf16_t* vg = it.v + (long)vkey * it.ks + vd * 32 + vsub * 8;
#define A_LOAD(RK, RV, t)                                                                                        \
  if (!F32) {                                                                                                    \
    _Pragma("unroll") for (int i = 0; i < 2; ++i) RK[i] = *(const u32x4*)(kg + (long)((t) * 64 + 32 * i) * it.ks); \
    _Pragma("unroll") for (int i = 0; i < 2; ++i) RV[i] = *(const u32x4*)(vg + (long)((t) * 64) * it.ks + 64 * i); \
  } else {                                                                                                       \
    const bool nw = (t) >= it.ncache;             \
    _Pragma("unroll") for (int i = 0; i < 2; ++i) {                                                              \
      const int kr = krow + 32 * i;                                                                              \
      const float* src = nw ? it.kn + (long)(kr < 15 ? kr : 15) * it.ks : it.kf + (long)((t) * 64 + kr) * it.ks; \
      fk[2 * i] = *(const float4*)(src + kch * 8); fk[2 * i + 1] = *(const float4*)(src + kch * 8 + 4);          \
    }                                                                                                            \
    {                                                                                                            \
      const float* src = nw ? it.vn + (long)(vkey < 15 ? vkey : 15) * it.ks : it.vf + (long)((t) * 64 + vkey) * it.ks; \
      _Pragma("unroll") for (int i = 0; i < 2; ++i) {                                                            \
        fv[2 * i] = *(const float4*)(src + (vd + 2 * i) * 32 + vsub * 8); fv[2 * i + 1] = *(const float4*)(src + (vd + 2 * i) * 32 + vsub * 8 + 4); \
      }                                                                                                          \
    }                                                                                                            \
  }
#define A_WRITE(RK, RV, stage)                                                                                   \
  {                                                                                                              \
    char* Kb_ = g_lds_all + (stage) * A_BUF; char* Vb_ = Kb_ + AK_BYTES;                                         \
    if (F32) {                                                                                                   \
      _Pragma("unroll") for (int i = 0; i < 2; ++i) {                                                            \
        RK[i].x = cvtpk(fk[2 * i].x, fk[2 * i].y); RK[i].y = cvtpk(fk[2 * i].z, fk[2 * i].w); RK[i].z = cvtpk(fk[2 * i + 1].x, fk[2 * i + 1].y); RK[i].w = cvtpk(fk[2 * i + 1].z, fk[2 * i + 1].w); \
        RV[i].x = cvtpk(fv[2 * i].x, fv[2 * i].y); RV[i].y = cvtpk(fv[2 * i].z, fv[2 * i].w); RV[i].z = cvtpk(fv[2 * i + 1].x, fv[2 * i + 1].y); RV[i].w = cvtpk(fv[2 * i + 1].z, fv[2 * i + 1].w); \
      }                                                                                                          \
    }                                                                                                            \
    _Pragma("unroll") for (int i = 0; i < 2; ++i) *(u32x4*)(Kb_ + (krow + 32 * i) * AK_RS + kch * 16) = RK[i];   \
    _Pragma("unroll") for (int i = 0; i < 2; ++i) *(u32x4*)(Vb_ + (vd + 2 * i) * 4096 + vkey * 64 + vsub * 16) = RV[i]; \
  }
  const int vlane = ((lane >> 4) & 1) * 32 + (lane & 3) * 8 + (4 * h + ((lane & 15) >> 2)) * 64;
  const float* biasT = (const float*)(g_lds_all + A_BIAS_OFF) + (it.head0 + m) * 257;
  const int qpos = (half ? it.qpos1 : it.qpos0) + qh * 32 + r;
#define A_COMPUTE(t, stage)                                                                                      \
  if ((t) >= tlo && (t) < thi) {                                                                                 \
    const char* Kb = g_lds_all + (stage) * A_BUF; const char* Vb = Kb + AK_BYTES;                                \
    f32x16 s0, s1;                                                                                               \
    _Pragma("unroll") for (int i = 0; i < 16; ++i) { s0[i] = 0.f; s1[i] = 0.f; }                                 \
    _Pragma("unroll") for (int s = 0; s < 4; ++s) {                                                              \
      const int co = (m * 64 + 16 * s + 8 * h) * 2;                                                              \
      const bf16x8 k0 = *(const bf16x8*)(Kb + r * AK_RS + co);                                                   \
      const bf16x8 k1 = *(const bf16x8*)(Kb + (32 + r) * AK_RS + co);                                            \
      const bf16x8 qfs = *(const bf16x8*)(qlds + s * 1024);                                                      \
      s0 = MFMA32(k0, qfs, s0);                                                                                  \
      s1 = MFMA32(k1, qfs, s1);                                                                                  \
    }                                                                                                            \
    if (BIAS) {                                                                                                  \
      const int kb = it.kpos0 + (t) * 64 + 4 * h;                                                                \
      _Pragma("unroll") for (int i = 0; i < 16; ++i) {                                                           \
        const int kk = kb + (i & 3) + 8 * (i >> 2);                                                              \
        int d0 = qpos - kk, d1 = d0 - 32;                                                                        \
        d0 = min(max(d0, -128), 128) + 128; d1 = min(max(d1, -128), 128) + 128;                                  \
        s0[i] += biasT[d0]; s1[i] += biasT[d1];                                                                  \
      }                                                                                                          \
    }                                                                                                            \
    if (MASK && ((t) + 1) * 64 > it.nkeys) {                                                                     \
      const int kb = (t) * 64 + 4 * h;                                                                           \
      _Pragma("unroll") for (int i = 0; i < 16; ++i) {                                                           \
        const int kk = kb + (i & 3) + 8 * (i >> 2);                                                              \
        if (kk >= it.nkeys) s0[i] = -1e30f;                                                                      \
        if (kk + 32 >= it.nkeys) s1[i] = -1e30f;                                                                 \
      }                                                                                                          \
    }                                                                                                            \
    float mx = fmaxf(s0[0], s1[0]);                                                                              \
    _Pragma("unroll") for (int i = 1; i < 16; ++i) mx = fmaxf(mx, fmaxf(s0[i], s1[i]));                          \
    mx = fmaxf(mx, xor32f(mx));                                                                                  \
    const float m_new = (mx > m_run + 8.f) ? mx : m_run;     \
    const float alpha = fexp2(m_run - m_new);                                                                    \
    if (__builtin_amdgcn_ballot_w64(m_new > m_run) != 0ull) {                                                    \
      _Pragma("unroll") for (int d = 0; d < NDT; ++d)                                                            \
        _Pragma("unroll") for (int i = 0; i < 16; ++i) oacc[d][i] *= alpha;                                      \
    }                                                                                                            \
    l_run *= alpha;                                                                                              \
    m_run = m_new;                                                                                               \
    float ls = 0.f;                                                                                              \
    _Pragma("unroll") for (int i = 0; i < 16; ++i) { s0[i] = fexp2(s0[i] - m_new); s1[i] = fexp2(s1[i] - m_new); ls += s0[i] + s1[i]; } \
    l_run += ls;                                                                                                 \
    bf16x8 pf[4];                                                                                                \
    _Pragma("unroll") for (int s2 = 0; s2 < 2; ++s2) {                                                           \
      u32x4 a, b;                                                                                                \
      a.x = cvtpk(s0[8 * s2 + 0], s0[8 * s2 + 1]); a.y = cvtpk(s0[8 * s2 + 2], s0[8 * s2 + 3]);                  \
      a.z = cvtpk(s0[8 * s2 + 4], s0[8 * s2 + 5]); a.w = cvtpk(s0[8 * s2 + 6], s0[8 * s2 + 7]);                  \
      b.x = cvtpk(s1[8 * s2 + 0], s1[8 * s2 + 1]); b.y = cvtpk(s1[8 * s2 + 2], s1[8 * s2 + 3]);                  \
      b.z = cvtpk(s1[8 * s2 + 4], s1[8 * s2 + 5]); b.w = cvtpk(s1[8 * s2 + 6], s1[8 * s2 + 7]);                  \
      pf[s2] = __builtin_bit_cast(bf16x8, a); pf[2 + s2] = __builtin_bit_cast(bf16x8, b);                        \
    }                                                                                                            \
    const LDS3 char* vb3 = (const LDS3 char*)(Vb) + vlane + (DIFF ? 0 : m * 2 * 4096);                           \
    _Pragma("unroll") for (int ks = 0; ks < 4; ++ks) {                                                           \
      _Pragma("unroll") for (int d = 0; d < NDT; ++d) {                                                          \
        const s16x4 lo = __builtin_bit_cast(s16x4, __builtin_amdgcn_ds_read_tr16_b64_v4i16((LDS3 s16x4*)(vb3 + d * 4096 + ks * 1024))); \
        const s16x4 hi = __builtin_bit_cast(s16x4, __builtin_amdgcn_ds_read_tr16_b64_v4i16((LDS3 s16x4*)(vb3 + d * 4096 + ks * 1024 + 512))); \
        const bf16x8 vf = __builtin_shufflevector(lo, hi, 0, 1, 2, 3, 4, 5, 6, 7);                               \
        oacc[d] = MFMA32(vf, pf[ks], oacc[d]);                                                                   \
      }                                                                                                          \
      __builtin_amdgcn_sched_barrier(0);                                                                         \
    }                                                                                                            \
  }
  A_LOAD(rk0, rv0, 0);
  A_WRITE(rk0, rv0, 0);
  if (ntiles > 1) A_LOAD(rk0, rv0, 1);
  __syncthreads();
#pragma unroll 1
  for (int t = 0; t < ntiles; ++t) {
    const int par = t & 1;
    if (t + 1 < ntiles) A_WRITE(rk0, rv0, par ^ 1);
    if (t + 2 < ntiles) A_LOAD(rk0, rv0, t + 2);
    A_COMPUTE(t, par);
    __syncthreads();
  }
#undef A_LOAD
#undef A_WRITE
#undef A_COMPUTE
  const float l_tot = l_run + xor32f(l_run);
  const float inv = 1.f / l_tot;
  const int q = qh * 32 + r;
  if (!DIFF) {
    if (q < rows) {
      bf16_t* gp = gbase + (long)q * 1024 + m * 64 + 4 * h;
      u32x2 gvv[NDT][4];
#pragma unroll
      for (int d = 0; d < NDT; ++d)
#pragma unroll
        for (int g4 = 0; g4 < 4; ++g4) gvv[d][g4] = *(const u32x2*)(gp + d * 32 + 8 * g4);
#pragma unroll
      for (int d = 0; d < NDT; ++d)
#pragma unroll
        for (int g4 = 0; g4 < 4; ++g4) {
          u32x2* ptr = (u32x2*)(gp + d * 32 + 8 * g4);
          const u32x2 gv = gvv[d][g4];
          u32x2 o;
          o.x = cvtpk(oacc[d][4 * g4 + 0] * inv * bflo(gv.x), oacc[d][4 * g4 + 1] * inv * bfhi(gv.x));
          o.y = cvtpk(oacc[d][4 * g4 + 2] * inv * bflo(gv.y), oacc[d][4 * g4 + 3] * inv * bfhi(gv.y));
          *ptr = o;
        }
    }
  } else {
    float* xb = (float*)g_lds_all + half * 8192 + qh * 4096 + lane;
    if (m == 1) {
      const float sc = lam * inv;
#pragma unroll
      for (int d = 0; d < NDT; ++d)
#pragma unroll
        for (int i = 0; i < 16; ++i) xb[(d * 16 + i) * 64] = oacc[d][i] * sc;
    }
    __syncthreads();
    if (m == 0) {
      float ss = 0.f;
#pragma unroll
      for (int d = 0; d < NDT; ++d)
#pragma unroll
        for (int i = 0; i < 16; ++i) { const float o = oacc[d][i] * inv - xb[(d * 16 + i) * 64]; oacc[d][i] = o; ss += o * o; }
      ss += xor32f(ss);
      const float rn = rsqrtf(ss * (1.f / 128.f) + 1e-5f) * 0.8f;
      if (q < rows) {
        bf16_t* gp = gbase + (long)q * 1024 + 4 * h;
        u32x2 gvv[NDT][4];
#pragma unroll
        for (int d = 0; d < NDT; ++d)
#pragma unroll
          for (int g4 = 0; g4 < 4; ++g4) gvv[d][g4] = *(const u32x2*)(gp + d * 32 + 8 * g4);
#pragma unroll
        for (int d = 0; d < NDT; ++d)
#pragma unroll
          for (int g4 = 0; g4 < 4; ++g4) {
            const float4 sg = *(const float4*)(subg + d * 32 + 8 * g4 + 4 * h);
            u32x2* ptr = (u32x2*)(gp + d * 32 + 8 * g4);
            const u32x2 gv = gvv[d][g4];
            u32x2 o;
            o.x = cvtpk(oacc[d][4 * g4 + 0] * rn * sg.x * bflo(gv.x), oacc[d][4 * g4 + 1] * rn * sg.y * bfhi(gv.x));
            o.y = cvtpk(oacc[d][4 * g4 + 2] * rn * sg.z * bflo(gv.y), oacc[d][4 * g4 + 3] * rn * sg.w * bfhi(gv.y));
            *ptr = o;
          }
      }
    }
    __syncthreads();
  }
}

DI void phase2(const Params& p) {
  char* ws = p.ws;
  float* biasT = (float*)(g_lds_all + A_BIAS_OFF);
  for (int i = threadIdx.x; i < 4 * 257; i += 512) biasT[i] = p.relb[i] * LOG2E;
  float s1 = 0.f, s2 = 0.f;
  for (int i = 0; i < 64; ++i) { s1 += p.dlam[i] * p.dlam[64 + i]; s2 += p.dlam[128 + i] * p.dlam[192 + i]; }
  const float lam = expf(s1) - expf(s2) + 0.2f;
  __syncthreads();
  int* ctr = (int*)(ws + WS_CTR);
  int* s_item = (int*)(g_lds_all + A_ITEM_OFF);
  const char* ob = (const char*)p.out;
  const bf16_t* AQ = (const bf16_t*)(ob + OB_AQ); const bf16_t* AK = (const bf16_t*)(ob + OB_AK); const bf16_t* AV = (const bf16_t*)(ob + OB_AV);
  const bf16_t* BQ = (const bf16_t*)(ob + OB_BQ); const bf16_t* BK = (const bf16_t*)(ob + OB_BK); const bf16_t* BV = (const bf16_t*)(ws + WS_BV);
  const bf16_t* MQ = (const bf16_t*)(ob + OB_MQ); const bf16_t* MK = (const bf16_t*)(ws + WS_MK); const bf16_t* MV = (const bf16_t*)(ws + WS_MV);
  bf16_t* G = (bf16_t*)(ws + WS_G);
  constexpr int N_BP = 1024, N_BS = 128, N_AP = 512, N_AS = 64, N_MP = 512, N_MS = 64;
  constexpr int N_ALL = N_BP + N_BS + N_AP + N_AS + N_MP + N_MS;
  for (;;) {
    if (threadIdx.x == 0) *s_item = atomicAdd(ctr, 1);
    __syncthreads();
    int item = *s_item;
    __syncthreads();
    if (item >= N_ALL) break;
    AttnItem it;
    it.bias = false; it.qpos0 = 0; it.qpos1 = 0; it.kpos0 = 0; it.head0 = 0; it.rows0 = 64; it.rows1 = 64;
    it.kf = nullptr; it.vf = nullptr; it.kn = nullptr; it.vn = nullptr; it.ncache = 0; it.k = nullptr; it.v = nullptr;
    if (item < N_BP) {
      const int j = 63 - (item >> 4), bh = item & 15, b = bh >> 2, hh = bh & 3;
      const long tok0 = (long)b * SEQ + j * 128;
      it.q0 = BQ + tok0 * 512 + hh * 128; it.q1 = it.q0 + 64 * 512;
      it.k = BK + (long)b * SEQ * 512 + hh * 128; it.v = BV + (long)b * SEQ * 512 + hh * 128;
      it.qs = 512; it.ks = 512; it.ntiles = 2 * j + 2; it.nkeys = it.ntiles * 64;
      it.tlo0 = 0; it.thi0 = 2 * j + 1; it.tlo1 = 0; it.thi1 = 2 * j + 2;
      it.g0 = G + tok0 * 1024 + 256 + hh * 128; it.g1 = it.g0 + 64 * 1024;
      attn_item<true, false, false, false>(it, lam, p.subg);
      continue;
    }
    item -= N_BP;
    if (item < N_BS) {
      const int b = item >> 2, hh = item & 3;
      const long tok0 = NTOKP + b * ST;
      it.q0 = BQ + tok0 * 512 + hh * 128; it.q1 = it.q0;
      it.kf = p.cbk + (long)b * PAST * 512 + hh * 128; it.vf = p.cbv + (long)b * PAST * 512 + hh * 128; it.ncache = PAST / 64;
      it.kn = p.out + O_BKS + (long)b * ST * 512 + hh * 128; it.vn = p.out + O_BVS + (long)b * ST * 512 + hh * 128;
      it.qs = 512; it.ks = 512; it.ntiles = 17; it.nkeys = PAST + ST;
      it.tlo0 = 0; it.thi0 = 17; it.tlo1 = 0; it.thi1 = 0; it.rows0 = ST; it.rows1 = 0;
      it.g0 = G + tok0 * 1024 + 256 + hh * 128; it.g1 = it.g0;
      attn_item<true, false, true, true>(it, lam, p.subg);
      continue;
    }
    item -= N_BS;
    if (item < N_AP) {
      const int j = 63 - (item >> 3), bh = item & 7, b = bh >> 1, hp = bh & 1;
      const int c0 = 2 * j, c1 = c0 + 1, cs0 = c0 > 8 ? c0 - 8 : 0, cs1 = c1 > 8 ? c1 - 8 : 0;
      const long tok0 = (long)b * SEQ + c0 * 64, k0 = (long)b * SEQ + cs0 * 64;
      it.q0 = AQ + tok0 * 256 + hp * 128; it.q1 = it.q0 + 64 * 256;
      it.k = AK + k0 * 256 + hp * 128; it.v = AV + k0 * 256 + hp * 128;
      it.qs = 256; it.ks = 256; it.ntiles = c1 - cs0 + 1; it.nkeys = it.ntiles * 64;
      it.tlo0 = 0; it.thi0 = c0 - cs0 + 1; it.tlo1 = cs1 - cs0; it.thi1 = it.ntiles;
      it.g0 = G + tok0 * 1024 + hp * 128; it.g1 = it.g0 + 64 * 1024;
      it.bias = true; it.qpos0 = c0 * 64; it.qpos1 = c1 * 64; it.kpos0 = cs0 * 64; it.head0 = hp * 2;
    } else if ((item -= N_AP) < N_AS) {
      const int b = item >> 1, hp = item & 1;
      const long tok0 = NTOKP + b * ST;
      it.q0 = AQ + tok0 * 256 + hp * 128; it.q1 = it.q0;
      it.kf = p.cak + (long)b * RA * 256 + hp * 128; it.vf = p.cav + (long)b * RA * 256 + hp * 128; it.ncache = RA / 64;
      it.kn = p.out + O_AKS + (long)b * ST * 256 + hp * 128; it.vn = p.out + O_AVS + (long)b * ST * 256 + hp * 128;
      it.qs = 256; it.ks = 256; it.ntiles = 9; it.nkeys = RA + ST;
      it.tlo0 = 0; it.thi0 = 9; it.tlo1 = 0; it.thi1 = 0; it.rows0 = ST; it.rows1 = 0;
      it.g0 = G + tok0 * 1024 + hp * 128; it.g1 = it.g0;
      it.bias = true; it.qpos0 = RA; it.qpos1 = RA; it.kpos0 = 0; it.head0 = hp * 2;
    } else if ((item -= N_AS) < N_MP) {
      const int j = item >> 3, bh = item & 7, b = bh >> 1, hp = bh & 1;
      const long tok0 = (long)b * SEQ + j * 128;
      it.q0 = MQ + tok0 * 256 + hp * 128; it.q1 = it.q0 + 64 * 256;
      it.k = MK + (long)b * NMEM * 256 + hp * 128; it.v = MV + (long)b * NMEM * 256 + hp * 128;
      it.qs = 256; it.ks = 256; it.ntiles = 4; it.nkeys = NMEM;
      it.tlo0 = 0; it.thi0 = 4; it.tlo1 = 0; it.thi1 = 4;
      it.g0 = G + tok0 * 1024 + 768 + hp * 128; it.g1 = it.g0 + 64 * 1024;
    } else {
      item -= N_MP;
      const int b = item >> 1, hp = item & 1;
      const long tok0 = NTOKP + b * ST;
      it.q0 = MQ + tok0 * 256 + hp * 128; it.q1 = it.q0;
      it.kf = p.cmk + (long)b * NMEM * 256 + hp * 128; it.vf = p.cmv + (long)b * NMEM * 256 + hp * 128; it.ncache = NMEM / 64;
      it.kn = it.kf; it.vn = it.vf;
      it.qs = 256; it.ks = 256; it.ntiles = 4; it.nkeys = NMEM;
      it.tlo0 = 0; it.thi0 = 4; it.tlo1 = 0; it.thi1 = 0; it.rows0 = ST; it.rows1 = 0;
      it.g0 = G + tok0 * 1024 + 768 + hp * 128; it.g1 = it.g0;
    }
    const bool f32src = it.kf != nullptr;
    if (it.bias) { if (f32src) attn_item<false, true, true, true>(it, lam, p.subg); else attn_item<false, true, false, false>(it, lam, p.subg); }
    else { if (f32src) attn_item<false, false, false, true>(it, lam, p.subg); else attn_item<false, false, false, false>(it, lam, p.subg); }
  }
}

DI void phase3(const Params& p) {
  pg8::Gemm g; g.A = (const bf16_t*)(p.ws + WS_G); g.Bt = (const bf16_t*)(p.ws + WS_WOUTT); g.M = NTOK; g.N = 1024; g.K = 1024;
  pg8::StaticOrder S; S.init(NTOK, 1024, (int)gridDim.x, (int)blockIdx.x);
  EpiOut E; E.ypre = (bf16_t*)(p.ws + WS_XB); E.xp = p.xp; E.xs = p.xs;
  pg8::gemm_phase<EpiOut, pg8::StaticOrder, false>((PG8_LAS unsigned char*)g_lds_all, g, S, E, nullptr);
  __syncthreads();
}

DI void phase4(const Params& p) {
  const int lane = threadIdx.x & 63, w = threadIdx.x >> 6;
  float4 g[4], bb[4];
#pragma unroll
  for (int j = 0; j < 4; ++j) { g[j] = *(const float4*)(p.ln_g + j * 256 + lane * 4); bb[j] = *(const float4*)(p.ln_b + j * 256 + lane * 4); }
  for (int row0 = (blockIdx.x * 8 + w) * 4; row0 < NTOK; row0 += gridDim.x * 32) {
    float4 v[4][4];
#pragma unroll
    for (int rr = 0; rr < 4; ++rr)
#pragma unroll
      for (int j = 0; j < 4; ++j) { const u32x2 w = __builtin_nontemporal_load((const u32x2*)((const bf16_t*)(p.ws + WS_XB) + (long)(row0 + rr) * 1024 + j * 256 + lane * 4)); v[rr][j] = make_float4(bflo(w.x), bfhi(w.x), bflo(w.y), bfhi(w.y)); }
    float s[4], q[4];
#pragma unroll
    for (int rr = 0; rr < 4; ++rr) { s[rr] = 0.f;
#pragma unroll
      for (int j = 0; j < 4; ++j) s[rr] += v[rr][j].x + v[rr][j].y + v[rr][j].z + v[rr][j].w; }
#pragma unroll
    for (int o = 1; o < 64; o <<= 1)
#pragma unroll
      for (int rr = 0; rr < 4; ++rr) s[rr] += __shfl_xor(s[rr], o);
#pragma unroll
    for (int rr = 0; rr < 4; ++rr) { const float mu = s[rr] * (1.f / 1024.f); s[rr] = mu; q[rr] = 0.f;
#pragma unroll
      for (int j = 0; j < 4; ++j) { const float a = v[rr][j].x - mu, b = v[rr][j].y - mu, c = v[rr][j].z - mu, d = v[rr][j].w - mu; q[rr] += a * a + b * b + c * c + d * d; } }
#pragma unroll
    for (int o = 1; o < 64; o <<= 1)
#pragma unroll
      for (int rr = 0; rr < 4; ++rr) q[rr] += __shfl_xor(q[rr], o);
#pragma unroll
    for (int rr = 0; rr < 4; ++rr) {
      const float mu = s[rr], rs = rsqrtf(q[rr] * (1.f / 1024.f) + 1e-5f);
#pragma unroll
      for (int j = 0; j < 4; ++j) {
        float4 o;
        o.x = (v[rr][j].x - mu) * rs * g[j].x + bb[j].x; o.y = (v[rr][j].y - mu) * rs * g[j].y + bb[j].y;
        o.z = (v[rr][j].z - mu) * rs * g[j].z + bb[j].z; o.w = (v[rr][j].w - mu) * rs * g[j].w + bb[j].w;
        { const pg8::f32x4 ov = {o.x, o.y, o.z, o.w}; __builtin_nontemporal_store(ov, (pg8::f32x4*)(p.out + O_Y + (long)(row0 + rr) * 1024 + j * 256 + lane * 4)); }
      }
    }
  }
}

DI void grid_barrier(unsigned* bar, unsigned target) {
  asm volatile("s_waitcnt vmcnt(0) lgkmcnt(0)" ::: "memory");
  __syncthreads();
  if (threadIdx.x == 0) {
    __builtin_amdgcn_fence(__ATOMIC_RELEASE, "agent");
    asm volatile("s_waitcnt vmcnt(0)" ::: "memory");
    __hip_atomic_fetch_add(bar, 1u, __ATOMIC_RELAXED, __HIP_MEMORY_SCOPE_AGENT);
    while (__hip_atomic_load(bar, __ATOMIC_RELAXED, __HIP_MEMORY_SCOPE_AGENT) < target) __builtin_amdgcn_s_sleep(2);
    __builtin_amdgcn_fence(__ATOMIC_ACQUIRE, "agent");
    asm volatile("s_waitcnt vmcnt(0)" ::: "memory");
  }
  __syncthreads();
}
__global__ void __launch_bounds__(512) fwd_megakernel(Params p) {
  cg::grid_group grid = cg::this_grid();
  unsigned* bar = (unsigned*)(p.ws + WS_CTR + 64);
  const unsigned nb = gridDim.x;
  phase0(p);
  if (p.ws == nullptr) grid.sync();
  grid_barrier(bar, nb);
  phase1(p);
  grid_barrier(bar, 2 * nb);
  phase2(p);
  grid_barrier(bar, 3 * nb);
  phase3(p);
  grid_barrier(bar, 4 * nb);
  phase4(p);
}

extern "C" void kernel_launch(void* const* d_in, const int* in_sizes, int n_in, void* d_out, int out_size,
                              void* d_ws, size_t ws_size, hipStream_t stream) {
  static int grid_blocks = 0;
  if (!grid_blocks) {
    int dev = 0, cus = 0, per_cu = 0;
    (void)hipGetDevice(&dev);
    (void)hipDeviceGetAttribute(&cus, hipDeviceAttributeMultiprocessorCount, dev);
    (void)hipOccupancyMaxActiveBlocksPerMultiprocessor(&per_cu, fwd_megakernel, 512, 0);
    if (per_cu > 1) per_cu = 1;
    if (per_cu < 1) per_cu = 1;
    grid_blocks = cus * per_cu;
    if (ws_size < WS_END || out_size != (int)O_END) fprintf(stderr, "kernel_launch: unexpected sizes ws %zu (need %zu) out %d (need %ld)\n", ws_size, (size_t)WS_END, out_size, (long)O_END);
  }
  (void)hipMemsetAsync((char*)d_ws + WS_CTR, 0, 256, stream);
  Params p{};
  p.xp = (const float*)d_in[0]; p.xs = (const float*)d_in[1];
  p.cak = (const float*)d_in[2]; p.cav = (const float*)d_in[3]; p.cbk = (const float*)d_in[4]; p.cbv = (const float*)d_in[5];
  p.cmk = (const float*)d_in[6]; p.cmv = (const float*)d_in[7];
  p.memp = (const float*)d_in[8]; p.w_in = (const float*)d_in[9]; p.w_mem = (const float*)d_in[10]; p.relb = (const float*)d_in[11];
  p.dlam = (const float*)d_in[12]; p.subg = (const float*)d_in[13]; p.w_out = (const float*)d_in[14]; p.ln_g = (const float*)d_in[15]; p.ln_b = (const float*)d_in[16];
  p.out = (float*)d_out; p.ws = (char*)d_ws;
  void* args[] = {&p};
  hipError_t e = hipLaunchCooperativeKernel((void*)fwd_megakernel, dim3(grid_blocks), dim3(512), args, 0, stream);
  if (e != hipSuccess) fprintf(stderr, "cooperative launch failed: %s (grid %d)\n", hipGetErrorString(e), grid_blocks);
}
```

```cpp
#include <hip/hip_runtime.h>
#include <hip/hip_cooperative_groups.h>
#include <cstdio>
#include <cstdint>
namespace cg = cooperative_groups;

typedef unsigned short bf16_t;
typedef short bf16x8 __attribute__((ext_vector_type(8)));
typedef short s16x4 __attribute__((ext_vector_type(4)));
typedef float f32x16 __attribute__((ext_vector_type(16)));
typedef float f32x2_t __attribute__((ext_vector_type(2)));
typedef __bf16 bf16x2_t __attribute__((ext_vector_type(2)));
typedef unsigned u32x2 __attribute__((ext_vector_type(2)));
typedef unsigned u32x4 __attribute__((ext_vector_type(4)));
typedef float f32x4g __attribute__((ext_vector_type(4)));
#define DI __device__ __forceinline__
#define MFMA32(a, b, c) __builtin_amdgcn_mfma_f32_32x32x16_bf16((a), (b), (c), 0, 0, 0)
#define LDS3 __attribute__((address_space(3)))

constexpr int D_MODEL = 1024, SEQ = 8192, NB = 4, NTOKP = NB * SEQ, SB = 32, ST = 16, NTOKS = SB * ST, NTOK = NTOKP + NTOKS;
constexpr int PAST = 1024, RA = 512, NMEM = 256, PROJ = 3584;
constexpr int SAK_ROWS = 576, SBK_ROWS = 1088;
constexpr int NTOKPAD = NTOK + 64;
constexpr float QSCALE = 0.125f * 1.4426950408889634f;
constexpr float LOG2E = 1.4426950408889634f;
constexpr float ALPHA = 1.189207115002721f;

constexpr long O_Y = 0;
constexpr long O_AKP = (long)NTOK * 1024;
constexpr long O_AVP = O_AKP + (long)NB * RA * 256;
constexpr long O_BKP = O_AVP + (long)NB * RA * 256;
constexpr long O_BVP = O_BKP + (long)NTOKP * 512;
constexpr long O_MKP = O_BVP + (long)NTOKP * 512;
constexpr long O_MVP = O_MKP + (long)NB * NMEM * 256;
constexpr long O_AKS = O_MVP + (long)NB * NMEM * 256;
constexpr long O_AVS = O_AKS + (long)NTOKS * 256;
constexpr long O_BKS = O_AVS + (long)NTOKS * 256;
constexpr long O_BVS = O_BKS + (long)NTOKS * 512;
constexpr long O_END = O_BVS + (long)NTOKS * 512;

constexpr size_t WS_CTR = 0;
constexpr size_t WS_WINT = 256;
constexpr size_t WS_WOUTT = WS_WINT + (size_t)PROJ * 1024 * 2;
constexpr size_t WS_WMEMT = WS_WOUTT + (size_t)1024 * 1024 * 2;
constexpr size_t WS_ROPE = WS_WMEMT + (size_t)512 * 1024 * 2;
constexpr size_t OB_AQ = 0;
constexpr size_t OB_BQ = OB_AQ + (size_t)NTOKPAD * 256 * 2;
constexpr size_t OB_MQ = OB_BQ + (size_t)NTOKPAD * 512 * 2;
constexpr size_t OB_AK = OB_MQ + (size_t)NTOKPAD * 256 * 2;
constexpr size_t OB_AV = OB_AK + (size_t)NTOKP * 256 * 2;
constexpr size_t OB_BK = OB_AV + (size_t)NTOKP * 256 * 2;
constexpr size_t OB_END = OB_BK + (size_t)NTOKP * 512 * 2;
static_assert(OB_END <= (size_t)NTOK * 1024 * 4, "temporaries must fit in the y region");
constexpr size_t WS_BV = WS_ROPE + (size_t)SEQ * 32 * 8;
constexpr size_t WS_G = WS_BV + (size_t)NTOKP * 512 * 2;
constexpr size_t WS_MK = WS_G + (size_t)NTOK * 1024 * 2;
constexpr size_t WS_MV = WS_MK + (size_t)NB * NMEM * 256 * 2;
constexpr size_t WS_SAK = WS_MV + (size_t)NB * NMEM * 256 * 2;
constexpr size_t WS_SAV = WS_SAK + (size_t)SB * SAK_ROWS * 256 * 2;
constexpr size_t WS_SBK = WS_SAV + (size_t)SB * SAK_ROWS * 256 * 2;
constexpr size_t WS_SBV = WS_SBK + (size_t)SB * SBK_ROWS * 512 * 2;
constexpr size_t WS_SMK = WS_SBV + (size_t)SB * SBK_ROWS * 512 * 2;
constexpr size_t WS_SMV = WS_SMK + (size_t)SB * NMEM * 256 * 2;
constexpr size_t WS_XB = WS_SMV + (size_t)SB * NMEM * 256 * 2;
constexpr size_t WS_MB = WS_XB + (size_t)NTOK * 1024 * 2;
constexpr size_t WS_END = WS_MB + (size_t)NB * NMEM * 1024 * 2;
static_assert(WS_END <= (size_t)512 * 1024 * 1024, "workspace budget");

struct Params {
  const float* xp; const float* xs;
  const float* cak; const float* cav; const float* cbk; const float* cbv; const float* cmk; const float* cmv;
  const float* memp; const float* w_in; const float* w_mem; const float* relb; const float* dlam; const float* subg;
  const float* w_out; const float* ln_g; const float* ln_b;
  float* out; char* ws;
};

constexpr int TEAM_LDS = 73728 + 64;
constexpr int LDS_BYTES = 2 * TEAM_LDS + 64;
__shared__ __attribute__((aligned(16))) char g_lds_all[LDS_BYTES];
#define TEAM (__builtin_amdgcn_readfirstlane((int)(threadIdx.x >> 8)))
#define g_lds (g_lds_all + TEAM * TEAM_LDS)

DI unsigned cvtpk(float lo, float hi) { f32x2_t v = {lo, hi}; bf16x2_t b = __builtin_convertvector(v, bf16x2_t); return __builtin_bit_cast(unsigned, b); }
DI bf16_t f2bf(float x) { return (bf16_t)(cvtpk(x, 0.f) & 0xffffu); }
DI float bf2f(unsigned short b) { return __uint_as_float(((unsigned)b) << 16); }
DI float bflo(unsigned u) { return __uint_as_float(u << 16); }
DI float bfhi(unsigned u) { return __uint_as_float(u & 0xffff0000u); }
DI float fexp2(float x) { return __builtin_amdgcn_exp2f(x); }
DI float xor32f(float v) { return __shfl_xor(v, 32); }

template <bool SWAP45>
DI void transpose_tile(const float* __restrict__ src, int N, bf16_t* __restrict__ dst, int K, int k0, int n0) {
  float* tile = (float*)g_lds;
  const int tid = threadIdx.x & 255, c = tid & 63, r0 = tid >> 6;
#pragma unroll
  for (int i = 0; i < 16; ++i) { const int row = r0 + 4 * i; tile[row * 65 + c] = src[(long)(k0 + row) * N + n0 + c]; }
  __syncthreads();
#pragma unroll
  for (int i = 0; i < 16; ++i) { const int rr = r0 + 4 * i; const int pr = SWAP45 ? ((rr & 15) | ((rr & 16) << 1) | ((rr & 32) >> 1)) : rr; dst[(long)(n0 + pr) * K + k0 + c] = f2bf(tile[c * 65 + rr]); }
  __syncthreads();
}

DI void convert_rows(const float* __restrict__ src, bf16_t* __restrict__ dst, int rows_w8, int dst_bstride_w8, long gtid, long gsz) {
  const long total = (long)SB * rows_w8;
  for (long u = gtid; u < total; u += gsz) {
    const int b = (int)(u / rows_w8); const int j = (int)(u - (long)b * rows_w8);
    const float4 a0 = *(const float4*)(src + u * 8), a1 = *(const float4*)(src + u * 8 + 4);
    u32x4 v; v.x = cvtpk(a0.x, a0.y); v.y = cvtpk(a0.z, a0.w); v.z = cvtpk(a1.x, a1.y); v.w = cvtpk(a1.z, a1.w);
    *(u32x4*)(dst + ((long)b * dst_bstride_w8 + j) * 8) = v;
  }
}

DI void phase0(const Params& p) {
  bf16_t* winT = (bf16_t*)(p.ws + WS_WINT); bf16_t* woutT = (bf16_t*)(p.ws + WS_WOUTT); bf16_t* wmemT = (bf16_t*)(p.ws + WS_WMEMT);
  constexpr int T_IN = 16 * 56, T_OUT = 16 * 16, T_MEM = 16 * 8;
  for (int t = blockIdx.x * 2 + TEAM; t < T_IN + T_OUT + T_MEM; t += gridDim.x * 2) {
    if (t < T_IN) transpose_tile<true>(p.w_in, PROJ, winT, 1024, (t / 56) * 64, (t % 56) * 64);
    else if (t < T_IN + T_OUT) { const int u = t - T_IN; transpose_tile<false>(p.w_out, 1024, woutT, 1024, (u >> 4) * 64, (u & 15) * 64); }
    else { const int u = t - T_IN - T_OUT; transpose_tile<false>(p.w_mem, 512, wmemT, 1024, (u >> 3) * 64, (u & 7) * 64); }
  }
  float2* rope = (float2*)(p.ws + WS_ROPE);
  for (int idx = blockIdx.x * 512 + threadIdx.x; idx < SEQ * 32; idx += gridDim.x * 512) {
    const int pos = idx >> 5, i = idx & 31;
    const double inv = exp(-(double)i * (9.210340371976184 / 32.0));
    const double rev = (double)pos * inv * 0.15915494309189535;
    const double fr = rev - rint(rev);
    const float a = (float)(fr * 6.283185307179586);
    rope[idx] = make_float2(cosf(a), sinf(a));
  }
  const int G = gridDim.x;
  const long gtid = (long)blockIdx.x * 512 + threadIdx.x, gsz = (long)G * 512;
  {
    bf16_t* XB = (bf16_t*)(p.ws + WS_XB); bf16_t* MB = (bf16_t*)(p.ws + WS_MB);
    const long nxp = (long)NTOKP * 1024 / 8, nxs = (long)NTOKS * 1024 / 8, nmb = (long)NB * NMEM * 1024 / 8;
#pragma unroll 4
    for (long u = gtid; u < nxp + nxs + nmb; u += gsz) {
      const float* src; bf16_t* dst;
      if (u < nxp) { src = p.xp + u * 8; dst = XB + u * 8; }
      else if (u < nxp + nxs) { src = p.xs + (u - nxp) * 8; dst = XB + u * 8; }
      else { src = p.memp + (u - nxp - nxs) * 8; dst = MB + (u - nxp - nxs) * 8; }
      const f32x4g a0 = __builtin_nontemporal_load((const f32x4g*)(src)), a1 = __builtin_nontemporal_load((const f32x4g*)(src + 4));
      u32x4 v; v.x = cvtpk(a0[0], a0[1]); v.y = cvtpk(a0[2], a0[3]); v.z = cvtpk(a1[0], a1[1]); v.w = cvtpk(a1[2], a1[3]);
      *(u32x4*)dst = v;
    }
  }
}

constexpr int G_RS = 144, GA_BYTES = 128 * G_RS, GB_BYTES = 256 * G_RS, G_STAGE = GA_BYTES + GB_BYTES;
DI void gemm_core(const bf16_t* __restrict__ Ap, int lda, const bf16_t* __restrict__ Bp, int ldb, int K, f32x16 (&acc)[2][2]) {
  const int tid = threadIdx.x, lane = tid & 63, w = tid >> 6, wm = w >> 2, wn = w & 3, r = lane & 31, h = lane >> 5;
#pragma unroll
  for (int a = 0; a < 2; ++a)
#pragma unroll
    for (int b = 0; b < 2; ++b)
#pragma unroll
      for (int i = 0; i < 16; ++i) acc[a][b][i] = 0.f;
  u32x4 ra0[2], rb0[4], ra1[2], rb1[4];
  const int lrow = tid >> 3, lch = tid & 7;
  const bf16_t* Ag = Ap + (long)lrow * lda + lch * 8;
  const bf16_t* Bg = Bp + (long)lrow * ldb + lch * 8;
#define G_LOAD(RA, RB, kt)                                                                                      \
  {                                                                                                             \
    _Pragma("unroll") for (int i = 0; i < 2; ++i) RA[i] = *(const u32x4*)(Ag + (long)(64 * i) * lda + (kt) * 64); \
    _Pragma("unroll") for (int i = 0; i < 4; ++i) RB[i] = *(const u32x4*)(Bg + (long)(64 * i) * ldb + (kt) * 64); \
  }
#define G_WRITE(RA, RB, buf)                                                                                    \
  {                                                                                                             \
    char* Ab_ = g_lds_all + (buf) * G_STAGE; char* Bb_ = Ab_ + GA_BYTES;                                        \
    _Pragma("unroll") for (int i = 0; i < 2; ++i) *(u32x4*)(Ab_ + (lrow + 64 * i) * G_RS + lch * 16) = RA[i];   \
    _Pragma("unroll") for (int i = 0; i < 4; ++i) *(u32x4*)(Bb_ + (lrow + 64 * i) * G_RS + lch * 16) = RB[i];   \
  }
#define G_COMPUTE(buf)                                                                                          \
  {                                                                                                             \
    const char* Ab = g_lds_all + (buf) * G_STAGE; const char* Bb = Ab + GA_BYTES;                               \
    _Pragma("unroll") for (int s = 0; s < 4; ++s) {                                                             \
      const int co = (16 * s + 8 * h) * 2;                                                                      \
      const bf16x8 a0 = *(const bf16x8*)(Ab + (wm * 64 + r) * G_RS + co);                                       \
      const bf16x8 a1 = *(const bf16x8*)(Ab + (wm * 64 + 32 + r) * G_RS + co);                                  \
      const bf16x8 b0 = *(const bf16x8*)(Bb + (wn * 64 + r) * G_RS + co);                                       \
      const bf16x8 b1 = *(const bf16x8*)(Bb + (wn * 64 + 32 + r) * G_RS + co);                                  \
      acc[0][0] = MFMA32(a0, b0, acc[0][0]);                                                                    \
      acc[0][1] = MFMA32(a0, b1, acc[0][1]);                                                                    \
      acc[1][0] = MFMA32(a1, b0, acc[1][0]);                                                                    \
      acc[1][1] = MFMA32(a1, b1, acc[1][1]);                                                                    \
    }                                                                                                           \
  }
  const int nk = K >> 6;
  G_LOAD(ra0, rb0, 0);
  G_LOAD(ra1, rb1, 1);
  G_WRITE(ra0, rb0, 0);
  __syncthreads();
  for (int kt = 0; kt < nk; kt += 2) {
    if (kt + 2 < nk) G_LOAD(ra0, rb0, kt + 2);
    G_COMPUTE(0);
    G_WRITE(ra1, rb1, 1);
    __syncthreads();
    if (kt + 3 < nk) G_LOAD(ra1, rb1, kt + 3);
    G_COMPUTE(1);
    if (kt + 2 < nk) G_WRITE(ra0, rb0, 0);
    __syncthreads();
  }
#undef G_COMPUTE
#undef G_LOAD
#undef G_WRITE
}

namespace pg8 {
#define PG8_LAS __attribute__((address_space(3)))
typedef unsigned short bf16_t;
typedef short bf16x8 __attribute__((ext_vector_type(8)));
typedef float f32x4 __attribute__((ext_vector_type(4)));
typedef unsigned u32x4 __attribute__((ext_vector_type(4)));
constexpr int BM = 256, BK = 64, HALF = 128, HTB = HALF * BK * 2  , STAGE_BYTES = 8 * HTB, NXCD = 8, WGM = 8;

__host__ __device__ __forceinline__ int lds_byte(int r, int c) { const int st = (r >> 4) * 2 + (c >> 5), rr = r & 15, cc = c & 31, ob = rr * 64 + cc * 2; return st * 1024 + (ob ^ (((ob >> 9) & 1) << 5)); }
__host__ __device__ __forceinline__ void stage_rc(int b, int& R, int& C) { const int st = b / 1024, sb = b % 1024, swz = sb ^ (((sb >> 9) & 1) << 5); R = (st >> 1) * 16 + swz / 64; C = (st & 1) * 32 + (swz % 64) / 2; }
__host__ __device__ __forceinline__ int perm32(int rho) { const int n = rho >> 4, i = rho & 15; return 8 * (i >> 2) + 4 * n + (i & 3); }

struct Unit { int pm, pn; };
struct Gemm { const bf16_t* A; const bf16_t* Bt; int M, N, K; };

struct StaticOrder {
    int nM, nN, nwg, G, c;
    __host__ __device__ void init(int M, int N, int G_, int c_) { nM = M / BM; nN = N / BM; nwg = nM * nN; G = G_; c = c_; }
    __host__ __device__ bool next(int i, Unit& u) const {
        const long L = (long)i * G + c; if (L >= nwg) return false;
        int wgid = (int)L; { const int q = nwg / NXCD, r = nwg % NXCD, xcd = wgid % NXCD, off = wgid / NXCD; wgid = (xcd < r ? xcd * (q + 1) : r * (q + 1) + (xcd - r) * q) + off; }
        const int nig = WGM * nN, gid = wgid / nig, fm = gid * WGM, gsz = (nM - fm) < WGM ? (nM - fm) : WGM;
        u.pm = fm + ((wgid % nig) % gsz); u.pn = (wgid % nig) / gsz; return true;
    }
    __device__ __forceinline__ void a_ready(const Unit&) const {}
    __device__ __forceinline__ void done(const Unit&) const {}
};
template <class Epi, class Sched, bool STAMP = false>
__device__ __forceinline__ void gemm_phase(PG8_LAS unsigned char* lds, const Gemm g, const Sched& S, const Epi& E, unsigned long long* stamps) {
    const int tid = threadIdx.x, wid = __builtin_amdgcn_readfirstlane(tid >> 6), lane = tid & 63, wr = wid >> 2, wc = wid & 3, fr = lane & 15, fq = lane >> 4;
    const int K = g.K, nt = K / BK;
    int ts_lo = 0, ts_hi = 0, nts = 0; const unsigned long long rt_entry = STAMP ? (unsigned long long)wall_clock64() : 0ull;
#define PG8_STAMP() do { if (STAMP && wid == 0 && nts < 64) { const unsigned long long _c = (unsigned long long)clock64(); \
        ts_lo = (lane == nts) ? (int)(unsigned)_c : ts_lo; ts_hi = (lane == nts) ? (int)(unsigned)(_c >> 32) : ts_hi; ++nts; } } while (0)
    PG8_STAMP();
    unsigned voffA[2], voffB[2];
#pragma unroll
    for (int i = 0; i < 2; ++i) { int R, C; stage_rc(tid * 16 + i * 8192, R, C); const int Rb = Epi::PERM ? ((R & ~31) + perm32(R & 31)) : R;
        voffA[i] = (unsigned)(R * K + C) * 2u; voffB[i] = (unsigned)(Rb * K + C) * 2u; }
    const size_t kstep = (size_t)(BK * 2);
    const size_t hstep = (size_t)HALF * K * 2;
    const size_t tstep = 2 * hstep;
    const unsigned ldsw = (unsigned)wid * 1024u;
    const int aoff = lds_byte(wr * 64 + fr, fq * 8), boff = lds_byte(wc * 32 + fr, fq * 8);
#define PG8_SA(b, h) (((b) * 2 + (h)) * HTB)
#define PG8_SB(b, h) ((4 + (b) * 2 + (h)) * HTB)
#define PG8_STAGE(bufoff, gbase, voff) do { _Pragma("unroll") for (int _i = 0; _i < 2; ++_i) \
        __builtin_amdgcn_global_load_lds((const unsigned*)((const char*)(gbase) + (voff)[_i]), (PG8_LAS unsigned*)(lds + (bufoff) + ldsw + _i * 8192), 16, 0, 0); } while (0)
#define PG8_LDA(dst, b, h) do { _Pragma("unroll") for (int m = 0; m < 4; ++m) _Pragma("unroll") for (int k = 0; k < 2; ++k) dst[m][k] = *(const PG8_LAS bf16x8*)(lds + PG8_SA(b, h) + aoff + m * 2048 + k * 1024); } while (0)
#define PG8_LDB(dst, b, h) do { _Pragma("unroll") for (int n = 0; n < 2; ++n) _Pragma("unroll") for (int k = 0; k < 2; ++k) dst[n][k] = *(const PG8_LAS bf16x8*)(lds + PG8_SB(b, h) + boff + n * 2048 + k * 1024); } while (0)
#define PG8_MMA(ai, bj, At, Bt) do { __builtin_amdgcn_s_setprio(1); _Pragma("unroll") for (int m = 0; m < 4; ++m) _Pragma("unroll") for (int n = 0; n < 2; ++n) _Pragma("unroll") for (int k = 0; k < 2; ++k) \
        acc[ai][bj][m][n] = __builtin_amdgcn_mfma_f32_16x16x32_bf16(Bt[n][k], At[m][k], acc[ai][bj][m][n], 0, 0, 0); __builtin_amdgcn_s_setprio(0); } while (0)
#define PG8_WAIT_V(n) asm volatile("s_waitcnt vmcnt(" #n ")" ::: "memory")
#define PG8_WAIT_L(n) asm volatile("s_waitcnt lgkmcnt(" #n ")" ::: "memory")
#define PG8_BAR __builtin_amdgcn_s_barrier()
#define PG8_SCHED __builtin_amdgcn_sched_barrier(0)
    Unit cur, nxt; int ui = 0;
    if (!S.next(0, cur)) return;
    f32x4 acc[2][2][4][2];
#pragma unroll
    for (int a = 0; a < 2; ++a)
#pragma unroll
        for (int b = 0; b < 2; ++b)
#pragma unroll
            for (int m = 0; m < 4; ++m)
#pragma unroll
                for (int n = 0; n < 2; ++n) acc[a][b][m][n] = (f32x4){0.f, 0.f, 0.f, 0.f};
    bf16x8 At[4][2], B0[2][2], B1[2][2];
    const char* cA = (const char*)g.A + (size_t)cur.pm * tstep; const char* cB = (const char*)g.Bt + (size_t)cur.pn * tstep;
    S.a_ready(cur);
    PG8_STAGE(PG8_SB(0, 0), cB, voffB); PG8_STAGE(PG8_SA(0, 0), cA, voffA); PG8_STAGE(PG8_SB(0, 1), cB + hstep, voffB); PG8_STAGE(PG8_SA(0, 1), cA + hstep, voffA);
    if (wr == 1) PG8_BAR;
    PG8_WAIT_V(4); PG8_BAR;
    PG8_STAGE(PG8_SB(1, 0), cB + kstep, voffB); PG8_STAGE(PG8_SA(1, 0), cA + kstep, voffA); PG8_STAGE(PG8_SB(1, 1), cB + hstep + kstep, voffB);
    PG8_WAIT_V(6); PG8_BAR;
    PG8_STAMP();
    for (;;) {
        const bool has_next = S.next(ui + 1, nxt);
        const char* nA = has_next ? (const char*)g.A + (size_t)nxt.pm * tstep : cA; const char* nB = has_next ? (const char*)g.Bt + (size_t)nxt.pn * tstep : cB;
        for (int t = 0; t < nt; t += 2) {
            const bool last = (t == nt - 2);
            const char* a1 = cA + (size_t)(t + 1) * kstep;
            const char* a2 = last ? nA : cA + (size_t)(t + 2) * kstep; const char* b2 = last ? nB : cB + (size_t)(t + 2) * kstep;
            const char* a3 = a2 + kstep; const char* b3 = b2 + kstep;
            if (last && has_next) S.a_ready(nxt);
            PG8_LDB(B0, 0, 0); PG8_SCHED; PG8_LDA(At, 0, 0); PG8_STAGE(PG8_SA(1, 1), a1 + hstep, voffA);
            PG8_WAIT_L(8); PG8_BAR; PG8_WAIT_L(0); PG8_MMA(0, 0, At, B0); PG8_BAR; PG8_SCHED;
            PG8_LDB(B1, 0, 1); PG8_STAGE(PG8_SB(0, 0), b2, voffB);
            PG8_BAR; PG8_WAIT_L(0); PG8_MMA(0, 1, At, B1); PG8_BAR;
            PG8_LDA(At, 0, 1); PG8_STAGE(PG8_SA(0, 0), a2, voffA);
            PG8_BAR; PG8_WAIT_L(0); PG8_MMA(1, 0, At, B0); PG8_BAR; PG8_SCHED;
            PG8_STAGE(PG8_SB(0, 1), b2 + hstep, voffB);
            PG8_WAIT_V(6); PG8_BAR; PG8_MMA(1, 1, At, B1); PG8_BAR;
            PG8_LDB(B0, 1, 0); PG8_SCHED; PG8_LDA(At, 1, 0); PG8_STAGE(PG8_SA(0, 1), a2 + hstep, voffA);
            PG8_WAIT_L(8); PG8_BAR; PG8_WAIT_L(0); PG8_MMA(0, 0, At, B0); PG8_BAR; PG8_SCHED;
            PG8_LDB(B1, 1, 1); PG8_STAGE(PG8_SB(1, 0), b3, voffB);
            PG8_BAR; PG8_WAIT_L(0); PG8_MMA(0, 1, At, B1); PG8_BAR;
            PG8_LDA(At, 1, 1); PG8_STAGE(PG8_SA(1, 0), a3, voffA);
            PG8_BAR; PG8_WAIT_L(0); PG8_MMA(1, 0, At, B0); PG8_BAR; PG8_SCHED;
            PG8_STAGE(PG8_SB(1, 1), b3 + hstep, voffB);
            PG8_WAIT_V(6); PG8_BAR; PG8_MMA(1, 1, At, B1); PG8_BAR;
        }
        PG8_STAMP();
        if constexpr (!Epi::AFTER_DRAIN) { E(acc, cur, wr, wc, fr, fq); S.done(cur); }
        PG8_STAMP();
        if (!has_next) break;
#pragma unroll
        for (int a = 0; a < 2; ++a)
#pragma unroll
            for (int b = 0; b < 2; ++b)
#pragma unroll
                for (int m = 0; m < 4; ++m)
#pragma unroll
                    for (int n = 0; n < 2; ++n) acc[a][b][m][n] = (f32x4){0.f, 0.f, 0.f, 0.f};
        cur = nxt; cA = nA; cB = nB; ++ui;
    }
    PG8_WAIT_V(0);
    if (wr == 0) PG8_BAR;
    PG8_BAR;
    if constexpr (Epi::AFTER_DRAIN) { E.fused(acc, cur, wr, wc, fr, fq, lds, wid, lane); S.done(cur); }
    PG8_STAMP();
    if (STAMP && wid == 0) { stamps[lane] = lane < nts ? (((unsigned long long)(unsigned)ts_hi << 32) | (unsigned)ts_lo) : 0ull;
        if (lane == 62) stamps[62] = rt_entry; if (lane == 63) stamps[63] = (unsigned long long)wall_clock64(); }
#undef PG8_STAMP
#undef PG8_SA
#undef PG8_SB
#undef PG8_STAGE
#undef PG8_LDA
#undef PG8_LDB
#undef PG8_MMA
#undef PG8_WAIT_V
#undef PG8_WAIT_L
#undef PG8_BAR
#undef PG8_SCHED
}
}

struct EpiProj {
  static constexpr bool PERM = false, AFTER_DRAIN = false;
  float* out; char* ws;
  __device__ __forceinline__ void operator()(const pg8::f32x4 (&acc)[2][2][4][2], const pg8::Unit& u, int wr, int wc, int fr, int fq) const {
    asm volatile("" : "+v"(fr), "+v"(fq));
    char* ob = (char*)out;
    const int n0 = u.pn * 256;
    int seg, sbase;
    if (n0 < 256) { seg = 0; sbase = 0; } else if (n0 < 512) { seg = 1; sbase = 256; } else if (n0 < 768) { seg = 2; sbase = 512; }
    else if (n0 < 1280) { seg = 3; sbase = 768; } else if (n0 < 1792) { seg = 4; sbase = 1280; } else if (n0 < 2304) { seg = 5; sbase = 1792; }
    else if (n0 < 2560) { seg = 6; sbase = 2304; } else { seg = 7; sbase = 2560; }
    const bool smp = u.pm >= NTOKP / 256;
    const float2* rope = (const float2*)(ws + WS_ROPE);
    const int fi = 16 * (wc & 1) + 4 * fq;
#pragma unroll
    for (int ai = 0; ai < 2; ++ai)
#pragma unroll
      for (int m = 0; m < 4; ++m) {
        const int row = 128 * ai + 64 * wr + 16 * m + fr;
        const unsigned tok = (unsigned)(u.pm * 256 + row);
        const unsigned ts = tok - (unsigned)NTOKP;
        float4 c01, s01, c23, s23;
        if (seg == 3 || seg == 4) {
          const int pos = smp ? (PAST + (int)(ts & 15)) : (int)(tok & (SEQ - 1));
          const float4 r0 = *(const float4*)(rope + pos * 32 + fi), r1 = *(const float4*)(rope + pos * 32 + fi + 2);
          c01 = make_float4(r0.x, r0.z, r1.x, r1.z); s01 = make_float4(r0.y, r0.w, r1.y, r1.w);
        }
#pragma unroll
        for (int bj = 0; bj < 2; ++bj) {
          const int blk = 4 * u.pn + 2 * bj + (wc >> 1);
          const int col = 64 * blk + fi - sbase;
          pg8::f32x4 v0 = acc[ai][bj][m][0], v1 = acc[ai][bj][m][1];
          if (seg == 3 || seg == 4) {
            const pg8::f32x4 cc = {c01.x, c01.y, c01.z, c01.w}, ss = {s01.x, s01.y, s01.z, s01.w};
            const pg8::f32x4 a = v0 * cc - v1 * ss, b = v1 * cc + v0 * ss;
            v0 = a; v1 = b;
          }
          if (seg == 0 || seg == 3 || seg == 6) {
            bf16_t* q = (seg == 0) ? (bf16_t*)(ob + OB_AQ) + tok * 256 : (seg == 3) ? (bf16_t*)(ob + OB_BQ) + tok * 512 : (bf16_t*)(ob + OB_MQ) + tok * 256;
            u32x2 w0, w1; w0.x = cvtpk(v0[0] * QSCALE, v0[1] * QSCALE); w0.y = cvtpk(v0[2] * QSCALE, v0[3] * QSCALE);
            w1.x = cvtpk(v1[0] * QSCALE, v1[1] * QSCALE); w1.y = cvtpk(v1[2] * QSCALE, v1[3] * QSCALE);
            *(u32x2*)(q + col) = w0; *(u32x2*)(q + col + 32) = w1;
          } else if (seg == 7) {
            bf16_t* g = (bf16_t*)(ws + WS_G) + tok * 1024;
            float a[4], b[4];
#pragma unroll
            for (int j = 0; j < 4; ++j) { a[j] = v0[j] * __builtin_amdgcn_rcpf(1.f + __expf(-v0[j])); b[j] = v1[j] * __builtin_amdgcn_rcpf(1.f + __expf(-v1[j])); }
            u32x2 w0, w1; w0.x = cvtpk(a[0], a[1]); w0.y = cvtpk(a[2], a[3]); w1.x = cvtpk(b[0], b[1]); w1.y = cvtpk(b[2], b[3]);
            *(u32x2*)(g + col) = w0; *(u32x2*)(g + col + 32) = w1;
          } else {
            const bool wide = (seg >= 4);
            const int W = wide ? 512 : 256;
            bf16_t* kw; float* o = nullptr;
            if (!smp) {
              if (seg == 1) kw = (bf16_t*)(ob + OB_AK) + tok * 256; else if (seg == 2) kw = (bf16_t*)(ob + OB_AV) + tok * 256;
              else if (seg == 4) kw = (bf16_t*)(ob + OB_BK) + tok * 512; else kw = (bf16_t*)(ws + WS_BV) + tok * 512;
              if (wide) o = out + (seg == 4 ? O_BKP : O_BVP) + tok * 512;
              else { const unsigned ps = tok & (SEQ - 1), pb = tok >> 13; if (ps >= (unsigned)(SEQ - RA)) o = out + (seg == 1 ? O_AKP : O_AVP) + (pb * RA + ps - (SEQ - RA)) * 256u; }
            } else {
              kw = nullptr;
              if (wide) o = out + (seg == 4 ? O_BKS : O_BVS) + ts * 512; else o = out + (seg == 1 ? O_AKS : O_AVS) + ts * 256;
            }
            (void)W;
            u32x2 w0, w1; w0.x = cvtpk(v0[0], v0[1]); w0.y = cvtpk(v0[2], v0[3]); w1.x = cvtpk(v1[0], v1[1]); w1.y = cvtpk(v1[2], v1[3]);
            if (kw) { *(u32x2*)(kw + col) = w0; *(u32x2*)(kw + col + 32) = w1; }
            if (o) { __builtin_nontemporal_store(v0, (pg8::f32x4*)(o + col)); __builtin_nontemporal_store(v1, (pg8::f32x4*)(o + col + 32)); }
          }
        }
      }
  }
};

struct EpiOut {
  static constexpr bool PERM = false, AFTER_DRAIN = false;
  bf16_t* ypre; const float* xp; const float* xs;
  __device__ __forceinline__ void operator()(const pg8::f32x4 (&acc)[2][2][4][2], const pg8::Unit& u, int wr, int wc, int fr, int fq) const {
    asm volatile("" : "+v"(fr), "+v"(fq));
    const float* xb = (u.pm < NTOKP / 256) ? xp + (long)u.pm * 256 * 1024 : xs + (long)(u.pm - NTOKP / 256) * 256 * 1024;
    bf16_t* yb = ypre + (long)u.pm * 256 * 1024;
    const int col0 = u.pn * 256 + wc * 32 + 4 * fq;
#pragma unroll
    for (int ai = 0; ai < 2; ++ai)
#pragma unroll
      for (int mp = 0; mp < 2; ++mp) {
        pg8::f32x4 xv[2][2][2];
#pragma unroll
        for (int mm = 0; mm < 2; ++mm) {
          const unsigned ro = (unsigned)((128 * ai + 64 * wr + 16 * (2 * mp + mm) + fr) * 1024 + col0);
#pragma unroll
          for (int bj = 0; bj < 2; ++bj)
#pragma unroll
            for (int n = 0; n < 2; ++n) xv[mm][bj][n] = __builtin_nontemporal_load((const pg8::f32x4*)(xb + ro + bj * 128 + n * 16));
        }
#pragma unroll
        for (int mm = 0; mm < 2; ++mm) {
          const unsigned ro = (unsigned)((128 * ai + 64 * wr + 16 * (2 * mp + mm) + fr) * 1024 + col0);
#pragma unroll
          for (int bj = 0; bj < 2; ++bj)
#pragma unroll
            for (int n = 0; n < 2; ++n) { const pg8::f32x4 y = acc[ai][bj][2 * mp + mm][n] + ALPHA * xv[mm][bj][n]; u32x2 w; w.x = cvtpk(y[0], y[1]); w.y = cvtpk(y[2], y[3]); *(u32x2*)(yb + ro + bj * 128 + n * 16) = w; }
        }
      }
  }
};

DI void mem_epilogue(const Params& p, int mt, int nt, f32x16 (&acc)[2][2]) {
  const int tid = threadIdx.x, lane = tid & 63, w = tid >> 6, wm = w >> 2, wn = w & 3, c = lane & 31, h = lane >> 5;
  const int n0 = nt * 256 + wn * 64;
  const bool isv = n0 >= 256;
  const int cb = isv ? n0 - 256 : n0;
  bf16_t* kw = (bf16_t*)(p.ws + (isv ? WS_MV : WS_MK));
  float* o = p.out + (isv ? O_MVP : O_MKP);
#pragma unroll
  for (int mi = 0; mi < 2; ++mi)
#pragma unroll
    for (int i = 0; i < 16; ++i) {
      const long row = mt * 128 + wm * 64 + mi * 32 + (i & 3) + 8 * (i >> 2) + 4 * h;
      const float v0 = acc[mi][0][i], v1 = acc[mi][1][i];
      kw[row * 256 + cb + c] = f2bf(v0); kw[row * 256 + cb + c + 32] = f2bf(v1);
      o[row * 256 + cb + c] = v0; o[row * 256 + cb + c + 32] = v1;
    }
}

DI void phase1(const Params& p) {
  const int G = gridDim.x;
  const bf16_t* winT = (const bf16_t*)(p.ws + WS_WINT); const bf16_t* wmemT = (const bf16_t*)(p.ws + WS_WMEMT);
  const bf16_t* XB = (const bf16_t*)(p.ws + WS_XB); const bf16_t* MB = (const bf16_t*)(p.ws + WS_MB);
  {
    pg8::Gemm g; g.A = XB; g.Bt = winT; g.M = NTOK; g.N = PROJ; g.K = 1024;
    pg8::StaticOrder S; S.init(NTOK, PROJ, G, (int)blockIdx.x);
    EpiProj E; E.out = p.out; E.ws = p.ws;
    pg8::gemm_phase<EpiProj, pg8::StaticOrder, false>((PG8_LAS unsigned char*)g_lds_all, g, S, E, nullptr);
  }
  __syncthreads();
  constexpr int T2 = 8 * 2;
  f32x16 acc[2][2];
  for (int t = (int)blockIdx.x - 64; t >= 0 && t < T2; t += G) {
    const int mt = t >> 1, nt = t & 1;
    gemm_core(MB + (long)mt * 128 * 1024, 1024, wmemT + (long)nt * 256 * 1024, 1024, 1024, acc);
    mem_epilogue(p, mt, nt, acc);
  }
}

struct AttnItem {
  const bf16_t* q0; const bf16_t* q1;
  const bf16_t* k; const bf16_t* v;
  bf16_t* g0; bf16_t* g1;
  int qs, ks, ntiles, nkeys;
  int tlo0, thi0, tlo1, thi1;
  int rows0, rows1;
  int qpos0, qpos1, kpos0, head0; bool bias;
  const float* kf; const float* vf;
  const float* kn; const float* vn;
  int ncache;
};
constexpr int AK_RS = 272, AK_BYTES = 64 * AK_RS, AV_BYTES = 16384, A_BUF = AK_BYTES + AV_BYTES;
constexpr int A_BIAS_OFF = 2 * A_BUF;
constexpr int A_ITEM_OFF = 2 * TEAM_LDS;
constexpr int A_Q_OFF = 73728;

template <bool DIFF, bool BIAS, bool MASK, bool F32>
DI void attn_item(const AttnItem& it, float lam, const float* __restrict__ subg) {
  const int tid = threadIdx.x, lane = tid & 63, w = tid >> 6, r = lane & 31, h = lane >> 5;
  const int half = __builtin_amdgcn_readfirstlane(w >> 2), qh = w & 1, m = (w >> 1) & 1;
  constexpr int NDT = DIFF ? 4 : 2;
  const int ntiles = it.ntiles;
  const int tlo = half ? it.tlo1 : it.tlo0, thi = half ? it.thi1 : it.thi0, rows = half ? it.rows1 : it.rows0;
  const bf16_t* qbase = half ? it.q1 : it.q0;
  bf16_t* gbase = half ? it.g1 : it.g0;
  char* qlds = g_lds_all + A_Q_OFF + w * 4096 + lane * 16;
  {
    const bf16_t* qp = qbase + (long)(qh * 32 + r) * it.qs + m * 64 + 8 * h;
#pragma unroll
    for (int s = 0; s < 4; ++s) *(bf16x8*)(qlds + s * 1024) = *(const bf16x8*)(qp + 16 * s);
  }
  f32x16 oacc[NDT];
#pragma unroll
  for (int d = 0; d < NDT; ++d)
#pragma unroll
    for (int i = 0; i < 16; ++i) oacc[d][i] = 0.f;
  float m_run = -1e30f, l_run = 0.f;
  u32x4 rk0[2], rv0[2];
  float4 fk[4], fv[4];
  const int kch = tid & 15, krow = tid >> 4, vsub = tid & 3, vkey = (tid >> 2) & 63, vd = tid >> 8;
  const bf16_t* kg = it.k + (long)krow * it.ks + kch * 8;
  const bf16_t* vg = it.v + (long)vkey * it.ks + vd * 32 + vsub * 8;
#define A_LOAD(RK, RV, t)                                                                                        \
  if (!F32) {                                                                                                    \
    _Pragma("unroll") for (int i = 0; i < 2; ++i) RK[i] = *(const u32x4*)(kg + (long)((t) * 64 + 32 * i) * it.ks); \
    _Pragma("unroll") for (int i = 0; i < 2; ++i) RV[i] = *(const u32x4*)(vg + (long)((t) * 64) * it.ks + 64 * i); \
  } else {                                                                                                       \
    const bool nw = (t) >= it.ncache;             \
    _Pragma("unroll") for (int i = 0; i < 2; ++i) {                                                              \
      const int kr = krow + 32 * i;                                                                              \
      const float* src = nw ? it.kn + (long)(kr < 15 ? kr : 15) * it.ks : it.kf + (long)((t) * 64 + kr) * it.ks; \
      fk[2 * i] = *(const float4*)(src + kch * 8); fk[2 * i + 1] = *(const float4*)(src + kch * 8 + 4);          \
    }                                                                                                            \
    {                                                                                                            \
      const float* src = nw ? it.vn + (long)(vkey < 15 ? vkey : 15) * it.ks : it.vf + (long)((t) * 64 + vkey) * it.ks; \
      _Pragma("unroll") for (int i = 0; i < 2; ++i) {                                                            \
        fv[2 * i] = *(const float4*)(src + (vd + 2 * i) * 32 + vsub * 8); fv[2 * i + 1] = *(const float4*)(src + (vd + 2 * i) * 32 + vsub * 8 + 4); \
      }                                                                                                          \
    }                                                                                                            \
  }
#define A_WRITE(RK, RV, stage)                                                                                   \
  {                                                                                                              \
    char* Kb_ = g_lds_all + (stage) * A_BUF; char* Vb_ = Kb_ + AK_BYTES;                                         \
    if (F32) {                                                                                                   \
      _Pragma("unroll") for (int i = 0; i < 2; ++i) {                                                            \
        RK[i].x = cvtpk(fk[2 * i].x, fk[2 * i].y); RK[i].y = cvtpk(fk[2 * i].z, fk[2 * i].w); RK[i].z = cvtpk(fk[2 * i + 1].x, fk[2 * i + 1].y); RK[i].w = cvtpk(fk[2 * i + 1].z, fk[2 * i + 1].w); \
        RV[i].x = cvtpk(fv[2 * i].x, fv[2 * i].y); RV[i].y = cvtpk(fv[2 * i].z, fv[2 * i].w); RV[i].z = cvtpk(fv[2 * i + 1].x, fv[2 * i + 1].y); RV[i].w = cvtpk(fv[2 * i + 1].z, fv[2 * i + 1].w); \
      }                                                                                                          \
    }                                                                                                            \
    _Pragma("unroll") for (int i = 0; i < 2; ++i) *(u32x4*)(Kb_ + (krow + 32 * i) * AK_RS + kch * 16) = RK[i];   \
    _Pragma("unroll") for (int i = 0; i < 2; ++i) *(u32x4*)(Vb_ + (vd + 2 * i) * 4096 + vkey * 64 + vsub * 16) = RV[i]; \
  }
  const int vlane = ((lane >> 4) & 1) * 32 + (lane & 3) * 8 + (4 * h + ((lane & 15) >> 2)) * 64;
  const float* biasT = (const float*)(g_lds_all + A_BIAS_OFF) + (it.head0 + m) * 257;
  const int qpos = (half ? it.qpos1 : it.qpos0) + qh * 32 + r;
#define A_COMPUTE(t, stage)                                                                                      \
  if ((t) >= tlo && (t) < thi) {                                                                                 \
    const char* Kb = g_lds_all + (stage) * A_BUF; const char* Vb = Kb + AK_BYTES;                                \
    f32x16 s0, s1;                                                                                               \
    _Pragma("unroll") for (int i = 0; i < 16; ++i) { s0[i] = 0.f; s1[i] = 0.f; }                                 \
    _Pragma("unroll") for (int s = 0; s < 4; ++s) {                                                              \
      const int co = (m * 64 + 16 * s + 8 * h) * 2;                                                              \
      const bf16x8 k0 = *(const bf16x8*)(Kb + r * AK_RS + co);                                                   \
      const bf16x8 k1 = *(const bf16x8*)(Kb + (32 + r) * AK_RS + co);                                            \
      const bf16x8 qfs = *(const bf16x8*)(qlds + s * 1024);                                                      \
      s0 = MFMA32(k0, qfs, s0);                                                                                  \
      s1 = MFMA32(k1, qfs, s1);                                                                                  \
    }                                                                                                            \
    if (BIAS) {                                                                                                  \
      const int kb = it.kpos0 + (t) * 64 + 4 * h;                                                                \
      _Pragma("unroll") for (int i = 0; i < 16; ++i) {                                                           \
        const int kk = kb + (i & 3) + 8 * (i >> 2);                                                              \
        int d0 = qpos - kk, d1 = d0 - 32;                                                                        \
        d0 = min(max(d0, -128), 128) + 128; d1 = min(max(d1, -128), 128) + 128;                                  \
        s0[i] += biasT[d0]; s1[i] += biasT[d1];                                                                  \
      }                                                                                                          \
    }                                                                                                            \
    if (MASK && ((t) + 1) * 64 > it.nkeys) {                                                                     \
      const int kb = (t) * 64 + 4 * h;                                                                           \
      _Pragma("unroll") for (int i = 0; i < 16; ++i) {                                                           \
        const int kk = kb + (i & 3) + 8 * (i >> 2);                                                              \
        if (kk >= it.nkeys) s0[i] = -1e30f;                                                                      \
        if (kk + 32 >= it.nkeys) s1[i] = -1e30f;                                                                 \
      }                                                                                                          \
    }                                                                                                            \
    float mxa = fmaxf(s0[0], s1[0]), mxb = fmaxf(s0[1], s1[1]);                                                  \
    _Pragma("unroll") for (int i = 2; i < 16; i += 2) { mxa = fmaxf(fmaxf(mxa, s0[i]), s1[i]); mxb = fmaxf(fmaxf(mxb, s0[i + 1]), s1[i + 1]); } \
    float mx = fmaxf(mxa, mxb);                                                                                  \
    mx = fmaxf(mx, xor32f(mx));                                                                                  \
    const float m_new = (mx > m_run + 8.f) ? mx : m_run;     \
    const float alpha = fexp2(m_run - m_new);                                                                    \
    if (__builtin_amdgcn_ballot_w64(m_new > m_run) != 0ull) {                                                    \
      _Pragma("unroll") for (int d = 0; d < NDT; ++d)                                                            \
        _Pragma("unroll") for (int i = 0; i < 16; ++i) oacc[d][i] *= alpha;                                      \
    }                                                                                                            \
    l_run *= alpha;                                                                                              \
    m_run = m_new;                                                                                               \
    float ls = 0.f;                                                                                              \
    _Pragma("unroll") for (int i = 0; i < 16; ++i) { s0[i] = fexp2(s0[i] - m_new); s1[i] = fexp2(s1[i] - m_new); ls += s0[i] + s1[i]; } \
    l_run += ls;                                                                                                 \
    bf16x8 pf[4];                                                                                                \
    _Pragma("unroll") for (int s2 = 0; s2 < 2; ++s2) {                                                           \
      u32x4 a, b;                                                                                                \
      a.x = cvtpk(s0[8 * s2 + 0], s0[8 * s2 + 1]); a.y = cvtpk(s0[8 * s2 + 2], s0[8 * s2 + 3]);                  \
      a.z = cvtpk(s0[8 * s2 + 4], s0[8 * s2 + 5]); a.w = cvtpk(s0[8 * s2 + 6], s0[8 * s2 + 7]);                  \
      b.x = cvtpk(s1[8 * s2 + 0], s1[8 * s2 + 1]); b.y = cvtpk(s1[8 * s2 + 2], s1[8 * s2 + 3]);                  \
      b.z = cvtpk(s1[8 * s2 + 4], s1[8 * s2 + 5]); b.w = cvtpk(s1[8 * s2 + 6], s1[8 * s2 + 7]);                  \
      pf[s2] = __builtin_bit_cast(bf16x8, a); pf[2 + s2] = __builtin_bit_cast(bf16x8, b);                        \
    }                                                                                                            \
    const LDS3 char* vb3 = (const LDS3 char*)(Vb) + vlane + (DIFF ? 0 : m * 2 * 4096);                           \
    _Pragma("unroll") for (int ks = 0; ks < 4; ++ks) {                                                           \
      _Pragma("unroll") for (int d = 0; d < NDT; ++d) {                                                          \
        const s16x4 lo = __builtin_bit_cast(s16x4, __builtin_amdgcn_ds_read_tr16_b64_v4i16((LDS3 s16x4*)(vb3 + d * 4096 + ks * 1024))); \
        const s16x4 hi = __builtin_bit_cast(s16x4, __builtin_amdgcn_ds_read_tr16_b64_v4i16((LDS3 s16x4*)(vb3 + d * 4096 + ks * 1024 + 512))); \
        const bf16x8 vf = __builtin_shufflevector(lo, hi, 0, 1, 2, 3, 4, 5, 6, 7);                               \
        oacc[d] = MFMA32(vf, pf[ks], oacc[d]);                                                                   \
      }                                                                                                          \
      __builtin_amdgcn_sched_barrier(0);                                                                         \
    }                                                                                                            \
  }
  A_LOAD(rk0, rv0, 0);
  A_WRITE(rk0, rv0, 0);
  if (ntiles > 1) A_LOAD(rk0, rv0, 1);
  __syncthreads();
#pragma unroll 1
  for (int t = 0; t < ntiles; ++t) {
    const int par = t & 1;
    if (t + 1 < ntiles) A_WRITE(rk0, rv0, par ^ 1);
    if (t + 2 < ntiles) A_LOAD(rk0, rv0, t + 2);
    A_COMPUTE(t, par);
    __syncthreads();
  }
#undef A_LOAD
#undef A_WRITE
#undef A_COMPUTE
  const float l_tot = l_run + xor32f(l_run);
  const float inv = 1.f / l_tot;
  const int q = qh * 32 + r;
  if (!DIFF) {
    if (q < rows) {
      bf16_t* gp = gbase + (long)q * 1024 + m * 64 + 4 * h;
      u32x2 gvv[NDT][4];
#pragma unroll
      for (int d = 0; d < NDT; ++d)
#pragma unroll
        for (int g4 = 0; g4 < 4; ++g4) gvv[d][g4] = *(const u32x2*)(gp + d * 32 + 8 * g4);
#pragma unroll
      for (int d = 0; d < NDT; ++d)
#pragma unroll
        for (int g4 = 0; g4 < 4; ++g4) {
          u32x2* ptr = (u32x2*)(gp + d * 32 + 8 * g4);
          const u32x2 gv = gvv[d][g4];
          u32x2 o;
          o.x = cvtpk(oacc[d][4 * g4 + 0] * inv * bflo(gv.x), oacc[d][4 * g4 + 1] * inv * bfhi(gv.x));
          o.y = cvtpk(oacc[d][4 * g4 + 2] * inv * bflo(gv.y), oacc[d][4 * g4 + 3] * inv * bfhi(gv.y));
          *ptr = o;
        }
    }
  } else {
    float* xb = (float*)g_lds_all + half * 8192 + qh * 4096 + lane;
    if (m == 1) {
      const float sc = lam * inv;
#pragma unroll
      for (int d = 0; d < NDT; ++d)
#pragma unroll
        for (int i = 0; i < 16; ++i) xb[(d * 16 + i) * 64] = oacc[d][i] * sc;
    }
    __syncthreads();
    if (m == 0) {
      float ss = 0.f;
#pragma unroll
      for (int d = 0; d < NDT; ++d)
#pragma unroll
        for (int i = 0; i < 16; ++i) { const float o = oacc[d][i] * inv - xb[(d * 16 + i) * 64]; oacc[d][i] = o; ss += o * o; }
      ss += xor32f(ss);
      const float rn = rsqrtf(ss * (1.f / 128.f) + 1e-5f) * 0.8f;
      if (q < rows) {
        bf16_t* gp = gbase + (long)q * 1024 + 4 * h;
        u32x2 gvv[NDT][4];
#pragma unroll
        for (int d = 0; d < NDT; ++d)
#pragma unroll
          for (int g4 = 0; g4 < 4; ++g4) gvv[d][g4] = *(const u32x2*)(gp + d * 32 + 8 * g4);
#pragma unroll
        for (int d = 0; d < NDT; ++d)
#pragma unroll
          for (int g4 = 0; g4 < 4; ++g4) {
            const float4 sg = *(const float4*)(subg + d * 32 + 8 * g4 + 4 * h);
            u32x2* ptr = (u32x2*)(gp + d * 32 + 8 * g4);
            const u32x2 gv = gvv[d][g4];
            u32x2 o;
            o.x = cvtpk(oacc[d][4 * g4 + 0] * rn * sg.x * bflo(gv.x), oacc[d][4 * g4 + 1] * rn * sg.y * bfhi(gv.x));
            o.y = cvtpk(oacc[d][4 * g4 + 2] * rn * sg.z * bflo(gv.y), oacc[d][4 * g4 + 3] * rn * sg.w * bfhi(gv.y));
            *ptr = o;
          }
      }
    }
    __syncthreads();
  }
}

DI void phase2(const Params& p) {
  char* ws = p.ws;
  float* biasT = (float*)(g_lds_all + A_BIAS_OFF);
  for (int i = threadIdx.x; i < 4 * 257; i += 512) biasT[i] = p.relb[i] * LOG2E;
  float s1 = 0.f, s2 = 0.f;
  for (int i = 0; i < 64; ++i) { s1 += p.dlam[i] * p.dlam[64 + i]; s2 += p.dlam[128 + i] * p.dlam[192 + i]; }
  const float lam = expf(s1) - expf(s2) + 0.2f;
  __syncthreads();
  int* ctr = (int*)(ws + WS_CTR);
  int* s_item = (int*)(g_lds_all + A_ITEM_OFF);
  const char* ob = (const char*)p.out;
  const bf16_t* AQ = (const bf16_t*)(ob + OB_AQ); const bf16_t* AK = (const bf16_t*)(ob + OB_AK); const bf16_t* AV = (const bf16_t*)(ob + OB_AV);
  const bf16_t* BQ = (const bf16_t*)(ob + OB_BQ); const bf16_t* BK = (const bf16_t*)(ob + OB_BK); const bf16_t* BV = (const bf16_t*)(ws + WS_BV);
  const bf16_t* MQ = (const bf16_t*)(ob + OB_MQ); const bf16_t* MK = (const bf16_t*)(ws + WS_MK); const bf16_t* MV = (const bf16_t*)(ws + WS_MV);
  bf16_t* G = (bf16_t*)(ws + WS_G);
  constexpr int N_BP = 1024, N_BS = 128, N_AP = 512, N_AS = 64, N_MP = 512, N_MS = 64;
  constexpr int N_ALL = N_BP + N_BS + N_AP + N_AS + N_MP + N_MS;
  for (;;) {
    if (threadIdx.x == 0) *s_item = atomicAdd(ctr, 1);
    __syncthreads();
    int item = *s_item;
    __syncthreads();
    if (item >= N_ALL) break;
    AttnItem it;
    it.bias = false; it.qpos0 = 0; it.qpos1 = 0; it.kpos0 = 0; it.head0 = 0; it.rows0 = 64; it.rows1 = 64;
    it.kf = nullptr; it.vf = nullptr; it.kn = nullptr; it.vn = nullptr; it.ncache = 0; it.k = nullptr; it.v = nullptr;
    if (item < N_BP) {
      const int j = 63 - (item >> 4), bh = item & 15, b = bh >> 2, hh = bh & 3;
      const long tok0 = (long)b * SEQ + j * 128;
      it.q0 = BQ + tok0 * 512 + hh * 128; it.q1 = it.q0 + 64 * 512;
      it.k = BK + (long)b * SEQ * 512 + hh * 128; it.v = BV + (long)b * SEQ * 512 + hh * 128;
      it.qs = 512; it.ks = 512; it.ntiles = 2 * j + 2; it.nkeys = it.ntiles * 64;
      it.tlo0 = 0; it.thi0 = 2 * j + 1; it.tlo1 = 0; it.thi1 = 2 * j + 2;
      it.g0 = G + tok0 * 1024 + 256 + hh * 128; it.g1 = it.g0 + 64 * 1024;
      attn_item<true, false, false, false>(it, lam, p.subg);
      continue;
    }
    item -= N_BP;
    if (item < N_BS) {
      const int b = item >> 2, hh = item & 3;
      const long tok0 = NTOKP + b * ST;
      it.q0 = BQ + tok0 * 512 + hh * 128; it.q1 = it.q0;
      it.kf = p.cbk + (long)b * PAST * 512 + hh * 128; it.vf = p.cbv + (long)b * PAST * 512 + hh * 128; it.ncache = PAST / 64;
      it.kn = p.out + O_BKS + (long)b * ST * 512 + hh * 128; it.vn = p.out + O_BVS + (long)b * ST * 512 + hh * 128;
      it.qs = 512; it.ks = 512; it.ntiles = 17; it.nkeys = PAST + ST;
      it.tlo0 = 0; it.thi0 = 17; it.tlo1 = 0; it.thi1 = 0; it.rows0 = ST; it.rows1 = 0;
      it.g0 = G + tok0 * 1024 + 256 + hh * 128; it.g1 = it.g0;
      attn_item<true, false, true, true>(it, lam, p.subg);
      continue;
    }
    item -= N_BS;
    if (item < N_AP) {
      const int j = 63 - (item >> 3), bh = item & 7, b = bh >> 1, hp = bh & 1;
      const int c0 = 2 * j, c1 = c0 + 1, cs0 = c0 > 8 ? c0 - 8 : 0, cs1 = c1 > 8 ? c1 - 8 : 0;
      const long tok0 = (long)b * SEQ + c0 * 64, k0 = (long)b * SEQ + cs0 * 64;
      it.q0 = AQ + tok0 * 256 + hp * 128; it.q1 = it.q0 + 64 * 256;
      it.k = AK + k0 * 256 + hp * 128; it.v = AV + k0 * 256 + hp * 128;
      it.qs = 256; it.ks = 256; it.ntiles = c1 - cs0 + 1; it.nkeys = it.ntiles * 64;
      it.tlo0 = 0; it.thi0 = c0 - cs0 + 1; it.tlo1 = cs1 - cs0; it.thi1 = it.ntiles;
      it.g0 = G + tok0 * 1024 + hp * 128; it.g1 = it.g0 + 64 * 1024;
      it.bias = true; it.qpos0 = c0 * 64; it.qpos1 = c1 * 64; it.kpos0 = cs0 * 64; it.head0 = hp * 2;
    } else if ((item -= N_AP) < N_AS) {
      const int b = item >> 1, hp = item & 1;
      const long tok0 = NTOKP + b * ST;
      it.q0 = AQ + tok0 * 256 + hp * 128; it.q1 = it.q0;
      it.kf = p.cak + (long)b * RA * 256 + hp * 128; it.vf = p.cav + (long)b * RA * 256 + hp * 128; it.ncache = RA / 64;
      it.kn = p.out + O_AKS + (long)b * ST * 256 + hp * 128; it.vn = p.out + O_AVS + (long)b * ST * 256 + hp * 128;
      it.qs = 256; it.ks = 256; it.ntiles = 9; it.nkeys = RA + ST;
      it.tlo0 = 0; it.thi0 = 9; it.tlo1 = 0; it.thi1 = 0; it.rows0 = ST; it.rows1 = 0;
      it.g0 = G + tok0 * 1024 + hp * 128; it.g1 = it.g0;
      it.bias = true; it.qpos0 = RA; it.qpos1 = RA; it.kpos0 = 0; it.head0 = hp * 2;
    } else if ((item -= N_AS) < N_MP) {
      const int j = item >> 3, bh = item & 7, b = bh >> 1, hp = bh & 1;
      const long tok0 = (long)b * SEQ + j * 128;
      it.q0 = MQ + tok0 * 256 + hp * 128; it.q1 = it.q0 + 64 * 256;
      it.k = MK + (long)b * NMEM * 256 + hp * 128; it.v = MV + (long)b * NMEM * 256 + hp * 128;
      it.qs = 256; it.ks = 256; it.ntiles = 4; it.nkeys = NMEM;
      it.tlo0 = 0; it.thi0 = 4; it.tlo1 = 0; it.thi1 = 4;
      it.g0 = G + tok0 * 1024 + 768 + hp * 128; it.g1 = it.g0 + 64 * 1024;
    } else {
      item -= N_MP;
      const int b = item >> 1, hp = item & 1;
      const long tok0 = NTOKP + b * ST;
      it.q0 = MQ + tok0 * 256 + hp * 128; it.q1 = it.q0;
      it.kf = p.cmk + (long)b * NMEM * 256 + hp * 128; it.vf = p.cmv + (long)b * NMEM * 256 + hp * 128; it.ncache = NMEM / 64;
      it.kn = it.kf; it.vn = it.vf;
      it.qs = 256; it.ks = 256; it.ntiles = 4; it.nkeys = NMEM;
      it.tlo0 = 0; it.thi0 = 4; it.tlo1 = 0; it.thi1 = 0; it.rows0 = ST; it.rows1 = 0;
      it.g0 = G + tok0 * 1024 + 768 + hp * 128; it.g1 = it.g0;
    }
    const bool f32src = it.kf != nullptr;
    if (it.bias) { if (f32src) attn_item<false, true, true, true>(it, lam, p.subg); else attn_item<false, true, false, false>(it, lam, p.subg); }
    else { if (f32src) attn_item<false, false, false, true>(it, lam, p.subg); else attn_item<false, false, false, false>(it, lam, p.subg); }
  }
}

DI void phase3(const Params& p) {
  pg8::Gemm g; g.A = (const bf16_t*)(p.ws + WS_G); g.Bt = (const bf16_t*)(p.ws + WS_WOUTT); g.M = NTOK; g.N = 1024; g.K = 1024;
  pg8::StaticOrder S; S.init(NTOK, 1024, (int)gridDim.x, (int)blockIdx.x);
  EpiOut E; E.ypre = (bf16_t*)(p.ws + WS_XB); E.xp = p.xp; E.xs = p.xs;
  pg8::gemm_phase<EpiOut, pg8::StaticOrder, false>((PG8_LAS unsigned char*)g_lds_all, g, S, E, nullptr);
  __syncthreads();
}

DI void phase4(const Params& p) {
  const int lane = threadIdx.x & 63, w = threadIdx.x >> 6;
  float4 g[4], bb[4];
#pragma unroll
  for (int j = 0; j < 4; ++j) { g[j] = *(const float4*)(p.ln_g + j * 256 + lane * 4); bb[j] = *(const float4*)(p.ln_b + j * 256 + lane * 4); }
  for (int row0 = (blockIdx.x * 8 + w) * 4; row0 < NTOK; row0 += gridDim.x * 32) {
    float4 v[4][4];
#pragma unroll
    for (int rr = 0; rr < 4; ++rr)
#pragma unroll
      for (int j = 0; j < 4; ++j) { const u32x2 w = __builtin_nontemporal_load((const u32x2*)((const bf16_t*)(p.ws + WS_XB) + (long)(row0 + rr) * 1024 + j * 256 + lane * 4)); v[rr][j] = make_float4(bflo(w.x), bfhi(w.x), bflo(w.y), bfhi(w.y)); }
    float s[4], q[4];
#pragma unroll
    for (int rr = 0; rr < 4; ++rr) { s[rr] = 0.f;
#pragma unroll
      for (int j = 0; j < 4; ++j) s[rr] += v[rr][j].x + v[rr][j].y + v[rr][j].z + v[rr][j].w; }
#pragma unroll
    for (int o = 1; o < 64; o <<= 1)
#pragma unroll
      for (int rr = 0; rr < 4; ++rr) s[rr] += __shfl_xor(s[rr], o);
#pragma unroll
    for (int rr = 0; rr < 4; ++rr) { const float mu = s[rr] * (1.f / 1024.f); s[rr] = mu; q[rr] = 0.f;
#pragma unroll
      for (int j = 0; j < 4; ++j) { const float a = v[rr][j].x - mu, b = v[rr][j].y - mu, c = v[rr][j].z - mu, d = v[rr][j].w - mu; q[rr] += a * a + b * b + c * c + d * d; } }
#pragma unroll
    for (int o = 1; o < 64; o <<= 1)
#pragma unroll
      for (int rr = 0; rr < 4; ++rr) q[rr] += __shfl_xor(q[rr], o);
#pragma unroll
    for (int rr = 0; rr < 4; ++rr) {
      const float mu = s[rr], rs = rsqrtf(q[rr] * (1.f / 1024.f) + 1e-5f);
#pragma unroll
      for (int j = 0; j < 4; ++j) {
        float4 o;
        o.x = (v[rr][j].x - mu) * rs * g[j].x + bb[j].x; o.y = (v[rr][j].y - mu) * rs * g[j].y + bb[j].y;
        o.z = (v[rr][j].z - mu) * rs * g[j].z + bb[j].z; o.w = (v[rr][j].w - mu) * rs * g[j].w + bb[j].w;
        { const pg8::f32x4 ov = {o.x, o.y, o.z, o.w}; __builtin_nontemporal_store(ov, (pg8::f32x4*)(p.out + O_Y + (long)(row0 + rr) * 1024 + j * 256 + lane * 4)); }
      }
    }
  }
}

DI void grid_barrier(unsigned* bar, unsigned target) {
  asm volatile("s_waitcnt vmcnt(0) lgkmcnt(0)" ::: "memory");
  __syncthreads();
  if (threadIdx.x == 0) {
    __builtin_amdgcn_fence(__ATOMIC_RELEASE, "agent");
    asm volatile("s_waitcnt vmcnt(0)" ::: "memory");
    __hip_atomic_fetch_add(bar, 1u, __ATOMIC_RELAXED, __HIP_MEMORY_SCOPE_AGENT);
    while (__hip_atomic_load(bar, __ATOMIC_RELAXED, __HIP_MEMORY_SCOPE_AGENT) < target) __builtin_amdgcn_s_sleep(2);
    __builtin_amdgcn_fence(__ATOMIC_ACQUIRE, "agent");
    asm volatile("s_waitcnt vmcnt(0)" ::: "memory");
  }
  __syncthreads();
}
__global__ void __launch_bounds__(512) fwd_megakernel(Params p) {
  cg::grid_group grid = cg::this_grid();
  unsigned* bar = (unsigned*)(p.ws + WS_CTR + 64);
  const unsigned nb = gridDim.x;
  phase0(p);
  if (p.ws == nullptr) grid.sync();
  grid_barrier(bar, nb);
  phase1(p);
  grid_barrier(bar, 2 * nb);
  phase2(p);
  grid_barrier(bar, 3 * nb);
  phase3(p);
  grid_barrier(bar, 4 * nb);
  phase4(p);
}

extern "C" void kernel_launch(void* const* d_in, const int* in_sizes, int n_in, void* d_out, int out_size,
                              void* d_ws, size_t ws_size, hipStream_t stream) {
  static int grid_blocks = 0;
  if (!grid_blocks) {
    int dev = 0, cus = 0, per_cu = 0;
    (void)hipGetDevice(&dev);
    (void)hipDeviceGetAttribute(&cus, hipDeviceAttributeMultiprocessorCount, dev);
    (void)hipOccupancyMaxActiveBlocksPerMultiprocessor(&per_cu, fwd_megakernel, 512, 0);
    if (per_cu > 1) per_cu = 1;
    if (per_cu < 1) per_cu = 1;
    grid_blocks = cus * per_cu;
    if (ws_size < WS_END || out_size != (int)O_END) fprintf(stderr, "kernel_launch: unexpected sizes ws %zu (need %zu) out %d (need %ld)\n", ws_size, (size_t)WS_END, out_size, (long)O_END);
  }
  (void)hipMemsetAsync((char*)d_ws + WS_CTR, 0, 256, stream);
  Params p{};
  p.xp = (const float*)d_in[0]; p.xs = (const float*)d_in[1];
  p.cak = (const float*)d_in[2]; p.cav = (const float*)d_in[3]; p.cbk = (const float*)d_in[4]; p.cbv = (const float*)d_in[5];
  p.cmk = (const float*)d_in[6]; p.cmv = (const float*)d_in[7];
  p.memp = (const float*)d_in[8]; p.w_in = (const float*)d_in[9]; p.w_mem = (const float*)d_in[10]; p.relb = (const float*)d_in[11];
  p.dlam = (const float*)d_in[12]; p.subg = (const float*)d_in[13]; p.w_out = (const float*)d_in[14]; p.ln_g = (const float*)d_in[15]; p.ln_b = (const float*)d_in[16];
  p.out = (float*)d_out; p.ws = (char*)d_ws;
  void* args[] = {&p};
  hipError_t e = hipLaunchCooperativeKernel((void*)fwd_megakernel, dim3(grid_blocks), dim3(512), args, 0, stream);
  if (e != hipSuccess) fprintf(stderr, "cooperative launch failed: %s (grid %d)\n", hipGetErrorString(e), grid_blocks);
}
```

```cpp
#include <hip/hip_runtime.h>
#include <hip/hip_cooperative_groups.h>
#include <cstdio>
#include <cstdint>
namespace cg = cooperative_groups;

typedef unsigned short bf16_t;
typedef short bf16x8 __attribute__((ext_vector_type(8)));
typedef short s16x4 __attribute__((ext_vector_type(4)));
typedef float f32x16 __attribute__((ext_vector_type(16)));
typedef float f32x2_t __attribute__((ext_vector_type(2)));
typedef __bf16 bf16x2_t __attribute__((ext_vector_type(2)));
typedef unsigned u32x2 __attribute__((ext_vector_type(2)));
typedef unsigned u32x4 __attribute__((ext_vector_type(4)));
typedef float f32x4g __attribute__((ext_vector_type(4)));
#define DI __device__ __forceinline__
#define MFMA32(a, b, c) __builtin_amdgcn_mfma_f32_32x32x16_bf16((a), (b), (c), 0, 0, 0)
#define LDS3 __attribute__((address_space(3)))

constexpr int D_MODEL = 1024, SEQ = 8192, NB = 4, NTOKP = NB * SEQ, SB = 32, ST = 16, NTOKS = SB * ST, NTOK = NTOKP + NTOKS;
constexpr int PAST = 1024, RA = 512, NMEM = 256, PROJ = 3584;
constexpr int SAK_ROWS = 576, SBK_ROWS = 1088;
constexpr int NTOKPAD = NTOK + 64;
constexpr float QSCALE = 0.125f * 1.4426950408889634f;
constexpr float LOG2E = 1.4426950408889634f;
constexpr float ALPHA = 1.189207115002721f;

constexpr long O_Y = 0;
constexpr long O_AKP = (long)NTOK * 1024;
constexpr long O_AVP = O_AKP + (long)NB * RA * 256;
constexpr long O_BKP = O_AVP + (long)NB * RA * 256;
constexpr long O_BVP = O_BKP + (long)NTOKP * 512;
constexpr long O_MKP = O_BVP + (long)NTOKP * 512;
constexpr long O_MVP = O_MKP + (long)NB * NMEM * 256;
constexpr long O_AKS = O_MVP + (long)NB * NMEM * 256;
constexpr long O_AVS = O_AKS + (long)NTOKS * 256;
constexpr long O_BKS = O_AVS + (long)NTOKS * 256;
constexpr long O_BVS = O_BKS + (long)NTOKS * 512;
constexpr long O_END = O_BVS + (long)NTOKS * 512;

constexpr size_t WS_CTR = 0;
constexpr size_t WS_WINT = 256;
constexpr size_t WS_WOUTT = WS_WINT + (size_t)PROJ * 1024 * 2;
constexpr size_t WS_WMEMT = WS_WOUTT + (size_t)1024 * 1024 * 2;
constexpr size_t WS_ROPE = WS_WMEMT + (size_t)512 * 1024 * 2;
constexpr size_t OB_AQ = 0;
constexpr size_t OB_BQ = OB_AQ + (size_t)NTOKPAD * 256 * 2;
constexpr size_t OB_MQ = OB_BQ + (size_t)NTOKPAD * 512 * 2;
constexpr size_t OB_AK = OB_MQ + (size_t)NTOKPAD * 256 * 2;
constexpr size_t OB_AV = OB_AK + (size_t)NTOKP * 256 * 2;
constexpr size_t OB_BK = OB_AV + (size_t)NTOKP * 256 * 2;
constexpr size_t OB_END = OB_BK + (size_t)NTOKP * 512 * 2;
static_assert(OB_END <= (size_t)NTOK * 1024 * 4, "temporaries must fit in the y region");
constexpr size_t WS_BV = WS_ROPE + (size_t)SEQ * 32 * 8;
constexpr size_t WS_G = WS_BV + (size_t)NTOKP * 512 * 2;
constexpr size_t WS_MK = WS_G + (size_t)NTOK * 1024 * 2;
constexpr size_t WS_MV = WS_MK + (size_t)NB * NMEM * 256 * 2;
constexpr size_t WS_SAK = WS_MV + (size_t)NB * NMEM * 256 * 2;
constexpr size_t WS_SAV = WS_SAK + (size_t)SB * SAK_ROWS * 256 * 2;
constexpr size_t WS_SBK = WS_SAV + (size_t)SB * SAK_ROWS * 256 * 2;
constexpr size_t WS_SBV = WS_SBK + (size_t)SB * SBK_ROWS * 512 * 2;
constexpr size_t WS_SMK = WS_SBV + (size_t)SB * SBK_ROWS * 512 * 2;
constexpr size_t WS_SMV = WS_SMK + (size_t)SB * NMEM * 256 * 2;
constexpr size_t WS_XB = WS_SMV + (size_t)SB * NMEM * 256 * 2;
constexpr size_t WS_MB = WS_XB + (size_t)NTOK * 1024 * 2;
constexpr size_t WS_END = WS_MB + (size_t)NB * NMEM * 1024 * 2;
static_assert(WS_END <= (size_t)512 * 1024 * 1024, "workspace budget");

struct Params {
  const float* xp; const float* xs;
  const float* cak; const float* cav; const float* cbk; const float* cbv; const float* cmk; const float* cmv;
  const float* memp; const float* w_in; const float* w_mem; const float* relb; const float* dlam; const float* subg;
  const float* w_out; const float* ln_g; const float* ln_b;
  float* out; char* ws;
};

constexpr int TEAM_LDS = 73728 + 64;
constexpr int LDS_BYTES = 2 * TEAM_LDS + 64;
__shared__ __attribute__((aligned(16))) char g_lds_all[LDS_BYTES];
#define TEAM (__builtin_amdgcn_readfirstlane((int)(threadIdx.x >> 8)))
#define g_lds (g_lds_all + TEAM * TEAM_LDS)

DI unsigned cvtpk(float lo, float hi) { f32x2_t v = {lo, hi}; bf16x2_t b = __builtin_convertvector(v, bf16x2_t); return __builtin_bit_cast(unsigned, b); }
DI bf16_t f2bf(float x) { return (bf16_t)(cvtpk(x, 0.f) & 0xffffu); }
DI float bf2f(unsigned short b) { return __uint_as_float(((unsigned)b) << 16); }
DI float bflo(unsigned u) { return __uint_as_float(u << 16); }
DI float bfhi(unsigned u) { return __uint_as_float(u & 0xffff0000u); }
DI float fexp2(float x) { return __builtin_amdgcn_exp2f(x); }
DI float xor32f(float v) { return __shfl_xor(v, 32); }

template <bool SWAP45>
DI void transpose_tile(const float* __restrict__ src, int N, bf16_t* __restrict__ dst, int K, int k0, int n0) {
  float* tile = (float*)g_lds;
  const int tid = threadIdx.x & 255, c = tid & 63, r0 = tid >> 6;
#pragma unroll
  for (int i = 0; i < 16; ++i) { const int row = r0 + 4 * i; tile[row * 65 + c] = src[(long)(k0 + row) * N + n0 + c]; }
  __syncthreads();
#pragma unroll
  for (int i = 0; i < 16; ++i) { const int rr = r0 + 4 * i; const int pr = SWAP45 ? ((rr & 15) | ((rr & 16) << 1) | ((rr & 32) >> 1)) : rr; dst[(long)(n0 + pr) * K + k0 + c] = f2bf(tile[c * 65 + rr]); }
  __syncthreads();
}

DI void convert_rows(const float* __restrict__ src, bf16_t* __restrict__ dst, int rows_w8, int dst_bstride_w8, long gtid, long gsz) {
  const long total = (long)SB * rows_w8;
  for (long u = gtid; u < total; u += gsz) {
    const int b = (int)(u / rows_w8); const int j = (int)(u - (long)b * rows_w8);
    const float4 a0 = *(const float4*)(src + u * 8), a1 = *(const float4*)(src + u * 8 + 4);
    u32x4 v; v.x = cvtpk(a0.x, a0.y); v.y = cvtpk(a0.z, a0.w); v.z = cvtpk(a1.x, a1.y); v.w = cvtpk(a1.z, a1.w);
    *(u32x4*)(dst + ((long)b * dst_bstride_w8 + j) * 8) = v;
  }
}

DI void phase0(const Params& p) {
  bf16_t* winT = (bf16_t*)(p.ws + WS_WINT); bf16_t* woutT = (bf16_t*)(p.ws + WS_WOUTT); bf16_t* wmemT = (bf16_t*)(p.ws + WS_WMEMT);
  constexpr int T_IN = 16 * 56, T_OUT = 16 * 16, T_MEM = 16 * 8;
  for (int t = blockIdx.x * 2 + TEAM; t < T_IN + T_OUT + T_MEM; t += gridDim.x * 2) {
    if (t < T_IN) transpose_tile<true>(p.w_in, PROJ, winT, 1024, (t / 56) * 64, (t % 56) * 64);
    else if (t < T_IN + T_OUT) { const int u = t - T_IN; transpose_tile<false>(p.w_out, 1024, woutT, 1024, (u >> 4) * 64, (u & 15) * 64); }
    else { const int u = t - T_IN - T_OUT; transpose_tile<false>(p.w_mem, 512, wmemT, 1024, (u >> 3) * 64, (u & 7) * 64); }
  }
  float2* rope = (float2*)(p.ws + WS_ROPE);
  for (int idx = blockIdx.x * 512 + threadIdx.x; idx < SEQ * 32; idx += gridDim.x * 512) {
    const int pos = idx >> 5, i = idx & 31;
    const double inv = exp(-(double)i * (9.210340371976184 / 32.0));
    const double rev = (double)pos * inv * 0.15915494309189535;
    const double fr = rev - rint(rev);
    const float a = (float)(fr * 6.283185307179586);
    rope[idx] = make_float2(cosf(a), sinf(a));
  }
  const int G = gridDim.x;
  const long gtid = (long)blockIdx.x * 512 + threadIdx.x, gsz = (long)G * 512;
  {
    bf16_t* XB = (bf16_t*)(p.ws + WS_XB); bf16_t* MB = (bf16_t*)(p.ws + WS_MB);
    const long nxp = (long)NTOKP * 1024 / 8, nxs = (long)NTOKS * 1024 / 8, nmb = (long)NB * NMEM * 1024 / 8;
#pragma unroll 4
    for (long u = gtid; u < nxp + nxs + nmb; u += gsz) {
      const float* src; bf16_t* dst;
      if (u < nxp) { src = p.xp + u * 8; dst = XB + u * 8; }
      else if (u < nxp + nxs) { src = p.xs + (u - nxp) * 8; dst = XB + u * 8; }
      else { src = p.memp + (u - nxp - nxs) * 8; dst = MB + (u - nxp - nxs) * 8; }
      const f32x4g a0 = __builtin_nontemporal_load((const f32x4g*)(src)), a1 = __builtin_nontemporal_load((const f32x4g*)(src + 4));
      u32x4 v; v.x = cvtpk(a0[0], a0[1]); v.y = cvtpk(a0[2], a0[3]); v.z = cvtpk(a1[0], a1[1]); v.w = cvtpk(a1[2], a1[3]);
      *(u32x4*)dst = v;
    }
  }
}

constexpr int G_RS = 144, GA_BYTES = 128 * G_RS, GB_BYTES = 256 * G_RS, G_STAGE = GA_BYTES + GB_BYTES;
DI void gemm_core(const bf16_t* __restrict__ Ap, int lda, const bf16_t* __restrict__ Bp, int ldb, int K, f32x16 (&acc)[2][2]) {
  const int tid = threadIdx.x, lane = tid & 63, w = tid >> 6, wm = w >> 2, wn = w & 3, r = lane & 31, h = lane >> 5;
#pragma unroll
  for (int a = 0; a < 2; ++a)
#pragma unroll
    for (int b = 0; b < 2; ++b)
#pragma unroll
      for (int i = 0; i < 16; ++i) acc[a][b][i] = 0.f;
  u32x4 ra0[2], rb0[4], ra1[2], rb1[4];
  const int lrow = tid >> 3, lch = tid & 7;
  const bf16_t* Ag = Ap + (long)lrow * lda + lch * 8;
  const bf16_t* Bg = Bp + (long)lrow * ldb + lch * 8;
#define G_LOAD(RA, RB, kt)                                                                                      \
  {                                                                                                             \
    _Pragma("unroll") for (int i = 0; i < 2; ++i) RA[i] = *(const u32x4*)(Ag + (long)(64 * i) * lda + (kt) * 64); \
    _Pragma("unroll") for (int i = 0; i < 4; ++i) RB[i] = *(const u32x4*)(Bg + (long)(64 * i) * ldb + (kt) * 64); \
  }
#define G_WRITE(RA, RB, buf)                                                                                    \
  {                                                                                                             \
    char* Ab_ = g_lds_all + (buf) * G_STAGE; char* Bb_ = Ab_ + GA_BYTES;                                        \
    _Pragma("unroll") for (int i = 0; i < 2; ++i) *(u32x4*)(Ab_ + (lrow + 64 * i) * G_RS + lch * 16) = RA[i];   \
    _Pragma("unroll") for (int i = 0; i < 4; ++i) *(u32x4*)(Bb_ + (lrow + 64 * i) * G_RS + lch * 16) = RB[i];   \
  }
#define G_COMPUTE(buf)                                                                                          \
  {                                                                                                             \
    const char* Ab = g_lds_all + (buf) * G_STAGE; const char* Bb = Ab + GA_BYTES;                               \
    _Pragma("unroll") for (int s = 0; s < 4; ++s) {                                                             \
      const int co = (16 * s + 8 * h) * 2;                                                                      \
      const bf16x8 a0 = *(const bf16x8*)(Ab + (wm * 64 + r) * G_RS + co);                                       \
      const bf16x8 a1 = *(const bf16x8*)(Ab + (wm * 64 + 32 + r) * G_RS + co);                                  \
      const bf16x8 b0 = *(const bf16x8*)(Bb + (wn * 64 + r) * G_RS + co);                                       \
      const bf16x8 b1 = *(const bf16x8*)(Bb + (wn * 64 + 32 + r) * G_RS + co);                                  \
      acc[0][0] = MFMA32(a0, b0, acc[0][0]);                                                                    \
      acc[0][1] = MFMA32(a0, b1, acc[0][1]);                                                                    \
      acc[1][0] = MFMA32(a1, b0, acc[1][0]);                                                                    \
      acc[1][1] = MFMA32(a1, b1, acc[1][1]);                                                                    \
    }                                                                                                           \
  }
  const int nk = K >> 6;
  G_LOAD(ra0, rb0, 0);
  G_LOAD(ra1, rb1, 1);
  G_WRITE(ra0, rb0, 0);
  __syncthreads();
  for (int kt = 0; kt < nk; kt += 2) {
    if (kt + 2 < nk) G_LOAD(ra0, rb0, kt + 2);
    G_COMPUTE(0);
    G_WRITE(ra1, rb1, 1);
    __syncthreads();
    if (kt + 3 < nk) G_LOAD(ra1, rb1, kt + 3);
    G_COMPUTE(1);
    if (kt + 2 < nk) G_WRITE(ra0, rb0, 0);
    __syncthreads();
  }
#undef G_COMPUTE
#undef G_LOAD
#undef G_WRITE
}

namespace pg8 {
#define PG8_LAS __attribute__((address_space(3)))
typedef unsigned short bf16_t;
typedef short bf16x8 __attribute__((ext_vector_type(8)));
typedef float f32x4 __attribute__((ext_vector_type(4)));
typedef unsigned u32x4 __attribute__((ext_vector_type(4)));
constexpr int BM = 256, BK = 64, HALF = 128, HTB = HALF * BK * 2  , STAGE_BYTES = 8 * HTB, NXCD = 8, WGM = 8;

__host__ __device__ __forceinline__ int lds_byte(int r, int c) { const int st = (r >> 4) * 2 + (c >> 5), rr = r & 15, cc = c & 31, ob = rr * 64 + cc * 2; return st * 1024 + (ob ^ (((ob >> 9) & 1) << 5)); }
__host__ __device__ __forceinline__ void stage_rc(int b, int& R, int& C) { const int st = b / 1024, sb = b % 1024, swz = sb ^ (((sb >> 9) & 1) << 5); R = (st >> 1) * 16 + swz / 64; C = (st & 1) * 32 + (swz % 64) / 2; }
__host__ __device__ __forceinline__ int perm32(int rho) { const int n = rho >> 4, i = rho & 15; return 8 * (i >> 2) + 4 * n + (i & 3); }

struct Unit { int pm, pn; };
struct Gemm { const bf16_t* A; const bf16_t* Bt; int M, N, K; };

struct StaticOrder {
    int nM, nN, nwg, G, c;
    __host__ __device__ void init(int M, int N, int G_, int c_) { nM = M / BM; nN = N / BM; nwg = nM * nN; G = G_; c = c_; }
    __host__ __device__ bool next(int i, Unit& u) const {
        const long L = (long)i * G + c; if (L >= nwg) return false;
        int wgid = (int)L; { const int q = nwg / NXCD, r = nwg % NXCD, xcd = wgid % NXCD, off = wgid / NXCD; wgid = (xcd < r ? xcd * (q + 1) : r * (q + 1) + (xcd - r) * q) + off; }
        const int nig = WGM * nN, gid = wgid / nig, fm = gid * WGM, gsz = (nM - fm) < WGM ? (nM - fm) : WGM;
        u.pm = fm + ((wgid % nig) % gsz); u.pn = (wgid % nig) / gsz; return true;
    }
    __device__ __forceinline__ void a_ready(const Unit&) const {}
    __device__ __forceinline__ void done(const Unit&) const {}
};
template <class Epi, class Sched, bool STAMP = false>
__device__ __forceinline__ void gemm_phase(PG8_LAS unsigned char* lds, const Gemm g, const Sched& S, const Epi& E, unsigned long long* stamps) {
    const int tid = threadIdx.x, wid = __builtin_amdgcn_readfirstlane(tid >> 6), lane = tid & 63, wr = wid >> 2, wc = wid & 3, fr = lane & 15, fq = lane >> 4;
    const int K = g.K, nt = K / BK;
    int ts_lo = 0, ts_hi = 0, nts = 0; const unsigned long long rt_entry = STAMP ? (unsigned long long)wall_clock64() : 0ull;
#define PG8_STAMP() do { if (STAMP && wid == 0 && nts < 64) { const unsigned long long _c = (unsigned long long)clock64(); \
        ts_lo = (lane == nts) ? (int)(unsigned)_c : ts_lo; ts_hi = (lane == nts) ? (int)(unsigned)(_c >> 32) : ts_hi; ++nts; } } while (0)
    PG8_STAMP();
    unsigned voffA[2], voffB[2];
#pragma unroll
    for (int i = 0; i < 2; ++i) { int R, C; stage_rc(tid * 16 + i * 8192, R, C); const int Rb = Epi::PERM ? ((R & ~31) + perm32(R & 31)) : R;
        voffA[i] = (unsigned)(R * K + C) * 2u; voffB[i] = (unsigned)(Rb * K + C) * 2u; }
    const size_t kstep = (size_t)(BK * 2);
    const size_t hstep = (size_t)HALF * K * 2;
    const size_t tstep = 2 * hstep;
    const unsigned ldsw = (unsigned)wid * 1024u;
    const int aoff = lds_byte(wr * 64 + fr, fq * 8), boff = lds_byte(wc * 32 + fr, fq * 8);
#define PG8_SA(b, h) (((b) * 2 + (h)) * HTB)
#define PG8_SB(b, h) ((4 + (b) * 2 + (h)) * HTB)
#define PG8_STAGE(bufoff, gbase, voff) do { _Pragma("unroll") for (int _i = 0; _i < 2; ++_i) \
        __builtin_amdgcn_global_load_lds((const unsigned*)((const char*)(gbase) + (voff)[_i]), (PG8_LAS unsigned*)(lds + (bufoff) + ldsw + _i * 8192), 16, 0, 0); } while (0)
#define PG8_LDA(dst, b, h) do { _Pragma("unroll") for (int m = 0; m < 4; ++m) _Pragma("unroll") for (int k = 0; k < 2; ++k) dst[m][k] = *(const PG8_LAS bf16x8*)(lds + PG8_SA(b, h) + aoff + m * 2048 + k * 1024); } while (0)
#define PG8_LDB(dst, b, h) do { _Pragma("unroll") for (int n = 0; n < 2; ++n) _Pragma("unroll") for (int k = 0; k < 2; ++k) dst[n][k] = *(const PG8_LAS bf16x8*)(lds + PG8_SB(b, h) + boff + n * 2048 + k * 1024); } while (0)
#define PG8_MMA(ai, bj, At, Bt) do { __builtin_amdgcn_s_setprio(1); _Pragma("unroll") for (int m = 0; m < 4; ++m) _Pragma("unroll") for (int n = 0; n < 2; ++n) _Pragma("unroll") for (int k = 0; k < 2; ++k) \
        acc[ai][bj][m][n] = __builtin_amdgcn_mfma_f32_16x16x32_bf16(Bt[n][k], At[m][k], acc[ai][bj][m][n], 0, 0, 0); __builtin_amdgcn_s_setprio(0); } while (0)
#define PG8_WAIT_V(n) asm volatile("s_waitcnt vmcnt(" #n ")" ::: "memory")
#define PG8_WAIT_L(n) asm volatile("s_waitcnt lgkmcnt(" #n ")" ::: "memory")
#define PG8_BAR __builtin_amdgcn_s_barrier()
#define PG8_SCHED __builtin_amdgcn_sched_barrier(0)
    Unit cur, nxt; int ui = 0;
    if (!S.next(0, cur)) return;
    f32x4 acc[2][2][4][2];
#pragma unroll
    for (int a = 0; a < 2; ++a)
#pragma unroll
        for (int b = 0; b < 2; ++b)
#pragma unroll
            for (int m = 0; m < 4; ++m)
#pragma unroll
                for (int n = 0; n < 2; ++n) acc[a][b][m][n] = (f32x4){0.f, 0.f, 0.f, 0.f};
    bf16x8 At[4][2], B0[2][2], B1[2][2];
    const char* cA = (const char*)g.A + (size_t)cur.pm * tstep; const char* cB = (const char*)g.Bt + (size_t)cur.pn * tstep;
    S.a_ready(cur);
    PG8_STAGE(PG8_SB(0, 0), cB, voffB); PG8_STAGE(PG8_SA(0, 0), cA, voffA); PG8_STAGE(PG8_SB(0, 1), cB + hstep, voffB); PG8_STAGE(PG8_SA(0, 1), cA + hstep, voffA);
    if (wr == 1) PG8_BAR;
    PG8_WAIT_V(4); PG8_BAR;
    PG8_STAGE(PG8_SB(1, 0), cB + kstep, voffB); PG8_STAGE(PG8_SA(1, 0), cA + kstep, voffA); PG8_STAGE(PG8_SB(1, 1), cB + hstep + kstep, voffB);
    PG8_WAIT_V(6); PG8_BAR;
    PG8_STAMP();
    for (;;) {
        const bool has_next = S.next(ui + 1, nxt);
        const char* nA = has_next ? (const char*)g.A + (size_t)nxt.pm * tstep : cA; const char* nB = has_next ? (const char*)g.Bt + (size_t)nxt.pn * tstep : cB;
        for (int t = 0; t < nt; t += 2) {
            const bool last = (t == nt - 2);
            const char* a1 = cA + (size_t)(t + 1) * kstep;
            const char* a2 = last ? nA : cA + (size_t)(t + 2) * kstep; const char* b2 = last ? nB : cB + (size_t)(t + 2) * kstep;
            const char* a3 = a2 + kstep; const char* b3 = b2 + kstep;
            if (last && has_next) S.a_ready(nxt);
            PG8_LDB(B0, 0, 0); PG8_SCHED; PG8_LDA(At, 0, 0); PG8_STAGE(PG8_SA(1, 1), a1 + hstep, voffA);
            PG8_WAIT_L(8); PG8_BAR; PG8_WAIT_L(0); PG8_MMA(0, 0, At, B0); PG8_BAR; PG8_SCHED;
            PG8_LDB(B1, 0, 1); PG8_STAGE(PG8_SB(0, 0), b2, voffB);
            PG8_BAR; PG8_WAIT_L(0); PG8_MMA(0, 1, At, B1); PG8_BAR;
            PG8_LDA(At, 0, 1); PG8_STAGE(PG8_SA(0, 0), a2, voffA);
            PG8_BAR; PG8_WAIT_L(0); PG8_MMA(1, 0, At, B0); PG8_BAR; PG8_SCHED;
            PG8_STAGE(PG8_SB(0, 1), b2 + hstep, voffB);
            PG8_WAIT_V(6); PG8_BAR; PG8_MMA(1, 1, At, B1); PG8_BAR;
            PG8_LDB(B0, 1, 0); PG8_SCHED; PG8_LDA(At, 1, 0); PG8_STAGE(PG8_SA(0, 1), a2 + hstep, voffA);
            PG8_WAIT_L(8); PG8_BAR; PG8_WAIT_L(0); PG8_MMA(0, 0, At, B0); PG8_BAR; PG8_SCHED;
            PG8_LDB(B1, 1, 1); PG8_STAGE(PG8_SB(1, 0), b3, voffB);
            PG8_BAR; PG8_WAIT_L(0); PG8_MMA(0, 1, At, B1); PG8_BAR;
            PG8_LDA(At, 1, 1); PG8_STAGE(PG8_SA(1, 0), a3, voffA);
            PG8_BAR; PG8_WAIT_L(0); PG8_MMA(1, 0, At, B0); PG8_BAR; PG8_SCHED;
            PG8_STAGE(PG8_SB(1, 1), b3 + hstep, voffB);
            PG8_WAIT_V(6); PG8_BAR; PG8_MMA(1, 1, At, B1); PG8_BAR;
        }
        PG8_STAMP();
        if constexpr (!Epi::AFTER_DRAIN) { E(acc, cur, wr, wc, fr, fq); S.done(cur); }
        PG8_STAMP();
        if (!has_next) break;
#pragma unroll
        for (int a = 0; a < 2; ++a)
#pragma unroll
            for (int b = 0; b < 2; ++b)
#pragma unroll
                for (int m = 0; m < 4; ++m)
#pragma unroll
                    for (int n = 0; n < 2; ++n) acc[a][b][m][n] = (f32x4){0.f, 0.f, 0.f, 0.f};
        cur = nxt; cA = nA; cB = nB; ++ui;
    }
    PG8_WAIT_V(0);
    if (wr == 0) PG8_BAR;
    PG8_BAR;
    if constexpr (Epi::AFTER_DRAIN) { E.fused(acc, cur, wr, wc, fr, fq, lds, wid, lane); S.done(cur); }
    PG8_STAMP();
    if (STAMP && wid == 0) { stamps[lane] = lane < nts ? (((unsigned long long)(unsigned)ts_hi << 32) | (unsigned)ts_lo) : 0ull;
        if (lane == 62) stamps[62] = rt_entry; if (lane == 63) stamps[63] = (unsigned long long)wall_clock64(); }
#undef PG8_STAMP
#undef PG8_SA
#undef PG8_SB
#undef PG8_STAGE
#undef PG8_LDA
#undef PG8_LDB
#undef PG8_MMA
#undef PG8_WAIT_V
#undef PG8_WAIT_L
#undef PG8_BAR
#undef PG8_SCHED
}
}

struct EpiProj {
  static constexpr bool PERM = false, AFTER_DRAIN = false;
  float* out; char* ws;
  __device__ __forceinline__ void operator()(const pg8::f32x4 (&acc)[2][2][4][2], const pg8::Unit& u, int wr, int wc, int fr, int fq) const {
    asm volatile("" : "+v"(fr), "+v"(fq));
    char* ob = (char*)out;
    const int n0 = u.pn * 256;
    int seg, sbase;
    if (n0 < 256) { seg = 0; sbase = 0; } else if (n0 < 512) { seg = 1; sbase = 256; } else if (n0 < 768) { seg = 2; sbase = 512; }
    else if (n0 < 1280) { seg = 3; sbase = 768; } else if (n0 < 1792) { seg = 4; sbase = 1280; } else if (n0 < 2304) { seg = 5; sbase = 1792; }
    else if (n0 < 2560) { seg = 6; sbase = 2304; } else { seg = 7; sbase = 2560; }
    const bool smp = u.pm >= NTOKP / 256;
    const float2* rope = (const float2*)(ws + WS_ROPE);
    const int fi = 16 * (wc & 1) + 4 * fq;
#pragma unroll
    for (int ai = 0; ai < 2; ++ai)
#pragma unroll
      for (int m = 0; m < 4; ++m) {
        const int row = 128 * ai + 64 * wr + 16 * m + fr;
        const unsigned tok = (unsigned)(u.pm * 256 + row);
        const unsigned ts = tok - (unsigned)NTOKP;
        float4 c01, s01, c23, s23;
        if (seg == 3 || seg == 4) {
          const int pos = smp ? (PAST + (int)(ts & 15)) : (int)(tok & (SEQ - 1));
          const float4 r0 = *(const float4*)(rope + pos * 32 + fi), r1 = *(const float4*)(rope + pos * 32 + fi + 2);
          c01 = make_float4(r0.x, r0.z, r1.x, r1.z); s01 = make_float4(r0.y, r0.w, r1.y, r1.w);
        }
#pragma unroll
        for (int bj = 0; bj < 2; ++bj) {
          const int blk = 4 * u.pn + 2 * bj + (wc >> 1);
          const int col = 64 * blk + fi - sbase;
          pg8::f32x4 v0 = acc[ai][bj][m][0], v1 = acc[ai][bj][m][1];
          if (seg == 3 || seg == 4) {
            const pg8::f32x4 cc = {c01.x, c01.y, c01.z, c01.w}, ss = {s01.x, s01.y, s01.z, s01.w};
            const pg8::f32x4 a = v0 * cc - v1 * ss, b = v1 * cc + v0 * ss;
            v0 = a; v1 = b;
          }
          if (seg == 0 || seg == 3 || seg == 6) {
            bf16_t* q = (seg == 0) ? (bf16_t*)(ob + OB_AQ) + tok * 256 : (seg == 3) ? (bf16_t*)(ob + OB_BQ) + tok * 512 : (bf16_t*)(ob + OB_MQ) + tok * 256;
            u32x2 w0, w1; w0.x = cvtpk(v0[0] * QSCALE, v0[1] * QSCALE); w0.y = cvtpk(v0[2] * QSCALE, v0[3] * QSCALE);
            w1.x = cvtpk(v1[0] * QSCALE, v1[1] * QSCALE); w1.y = cvtpk(v1[2] * QSCALE, v1[3] * QSCALE);
            *(u32x2*)(q + col) = w0; *(u32x2*)(q + col + 32) = w1;
          } else if (seg == 7) {
            bf16_t* g = (bf16_t*)(ws + WS_G) + tok * 1024;
            float a[4], b[4];
#pragma unroll
            for (int j = 0; j < 4; ++j) { a[j] = v0[j] * __builtin_amdgcn_rcpf(1.f + __expf(-v0[j])); b[j] = v1[j] * __builtin_amdgcn_rcpf(1.f + __expf(-v1[j])); }
            u32x2 w0, w1; w0.x = cvtpk(a[0], a[1]); w0.y = cvtpk(a[2], a[3]); w1.x = cvtpk(b[0], b[1]); w1.y = cvtpk(b[2], b[3]);
            *(u32x2*)(g + col) = w0; *(u32x2*)(g + col + 32) = w1;
          } else {
            const bool wide = (seg >= 4);
            const int W = wide ? 512 : 256;
            bf16_t* kw; float* o = nullptr;
            if (!smp) {
              if (seg == 1) kw = (bf16_t*)(ob + OB_AK) + tok * 256; else if (seg == 2) kw = (bf16_t*)(ob + OB_AV) + tok * 256;
              else if (seg == 4) kw = (bf16_t*)(ob + OB_BK) + tok * 512; else kw = (bf16_t*)(ws + WS_BV) + tok * 512;
              if (wide) o = out + (seg == 4 ? O_BKP : O_BVP) + tok * 512;
              else { const unsigned ps = tok & (SEQ - 1), pb = tok >> 13; if (ps >= (unsigned)(SEQ - RA)) o = out + (seg == 1 ? O_AKP : O_AVP) + (pb * RA + ps - (SEQ - RA)) * 256u; }
            } else {
              kw = nullptr;
              if (wide) o = out + (seg == 4 ? O_BKS : O_BVS) + ts * 512; else o = out + (seg == 1 ? O_AKS : O_AVS) + ts * 256;
            }
            (void)W;
            u32x2 w0, w1; w0.x = cvtpk(v0[0], v0[1]); w0.y = cvtpk(v0[2], v0[3]); w1.x = cvtpk(v1[0], v1[1]); w1.y = cvtpk(v1[2], v1[3]);
            if (kw) { *(u32x2*)(kw + col) = w0; *(u32x2*)(kw + col + 32) = w1; }
            if (o) { __builtin_nontemporal_store(v0, (pg8::f32x4*)(o + col)); __builtin_nontemporal_store(v1, (pg8::f32x4*)(o + col + 32)); }
          }
        }
      }
  }
};

struct EpiOut {
  static constexpr bool PERM = true, AFTER_DRAIN = false;
  bf16_t* ypre; const float* xp; const float* xs;
  __device__ __forceinline__ void operator()(const pg8::f32x4 (&acc)[2][2][4][2], const pg8::Unit& u, int wr, int wc, int fr, int fq) const {
    asm volatile("" : "+v"(fr), "+v"(fq));
    const float* xb = (u.pm < NTOKP / 256) ? xp + (long)u.pm * 256 * 1024 : xs + (long)(u.pm - NTOKP / 256) * 256 * 1024;
    bf16_t* yb = ypre + (long)u.pm * 256 * 1024;
    const int col0 = u.pn * 256 + wc * 32 + 8 * fq;
#pragma unroll
    for (int ai = 0; ai < 2; ++ai)
#pragma unroll
      for (int mp = 0; mp < 2; ++mp) {
        pg8::f32x4 xv[2][2][2];
#pragma unroll
        for (int mm = 0; mm < 2; ++mm) {
          const unsigned ro = (unsigned)((128 * ai + 64 * wr + 16 * (2 * mp + mm) + fr) * 1024 + col0);
#pragma unroll
          for (int bj = 0; bj < 2; ++bj)
#pragma unroll
            for (int n = 0; n < 2; ++n) xv[mm][bj][n] = __builtin_nontemporal_load((const pg8::f32x4*)(xb + ro + bj * 128 + n * 4));
        }
#pragma unroll
        for (int mm = 0; mm < 2; ++mm) {
          const unsigned ro = (unsigned)((128 * ai + 64 * wr + 16 * (2 * mp + mm) + fr) * 1024 + col0);
#pragma unroll
          for (int bj = 0; bj < 2; ++bj) {
            const pg8::f32x4 y0 = acc[ai][bj][2 * mp + mm][0] + ALPHA * xv[mm][bj][0], y1 = acc[ai][bj][2 * mp + mm][1] + ALPHA * xv[mm][bj][1];
            u32x4 w; w.x = cvtpk(y0[0], y0[1]); w.y = cvtpk(y0[2], y0[3]); w.z = cvtpk(y1[0], y1[1]); w.w = cvtpk(y1[2], y1[3]);
            *(u32x4*)(yb + ro + bj * 128) = w;
          }
        }
      }
  }
};

DI void mem_epilogue(const Params& p, int mt, int nt, f32x16 (&acc)[2][2]) {
  const int tid = threadIdx.x, lane = tid & 63, w = tid >> 6, wm = w >> 2, wn = w & 3, c = lane & 31, h = lane >> 5;
  const int n0 = nt * 256 + wn * 64;
  const bool isv = n0 >= 256;
  const int cb = isv ? n0 - 256 : n0;
  bf16_t* kw = (bf16_t*)(p.ws + (isv ? WS_MV : WS_MK));
  float* o = p.out + (isv ? O_MVP : O_MKP);
#pragma unroll
  for (int mi = 0; mi < 2; ++mi)
#pragma unroll
    for (int i = 0; i < 16; ++i) {
      const long row = mt * 128 + wm * 64 + mi * 32 + (i & 3) + 8 * (i >> 2) + 4 * h;
      const float v0 = acc[mi][0][i], v1 = acc[mi][1][i];
      kw[row * 256 + cb + c] = f2bf(v0); kw[row * 256 + cb + c + 32] = f2bf(v1);
      o[row * 256 + cb + c] = v0; o[row * 256 + cb + c + 32] = v1;
    }
}

DI void phase1(const Params& p) {
  const int G = gridDim.x;
  const bf16_t* winT = (const bf16_t*)(p.ws + WS_WINT); const bf16_t* wmemT = (const bf16_t*)(p.ws + WS_WMEMT);
  const bf16_t* XB = (const bf16_t*)(p.ws + WS_XB); const bf16_t* MB = (const bf16_t*)(p.ws + WS_MB);
  {
    pg8::Gemm g; g.A = XB; g.Bt = winT; g.M = NTOK; g.N = PROJ; g.K = 1024;
    pg8::StaticOrder S; S.init(NTOK, PROJ, G, (int)blockIdx.x);
    EpiProj E; E.out = p.out; E.ws = p.ws;
    pg8::gemm_phase<EpiProj, pg8::StaticOrder, false>((PG8_LAS unsigned char*)g_lds_all, g, S, E, nullptr);
  }
  __syncthreads();
  constexpr int T2 = 8 * 2;
  f32x16 acc[2][2];
  for (int t = (int)blockIdx.x - 64; t >= 0 && t < T2; t += G) {
    const int mt = t >> 1, nt = t & 1;
    gemm_core(MB + (long)mt * 128 * 1024, 1024, wmemT + (long)nt * 256 * 1024, 1024, 1024, acc);
    mem_epilogue(p, mt, nt, acc);
  }
}

struct AttnItem {
  const bf16_t* q0; const bf16_t* q1;
  const bf16_t* k; const bf16_t* v;
  bf16_t* g0; bf16_t* g1;
  int qs, ks, ntiles, nkeys;
  int tlo0, thi0, tlo1, thi1;
  int rows0, rows1;
  int qpos0, qpos1, kpos0, head0; bool bias;
  const float* kf; const float* vf;
  const float* kn; const float* vn;
  int ncache;
};
constexpr int AK_RS = 272, AK_BYTES = 64 * AK_RS, AV_BYTES = 16384, A_BUF = AK_BYTES + AV_BYTES;
constexpr int A_BIAS_OFF = 2 * A_BUF;
constexpr int A_ITEM_OFF = 2 * TEAM_LDS;
constexpr int A_Q_OFF = 73728;

template <bool DIFF, bool BIAS, bool MASK, bool F32>
DI void attn_item(const AttnItem& it, float lam, const float* __restrict__ subg) {
  const int tid = threadIdx.x, lane = tid & 63, w = tid >> 6, r = lane & 31, h = lane >> 5;
  const int half = __builtin_amdgcn_readfirstlane(w >> 2), qh = w & 1, m = (w >> 1) & 1;
  constexpr int NDT = DIFF ? 4 : 2;
  const int ntiles = it.ntiles;
  const int tlo = half ? it.tlo1 : it.tlo0, thi = half ? it.thi1 : it.thi0, rows = half ? it.rows1 : it.rows0;
  const bf16_t* qbase = half ? it.q1 : it.q0;
  bf16_t* gbase = half ? it.g1 : it.g0;
  char* qlds = g_lds_all + A_Q_OFF + w * 4096 + lane * 16;
  {
    const bf16_t* qp = qbase + (long)(qh * 32 + r) * it.qs + m * 64 + 8 * h;
#pragma unroll
    for (int s = 0; s < 4; ++s) *(bf16x8*)(qlds + s * 1024) = *(const bf16x8*)(qp + 16 * s);
  }
  f32x16 oacc[NDT];
#pragma unroll
  for (int d = 0; d < NDT; ++d)
#pragma unroll
    for (int i = 0; i < 16; ++i) oacc[d][i] = 0.f;
  float m_run = -1e30f, l_run = 0.f;
  u32x4 rk0[2], rv0[2];
  float4 fk[4], fv[4];
  const int kch = tid & 15, krow = tid >> 4, vsub = tid & 3, vkey = (tid >> 2) & 63, vd = tid >> 8;
  const bf16_t* kg = it.k + (long)krow * it.ks + kch * 8;
  const bf16_t* vg = it.v + (long)vkey * it.ks + vd * 32 + vsub * 8;
#define A_LOAD(RK, RV, t)                                                                                        \
  if (!F32) {                                                                                                    \
    _Pragma("unroll") for (int i = 0; i < 2; ++i) RK[i] = *(const u32x4*)(kg + (long)((t) * 64 + 32 * i) * it.ks); \
    _Pragma("unroll") for (int i = 0; i < 2; ++i) RV[i] = *(const u32x4*)(vg + (long)((t) * 64) * it.ks + 64 * i); \
  } else {                                                                                                       \
    const bool nw = (t) >= it.ncache;             \
    _Pragma("unroll") for (int i = 0; i < 2; ++i) {                                                              \
      const int kr = krow + 32 * i;                                                                              \
      const float* src = nw ? it.kn + (long)(kr < 15 ? kr : 15) * it.ks : it.kf + (long)((t) * 64 + kr) * it.ks; \
      fk[2 * i] = *(const float4*)(src + kch * 8); fk[2 * i + 1] = *(const float4*)(src + kch * 8 + 4);          \
    }                                                                                                            \
    {                                                                                                            \
      const float* src = nw ? it.vn + (long)(vkey < 15 ? vkey : 15) * it.ks : it.vf + (long)((t) * 64 + vkey) * it.ks; \
      _Pragma("unroll") for (int i = 0; i < 2; ++i) {                                                            \
        fv[2 * i] = *(const float4*)(src + (vd + 2 * i) * 32 + vsub * 8); fv[2 * i + 1] = *(const float4*)(src + (vd + 2 * i) * 32 + vsub * 8 + 4); \
      }                                                                                                          \
    }                                                                                                            \
  }
#define A_WRITE(RK, RV, stage)                                                                                   \
  {                                                                                                              \
    char* Kb_ = g_lds_all + (stage) * A_BUF; char* Vb_ = Kb_ + AK_BYTES;                                         \
    if (F32) {                                                                                                   \
      _Pragma("unroll") for (int i = 0; i < 2; ++i) {                                                            \
        RK[i].x = cvtpk(fk[2 * i].x, fk[2 * i].y); RK[i].y = cvtpk(fk[2 * i].z, fk[2 * i].w); RK[i].z = cvtpk(fk[2 * i + 1].x, fk[2 * i + 1].y); RK[i].w = cvtpk(fk[2 * i + 1].z, fk[2 * i + 1].w); \
        RV[i].x = cvtpk(fv[2 * i].x, fv[2 * i].y); RV[i].y = cvtpk(fv[2 * i].z, fv[2 * i].w); RV[i].z = cvtpk(fv[2 * i + 1].x, fv[2 * i + 1].y); RV[i].w = cvtpk(fv[2 * i + 1].z, fv[2 * i + 1].w); \
      }                                                                                                          \
    }                                                                                                            \
    _Pragma("unroll") for (int i = 0; i < 2; ++i) *(u32x4*)(Kb_ + (krow + 32 * i) * AK_RS + kch * 16) = RK[i];   \
    _Pragma("unroll") for (int i = 0; i < 2; ++i) *(u32x4*)(Vb_ + (vd + 2 * i) * 4096 + vkey * 64 + vsub * 16) = RV[i]; \
  }
  const int vlane = ((lane >> 4) & 1) * 32 + (lane & 3) * 8 + (4 * h + ((lane & 15) >> 2)) * 64;
  const float* biasT = (const float*)(g_lds_all + A_BIAS_OFF) + (it.head0 + m) * 257;
  const int qpos = (half ? it.qpos1 : it.qpos0) + qh * 32 + r;
#define A_COMPUTE(t, stage)                                                                                      \
  if ((t) >= tlo && (t) < thi) {                                                                                 \
    const char* Kb = g_lds_all + (stage) * A_BUF; const char* Vb = Kb + AK_BYTES;                                \
    f32x16 s0, s1;                                                                                               \
    _Pragma("unroll") for (int i = 0; i < 16; ++i) { s0[i] = 0.f; s1[i] = 0.f; }                                 \
    _Pragma("unroll") for (int s = 0; s < 4; ++s) {                                                              \
      const int co = (m * 64 + 16 * s + 8 * h) * 2;                                                              \
      const bf16x8 k0 = *(const bf16x8*)(Kb + r * AK_RS + co);                                                   \
      const bf16x8 k1 = *(const bf16x8*)(Kb + (32 + r) * AK_RS + co);                                            \
      const bf16x8 qfs = *(const bf16x8*)(qlds + s * 1024);                                                      \
      s0 = MFMA32(k0, qfs, s0);                                                                                  \
      s1 = MFMA32(k1, qfs, s1);                                                                                  \
    }                                                                                                            \
    if (BIAS) {                                                                                                  \
      const int kb = it.kpos0 + (t) * 64 + 4 * h;                                                                \
      _Pragma("unroll") for (int i = 0; i < 16; ++i) {                                                           \
        const int kk = kb + (i & 3) + 8 * (i >> 2);                                                              \
        int d0 = qpos - kk, d1 = d0 - 32;                                                                        \
        d0 = min(max(d0, -128), 128) + 128; d1 = min(max(d1, -128), 128) + 128;                                  \
        s0[i] += biasT[d0]; s1[i] += biasT[d1];                                                                  \
      }                                                                                                          \
    }                                                                                                            \
    if (MASK && ((t) + 1) * 64 > it.nkeys) {                                                                     \
      const int kb = (t) * 64 + 4 * h;                                                                           \
      _Pragma("unroll") for (int i = 0; i < 16; ++i) {                                                           \
        const int kk = kb + (i & 3) + 8 * (i >> 2);                                                              \
        if (kk >= it.nkeys) s0[i] = -1e30f;                                                                      \
        if (kk + 32 >= it.nkeys) s1[i] = -1e30f;                                                                 \
      }                                                                                                          \
    }                                                                                                            \
    float mxa = fmaxf(s0[0], s1[0]), mxb = fmaxf(s0[1], s1[1]);                                                  \
    _Pragma("unroll") for (int i = 2; i < 16; i += 2) { mxa = fmaxf(fmaxf(mxa, s0[i]), s1[i]); mxb = fmaxf(fmaxf(mxb, s0[i + 1]), s1[i + 1]); } \
    float mx = fmaxf(mxa, mxb);                                                                                  \
    mx = fmaxf(mx, xor32f(mx));                                                                                  \
    const float m_new = (mx > m_run + 8.f) ? mx : m_run;     \
    const float alpha = fexp2(m_run - m_new);                                                                    \
    if (__builtin_amdgcn_ballot_w64(m_new > m_run) != 0ull) {                                                    \
      _Pragma("unroll") for (int d = 0; d < NDT; ++d)                                                            \
        _Pragma("unroll") for (int i = 0; i < 16; ++i) oacc[d][i] *= alpha;                                      \
    }                                                                                                            \
    l_run *= alpha;                                                                                              \
    m_run = m_new;                                                                                               \
    float ls = 0.f;                                                                                              \
    _Pragma("unroll") for (int i = 0; i < 16; ++i) { s0[i] = fexp2(s0[i] - m_new); s1[i] = fexp2(s1[i] - m_new); ls += s0[i] + s1[i]; } \
    l_run += ls;                                                                                                 \
    bf16x8 pf[4];                                                                                                \
    _Pragma("unroll") for (int s2 = 0; s2 < 2; ++s2) {                                                           \
      u32x4 a, b;                                                                                                \
      a.x = cvtpk(s0[8 * s2 + 0], s0[8 * s2 + 1]); a.y = cvtpk(s0[8 * s2 + 2], s0[8 * s2 + 3]);                  \
      a.z = cvtpk(s0[8 * s2 + 4], s0[8 * s2 + 5]); a.w = cvtpk(s0[8 * s2 + 6], s0[8 * s2 + 7]);                  \
      b.x = cvtpk(s1[8 * s2 + 0], s1[8 * s2 + 1]); b.y = cvtpk(s1[8 * s2 + 2], s1[8 * s2 + 3]);                  \
      b.z = cvtpk(s1[8 * s2 + 4], s1[8 * s2 + 5]); b.w = cvtpk(s1[8 * s2 + 6], s1[8 * s2 + 7]);                  \
      pf[s2] = __builtin_bit_cast(bf16x8, a); pf[2 + s2] = __builtin_bit_cast(bf16x8, b);                        \
    }                                                                                                            \
    const LDS3 char* vb3 = (const LDS3 char*)(Vb) + vlane + (DIFF ? 0 : m * 2 * 4096);                           \
    _Pragma("unroll") for (int ks = 0; ks < 4; ++ks) {                                                           \
      _Pragma("unroll") for (int d = 0; d < NDT; ++d) {                                                          \
        const s16x4 lo = __builtin_bit_cast(s16x4, __builtin_amdgcn_ds_read_tr16_b64_v4i16((LDS3 s16x4*)(vb3 + d * 4096 + ks * 1024))); \
        const s16x4 hi = __builtin_bit_cast(s16x4, __builtin_amdgcn_ds_read_tr16_b64_v4i16((LDS3 s16x4*)(vb3 + d * 4096 + ks * 1024 + 512))); \
        const bf16x8 vf = __builtin_shufflevector(lo, hi, 0, 1, 2, 3, 4, 5, 6, 7);                               \
        oacc[d] = MFMA32(vf, pf[ks], oacc[d]);                                                                   \
      }                                                                                                          \
      __builtin_amdgcn_sched_barrier(0);                                                                         \
    }                                                                                                            \
  }
  A_LOAD(rk0, rv0, 0);
  A_WRITE(rk0, rv0, 0);
  if (ntiles > 1) A_LOAD(rk0, rv0, 1);
  __syncthreads();
#pragma unroll 1
  for (int t = 0; t < ntiles; ++t) {
    const int par = t & 1;
    if (t + 1 < ntiles) A_WRITE(rk0, rv0, par ^ 1);
    if (t + 2 < ntiles) A_LOAD(rk0, rv0, t + 2);
    A_COMPUTE(t, par);
    __syncthreads();
  }
#undef A_LOAD
#undef A_WRITE
#undef A_COMPUTE
  const float l_tot = l_run + xor32f(l_run);
  const float inv = 1.f / l_tot;
  const int q = qh * 32 + r;
  if (!DIFF) {
    if (q < rows) {
      bf16_t* gp = gbase + (long)q * 1024 + m * 64 + 4 * h;
      u32x2 gvv[NDT][4];
#pragma unroll
      for (int d = 0; d < NDT; ++d)
#pragma unroll
        for (int g4 = 0; g4 < 4; ++g4) gvv[d][g4] = *(const u32x2*)(gp + d * 32 + 8 * g4);
#pragma unroll
      for (int d = 0; d < NDT; ++d)
#pragma unroll
        for (int g4 = 0; g4 < 4; ++g4) {
          u32x2* ptr = (u32x2*)(gp + d * 32 + 8 * g4);
          const u32x2 gv = gvv[d][g4];
          u32x2 o;
          o.x = cvtpk(oacc[d][4 * g4 + 0] * inv * bflo(gv.x), oacc[d][4 * g4 + 1] * inv * bfhi(gv.x));
          o.y = cvtpk(oacc[d][4 * g4 + 2] * inv * bflo(gv.y), oacc[d][4 * g4 + 3] * inv * bfhi(gv.y));
          *ptr = o;
        }
    }
  } else {
    float* xb = (float*)g_lds_all + half * 8192 + qh * 4096 + lane;
    if (m == 1) {
      const float sc = lam * inv;
#pragma unroll
      for (int d = 0; d < NDT; ++d)
#pragma unroll
        for (int i = 0; i < 16; ++i) xb[(d * 16 + i) * 64] = oacc[d][i] * sc;
    }
    __syncthreads();
    if (m == 0) {
      float ss = 0.f;
#pragma unroll
      for (int d = 0; d < NDT; ++d)
#pragma unroll
        for (int i = 0; i < 16; ++i) { const float o = oacc[d][i] * inv - xb[(d * 16 + i) * 64]; oacc[d][i] = o; ss += o * o; }
      ss += xor32f(ss);
      const float rn = rsqrtf(ss * (1.f / 128.f) + 1e-5f) * 0.8f;
      if (q < rows) {
        bf16_t* gp = gbase + (long)q * 1024 + 4 * h;
        u32x2 gvv[NDT][4];
#pragma unroll
        for (int d = 0; d < NDT; ++d)
#pragma unroll
          for (int g4 = 0; g4 < 4; ++g4) gvv[d][g4] = *(const u32x2*)(gp + d * 32 + 8 * g4);
#pragma unroll
        for (int d = 0; d < NDT; ++d)
#pragma unroll
          for (int g4 = 0; g4 < 4; ++g4) {
            const float4 sg = *(const float4*)(subg + d * 32 + 8 * g4 + 4 * h);
            u32x2* ptr = (u32x2*)(gp + d * 32 + 8 * g4);
            const u32x2 gv = gvv[d][g4];
            u32x2 o;
            o.x = cvtpk(oacc[d][4 * g4 + 0] * rn * sg.x * bflo(gv.x), oacc[d][4 * g4 + 1] * rn * sg.y * bfhi(gv.x));
            o.y = cvtpk(oacc[d][4 * g4 + 2] * rn * sg.z * bflo(gv.y), oacc[d][4 * g4 + 3] * rn * sg.w * bfhi(gv.y));
            *ptr = o;
          }
      }
    }
    __syncthreads();
  }
}

DI void phase2(const Params& p) {
  char* ws = p.ws;
  float* biasT = (float*)(g_lds_all + A_BIAS_OFF);
  for (int i = threadIdx.x; i < 4 * 257; i += 512) biasT[i] = p.relb[i] * LOG2E;
  float s1 = 0.f, s2 = 0.f;
  for (int i = 0; i < 64; ++i) { s1 += p.dlam[i] * p.dlam[64 + i]; s2 += p.dlam[128 + i] * p.dlam[192 + i]; }
  const float lam = expf(s1) - expf(s2) + 0.2f;
  __syncthreads();
  int* ctr = (int*)(ws + WS_CTR);
  int* s_item = (int*)(g_lds_all + A_ITEM_OFF);
  const char* ob = (const char*)p.out;
  const bf16_t* AQ = (const bf16_t*)(ob + OB_AQ); const bf16_t* AK = (const bf16_t*)(ob + OB_AK); const bf16_t* AV = (const bf16_t*)(ob + OB_AV);
  const bf16_t* BQ = (const bf16_t*)(ob + OB_BQ); const bf16_t* BK = (const bf16_t*)(ob + OB_BK); const bf16_t* BV = (const bf16_t*)(ws + WS_BV);
  const bf16_t* MQ = (const bf16_t*)(ob + OB_MQ); const bf16_t* MK = (const bf16_t*)(ws + WS_MK); const bf16_t* MV = (const bf16_t*)(ws + WS_MV);
  bf16_t* G = (bf16_t*)(ws + WS_G);
  constexpr int N_BP = 1024, N_BS = 128, N_AP = 512, N_AS = 64, N_MP = 512, N_MS = 64;
  constexpr int N_ALL = N_BP + N_BS + N_AP + N_AS + N_MP + N_MS;
  for (;;) {
    if (threadIdx.x == 0) *s_item = atomicAdd(ctr, 1);
    __syncthreads();
    int item = *s_item;
    __syncthreads();
    if (item >= N_ALL) break;
    AttnItem it;
    it.bias = false; it.qpos0 = 0; it.qpos1 = 0; it.kpos0 = 0; it.head0 = 0; it.rows0 = 64; it.rows1 = 64;
    it.kf = nullptr; it.vf = nullptr; it.kn = nullptr; it.vn = nullptr; it.ncache = 0; it.k = nullptr; it.v = nullptr;
    if (item < N_BP) {
      const int j = 63 - (item >> 4), bh = item & 15, b = bh >> 2, hh = bh & 3;
      const long tok0 = (long)b * SEQ + j * 128;
      it.q0 = BQ + tok0 * 512 + hh * 128; it.q1 = it.q0 + 64 * 512;
      it.k = BK + (long)b * SEQ * 512 + hh * 128; it.v = BV + (long)b * SEQ * 512 + hh * 128;
      it.qs = 512; it.ks = 512; it.ntiles = 2 * j + 2; it.nkeys = it.ntiles * 64;
      it.tlo0 = 0; it.thi0 = 2 * j + 1; it.tlo1 = 0; it.thi1 = 2 * j + 2;
      it.g0 = G + tok0 * 1024 + 256 + hh * 128; it.g1 = it.g0 + 64 * 1024;
      attn_item<true, false, false, false>(it, lam, p.subg);
      continue;
    }
    item -= N_BP;
    if (item < N_BS) {
      const int b = item >> 2, hh = item & 3;
      const long tok0 = NTOKP + b * ST;
      it.q0 = BQ + tok0 * 512 + hh * 128; it.q1 = it.q0;
      it.kf = p.cbk + (long)b * PAST * 512 + hh * 128; it.vf = p.cbv + (long)b * PAST * 512 + hh * 128; it.ncache = PAST / 64;
      it.kn = p.out + O_BKS + (long)b * ST * 512 + hh * 128; it.vn = p.out + O_BVS + (long)b * ST * 512 + hh * 128;
      it.qs = 512; it.ks = 512; it.ntiles = 17; it.nkeys = PAST + ST;
      it.tlo0 = 0; it.thi0 = 17; it.tlo1 = 0; it.thi1 = 0; it.rows0 = ST; it.rows1 = 0;
      it.g0 = G + tok0 * 1024 + 256 + hh * 128; it.g1 = it.g0;
      attn_item<true, false, true, true>(it, lam, p.subg);
      continue;
    }
    item -= N_BS;
    if (item < N_AP) {
      const int j = 63 - (item >> 3), bh = item & 7, b = bh >> 1, hp = bh & 1;
      const int c0 = 2 * j, c1 = c0 + 1, cs0 = c0 > 8 ? c0 - 8 : 0, cs1 = c1 > 8 ? c1 - 8 : 0;
      const long tok0 = (long)b * SEQ + c0 * 64, k0 = (long)b * SEQ + cs0 * 64;
      it.q0 = AQ + tok0 * 256 + hp * 128; it.q1 = it.q0 + 64 * 256;
      it.k = AK + k0 * 256 + hp * 128; it.v = AV + k0 * 256 + hp * 128;
      it.qs = 256; it.ks = 256; it.ntiles = c1 - cs0 + 1; it.nkeys = it.ntiles * 64;
      it.tlo0 = 0; it.thi0 = c0 - cs0 + 1; it.tlo1 = cs1 - cs0; it.thi1 = it.ntiles;
      it.g0 = G + tok0 * 1024 + hp * 128; it.g1 = it.g0 + 64 * 1024;
      it.bias = true; it.qpos0 = c0 * 64; it.qpos1 = c1 * 64; it.kpos0 = cs0 * 64; it.head0 = hp * 2;
    } else if ((item -= N_AP) < N_AS) {
      const int b = item >> 1, hp = item & 1;
      const long tok0 = NTOKP + b * ST;
      it.q0 = AQ + tok0 * 256 + hp * 128; it.q1 = it.q0;
      it.kf = p.cak + (long)b * RA * 256 + hp * 128; it.vf = p.cav + (long)b * RA * 256 + hp * 128; it.ncache = RA / 64;
      it.kn = p.out + O_AKS + (long)b * ST * 256 + hp * 128; it.vn = p.out + O_AVS + (long)b * ST * 256 + hp * 128;
      it.qs = 256; it.ks = 256; it.ntiles = 9; it.nkeys = RA + ST;
      it.tlo0 = 0; it.thi0 = 9; it.tlo1 = 0; it.thi1 = 0; it.rows0 = ST; it.rows1 = 0;
      it.g0 = G + tok0 * 1024 + hp * 128; it.g1 = it.g0;
      it.bias = true; it.qpos0 = RA; it.qpos1 = RA; it.kpos0 = 0; it.head0 = hp * 2;
    } else if ((item -= N_AS) < N_MP) {
      const int j = item >> 3, bh = item & 7, b = bh >> 1, hp = bh & 1;
      const long tok0 = (long)b * SEQ + j * 128;
      it.q0 = MQ + tok0 * 256 + hp * 128; it.q1 = it.q0 + 64 * 256;
      it.k = MK + (long)b * NMEM * 256 + hp * 128; it.v = MV + (long)b * NMEM * 256 + hp * 128;
      it.qs = 256; it.ks = 256; it.ntiles = 4; it.nkeys = NMEM;
      it.tlo0 = 0; it.thi0 = 4; it.tlo1 = 0; it.thi1 = 4;
      it.g0 = G + tok0 * 1024 + 768 + hp * 128; it.g1 = it.g0 + 64 * 1024;
    } else {
      item -= N_MP;
      const int b = item >> 1, hp = item & 1;
      const long tok0 = NTOKP + b * ST;
      it.q0 = MQ + tok0 * 256 + hp * 128; it.q1 = it.q0;
      it.kf = p.cmk + (long)b * NMEM * 256 + hp * 128; it.vf = p.cmv + (long)b * NMEM * 256 + hp * 128; it.ncache = NMEM / 64;
      it.kn = it.kf; it.vn = it.vf;
      it.qs = 256; it.ks = 256; it.ntiles = 4; it.nkeys = NMEM;
      it.tlo0 = 0; it.thi0 = 4; it.tlo1 = 0; it.thi1 = 0; it.rows0 = ST; it.rows1 = 0;
      it.g0 = G + tok0 * 1024 + 768 + hp * 128; it.g1 = it.g0;
    }
    const bool f32src = it.kf != nullptr;
    if (it.bias) { if (f32src) attn_item<false, true, true, true>(it, lam, p.subg); else attn_item<false, true, false, false>(it, lam, p.subg); }
    else { if (f32src) attn_item<false, false, false, true>(it, lam, p.subg); else attn_item<false, false, false, false>(it, lam, p.subg); }
  }
}

DI void phase3(const Params& p) {
  pg8::Gemm g; g.A = (const bf16_t*)(p.ws + WS_G); g.Bt = (const bf16_t*)(p.ws + WS_WOUTT); g.M = NTOK; g.N = 1024; g.K = 1024;
  pg8::StaticOrder S; S.init(NTOK, 1024, (int)gridDim.x, (int)blockIdx.x);
  EpiOut E; E.ypre = (bf16_t*)(p.ws + WS_XB); E.xp = p.xp; E.xs = p.xs;
  pg8::gemm_phase<EpiOut, pg8::StaticOrder, false>((PG8_LAS unsigned char*)g_lds_all, g, S, E, nullptr);
  __syncthreads();
}

DI void phase4(const Params& p) {
  const int lane = threadIdx.x & 63, w = threadIdx.x >> 6;
  float4 g[4], bb[4];
#pragma unroll
  for (int j = 0; j < 4; ++j) { g[j] = *(const float4*)(p.ln_g + j * 256 + lane * 4); bb[j] = *(const float4*)(p.ln_b + j * 256 + lane * 4); }
  for (int row0 = (blockIdx.x * 8 + w) * 4; row0 < NTOK; row0 += gridDim.x * 32) {
    float4 v[4][4];
#pragma unroll
    for (int rr = 0; rr < 4; ++rr)
#pragma unroll
      for (int j = 0; j < 4; ++j) { const u32x2 w = __builtin_nontemporal_load((const u32x2*)((const bf16_t*)(p.ws + WS_XB) + (long)(row0 + rr) * 1024 + j * 256 + lane * 4)); v[rr][j] = make_float4(bflo(w.x), bfhi(w.x), bflo(w.y), bfhi(w.y)); }
    float s[4], q[4];
#pragma unroll
    for (int rr = 0; rr < 4; ++rr) { s[rr] = 0.f;
#pragma unroll
      for (int j = 0; j < 4; ++j) s[rr] += v[rr][j].x + v[rr][j].y + v[rr][j].z + v[rr][j].w; }
#pragma unroll
    for (int o = 1; o < 64; o <<= 1)
#pragma unroll
      for (int rr = 0; rr < 4; ++rr) s[rr] += __shfl_xor(s[rr], o);
#pragma unroll
    for (int rr = 0; rr < 4; ++rr) { const float mu = s[rr] * (1.f / 1024.f); s[rr] = mu; q[rr] = 0.f;
#pragma unroll
      for (int j = 0; j < 4; ++j) { const float a = v[rr][j].x - mu, b = v[rr][j].y - mu, c = v[rr][j].z - mu, d = v[rr][j].w - mu; q[rr] += a * a + b * b + c * c + d * d; } }
#pragma unroll
    for (int o = 1; o < 64; o <<= 1)
#pragma unroll
      for (int rr = 0; rr < 4; ++rr) q[rr] += __shfl_xor(q[rr], o);
#pragma unroll
    for (int rr = 0; rr < 4; ++rr) {
      const float mu = s[rr], rs = rsqrtf(q[rr] * (1.f / 1024.f) + 1e-5f);
#pragma unroll
      for (int j = 0; j < 4; ++j) {
        float4 o;
        o.x = (v[rr][j].x - mu) * rs * g[j].x + bb[j].x; o.y = (v[rr][j].y - mu) * rs * g[j].y + bb[j].y;
        o.z = (v[rr][j].z - mu) * rs * g[j].z + bb[j].z; o.w = (v[rr][j].w - mu) * rs * g[j].w + bb[j].w;
        { const pg8::f32x4 ov = {o.x, o.y, o.z, o.w}; __builtin_nontemporal_store(ov, (pg8::f32x4*)(p.out + O_Y + (long)(row0 + rr) * 1024 + j * 256 + lane * 4)); }
      }
    }
  }
}

DI void grid_barrier(unsigned* bar, unsigned target) {
  asm volatile("s_waitcnt vmcnt(0) lgkmcnt(0)" ::: "memory");
  __syncthreads();
  if (threadIdx.x == 0) {
    __builtin_amdgcn_fence(__ATOMIC_RELEASE, "agent");
    asm volatile("s_waitcnt vmcnt(0)" ::: "memory");
    __hip_atomic_fetch_add(bar, 1u, __ATOMIC_RELAXED, __HIP_MEMORY_SCOPE_AGENT);
    while (__hip_atomic_load(bar, __ATOMIC_RELAXED, __HIP_MEMORY_SCOPE_AGENT) < target) __builtin_amdgcn_s_sleep(2);
    __builtin_amdgcn_fence(__ATOMIC_ACQUIRE, "agent");
    asm volatile("s_waitcnt vmcnt(0)" ::: "memory");
  }
  __syncthreads();
}
__global__ void __launch_bounds__(512) fwd_megakernel(Params p) {
  cg::grid_group grid = cg::this_grid();
  unsigned* bar = (unsigned*)(p.ws + WS_CTR + 64);
  const unsigned nb = gridDim.x;
  phase0(p);
  if (p.ws == nullptr) grid.sync();
  grid_barrier(bar, nb);
  phase1(p);
  grid_barrier(bar, 2 * nb);
  phase2(p);
  grid_barrier(bar, 3 * nb);
  phase3(p);
  grid_barrier(bar, 4 * nb);
  phase4(p);
}

extern "C" void kernel_launch(void* const* d_in, const int* in_sizes, int n_in, void* d_out, int out_size,
                              void* d_ws, size_t ws_size, hipStream_t stream) {
  static int grid_blocks = 0;
  if (!grid_blocks) {
    int dev = 0, cus = 0, per_cu = 0;
    (void)hipGetDevice(&dev);
    (void)hipDeviceGetAttribute(&cus, hipDeviceAttributeMultiprocessorCount, dev);
    (void)hipOccupancyMaxActiveBlocksPerMultiprocessor(&per_cu, fwd_megakernel, 512, 0);
    if (per_cu > 1) per_cu = 1;
    if (per_cu < 1) per_cu = 1;
    grid_blocks = cus * per_cu;
    if (ws_size < WS_END || out_size != (int)O_END) fprintf(stderr, "kernel_launch: unexpected sizes ws %zu (need %zu) out %d (need %ld)\n", ws_size, (size_t)WS_END, out_size, (long)O_END);
  }
  (void)hipMemsetAsync((char*)d_ws + WS_CTR, 0, 256, stream);
  Params p{};
  p.xp = (const float*)d_in[0]; p.xs = (const float*)d_in[1];
  p.cak = (const float*)d_in[2]; p.cav = (const float*)d_in[3]; p.cbk = (const float*)d_in[4]; p.cbv = (const float*)d_in[5];
  p.cmk = (const float*)d_in[6]; p.cmv = (const float*)d_in[7];
  p.memp = (const float*)d_in[8]; p.w_in = (const float*)d_in[9]; p.w_mem = (const float*)d_in[10]; p.relb = (const float*)d_in[11];
  p.dlam = (const float*)d_in[12]; p.subg = (const float*)d_in[13]; p.w_out = (const float*)d_in[14]; p.ln_g = (const float*)d_in[15]; p.ln_b = (const float*)d_in[16];
  p.out = (float*)d_out; p.ws = (char*)d_ws;
  void* args[] = {&p};
  hipError_t e = hipLaunchCooperativeKernel((void*)fwd_megakernel, dim3(grid_blocks), dim3(512), args, 0, stream);
  if (e != hipSuccess) fprintf(stderr, "cooperative launch failed: %s (grid %d)\n", hipGetErrorString(e), grid_blocks);
}
```

```cpp
#include <hip/hip_runtime.h>
#include <hip/hip_cooperative_groups.h>
#include <cstdio>
#include <cstdint>
namespace cg = cooperative_groups;

typedef unsigned short bf16_t;
typedef short bf16x8 __attribute__((ext_vector_type(8)));
typedef short s16x4 __attribute__((ext_vector_type(4)));
typedef float f32x16 __attribute__((ext_vector_type(16)));
typedef float f32x2_t __attribute__((ext_vector_type(2)));
typedef __bf16 bf16x2_t __attribute__((ext_vector_type(2)));
typedef unsigned u32x2 __attribute__((ext_vector_type(2)));
typedef unsigned u32x4 __attribute__((ext_vector_type(4)));
typedef float f32x4g __attribute__((ext_vector_type(4)));
#define DI __device__ __forceinline__
#define MFMA32(a, b, c) __builtin_amdgcn_mfma_f32_32x32x16_bf16((a), (b), (c), 0, 0, 0)
#define LDS3 __attribute__((address_space(3)))

constexpr int D_MODEL = 1024, SEQ = 8192, NB = 4, NTOKP = NB * SEQ, SB = 32, ST = 16, NTOKS = SB * ST, NTOK = NTOKP + NTOKS;
constexpr int PAST = 1024, RA = 512, NMEM = 256, PROJ = 3584;
constexpr int SAK_ROWS = 576, SBK_ROWS = 1088;
constexpr int NTOKPAD = NTOK + 64;
constexpr float QSCALE = 0.125f * 1.4426950408889634f;
constexpr float LOG2E = 1.4426950408889634f;
constexpr float ALPHA = 1.189207115002721f;

constexpr long O_Y = 0;
constexpr long O_AKP = (long)NTOK * 1024;
constexpr long O_AVP = O_AKP + (long)NB * RA * 256;
constexpr long O_BKP = O_AVP + (long)NB * RA * 256;
constexpr long O_BVP = O_BKP + (long)NTOKP * 512;
constexpr long O_MKP = O_BVP + (long)NTOKP * 512;
constexpr long O_MVP = O_MKP + (long)NB * NMEM * 256;
constexpr long O_AKS = O_MVP + (long)NB * NMEM * 256;
constexpr long O_AVS = O_AKS + (long)NTOKS * 256;
constexpr long O_BKS = O_AVS + (long)NTOKS * 256;
constexpr long O_BVS = O_BKS + (long)NTOKS * 512;
constexpr long O_END = O_BVS + (long)NTOKS * 512;

constexpr size_t WS_CTR = 0;
constexpr size_t WS_WINT = 256;
constexpr size_t WS_WOUTT = WS_WINT + (size_t)PROJ * 1024 * 2;
constexpr size_t WS_WMEMT = WS_WOUTT + (size_t)1024 * 1024 * 2;
constexpr size_t WS_ROPE = WS_WMEMT + (size_t)512 * 1024 * 2;
constexpr size_t OB_AQ = 0;
constexpr size_t OB_BQ = OB_AQ + (size_t)NTOKPAD * 256 * 2;
constexpr size_t OB_MQ = OB_BQ + (size_t)NTOKPAD * 512 * 2;
constexpr size_t OB_AK = OB_MQ + (size_t)NTOKPAD * 256 * 2;
constexpr size_t OB_AV = OB_AK + (size_t)NTOKP * 256 * 2;
constexpr size_t OB_BK = OB_AV + (size_t)NTOKP * 256 * 2;
constexpr size_t OB_END = OB_BK + (size_t)NTOKP * 512 * 2;
static_assert(OB_END <= (size_t)NTOK * 1024 * 4, "temporaries must fit in the y region");
constexpr size_t WS_BV = WS_ROPE + (size_t)SEQ * 32 * 8;
constexpr size_t WS_G = WS_BV + (size_t)NTOKP * 512 * 2;
constexpr size_t WS_MK = WS_G + (size_t)NTOK * 1024 * 2;
constexpr size_t WS_MV = WS_MK + (size_t)NB * NMEM * 256 * 2;
constexpr size_t WS_SAK = WS_MV + (size_t)NB * NMEM * 256 * 2;
constexpr size_t WS_SAV = WS_SAK + (size_t)SB * SAK_ROWS * 256 * 2;
constexpr size_t WS_SBK = WS_SAV + (size_t)SB * SAK_ROWS * 256 * 2;
constexpr size_t WS_SBV = WS_SBK + (size_t)SB * SBK_ROWS * 512 * 2;
constexpr size_t WS_SMK = WS_SBV + (size_t)SB * SBK_ROWS * 512 * 2;
constexpr size_t WS_SMV = WS_SMK + (size_t)SB * NMEM * 256 * 2;
constexpr size_t WS_XB = WS_SMV + (size_t)SB * NMEM * 256 * 2;
constexpr size_t WS_MB = WS_XB + (size_t)NTOK * 1024 * 2;
constexpr size_t WS_END = WS_MB + (size_t)NB * NMEM * 1024 * 2;
static_assert(WS_END <= (size_t)512 * 1024 * 1024, "workspace budget");

struct Params {
  const float* xp; const float* xs;
  const float* cak; const float* cav; const float* cbk; const float* cbv; const float* cmk; const float* cmv;
  const float* memp; const float* w_in; const float* w_mem; const float* relb; const float* dlam; const float* subg;
  const float* w_out; const float* ln_g; const float* ln_b;
  float* out; char* ws;
};

constexpr int TEAM_LDS = 73728 + 64;
constexpr int LDS_BYTES = 2 * TEAM_LDS + 64;
__shared__ __attribute__((aligned(16))) char g_lds_all[LDS_BYTES];
#define TEAM (__builtin_amdgcn_readfirstlane((int)(threadIdx.x >> 8)))
#define g_lds (g_lds_all + TEAM * TEAM_LDS)

DI unsigned cvtpk(float lo, float hi) { f32x2_t v = {lo, hi}; bf16x2_t b = __builtin_convertvector(v, bf16x2_t); return __builtin_bit_cast(unsigned, b); }
DI bf16_t f2bf(float x) { return (bf16_t)(cvtpk(x, 0.f) & 0xffffu); }
DI float bf2f(unsigned short b) { return __uint_as_float(((unsigned)b) << 16); }
DI float bflo(unsigned u) { return __uint_as_float(u << 16); }
DI float bfhi(unsigned u) { return __uint_as_float(u & 0xffff0000u); }
DI float fexp2(float x) { return __builtin_amdgcn_exp2f(x); }
DI float xor32f(float v) { return __shfl_xor(v, 32); }

template <bool SWAP45>
DI void transpose_tile(const float* __restrict__ src, int N, bf16_t* __restrict__ dst, int K, int k0, int n0) {
  float* tile = (float*)g_lds;
  const int tid = threadIdx.x & 255, c = tid & 63, r0 = tid >> 6;
#pragma unroll
  for (int i = 0; i < 16; ++i) { const int row = r0 + 4 * i; tile[row * 65 + c] = src[(long)(k0 + row) * N + n0 + c]; }
  __syncthreads();
#pragma unroll
  for (int i = 0; i < 16; ++i) { const int rr = r0 + 4 * i; const int pr = (SWAP45 && n0 >= 768 && n0 < 1792) ? (32 * ((rr >> 4) & 1) + 8 * ((rr >> 2) & 3) + 4 * (rr >> 5) + (rr & 3)) : rr;     dst[(long)(n0 + pr) * K + k0 + c] = f2bf(tile[c * 65 + rr]); }
  __syncthreads();
}

DI void convert_rows(const float* __restrict__ src, bf16_t* __restrict__ dst, int rows_w8, int dst_bstride_w8, long gtid, long gsz) {
  const long total = (long)SB * rows_w8;
  for (long u = gtid; u < total; u += gsz) {
    const int b = (int)(u / rows_w8); const int j = (int)(u - (long)b * rows_w8);
    const float4 a0 = *(const float4*)(src + u * 8), a1 = *(const float4*)(src + u * 8 + 4);
    u32x4 v; v.x = cvtpk(a0.x, a0.y); v.y = cvtpk(a0.z, a0.w); v.z = cvtpk(a1.x, a1.y); v.w = cvtpk(a1.z, a1.w);
    *(u32x4*)(dst + ((long)b * dst_bstride_w8 + j) * 8) = v;
  }
}

DI void phase0(const Params& p) {
  bf16_t* winT = (bf16_t*)(p.ws + WS_WINT); bf16_t* woutT = (bf16_t*)(p.ws + WS_WOUTT); bf16_t* wmemT = (bf16_t*)(p.ws + WS_WMEMT);
  constexpr int T_IN = 16 * 56, T_OUT = 16 * 16, T_MEM = 16 * 8;
  for (int t = blockIdx.x * 2 + TEAM; t < T_IN + T_OUT + T_MEM; t += gridDim.x * 2) {
    if (t < T_IN) transpose_tile<true>(p.w_in, PROJ, winT, 1024, (t / 56) * 64, (t % 56) * 64);
    else if (t < T_IN + T_OUT) { const int u = t - T_IN; transpose_tile<false>(p.w_out, 1024, woutT, 1024, (u >> 4) * 64, (u & 15) * 64); }
    else { const int u = t - T_IN - T_OUT; transpose_tile<false>(p.w_mem, 512, wmemT, 1024, (u >> 3) * 64, (u & 7) * 64); }
  }
  float2* rope = (float2*)(p.ws + WS_ROPE);
  for (int idx = blockIdx.x * 512 + threadIdx.x; idx < SEQ * 32; idx += gridDim.x * 512) {
    const int pos = idx >> 5, i = idx & 31;
    const double inv = exp(-(double)i * (9.210340371976184 / 32.0));
    const double rev = (double)pos * inv * 0.15915494309189535;
    const double fr = rev - rint(rev);
    const float a = (float)(fr * 6.283185307179586);
    rope[idx] = make_float2(cosf(a), sinf(a));
  }
  const int G = gridDim.x;
  const long gtid = (long)blockIdx.x * 512 + threadIdx.x, gsz = (long)G * 512;
  {
    bf16_t* XB = (bf16_t*)(p.ws + WS_XB); bf16_t* MB = (bf16_t*)(p.ws + WS_MB);
    const long nxp = (long)NTOKP * 1024 / 8, nxs = (long)NTOKS * 1024 / 8, nmb = (long)NB * NMEM * 1024 / 8;
#pragma unroll 4
    for (long u = gtid; u < nxp + nxs + nmb; u += gsz) {
      const float* src; bf16_t* dst;
      if (u < nxp) { src = p.xp + u * 8; dst = XB + u * 8; }
      else if (u < nxp + nxs) { src = p.xs + (u - nxp) * 8; dst = XB + u * 8; }
      else { src = p.memp + (u - nxp - nxs) * 8; dst = MB + (u - nxp - nxs) * 8; }
      const f32x4g a0 = __builtin_nontemporal_load((const f32x4g*)(src)), a1 = __builtin_nontemporal_load((const f32x4g*)(src + 4));
      u32x4 v; v.x = cvtpk(a0[0], a0[1]); v.y = cvtpk(a0[2], a0[3]); v.z = cvtpk(a1[0], a1[1]); v.w = cvtpk(a1[2], a1[3]);
      *(u32x4*)dst = v;
    }
  }
}

constexpr int G_RS = 144, GA_BYTES = 128 * G_RS, GB_BYTES = 256 * G_RS, G_STAGE = GA_BYTES + GB_BYTES;
DI void gemm_core(const bf16_t* __restrict__ Ap, int lda, const bf16_t* __restrict__ Bp, int ldb, int K, f32x16 (&acc)[2][2]) {
  const int tid = threadIdx.x, lane = tid & 63, w = tid >> 6, wm = w >> 2, wn = w & 3, r = lane & 31, h = lane >> 5;
#pragma unroll
  for (int a = 0; a < 2; ++a)
#pragma unroll
    for (int b = 0; b < 2; ++b)
#pragma unroll
      for (int i = 0; i < 16; ++i) acc[a][b][i] = 0.f;
  u32x4 ra0[2], rb0[4], ra1[2], rb1[4];
  const int lrow = tid >> 3, lch = tid & 7;
  const bf16_t* Ag = Ap + (long)lrow * lda + lch * 8;
  const bf16_t* Bg = Bp + (long)lrow * ldb + lch * 8;
#define G_LOAD(RA, RB, kt)                                                                                      \
  {                                                                                                             \
    _Pragma("unroll") for (int i = 0; i < 2; ++i) RA[i] = *(const u32x4*)(Ag + (long)(64 * i) * lda + (kt) * 64); \
    _Pragma("unroll") for (int i = 0; i < 4; ++i) RB[i] = *(const u32x4*)(Bg + (long)(64 * i) * ldb + (kt) * 64); \
  }
#define G_WRITE(RA, RB, buf)                                                                                    \
  {                                                                                                             \
    char* Ab_ = g_lds_all + (buf) * G_STAGE; char* Bb_ = Ab_ + GA_BYTES;                                        \
    _Pragma("unroll") for (int i = 0; i < 2; ++i) *(u32x4*)(Ab_ + (lrow + 64 * i) * G_RS + lch * 16) = RA[i];   \
    _Pragma("unroll") for (int i = 0; i < 4; ++i) *(u32x4*)(Bb_ + (lrow + 64 * i) * G_RS + lch * 16) = RB[i];   \
  }
#define G_COMPUTE(buf)                                                                                          \
  {                                                                                                             \
    const char* Ab = g_lds_all + (buf) * G_STAGE; const char* Bb = Ab + GA_BYTES;                               \
    _Pragma("unroll") for (int s = 0; s < 4; ++s) {                                                             \
      const int co = (16 * s + 8 * h) * 2;                                                                      \
      const bf16x8 a0 = *(const bf16x8*)(Ab + (wm * 64 + r) * G_RS + co);                                       \
      const bf16x8 a1 = *(const bf16x8*)(Ab + (wm * 64 + 32 + r) * G_RS + co);                                  \
      const bf16x8 b0 = *(const bf16x8*)(Bb + (wn * 64 + r) * G_RS + co);                                       \
      const bf16x8 b1 = *(const bf16x8*)(Bb + (wn * 64 + 32 + r) * G_RS + co);                                  \
      acc[0][0] = MFMA32(a0, b0, acc[0][0]);                                                                    \
      acc[0][1] = MFMA32(a0, b1, acc[0][1]);                                                                    \
      acc[1][0] = MFMA32(a1, b0, acc[1][0]);                                                                    \
      acc[1][1] = MFMA32(a1, b1, acc[1][1]);                                                                    \
    }                                                                                                           \
  }
  const int nk = K >> 6;
  G_LOAD(ra0, rb0, 0);
  G_LOAD(ra1, rb1, 1);
  G_WRITE(ra0, rb0, 0);
  __syncthreads();
  for (int kt = 0; kt < nk; kt += 2) {
    if (kt + 2 < nk) G_LOAD(ra0, rb0, kt + 2);
    G_COMPUTE(0);
    G_WRITE(ra1, rb1, 1);
    __syncthreads();
    if (kt + 3 < nk) G_LOAD(ra1, rb1, kt + 3);
    G_COMPUTE(1);
    if (kt + 2 < nk) G_WRITE(ra0, rb0, 0);
    __syncthreads();
  }
#undef G_COMPUTE
#undef G_LOAD
#undef G_WRITE
}

namespace pg8 {
#define PG8_LAS __attribute__((address_space(3)))
typedef unsigned short bf16_t;
typedef short bf16x8 __attribute__((ext_vector_type(8)));
typedef float f32x4 __attribute__((ext_vector_type(4)));
typedef unsigned u32x4 __attribute__((ext_vector_type(4)));
constexpr int BM = 256, BK = 64, HALF = 128, HTB = HALF * BK * 2  , STAGE_BYTES = 8 * HTB, NXCD = 8, WGM = 8;

__host__ __device__ __forceinline__ int lds_byte(int r, int c) { const int st = (r >> 4) * 2 + (c >> 5), rr = r & 15, cc = c & 31, ob = rr * 64 + cc * 2; return st * 1024 + (ob ^ (((ob >> 9) & 1) << 5)); }
__host__ __device__ __forceinline__ void stage_rc(int b, int& R, int& C) { const int st = b / 1024, sb = b % 1024, swz = sb ^ (((sb >> 9) & 1) << 5); R = (st >> 1) * 16 + swz / 64; C = (st & 1) * 32 + (swz % 64) / 2; }
__host__ __device__ __forceinline__ int perm32(int rho) { const int n = rho >> 4, i = rho & 15; return 8 * (i >> 2) + 4 * n + (i & 3); }

struct Unit { int pm, pn; };
struct Gemm { const bf16_t* A; const bf16_t* Bt; int M, N, K; };

struct StaticOrder {
    int nM, nN, nwg, G, c;
    __host__ __device__ void init(int M, int N, int G_, int c_) { nM = M / BM; nN = N / BM; nwg = nM * nN; G = G_; c = c_; }
    __host__ __device__ bool next(int i, Unit& u) const {
        const long L = (long)i * G + c; if (L >= nwg) return false;
        int wgid = (int)L; { const int q = nwg / NXCD, r = nwg % NXCD, xcd = wgid % NXCD, off = wgid / NXCD; wgid = (xcd < r ? xcd * (q + 1) : r * (q + 1) + (xcd - r) * q) + off; }
        const int nig = WGM * nN, gid = wgid / nig, fm = gid * WGM, gsz = (nM - fm) < WGM ? (nM - fm) : WGM;
        u.pm = fm + ((wgid % nig) % gsz); u.pn = (wgid % nig) / gsz; return true;
    }
    __device__ __forceinline__ void a_ready(const Unit&) const {}
    __device__ __forceinline__ void done(const Unit&) const {}
};
template <class Epi, class Sched, bool STAMP = false>
__device__ __forceinline__ void gemm_phase(PG8_LAS unsigned char* lds, const Gemm g, const Sched& S, const Epi& E, unsigned long long* stamps) {
    const int tid = threadIdx.x, wid = __builtin_amdgcn_readfirstlane(tid >> 6), lane = tid & 63, wr = wid >> 2, wc = wid & 3, fr = lane & 15, fq = lane >> 4;
    const int K = g.K, nt = K / BK;
    int ts_lo = 0, ts_hi = 0, nts = 0; const unsigned long long rt_entry = STAMP ? (unsigned long long)wall_clock64() : 0ull;
#define PG8_STAMP() do { if (STAMP && wid == 0 && nts < 64) { const unsigned long long _c = (unsigned long long)clock64(); \
        ts_lo = (lane == nts) ? (int)(unsigned)_c : ts_lo; ts_hi = (lane == nts) ? (int)(unsigned)(_c >> 32) : ts_hi; ++nts; } } while (0)
    PG8_STAMP();
    unsigned voffA[2], voffB[2];
#pragma unroll
    for (int i = 0; i < 2; ++i) { int R, C; stage_rc(tid * 16 + i * 8192, R, C); const int Rb = Epi::PERM ? ((R & ~31) + perm32(R & 31)) : R;
        voffA[i] = (unsigned)(R * K + C) * 2u; voffB[i] = (unsigned)(Rb * K + C) * 2u; }
    const size_t kstep = (size_t)(BK * 2);
    const size_t hstep = (size_t)HALF * K * 2;
    const size_t tstep = 2 * hstep;
    const unsigned ldsw = (unsigned)wid * 1024u;
    const int aoff = lds_byte(wr * 64 + fr, fq * 8), boff = lds_byte(wc * 32 + fr, fq * 8);
#define PG8_SA(b, h) (((b) * 2 + (h)) * HTB)
#define PG8_SB(b, h) ((4 + (b) * 2 + (h)) * HTB)
#define PG8_STAGE(bufoff, gbase, voff) do { _Pragma("unroll") for (int _i = 0; _i < 2; ++_i) \
        __builtin_amdgcn_global_load_lds((const unsigned*)((const char*)(gbase) + (voff)[_i]), (PG8_LAS unsigned*)(lds + (bufoff) + ldsw + _i * 8192), 16, 0, 0); } while (0)
#define PG8_LDA(dst, b, h) do { _Pragma("unroll") for (int m = 0; m < 4; ++m) _Pragma("unroll") for (int k = 0; k < 2; ++k) dst[m][k] = *(const PG8_LAS bf16x8*)(lds + PG8_SA(b, h) + aoff + m * 2048 + k * 1024); } while (0)
#define PG8_LDB(dst, b, h) do { _Pragma("unroll") for (int n = 0; n < 2; ++n) _Pragma("unroll") for (int k = 0; k < 2; ++k) dst[n][k] = *(const PG8_LAS bf16x8*)(lds + PG8_SB(b, h) + boff + n * 2048 + k * 1024); } while (0)
#define PG8_MMA(ai, bj, At, Bt) do { __builtin_amdgcn_s_setprio(1); _Pragma("unroll") for (int m = 0; m < 4; ++m) _Pragma("unroll") for (int n = 0; n < 2; ++n) _Pragma("unroll") for (int k = 0; k < 2; ++k) \
        acc[ai][bj][m][n] = __builtin_amdgcn_mfma_f32_16x16x32_bf16(Bt[n][k], At[m][k], acc[ai][bj][m][n], 0, 0, 0); __builtin_amdgcn_s_setprio(0); } while (0)
#define PG8_WAIT_V(n) asm volatile("s_waitcnt vmcnt(" #n ")" ::: "memory")
#define PG8_WAIT_L(n) asm volatile("s_waitcnt lgkmcnt(" #n ")" ::: "memory")
#define PG8_BAR __builtin_amdgcn_s_barrier()
#define PG8_SCHED __builtin_amdgcn_sched_barrier(0)
    Unit cur, nxt; int ui = 0;
    if (!S.next(0, cur)) return;
    f32x4 acc[2][2][4][2];
#pragma unroll
    for (int a = 0; a < 2; ++a)
#pragma unroll
        for (int b = 0; b < 2; ++b)
#pragma unroll
            for (int m = 0; m < 4; ++m)
#pragma unroll
                for (int n = 0; n < 2; ++n) acc[a][b][m][n] = (f32x4){0.f, 0.f, 0.f, 0.f};
    bf16x8 At[4][2], B0[2][2], B1[2][2];
    const char* cA = (const char*)g.A + (size_t)cur.pm * tstep; const char* cB = (const char*)g.Bt + (size_t)cur.pn * tstep;
    S.a_ready(cur);
    PG8_STAGE(PG8_SB(0, 0), cB, voffB); PG8_STAGE(PG8_SA(0, 0), cA, voffA); PG8_STAGE(PG8_SB(0, 1), cB + hstep, voffB); PG8_STAGE(PG8_SA(0, 1), cA + hstep, voffA);
    if (wr == 1) PG8_BAR;
    PG8_WAIT_V(4); PG8_BAR;
    PG8_STAGE(PG8_SB(1, 0), cB + kstep, voffB); PG8_STAGE(PG8_SA(1, 0), cA + kstep, voffA); PG8_STAGE(PG8_SB(1, 1), cB + hstep + kstep, voffB);
    PG8_WAIT_V(6); PG8_BAR;
    PG8_STAMP();
    for (;;) {
        const bool has_next = S.next(ui + 1, nxt);
        const char* nA = has_next ? (const char*)g.A + (size_t)nxt.pm * tstep : cA; const char* nB = has_next ? (const char*)g.Bt + (size_t)nxt.pn * tstep : cB;
        for (int t = 0; t < nt; t += 2) {
            const bool last = (t == nt - 2);
            const char* a1 = cA + (size_t)(t + 1) * kstep;
            const char* a2 = last ? nA : cA + (size_t)(t + 2) * kstep; const char* b2 = last ? nB : cB + (size_t)(t + 2) * kstep;
            const char* a3 = a2 + kstep; const char* b3 = b2 + kstep;
            if (last && has_next) S.a_ready(nxt);
            PG8_LDB(B0, 0, 0); PG8_SCHED; PG8_LDA(At, 0, 0); PG8_STAGE(PG8_SA(1, 1), a1 + hstep, voffA);
            PG8_WAIT_L(8); PG8_BAR; PG8_WAIT_L(0); PG8_MMA(0, 0, At, B0); PG8_BAR; PG8_SCHED;
            PG8_LDB(B1, 0, 1); PG8_STAGE(PG8_SB(0, 0), b2, voffB);
            PG8_BAR; PG8_WAIT_L(0); PG8_MMA(0, 1, At, B1); PG8_BAR;
            PG8_LDA(At, 0, 1); PG8_STAGE(PG8_SA(0, 0), a2, voffA);
            PG8_BAR; PG8_WAIT_L(0); PG8_MMA(1, 0, At, B0); PG8_BAR; PG8_SCHED;
            PG8_STAGE(PG8_SB(0, 1), b2 + hstep, voffB);
            PG8_WAIT_V(6); PG8_BAR; PG8_MMA(1, 1, At, B1); PG8_BAR;
            PG8_LDB(B0, 1, 0); PG8_SCHED; PG8_LDA(At, 1, 0); PG8_STAGE(PG8_SA(0, 1), a2 + hstep, voffA);
            PG8_WAIT_L(8); PG8_BAR; PG8_WAIT_L(0); PG8_MMA(0, 0, At, B0); PG8_BAR; PG8_SCHED;
            PG8_LDB(B1, 1, 1); PG8_STAGE(PG8_SB(1, 0), b3, voffB);
            PG8_BAR; PG8_WAIT_L(0); PG8_MMA(0, 1, At, B1); PG8_BAR;
            PG8_LDA(At, 1, 1); PG8_STAGE(PG8_SA(1, 0), a3, voffA);
            PG8_BAR; PG8_WAIT_L(0); PG8_MMA(1, 0, At, B0); PG8_BAR; PG8_SCHED;
            PG8_STAGE(PG8_SB(1, 1), b3 + hstep, voffB);
            PG8_WAIT_V(6); PG8_BAR; PG8_MMA(1, 1, At, B1); PG8_BAR;
        }
        PG8_STAMP();
        if constexpr (!Epi::AFTER_DRAIN) { E(acc, cur, wr, wc, fr, fq); S.done(cur); }
        PG8_STAMP();
        if (!has_next) break;
#pragma unroll
        for (int a = 0; a < 2; ++a)
#pragma unroll
            for (int b = 0; b < 2; ++b)
#pragma unroll
                for (int m = 0; m < 4; ++m)
#pragma unroll
                    for (int n = 0; n < 2; ++n) acc[a][b][m][n] = (f32x4){0.f, 0.f, 0.f, 0.f};
        cur = nxt; cA = nA; cB = nB; ++ui;
    }
    PG8_WAIT_V(0);
    if (wr == 0) PG8_BAR;
    PG8_BAR;
    if constexpr (Epi::AFTER_DRAIN) { E.fused(acc, cur, wr, wc, fr, fq, lds, wid, lane); S.done(cur); }
    PG8_STAMP();
    if (STAMP && wid == 0) { stamps[lane] = lane < nts ? (((unsigned long long)(unsigned)ts_hi << 32) | (unsigned)ts_lo) : 0ull;
        if (lane == 62) stamps[62] = rt_entry; if (lane == 63) stamps[63] = (unsigned long long)wall_clock64(); }
#undef PG8_STAMP
#undef PG8_SA
#undef PG8_SB
#undef PG8_STAGE
#undef PG8_LDA
#undef PG8_LDB
#undef PG8_MMA
#undef PG8_WAIT_V
#undef PG8_WAIT_L
#undef PG8_BAR
#undef PG8_SCHED
}
}

struct EpiProj {
  static constexpr bool PERM = true, AFTER_DRAIN = false;
  float* out; char* ws;
  __device__ __forceinline__ void operator()(const pg8::f32x4 (&acc)[2][2][4][2], const pg8::Unit& u, int wr, int wc, int fr, int fq) const {
    asm volatile("" : "+v"(fr), "+v"(fq));
    char* ob = (char*)out;
    const int n0 = u.pn * 256;
    int seg, sbase;
    if (n0 < 256) { seg = 0; sbase = 0; } else if (n0 < 512) { seg = 1; sbase = 256; } else if (n0 < 768) { seg = 2; sbase = 512; }
    else if (n0 < 1280) { seg = 3; sbase = 768; } else if (n0 < 1792) { seg = 4; sbase = 1280; } else if (n0 < 2304) { seg = 5; sbase = 1792; }
    else if (n0 < 2560) { seg = 6; sbase = 2304; } else { seg = 7; sbase = 2560; }
    const bool smp = u.pm >= NTOKP / 256;
    const float2* rope = (const float2*)(ws + WS_ROPE);
    const bool ropeseg = (seg == 3 || seg == 4);
    const int fi = 16 * (wc & 1) + 4 * fq;
    const int pi = 32 * (wc & 1) + 8 * fq;
    const int d1 = ropeseg ? 32 : 4;
#pragma unroll
    for (int ai = 0; ai < 2; ++ai)
#pragma unroll
      for (int m = 0; m < 4; ++m) {
        const int row = 128 * ai + 64 * wr + 16 * m + fr;
        const unsigned tok = (unsigned)(u.pm * 256 + row);
        const unsigned ts = tok - (unsigned)NTOKP;
        float4 c01, s01, c23, s23;
        if (seg == 3 || seg == 4) {
          const int pos = smp ? (PAST + (int)(ts & 15)) : (int)(tok & (SEQ - 1));
          const float4 r0 = *(const float4*)(rope + pos * 32 + fi), r1 = *(const float4*)(rope + pos * 32 + fi + 2);
          c01 = make_float4(r0.x, r0.z, r1.x, r1.z); s01 = make_float4(r0.y, r0.w, r1.y, r1.w);
        }
#pragma unroll
        for (int bj = 0; bj < 2; ++bj) {
          const int blk = 4 * u.pn + 2 * bj + (wc >> 1);
          const int col = 64 * blk + (ropeseg ? fi : pi) - sbase;
          pg8::f32x4 v0 = acc[ai][bj][m][0], v1 = acc[ai][bj][m][1];
          if (seg == 3 || seg == 4) {
            const pg8::f32x4 cc = {c01.x, c01.y, c01.z, c01.w}, ss = {s01.x, s01.y, s01.z, s01.w};
            const pg8::f32x4 a = v0 * cc - v1 * ss, b = v1 * cc + v0 * ss;
            v0 = a; v1 = b;
          }
          if (seg == 0 || seg == 3 || seg == 6) {
            bf16_t* q = (seg == 0) ? (bf16_t*)(ob + OB_AQ) + tok * 256 : (seg == 3) ? (bf16_t*)(ob + OB_BQ) + tok * 512 : (bf16_t*)(ob + OB_MQ) + tok * 256;
            u32x2 w0, w1; w0.x = cvtpk(v0[0] * QSCALE, v0[1] * QSCALE); w0.y = cvtpk(v0[2] * QSCALE, v0[3] * QSCALE);
            w1.x = cvtpk(v1[0] * QSCALE, v1[1] * QSCALE); w1.y = cvtpk(v1[2] * QSCALE, v1[3] * QSCALE);
            if (ropeseg) { *(u32x2*)(q + col) = w0; *(u32x2*)(q + col + 32) = w1; } else { u32x4 w; w.x = w0.x; w.y = w0.y; w.z = w1.x; w.w = w1.y; *(u32x4*)(q + col) = w; }
          } else if (seg == 7) {
            bf16_t* g = (bf16_t*)(ws + WS_G) + tok * 1024;
            float a[4], b[4];
#pragma unroll
            for (int j = 0; j < 4; ++j) { a[j] = v0[j] * __builtin_amdgcn_rcpf(1.f + __expf(-v0[j])); b[j] = v1[j] * __builtin_amdgcn_rcpf(1.f + __expf(-v1[j])); }
            u32x2 w0, w1; w0.x = cvtpk(a[0], a[1]); w0.y = cvtpk(a[2], a[3]); w1.x = cvtpk(b[0], b[1]); w1.y = cvtpk(b[2], b[3]);
            { u32x4 w; w.x = w0.x; w.y = w0.y; w.z = w1.x; w.w = w1.y; *(u32x4*)(g + col) = w; }
          } else {
            const bool wide = (seg >= 4);
            const int W = wide ? 512 : 256;
            bf16_t* kw; float* o = nullptr;
            if (!smp) {
              if (seg == 1) kw = (bf16_t*)(ob + OB_AK) + tok * 256; else if (seg == 2) kw = (bf16_t*)(ob + OB_AV) + tok * 256;
              else if (seg == 4) kw = (bf16_t*)(ob + OB_BK) + tok * 512; else kw = (bf16_t*)(ws + WS_BV) + tok * 512;
              if (wide) o = out + (seg == 4 ? O_BKP : O_BVP) + tok * 512;
              else { const unsigned ps = tok & (SEQ - 1), pb = tok >> 13; if (ps >= (unsigned)(SEQ - RA)) o = out + (seg == 1 ? O_AKP : O_AVP) + (pb * RA + ps - (SEQ - RA)) * 256u; }
            } else {
              kw = nullptr;
              if (wide) o = out + (seg == 4 ? O_BKS : O_BVS) + ts * 512; else o = out + (seg == 1 ? O_AKS : O_AVS) + ts * 256;
            }
            (void)W;
            u32x2 w0, w1; w0.x = cvtpk(v0[0], v0[1]); w0.y = cvtpk(v0[2], v0[3]); w1.x = cvtpk(v1[0], v1[1]); w1.y = cvtpk(v1[2], v1[3]);
            if (kw) { if (ropeseg) { *(u32x2*)(kw + col) = w0; *(u32x2*)(kw + col + 32) = w1; } else { u32x4 w; w.x = w0.x; w.y = w0.y; w.z = w1.x; w.w = w1.y; *(u32x4*)(kw + col) = w; } }
            if (o) { __builtin_nontemporal_store(v0, (pg8::f32x4*)(o + col)); __builtin_nontemporal_store(v1, (pg8::f32x4*)(o + col + d1)); }
          }
        }
      }
  }
};

struct EpiOut {
  static constexpr bool PERM = true, AFTER_DRAIN = false;
  bf16_t* ypre; const float* xp; const float* xs;
  __device__ __forceinline__ void operator()(const pg8::f32x4 (&acc)[2][2][4][2], const pg8::Unit& u, int wr, int wc, int fr, int fq) const {
    asm volatile("" : "+v"(fr), "+v"(fq));
    const float* xb = (u.pm < NTOKP / 256) ? xp + (long)u.pm * 256 * 1024 : xs + (long)(u.pm - NTOKP / 256) * 256 * 1024;
    bf16_t* yb = ypre + (long)u.pm * 256 * 1024;
    const int col0 = u.pn * 256 + wc * 32 + 8 * fq;
#pragma unroll
    for (int ai = 0; ai < 2; ++ai)
#pragma unroll
      for (int mp = 0; mp < 2; ++mp) {
        pg8::f32x4 xv[2][2][2];
#pragma unroll
        for (int mm = 0; mm < 2; ++mm) {
          const unsigned ro = (unsigned)((128 * ai + 64 * wr + 16 * (2 * mp + mm) + fr) * 1024 + col0);
#pragma unroll
          for (int bj = 0; bj < 2; ++bj)
#pragma unroll
            for (int n = 0; n < 2; ++n) xv[mm][bj][n] = __builtin_nontemporal_load((const pg8::f32x4*)(xb + ro + bj * 128 + n * 4));
        }
#pragma unroll
        for (int mm = 0; mm < 2; ++mm) {
          const unsigned ro = (unsigned)((128 * ai + 64 * wr + 16 * (2 * mp + mm) + fr) * 1024 + col0);
#pragma unroll
          for (int bj = 0; bj < 2; ++bj) {
            const pg8::f32x4 y0 = acc[ai][bj][2 * mp + mm][0] + ALPHA * xv[mm][bj][0], y1 = acc[ai][bj][2 * mp + mm][1] + ALPHA * xv[mm][bj][1];
            u32x4 w; w.x = cvtpk(y0[0], y0[1]); w.y = cvtpk(y0[2], y0[3]); w.z = cvtpk(y1[0], y1[1]); w.w = cvtpk(y1[2], y1[3]);
            *(u32x4*)(yb + ro + bj * 128) = w;
          }
        }
      }
  }
};

DI void mem_epilogue(const Params& p, int mt, int nt, f32x16 (&acc)[2][2]) {
  const int tid = threadIdx.x, lane = tid & 63, w = tid >> 6, wm = w >> 2, wn = w & 3, c = lane & 31, h = lane >> 5;
  const int n0 = nt * 256 + wn * 64;
  const bool isv = n0 >= 256;
  const int cb = isv ? n0 - 256 : n0;
  bf16_t* kw = (bf16_t*)(p.ws + (isv ? WS_MV : WS_MK));
  float* o = p.out + (isv ? O_MVP : O_MKP);
#pragma unroll
  for (int mi = 0; mi < 2; ++mi)
#pragma unroll
    for (int i = 0; i < 16; ++i) {
      const long row = mt * 128 + wm * 64 + mi * 32 + (i & 3) + 8 * (i >> 2) + 4 * h;
      const float v0 = acc[mi][0][i], v1 = acc[mi][1][i];
      kw[row * 256 + cb + c] = f2bf(v0); kw[row * 256 + cb + c + 32] = f2bf(v1);
      o[row * 256 + cb + c] = v0; o[row * 256 + cb + c + 32] = v1;
    }
}

DI void phase1(const Params& p) {
  const int G = gridDim.x;
  const bf16_t* winT = (const bf16_t*)(p.ws + WS_WINT); const bf16_t* wmemT = (const bf16_t*)(p.ws + WS_WMEMT);
  const bf16_t* XB = (const bf16_t*)(p.ws + WS_XB); const bf16_t* MB = (const bf16_t*)(p.ws + WS_MB);
  {
    pg8::Gemm g; g.A = XB; g.Bt = winT; g.M = NTOK; g.N = PROJ; g.K = 1024;
    pg8::StaticOrder S; S.init(NTOK, PROJ, G, (int)blockIdx.x);
    EpiProj E; E.out = p.out; E.ws = p.ws;
    pg8::gemm_phase<EpiProj, pg8::StaticOrder, false>((PG8_LAS unsigned char*)g_lds_all, g, S, E, nullptr);
  }
  __syncthreads();
  constexpr int T2 = 8 * 2;
  f32x16 acc[2][2];
  for (int t = (int)blockIdx.x - 64; t >= 0 && t < T2; t += G) {
    const int mt = t >> 1, nt = t & 1;
    gemm_core(MB + (long)mt * 128 * 1024, 1024, wmemT + (long)nt * 256 * 1024, 1024, 1024, acc);
    mem_epilogue(p, mt, nt, acc);
  }
}

struct AttnItem {
  const bf16_t* q0; const bf16_t* q1;
  const bf16_t* k; const bf16_t* v;
  bf16_t* g0; bf16_t* g1;
  int qs, ks, ntiles, nkeys;
  int tlo0, thi0, tlo1, thi1;
  int rows0, rows1;
  int qpos0, qpos1, kpos0, head0; bool bias;
  const float* kf; const float* vf;
  const float* kn; const float* vn;
  int ncache;
};
constexpr int AK_RS = 272, AK_BYTES = 64 * AK_RS, AV_BYTES = 16384, A_BUF = AK_BYTES + AV_BYTES;
constexpr int A_BIAS_OFF = 2 * A_BUF;
constexpr int A_ITEM_OFF = 2 * TEAM_LDS;
constexpr int A_Q_OFF = 73728;

template <bool DIFF, bool BIAS, bool MASK, bool F32>
DI void attn_item(const AttnItem& it, float lam, const float* __restrict__ subg) {
  const int tid = threadIdx.x, lane = tid & 63, w = tid >> 6, r = lane & 31, h = lane >> 5;
  const int half = __builtin_amdgcn_readfirstlane(w >> 2), qh = w & 1, m = (w >> 1) & 1;
  constexpr int NDT = DIFF ? 4 : 2;
  const int ntiles = it.ntiles;
  const int tlo = half ? it.tlo1 : it.tlo0, thi = half ? it.thi1 : it.thi0, rows = half ? it.rows1 : it.rows0;
  const bf16_t* qbase = half ? it.q1 : it.q0;
  bf16_t* gbase = half ? it.g1 : it.g0;
  char* qlds = g_lds_all + A_Q_OFF + w * 4096 + lane * 16;
  {
    const bf16_t* qp = qbase + (long)(qh * 32 + r) * it.qs + m * 64 + 8 * h;
#pragma unroll
    for (int s = 0; s < 4; ++s) *(bf16x8*)(qlds + s * 1024) = *(const bf16x8*)(qp + 16 * s);
  }
  f32x16 oacc[NDT];
#pragma unroll
  for (int d = 0; d < NDT; ++d)
#pragma unroll
    for (int i = 0; i < 16; ++i) oacc[d][i] = 0.f;
  float m_run = -1e30f, l_run = 0.f;
  u32x4 rk0[2], rv0[2];
  float4 fk[4], fv[4];
  const int kch = tid & 15, krow = tid >> 4, vsub = tid & 3, vkey = (tid >> 2) & 63, vd = tid >> 8;
  const bf16_t* kg = it.k + (long)krow * it.ks + kch * 8;
  const bf16_t* vg = it.v + (long)vkey * it.ks + vd * 32 + vsub * 8;
#define A_LOAD(RK, RV, t)                                                                                        \
  if (!F32) {                                                                                                    \
    _Pragma("unroll") for (int i = 0; i < 2; ++i) RK[i] = *(const u32x4*)(kg + (long)((t) * 64 + 32 * i) * it.ks); \
    _Pragma("unroll") for (int i = 0; i < 2; ++i) RV[i] = *(const u32x4*)(vg + (long)((t) * 64) * it.ks + 64 * i); \
  } else {                                                                                                       \
    const bool nw = (t) >= it.ncache;             \
    _Pragma("unroll") for (int i = 0; i < 2; ++i) {                                                              \
      const int kr = krow + 32 * i;                                                                              \
      const float* src = nw ? it.kn + (long)(kr < 15 ? kr : 15) * it.ks : it.kf + (long)((t) * 64 + kr) * it.ks; \
      fk[2 * i] = *(const float4*)(src + kch * 8); fk[2 * i + 1] = *(const float4*)(src + kch * 8 + 4);          \
    }                                                                                                            \
    {                                                                                                            \
      const float* src = nw ? it.vn + (long)(vkey < 15 ? vkey : 15) * it.ks : it.vf + (long)((t) * 64 + vkey) * it.ks; \
      _Pragma("unroll") for (int i = 0; i < 2; ++i) {                                                            \
        fv[2 * i] = *(const float4*)(src + (vd + 2 * i) * 32 + vsub * 8); fv[2 * i + 1] = *(const float4*)(src + (vd + 2 * i) * 32 + vsub * 8 + 4); \
      }                                                                                                          \
    }                                                                                                            \
  }
#define A_WRITE(RK, RV, stage)                                                                                   \
  {                                                                                                              \
    char* Kb_ = g_lds_all + (stage) * A_BUF; char* Vb_ = Kb_ + AK_BYTES;                                         \
    if (F32) {                                                                                                   \
      _Pragma("unroll") for (int i = 0; i < 2; ++i) {                                                            \
        RK[i].x = cvtpk(fk[2 * i].x, fk[2 * i].y); RK[i].y = cvtpk(fk[2 * i].z, fk[2 * i].w); RK[i].z = cvtpk(fk[2 * i + 1].x, fk[2 * i + 1].y); RK[i].w = cvtpk(fk[2 * i + 1].z, fk[2 * i + 1].w); \
        RV[i].x = cvtpk(fv[2 * i].x, fv[2 * i].y); RV[i].y = cvtpk(fv[2 * i].z, fv[2 * i].w); RV[i].z = cvtpk(fv[2 * i + 1].x, fv[2 * i + 1].y); RV[i].w = cvtpk(fv[2 * i + 1].z, fv[2 * i + 1].w); \
      }                                                                                                          \
    }                                                                                                            \
    _Pragma("unroll") for (int i = 0; i < 2; ++i) *(u32x4*)(Kb_ + (krow + 32 * i) * AK_RS + kch * 16) = RK[i];   \
    _Pragma("unroll") for (int i = 0; i < 2; ++i) *(u32x4*)(Vb_ + (vd + 2 * i) * 4096 + vkey * 64 + vsub * 16) = RV[i]; \
  }
  const int vlane = ((lane >> 4) & 1) * 32 + (lane & 3) * 8 + (4 * h + ((lane & 15) >> 2)) * 64;
  const float* biasT = (const float*)(g_lds_all + A_BIAS_OFF) + (it.head0 + m) * 257;
  const int qpos = (half ? it.qpos1 : it.qpos0) + qh * 32 + r;
#define A_COMPUTE(t, stage)                                                                                      \
  if ((t) >= tlo && (t) < thi) {                                                                                 \
    const char* Kb = g_lds_all + (stage) * A_BUF; const char* Vb = Kb + AK_BYTES;                                \
    f32x16 s0, s1;                                                                                               \
    _Pragma("unroll") for (int i = 0; i < 16; ++i) { s0[i] = 0.f; s1[i] = 0.f; }                                 \
    _Pragma("unroll") for (int s = 0; s < 4; ++s) {                                                              \
      const int co = (m * 64 + 16 * s + 8 * h) * 2;                                                              \
      const bf16x8 k0 = *(const bf16x8*)(Kb + r * AK_RS + co);                                                   \
      const bf16x8 k1 = *(const bf16x8*)(Kb + (32 + r) * AK_RS + co);                                            \
      const bf16x8 qfs = *(const bf16x8*)(qlds + s * 1024);                                                      \
      s0 = MFMA32(k0, qfs, s0);                                                                                  \
      s1 = MFMA32(k1, qfs, s1);                                                                                  \
    }                                                                                                            \
    if (BIAS) {                                                                                                  \
      const int kb = it.kpos0 + (t) * 64 + 4 * h;                                                                \
      _Pragma("unroll") for (int i = 0; i < 16; ++i) {                                                           \
        const int kk = kb + (i & 3) + 8 * (i >> 2);                                                              \
        int d0 = qpos - kk, d1 = d0 - 32;                                                                        \
        d0 = min(max(d0, -128), 128) + 128; d1 = min(max(d1, -128), 128) + 128;                                  \
        s0[i] += biasT[d0]; s1[i] += biasT[d1];                                                                  \
      }                                                                                                          \
    }                                                                                                            \
    if (MASK && ((t) + 1) * 64 > it.nkeys) {                                                                     \
      const int kb = (t) * 64 + 4 * h;                                                                           \
      _Pragma("unroll") for (int i = 0; i < 16; ++i) {                                                           \
        const int kk = kb + (i & 3) + 8 * (i >> 2);                                                              \
        if (kk >= it.nkeys) s0[i] = -1e30f;                                                                      \
        if (kk + 32 >= it.nkeys) s1[i] = -1e30f;                                                                 \
      }                                                                                                          \
    }                                                                                                            \
    float mxa = fmaxf(s0[0], s1[0]), mxb = fmaxf(s0[1], s1[1]);                                                  \
    _Pragma("unroll") for (int i = 2; i < 16; i += 2) { mxa = fmaxf(fmaxf(mxa, s0[i]), s1[i]); mxb = fmaxf(fmaxf(mxb, s0[i + 1]), s1[i + 1]); } \
    float mx = fmaxf(mxa, mxb);                                                                                  \
    mx = fmaxf(mx, xor32f(mx));                                                                                  \
    const float m_new = (mx > m_run + 8.f) ? mx : m_run;     \
    const float alpha = fexp2(m_run - m_new);                                                                    \
    if (__builtin_amdgcn_ballot_w64(m_new > m_run) != 0ull) {                                                    \
      _Pragma("unroll") for (int d = 0; d < NDT; ++d)                                                            \
        _Pragma("unroll") for (int i = 0; i < 16; ++i) oacc[d][i] *= alpha;                                      \
    }                                                                                                            \
    l_run *= alpha;                                                                                              \
    m_run = m_new;                                                                                               \
    float ls = 0.f;                                                                                              \
    _Pragma("unroll") for (int i = 0; i < 16; ++i) { s0[i] = fexp2(s0[i] - m_new); s1[i] = fexp2(s1[i] - m_new); ls += s0[i] + s1[i]; } \
    l_run += ls;                                                                                                 \
    bf16x8 pf[4];                                                                                                \
    _Pragma("unroll") for (int s2 = 0; s2 < 2; ++s2) {                                                           \
      u32x4 a, b;                                                                                                \
      a.x = cvtpk(s0[8 * s2 + 0], s0[8 * s2 + 1]); a.y = cvtpk(s0[8 * s2 + 2], s0[8 * s2 + 3]);                  \
      a.z = cvtpk(s0[8 * s2 + 4], s0[8 * s2 + 5]); a.w = cvtpk(s0[8 * s2 + 6], s0[8 * s2 + 7]);                  \
      b.x = cvtpk(s1[8 * s2 + 0], s1[8 * s2 + 1]); b.y = cvtpk(s1[8 * s2 + 2], s1[8 * s2 + 3]);                  \
      b.z = cvtpk(s1[8 * s2 + 4], s1[8 * s2 + 5]); b.w = cvtpk(s1[8 * s2 + 6], s1[8 * s2 + 7]);                  \
      pf[s2] = __builtin_bit_cast(bf16x8, a); pf[2 + s2] = __builtin_bit_cast(bf16x8, b);                        \
    }                                                                                                            \
    const LDS3 char* vb3 = (const LDS3 char*)(Vb) + vlane + (DIFF ? 0 : m * 2 * 4096);                           \
    _Pragma("unroll") for (int ks = 0; ks < 4; ++ks) {                                                           \
      _Pragma("unroll") for (int d = 0; d < NDT; ++d) {                                                          \
        const s16x4 lo = __builtin_bit_cast(s16x4, __builtin_amdgcn_ds_read_tr16_b64_v4i16((LDS3 s16x4*)(vb3 + d * 4096 + ks * 1024))); \
        const s16x4 hi = __builtin_bit_cast(s16x4, __builtin_amdgcn_ds_read_tr16_b64_v4i16((LDS3 s16x4*)(vb3 + d * 4096 + ks * 1024 + 512))); \
        const bf16x8 vf = __builtin_shufflevector(lo, hi, 0, 1, 2, 3, 4, 5, 6, 7);                               \
        oacc[d] = MFMA32(vf, pf[ks], oacc[d]);                                                                   \
      }                                                                                                          \
      __builtin_amdgcn_sched_barrier(0);                                                                         \
    }                                                                                                            \
  }
  A_LOAD(rk0, rv0, 0);
  A_WRITE(rk0, rv0, 0);
  if (ntiles > 1) A_LOAD(rk0, rv0, 1);
  __syncthreads();
#pragma unroll 1
  for (int t = 0; t < ntiles; ++t) {
    const int par = t & 1;
    if (t + 1 < ntiles) A_WRITE(rk0, rv0, par ^ 1);
    if (t + 2 < ntiles) A_LOAD(rk0, rv0, t + 2);
    A_COMPUTE(t, par);
    __syncthreads();
  }
#undef A_LOAD
#undef A_WRITE
#undef A_COMPUTE
  const float l_tot = l_run + xor32f(l_run);
  const float inv = 1.f / l_tot;
  const int q = qh * 32 + r;
  if (!DIFF) {
    if (q < rows) {
      bf16_t* gp = gbase + (long)q * 1024 + m * 64 + 4 * h;
      u32x2 gvv[NDT][4];
#pragma unroll
      for (int d = 0; d < NDT; ++d)
#pragma unroll
        for (int g4 = 0; g4 < 4; ++g4) gvv[d][g4] = *(const u32x2*)(gp + d * 32 + 8 * g4);
#pragma unroll
      for (int d = 0; d < NDT; ++d)
#pragma unroll
        for (int g4 = 0; g4 < 4; ++g4) {
          u32x2* ptr = (u32x2*)(gp + d * 32 + 8 * g4);
          const u32x2 gv = gvv[d][g4];
          u32x2 o;
          o.x = cvtpk(oacc[d][4 * g4 + 0] * inv * bflo(gv.x), oacc[d][4 * g4 + 1] * inv * bfhi(gv.x));
          o.y = cvtpk(oacc[d][4 * g4 + 2] * inv * bflo(gv.y), oacc[d][4 * g4 + 3] * inv * bfhi(gv.y));
          *ptr = o;
        }
    }
  } else {
    float* xb = (float*)g_lds_all + half * 8192 + qh * 4096 + lane;
    if (m == 1) {
      const float sc = lam * inv;
#pragma unroll
      for (int d = 0; d < NDT; ++d)
#pragma unroll
        for (int i = 0; i < 16; ++i) xb[(d * 16 + i) * 64] = oacc[d][i] * sc;
    }
    __syncthreads();
    if (m == 0) {
      float ss = 0.f;
#pragma unroll
      for (int d = 0; d < NDT; ++d)
#pragma unroll
        for (int i = 0; i < 16; ++i) { const float o = oacc[d][i] * inv - xb[(d * 16 + i) * 64]; oacc[d][i] = o; ss += o * o; }
      ss += xor32f(ss);
      const float rn = rsqrtf(ss * (1.f / 128.f) + 1e-5f) * 0.8f;
      if (q < rows) {
        bf16_t* gp = gbase + (long)q * 1024 + 4 * h;
        u32x2 gvv[NDT][4];
#pragma unroll
        for (int d = 0; d < NDT; ++d)
#pragma unroll
          for (int g4 = 0; g4 < 4; ++g4) gvv[d][g4] = *(const u32x2*)(gp + d * 32 + 8 * g4);
#pragma unroll
        for (int d = 0; d < NDT; ++d)
#pragma unroll
          for (int g4 = 0; g4 < 4; ++g4) {
            const float4 sg = *(const float4*)(subg + d * 32 + 8 * g4 + 4 * h);
            u32x2* ptr = (u32x2*)(gp + d * 32 + 8 * g4);
            const u32x2 gv = gvv[d][g4];
            u32x2 o;
            o.x = cvtpk(oacc[d][4 * g4 + 0] * rn * sg.x * bflo(gv.x), oacc[d][4 * g4 + 1] * rn * sg.y * bfhi(gv.x));
            o.y = cvtpk(oacc[d][4 * g4 + 2] * rn * sg.z * bflo(gv.y), oacc[d][4 * g4 + 3] * rn * sg.w * bfhi(gv.y));
            *ptr = o;
          }
      }
    }
    __syncthreads();
  }
}

DI void phase2(const Params& p) {
  char* ws = p.ws;
  float* biasT = (float*)(g_lds_all + A_BIAS_OFF);
  for (int i = threadIdx.x; i < 4 * 257; i += 512) biasT[i] = p.relb[i] * LOG2E;
  float s1 = 0.f, s2 = 0.f;
  for (int i = 0; i < 64; ++i) { s1 += p.dlam[i] * p.dlam[64 + i]; s2 += p.dlam[128 + i] * p.dlam[192 + i]; }
  const float lam = expf(s1) - expf(s2) + 0.2f;
  __syncthreads();
  int* ctr = (int*)(ws + WS_CTR);
  int* s_item = (int*)(g_lds_all + A_ITEM_OFF);
  const char* ob = (const char*)p.out;
  const bf16_t* AQ = (const bf16_t*)(ob + OB_AQ); const bf16_t* AK = (const bf16_t*)(ob + OB_AK); const bf16_t* AV = (const bf16_t*)(ob + OB_AV);
  const bf16_t* BQ = (const bf16_t*)(ob + OB_BQ); const bf16_t* BK = (const bf16_t*)(ob + OB_BK); const bf16_t* BV = (const bf16_t*)(ws + WS_BV);
  const bf16_t* MQ = (const bf16_t*)(ob + OB_MQ); const bf16_t* MK = (const bf16_t*)(ws + WS_MK); const bf16_t* MV = (const bf16_t*)(ws + WS_MV);
  bf16_t* G = (bf16_t*)(ws + WS_G);
  constexpr int N_BP = 1024, N_BS = 128, N_AP = 512, N_AS = 64, N_MP = 512, N_MS = 64;
  constexpr int N_ALL = N_BP + N_BS + N_AP + N_AS + N_MP + N_MS;
  for (;;) {
    if (threadIdx.x == 0) *s_item = atomicAdd(ctr, 1);
    __syncthreads();
    int item = *s_item;
    __syncthreads();
    if (item >= N_ALL) break;
    AttnItem it;
    it.bias = false; it.qpos0 = 0; it.qpos1 = 0; it.kpos0 = 0; it.head0 = 0; it.rows0 = 64; it.rows1 = 64;
    it.kf = nullptr; it.vf = nullptr; it.kn = nullptr; it.vn = nullptr; it.ncache = 0; it.k = nullptr; it.v = nullptr;
    if (item < N_BP) {
      const int j = 63 - (item >> 4), bh = item & 15, b = bh >> 2, hh = bh & 3;
      const long tok0 = (long)b * SEQ + j * 128;
      it.q0 = BQ + tok0 * 512 + hh * 128; it.q1 = it.q0 + 64 * 512;
      it.k = BK + (long)b * SEQ * 512 + hh * 128; it.v = BV + (long)b * SEQ * 512 + hh * 128;
      it.qs = 512; it.ks = 512; it.ntiles = 2 * j + 2; it.nkeys = it.ntiles * 64;
      it.tlo0 = 0; it.thi0 = 2 * j + 1; it.tlo1 = 0; it.thi1 = 2 * j + 2;
      it.g0 = G + tok0 * 1024 + 256 + hh * 128; it.g1 = it.g0 + 64 * 1024;
      attn_item<true, false, false, false>(it, lam, p.subg);
      continue;
    }
    item -= N_BP;
    if (item < N_BS) {
      const int b = item >> 2, hh = item & 3;
      const long tok0 = NTOKP + b * ST;
      it.q0 = BQ + tok0 * 512 + hh * 128; it.q1 = it.q0;
      it.kf = p.cbk + (long)b * PAST * 512 + hh * 128; it.vf = p.cbv + (long)b * PAST * 512 + hh * 128; it.ncache = PAST / 64;
      it.kn = p.out + O_BKS + (long)b * ST * 512 + hh * 128; it.vn = p.out + O_BVS + (long)b * ST * 512 + hh * 128;
      it.qs = 512; it.ks = 512; it.ntiles = 17; it.nkeys = PAST + ST;
      it.tlo0 = 0; it.thi0 = 17; it.tlo1 = 0; it.thi1 = 0; it.rows0 = ST; it.rows1 = 0;
      it.g0 = G + tok0 * 1024 + 256 + hh * 128; it.g1 = it.g0;
      attn_item<true, false, true, true>(it, lam, p.subg);
      continue;
    }
    item -= N_BS;
    if (item < N_AP) {
      const int j = 63 - (item >> 3), bh = item & 7, b = bh >> 1, hp = bh & 1;
      const int c0 = 2 * j, c1 = c0 + 1, cs0 = c0 > 8 ? c0 - 8 : 0, cs1 = c1 > 8 ? c1 - 8 : 0;
      const long tok0 = (long)b * SEQ + c0 * 64, k0 = (long)b * SEQ + cs0 * 64;
      it.q0 = AQ + tok0 * 256 + hp * 128; it.q1 = it.q0 + 64 * 256;
      it.k = AK + k0 * 256 + hp * 128; it.v = AV + k0 * 256 + hp * 128;
      it.qs = 256; it.ks = 256; it.ntiles = c1 - cs0 + 1; it.nkeys = it.ntiles * 64;
      it.tlo0 = 0; it.thi0 = c0 - cs0 + 1; it.tlo1 = cs1 - cs0; it.thi1 = it.ntiles;
      it.g0 = G + tok0 * 1024 + hp * 128; it.g1 = it.g0 + 64 * 1024;
      it.bias = true; it.qpos0 = c0 * 64; it.qpos1 = c1 * 64; it.kpos0 = cs0 * 64; it.head0 = hp * 2;
    } else if ((item -= N_AP) < N_AS) {
      const int b = item >> 1, hp = item & 1;
      const long tok0 = NTOKP + b * ST;
      it.q0 = AQ + tok0 * 256 + hp * 128; it.q1 = it.q0;
      it.kf = p.cak + (long)b * RA * 256 + hp * 128; it.vf = p.cav + (long)b * RA * 256 + hp * 128; it.ncache = RA / 64;
      it.kn = p.out + O_AKS + (long)b * ST * 256 + hp * 128; it.vn = p.out + O_AVS + (long)b * ST * 256 + hp * 128;
      it.qs = 256; it.ks = 256; it.ntiles = 9; it.nkeys = RA + ST;
      it.tlo0 = 0; it.thi0 = 9; it.tlo1 = 0; it.thi1 = 0; it.rows0 = ST; it.rows1 = 0;
      it.g0 = G + tok0 * 1024 + hp * 128; it.g1 = it.g0;
      it.bias = true; it.qpos0 = RA; it.qpos1 = RA; it.kpos0 = 0; it.head0 = hp * 2;
    } else if ((item -= N_AS) < N_MP) {
      const int j = item >> 3, bh = item & 7, b = bh >> 1, hp = bh & 1;
      const long tok0 = (long)b * SEQ + j * 128;
      it.q0 = MQ + tok0 * 256 + hp * 128; it.q1 = it.q0 + 64 * 256;
      it.k = MK + (long)b * NMEM * 256 + hp * 128; it.v = MV + (long)b * NMEM * 256 + hp * 128;
      it.qs = 256; it.ks = 256; it.ntiles = 4; it.nkeys = NMEM;
      it.tlo0 = 0; it.thi0 = 4; it.tlo1 = 0; it.thi1 = 4;
      it.g0 = G + tok0 * 1024 + 768 + hp * 128; it.g1 = it.g0 + 64 * 1024;
    } else {
      item -= N_MP;
      const int b = item >> 1, hp = item & 1;
      const long tok0 = NTOKP + b * ST;
      it.q0 = MQ + tok0 * 256 + hp * 128; it.q1 = it.q0;
      it.kf = p.cmk + (long)b * NMEM * 256 + hp * 128; it.vf = p.cmv + (long)b * NMEM * 256 + hp * 128; it.ncache = NMEM / 64;
      it.kn = it.kf; it.vn = it.vf;
      it.qs = 256; it.ks = 256; it.ntiles = 4; it.nkeys = NMEM;
      it.tlo0 = 0; it.thi0 = 4; it.tlo1 = 0; it.thi1 = 0; it.rows0 = ST; it.rows1 = 0;
      it.g0 = G + tok0 * 1024 + 768 + hp * 128; it.g1 = it.g0;
    }
    const bool f32src = it.kf != nullptr;
    if (it.bias) { if (f32src) attn_item<false, true, true, true>(it, lam, p.subg); else attn_item<false, true, false, false>(it, lam, p.subg); }
    else { if (f32src) attn_item<false, false, false, true>(it, lam, p.subg); else attn_item<false, false, false, false>(it, lam, p.subg); }
  }
}

DI void phase3(const Params& p) {
  pg8::Gemm g; g.A = (const bf16_t*)(p.ws + WS_G); g.Bt = (const bf16_t*)(p.ws + WS_WOUTT); g.M = NTOK; g.N = 1024; g.K = 1024;
  pg8::StaticOrder S; S.init(NTOK, 1024, (int)gridDim.x, (int)blockIdx.x);
  EpiOut E; E.ypre = (bf16_t*)(p.ws + WS_XB); E.xp = p.xp; E.xs = p.xs;
  pg8::gemm_phase<EpiOut, pg8::StaticOrder, false>((PG8_LAS unsigned char*)g_lds_all, g, S, E, nullptr);
  __syncthreads();
}

DI void phase4(const Params& p) {
  const int lane = threadIdx.x & 63, w = threadIdx.x >> 6;
  float4 g[4], bb[4];
#pragma unroll
  for (int j = 0; j < 4; ++j) { g[j] = *(const float4*)(p.ln_g + j * 256 + lane * 4); bb[j] = *(const float4*)(p.ln_b + j * 256 + lane * 4); }
  for (int row0 = (blockIdx.x * 8 + w) * 4; row0 < NTOK; row0 += gridDim.x * 32) {
    float4 v[4][4];
#pragma unroll
    for (int rr = 0; rr < 4; ++rr)
#pragma unroll
      for (int j = 0; j < 4; ++j) { const u32x2 w = __builtin_nontemporal_load((const u32x2*)((const bf16_t*)(p.ws + WS_XB) + (long)(row0 + rr) * 1024 + j * 256 + lane * 4)); v[rr][j] = make_float4(bflo(w.x), bfhi(w.x), bflo(w.y), bfhi(w.y)); }
    float s[4], q[4];
#pragma unroll
    for (int rr = 0; rr < 4; ++rr) { s[rr] = 0.f;
#pragma unroll
      for (int j = 0; j < 4; ++j) s[rr] += v[rr][j].x + v[rr][j].y + v[rr][j].z + v[rr][j].w; }
#pragma unroll
    for (int o = 1; o < 64; o <<= 1)
#pragma unroll
      for (int rr = 0; rr < 4; ++rr) s[rr] += __shfl_xor(s[rr], o);
#pragma unroll
    for (int rr = 0; rr < 4; ++rr) { const float mu = s[rr] * (1.f / 1024.f); s[rr] = mu; q[rr] = 0.f;
#pragma unroll
      for (int j = 0; j < 4; ++j) { const float a = v[rr][j].x - mu, b = v[rr][j].y - mu, c = v[rr][j].z - mu, d = v[rr][j].w - mu; q[rr] += a * a + b * b + c * c + d * d; } }
#pragma unroll
    for (int o = 1; o < 64; o <<= 1)
#pragma unroll
      for (int rr = 0; rr < 4; ++rr) q[rr] += __shfl_xor(q[rr], o);
#pragma unroll
    for (int rr = 0; rr < 4; ++rr) {
      const float mu = s[rr], rs = rsqrtf(q[rr] * (1.f / 1024.f) + 1e-5f);
#pragma unroll
      for (int j = 0; j < 4; ++j) {
        float4 o;
        o.x = (v[rr][j].x - mu) * rs * g[j].x + bb[j].x; o.y = (v[rr][j].y - mu) * rs * g[j].y + bb[j].y;
        o.z = (v[rr][j].z - mu) * rs * g[j].z + bb[j].z; o.w = (v[rr][j].w - mu) * rs * g[j].w + bb[j].w;
        { const pg8::f32x4 ov = {o.x, o.y, o.z, o.w}; __builtin_nontemporal_store(ov, (pg8::f32x4*)(p.out + O_Y + (long)(row0 + rr) * 1024 + j * 256 + lane * 4)); }
      }
    }
  }
}

DI void grid_barrier(unsigned* bar, unsigned target) {
  asm volatile("s_waitcnt vmcnt(0) lgkmcnt(0)" ::: "memory");
  __syncthreads();
  if (threadIdx.x == 0) {
    __builtin_amdgcn_fence(__ATOMIC_RELEASE, "agent");
    asm volatile("s_waitcnt vmcnt(0)" ::: "memory");
    __hip_atomic_fetch_add(bar, 1u, __ATOMIC_RELAXED, __HIP_MEMORY_SCOPE_AGENT);
    while (__hip_atomic_load(bar, __ATOMIC_RELAXED, __HIP_MEMORY_SCOPE_AGENT) < target) __builtin_amdgcn_s_sleep(2);
    __builtin_amdgcn_fence(__ATOMIC_ACQUIRE, "agent");
    asm volatile("s_waitcnt vmcnt(0)" ::: "memory");
  }
  __syncthreads();
}
__global__ void __launch_bounds__(512) fwd_megakernel(Params p) {
  cg::grid_group grid = cg::this_grid();
  unsigned* bar = (unsigned*)(p.ws + WS_CTR + 64);
  const unsigned nb = gridDim.x;
  phase0(p);
  if (p.ws == nullptr) grid.sync();
  grid_barrier(bar, nb);
  phase1(p);
  grid_barrier(bar, 2 * nb);
  phase2(p);
  grid_barrier(bar, 3 * nb);
  phase3(p);
  grid_barrier(bar, 4 * nb);
  phase4(p);
}

extern "C" void kernel_launch(void* const* d_in, const int* in_sizes, int n_in, void* d_out, int out_size,
                              void* d_ws, size_t ws_size, hipStream_t stream) {
  static int grid_blocks = 0;
  if (!grid_blocks) {
    int dev = 0, cus = 0, per_cu = 0;
    (void)hipGetDevice(&dev);
    (void)hipDeviceGetAttribute(&cus, hipDeviceAttributeMultiprocessorCount, dev);
    (void)hipOccupancyMaxActiveBlocksPerMultiprocessor(&per_cu, fwd_megakernel, 512, 0);
    if (per_cu > 1) per_cu = 1;
    if (per_cu < 1) per_cu = 1;
    grid_blocks = cus * per_cu;
    if (ws_size < WS_END || out_size != (int)O_END) fprintf(stderr, "kernel_launch: unexpected sizes ws %zu (need %zu) out %d (need %ld)\n", ws_size, (size_t)WS_END, out_size, (long)O_END);
  }
  (void)hipMemsetAsync((char*)d_ws + WS_CTR, 0, 256, stream);
  Params p{};
  p.xp = (const float*)d_in[0]; p.xs = (const float*)d_in[1];
  p.cak = (const float*)d_in[2]; p.cav = (const float*)d_in[3]; p.cbk = (const float*)d_in[4]; p.cbv = (const float*)d_in[5];
  p.cmk = (const float*)d_in[6]; p.cmv = (const float*)d_in[7];
  p.memp = (const float*)d_in[8]; p.w_in = (const float*)d_in[9]; p.w_mem = (const float*)d_in[10]; p.relb = (const float*)d_in[11];
  p.dlam = (const float*)d_in[12]; p.subg = (const float*)d_in[13]; p.w_out = (const float*)d_in[14]; p.ln_g = (const float*)d_in[15]; p.ln_b = (const float*)d_in[16];
  p.out = (float*)d_out; p.ws = (char*)d_ws;
  void* args[] = {&p};
  hipError_t e = hipLaunchCooperativeKernel((void*)fwd_megakernel, dim3(grid_blocks), dim3(512), args, 0, stream);
  if (e != hipSuccess) fprintf(stderr, "cooperative launch failed: %s (grid %d)\n", hipGetErrorString(e), grid_blocks);
}
```
